# Optimizing an MI355X kernel written in HIP

```python
import math
import jax
import jax.numpy as jnp
from jax import lax
import numpy as np

D_MODEL = 1024
BATCH = 8
SEQ = 4096
DEPTH = 2

CHUNK = 64
Q_BLOCK = 128
EPS = 1e-6
NEG_BIG = -1e30
EXP_CLIP = 60.0

D_MIX = D_MODEL
N_MIXERS = 4
GROUP_W = D_MIX // N_MIXERS

S5_CH = 16
S5_GROUPS = GROUP_W // S5_CH
S5_STATE = 64
S5_DT_MIN = 1e-3
S5_DT_MAX = 1e-1

HG_HEADS = 4
HG_DH = GROUP_W // HG_HEADS

FOX_HEADS = 4
FOX_DH = GROUP_W // FOX_HEADS

ML_HEADS = 4
ML_DH = GROUP_W // ML_HEADS
ML_CONV = 4

D_FF = int(math.ceil(8 * D_MODEL / 3 / 256)) * 256

COL_WIDTHS = (GROUP_W,) * 8 + (FOX_HEADS,) + (GROUP_W,) * 4 + (ML_HEADS, ML_HEADS)
D_IN = sum(COL_WIDTHS)
SPLIT_IDX = tuple(int(c) for c in np.cumsum(COL_WIDTHS)[:-1])

kernel_name = 'hybrid_s5_hgrn2_fox_mlstm_block'

F32 = jnp.float32


def rms_norm(x, gain):
    xf = x.astype(F32)
    y = xf * lax.rsqrt(jnp.mean(xf * xf, axis=-1, keepdims=True) + EPS)
    return (y * gain.astype(F32)).astype(x.dtype)


def headwise_rms_norm(x, gain, head_dim):
    shp = x.shape
    xf = x.astype(F32).reshape(shp[:-1] + (shp[-1] // head_dim, head_dim))
    y = xf * lax.rsqrt(jnp.mean(xf * xf, axis=-1, keepdims=True) + EPS)
    return (y.reshape(shp) * gain.astype(F32)).astype(x.dtype)


def causal_depthwise_conv(x, w):
    k_w, ch = w.shape
    return lax.conv_general_dilated(
        x, w[:, None, :].astype(x.dtype), window_strides=(1,), padding=[(k_w - 1, 0)],
        dimension_numbers=('NWC', 'WIO', 'NWC'), feature_group_count=ch)


def to_chunks(t):
    b, s, h, d = t.shape
    return t.reshape(b, s // CHUNK, CHUNK, h, d).transpose(1, 0, 3, 2, 4)


def from_chunks(t):
    nc, b, h, l, d = t.shape
    return t.transpose(1, 0, 3, 2, 4).reshape(b, nc * l, h, d)


def _complex_affine_combine(e1, e2):
    a1r, a1i, b1r, b1i = e1
    a2r, a2i, b2r, b2i = e2
    return (a2r * a1r - a2i * a1i, a2r * a1i + a2i * a1r,
            a2r * b1r - a2i * b1i + b2r, a2r * b1i + a2i * b1r + b2i)


def s5_mixer(u, lam_re, lam_im, b_re, b_im, c_re, c_im, d_skip, log_dt, w_glu, gain):
    bsz, seq, _ = u.shape
    uf = u.astype(F32)
    ug = uf.reshape(bsz, seq, S5_GROUPS, S5_CH)
    lr = jnp.minimum(lam_re.astype(F32), -1e-4)
    li = lam_im.astype(F32)
    dt = jnp.exp(log_dt.astype(F32))[:, None]
    mag = jnp.exp(lr * dt)
    ab_re = mag * jnp.cos(li * dt)
    ab_im = mag * jnp.sin(li * dt)
    den = lr * lr + li * li
    cf_re = ((ab_re - 1.0) * lr + ab_im * li) / den
    cf_im = (ab_im * lr - (ab_re - 1.0) * li) / den
    bre = b_re.astype(F32)
    bim = b_im.astype(F32)
    bb_re = cf_re[..., None] * bre - cf_im[..., None] * bim
    bb_im = cf_re[..., None] * bim + cf_im[..., None] * bre
    bu_re = jnp.einsum('bsgp,gnp->bsgn', ug, bb_re)
    bu_im = jnp.einsum('bsgp,gnp->bsgn', ug, bb_im)
    a_re = jnp.broadcast_to(ab_re, bu_re.shape)
    a_im = jnp.broadcast_to(ab_im, bu_im.shape)
    _, _, x_re, x_im = lax.associative_scan(
        _complex_affine_combine, (a_re, a_im, bu_re, bu_im), axis=1)
    y = (jnp.einsum('bsgn,gpn->bsgp', x_re, c_re.astype(F32))
         - jnp.einsum('bsgn,gpn->bsgp', x_im, c_im.astype(F32))).reshape(bsz, seq, GROUP_W)
    y = y + d_skip.astype(F32) * uf
    g = jax.nn.gelu(y)
    y = g * jax.nn.sigmoid(g @ w_glu.astype(F32))
    return rms_norm(y, gain).astype(u.dtype)


def _hgrn2_chunk(state, inp):
    q, k, v, lf = inp
    l = q.shape[2]
    b = jnp.cumsum(lf, axis=2)
    o_inter = jnp.einsum('bhtk,bhkv->bhtv', q * jnp.exp(b), state)
    causal = jnp.tril(jnp.ones((l, l), dtype=bool))
    diff = b[:, :, :, None, :] - b[:, :, None, :, :]
    decay = jnp.exp(jnp.where(causal[:, :, None], diff, NEG_BIG))
    scores = jnp.einsum('bhtk,bhsk,bhtsk->bhts', q, k, decay)
    o_intra = jnp.einsum('bhts,bhsv->bhtv', scores, v)
    b_last = b[:, :, -1:, :]
    new_state = (jnp.exp(b_last[:, :, 0, :])[..., None] * state
                 + jnp.einsum('bhsk,bhsv->bhkv', k * jnp.exp(b_last - b), v))
    return new_state, o_inter + o_intra


def hgrn2_mixer(q, fz, i, g, lb, gain):
    bsz, seq, _ = q.shape
    z = fz.astype(F32)
    logf = jax.nn.log_sigmoid(z) + jnp.log1p(lb * jnp.exp(jnp.minimum(-z, EXP_CLIP)))
    k = (1.0 - lb) * jax.nn.sigmoid(-z)

    def heads(t):
        return to_chunks(t.astype(F32).reshape(bsz, seq, HG_HEADS, HG_DH))

    s0 = jnp.zeros((bsz, HG_HEADS, HG_DH, HG_DH), F32)
    _, o = lax.scan(_hgrn2_chunk, s0, (heads(q), heads(k), heads(i), heads(logf)))
    o = from_chunks(o).reshape(bsz, seq, GROUP_W)
    o = headwise_rms_norm(o, gain, HG_DH) * jax.nn.silu(g.astype(F32))
    return o.astype(q.dtype)


def fox_mixer(q, k, v, fz, gain):
    bsz, seq, _ = q.shape

    def heads(t):
        return t.reshape(bsz, seq, FOX_HEADS, FOX_DH).transpose(0, 2, 1, 3)

    qh, kh, vh = heads(q), heads(k), heads(v)
    cum_logf = jnp.cumsum(jax.nn.log_sigmoid(fz.astype(F32)), axis=1).transpose(0, 2, 1)
    n_blk = seq // Q_BLOCK
    q_blocks = qh.reshape(bsz, FOX_HEADS, n_blk, Q_BLOCK, FOX_DH).transpose(2, 0, 1, 3, 4)
    f_blocks = cum_logf.reshape(bsz, FOX_HEADS, n_blk, Q_BLOCK).transpose(2, 0, 1, 3)
    k_pos = jnp.arange(seq)
    scale = FOX_DH ** -0.5

    def attend(args):
        blk, qb, fq = args
        q_pos = blk * Q_BLOCK + jnp.arange(Q_BLOCK)
        s = (jnp.einsum('bhqd,bhkd->bhqk', qb, kh).astype(F32) * scale
             + fq[..., None] - cum_logf[:, :, None, :])
        s = jnp.where(k_pos[None, :] <= q_pos[:, None], s, NEG_BIG)
        p = jax.nn.softmax(s, axis=-1)
        return jnp.einsum('bhqk,bhkd->bhqd', p.astype(vh.dtype), vh)

    out = lax.map(attend, (jnp.arange(n_blk), q_blocks, f_blocks))
    out = out.transpose(1, 0, 3, 2, 4).reshape(bsz, seq, GROUP_W)
    return headwise_rms_norm(out, gain, FOX_DH)


def _mlstm_chunk(carry, inp):
    c_mat, n_vec, m_prev = carry
    q, k, v, ig, lf = inp
    l = q.shape[2]
    b = jnp.cumsum(lf, axis=-1)
    causal = jnp.tril(jnp.ones((l, l), dtype=bool))
    d_log = jnp.where(causal, b[..., :, None] - b[..., None, :] + ig[..., None, :], NEG_BIG)
    inter_log = b + m_prev[..., None]
    m_t = jnp.maximum(inter_log, jnp.max(d_log, axis=-1))
    w_inter = jnp.exp(inter_log - m_t)
    qk = jnp.einsum('bhtd,bhsd->bhts', q, k) * jnp.exp(d_log - m_t[..., None])
    num = (w_inter[..., None] * jnp.einsum('bhtk,bhkv->bhtv', q, c_mat)
           + jnp.einsum('bhts,bhsv->bhtv', qk, v))
    den = w_inter * jnp.einsum('bhtk,bhk->bht', q, n_vec) + jnp.sum(qk, axis=-1)
    h = num / jnp.maximum(jnp.abs(den), jnp.exp(-m_t))[..., None]
    b_last = b[..., -1]
    src_log = b_last[..., None] - b + ig
    m_new = jnp.maximum(b_last + m_prev, jnp.max(src_log, axis=-1))
    w_src = jnp.exp(src_log - m_new[..., None])
    decay = jnp.exp(b_last + m_prev - m_new)
    c_new = decay[..., None, None] * c_mat + jnp.einsum('bhs,bhsk,bhsv->bhkv', w_src, k, v)
    n_new = decay[..., None] * n_vec + jnp.einsum('bhs,bhsk->bhk', w_src, k)
    return (c_new, n_new, m_new), h


def mlstm_mixer(q, k, v, o, ig, fz, conv_w, gain):
    bsz, seq, _ = q.shape
    qk = jax.nn.silu(causal_depthwise_conv(jnp.concatenate([q, k], axis=-1), conv_w))
    q_c, k_c = qk[..., :GROUP_W], qk[..., GROUP_W:]

    def heads(t):
        return to_chunks(t.astype(F32).reshape(bsz, seq, ML_HEADS, ML_DH))

    def gates(t):
        return to_chunks(t.astype(F32)[..., None])[..., 0]

    lf = jax.nn.log_sigmoid(fz.astype(F32))
    init = (jnp.zeros((bsz, ML_HEADS, ML_DH, ML_DH), F32),
            jnp.zeros((bsz, ML_HEADS, ML_DH), F32),
            jnp.zeros((bsz, ML_HEADS), F32))
    _, h = lax.scan(_mlstm_chunk, init,
                    (heads(q_c), heads(k_c * ML_DH ** -0.5), heads(v), gates(ig), gates(lf)))
    h = from_chunks(h).reshape(bsz, seq, GROUP_W)
    h = headwise_rms_norm(h, gain, ML_DH) * jax.nn.sigmoid(o.astype(F32))
    return h.astype(q.dtype)


def setup_inputs(seed: int = 0) -> dict:
    key = jax.random.key(seed)
    ks = jax.random.split(key, 26)

    def nrm(k, shape, scale):
        return scale * jax.random.normal(k, shape, F32)

    x = nrm(ks[0], (BATCH, SEQ, D_MODEL), 1.0)
    w_in = nrm(ks[1], (DEPTH, D_MODEL, D_IN), D_MODEL ** -0.5)
    fox_fb = 2.0 + nrm(ks[2], (DEPTH, FOX_HEADS), 0.1)
    ml_ib = nrm(ks[3], (DEPTH, ML_HEADS), 0.1)
    ml_fb = jnp.linspace(3.0, 6.0, ML_HEADS, dtype=F32)[None, :] + nrm(ks[4], (DEPTH, ML_HEADS), 0.1)
    gate_bias = jnp.concatenate([fox_fb, ml_ib, ml_fb], axis=-1)
    n_idx = jnp.arange(S5_STATE, dtype=F32)
    s5_lambda_re = -0.5 + nrm(ks[5], (DEPTH, S5_GROUPS, S5_STATE), 0.01)
    s5_lambda_im = math.pi * n_idx + nrm(ks[6], (DEPTH, S5_GROUPS, S5_STATE), 0.01)
    s5_b_re = nrm(ks[7], (DEPTH, S5_GROUPS, S5_STATE, S5_CH), (2 * S5_CH) ** -0.5)
    s5_b_im = nrm(ks[8], (DEPTH, S5_GROUPS, S5_STATE, S5_CH), (2 * S5_CH) ** -0.5)
    s5_c_re = nrm(ks[9], (DEPTH, S5_GROUPS, S5_CH, S5_STATE), (2 * S5_STATE) ** -0.5)
    s5_c_im = nrm(ks[10], (DEPTH, S5_GROUPS, S5_CH, S5_STATE), (2 * S5_STATE) ** -0.5)
    s5_d = nrm(ks[11], (DEPTH, GROUP_W), 1.0)
    s5_log_dt = jax.random.uniform(ks[12], (DEPTH, S5_GROUPS), F32,
                                   math.log(S5_DT_MIN), math.log(S5_DT_MAX))
    s5_w_glu = nrm(ks[13], (DEPTH, GROUP_W, GROUP_W), GROUP_W ** -0.5)
    hgrn_lb_logits = nrm(ks[14], (DEPTH, GROUP_W), 0.5)
    mlstm_conv_w = nrm(ks[15], (DEPTH, ML_CONV, 2 * GROUP_W), ML_CONV ** -0.5)
    mix_gain = 1.0 + nrm(ks[16], (DEPTH, D_MIX), 0.02)
    w_out = nrm(ks[17], (DEPTH, D_MIX, D_MODEL), D_MIX ** -0.5)
    ln_mix_pre = 1.0 + nrm(ks[18], (DEPTH, D_MODEL), 0.02)
    ln_mix_post = 1.0 + nrm(ks[19], (DEPTH, D_MODEL), 0.02)
    ln_ffn_pre = 1.0 + nrm(ks[20], (DEPTH, D_MODEL), 0.02)
    ln_ffn_post = 1.0 + nrm(ks[21], (DEPTH, D_MODEL), 0.02)
    w_ffn_gate = nrm(ks[22], (DEPTH, D_MODEL, D_FF), D_MODEL ** -0.5)
    w_ffn_up = nrm(ks[23], (DEPTH, D_MODEL, D_FF), D_MODEL ** -0.5)
    w_ffn_down = nrm(ks[24], (DEPTH, D_FF, D_MODEL), D_FF ** -0.5)
    return {'x': x, 'w_in': w_in, 'gate_bias': gate_bias,
            's5_lambda_re': s5_lambda_re, 's5_lambda_im': s5_lambda_im,
            's5_b_re': s5_b_re, 's5_b_im': s5_b_im, 's5_c_re': s5_c_re, 's5_c_im': s5_c_im,
            's5_d': s5_d, 's5_log_dt': s5_log_dt, 's5_w_glu': s5_w_glu,
            'hgrn_lb_logits': hgrn_lb_logits, 'mlstm_conv_w': mlstm_conv_w,
            'mix_gain': mix_gain, 'w_out': w_out,
            'ln_mix_pre': ln_mix_pre, 'ln_mix_post': ln_mix_post,
            'ln_ffn_pre': ln_ffn_pre, 'ln_ffn_post': ln_ffn_post,
            'w_ffn_gate': w_ffn_gate, 'w_ffn_up': w_ffn_up, 'w_ffn_down': w_ffn_down}


def reference(x, w_in, gate_bias, s5_lambda_re, s5_lambda_im, s5_b_re, s5_b_im, s5_c_re, s5_c_im,
              s5_d, s5_log_dt, s5_w_glu, hgrn_lb_logits, mlstm_conv_w, mix_gain, w_out,
              ln_mix_pre, ln_mix_post, ln_ffn_pre, ln_ffn_post, w_ffn_gate, w_ffn_up, w_ffn_down):
    lb_prob = jax.nn.softmax(hgrn_lb_logits.astype(F32), axis=0)
    lb_all = jnp.maximum(jnp.cumsum(lb_prob, axis=0) - lb_prob[0:1], 0.0)

    h = x
    for l in range(DEPTH):
        a = rms_norm(h, ln_mix_pre[l])
        proj = a @ w_in[l]
        (s5_u, hg_q, hg_f, hg_i, hg_g, fox_q, fox_k, fox_v, fox_f,
         ml_q, ml_k, ml_v, ml_o, ml_i, ml_f) = jnp.split(proj, SPLIT_IDX, axis=-1)
        gb = gate_bias[l]
        gain = mix_gain[l]
        y_a = s5_mixer(s5_u, s5_lambda_re[l], s5_lambda_im[l], s5_b_re[l], s5_b_im[l],
                       s5_c_re[l], s5_c_im[l], s5_d[l], s5_log_dt[l], s5_w_glu[l],
                       gain[0:GROUP_W])
        y_b = hgrn2_mixer(hg_q, hg_f, hg_i, hg_g, lb_all[l], gain[GROUP_W:2 * GROUP_W])
        y_c = fox_mixer(fox_q, fox_k, fox_v, fox_f + gb[0:FOX_HEADS],
                        gain[2 * GROUP_W:3 * GROUP_W])
        y_d = mlstm_mixer(ml_q, ml_k, ml_v, ml_o,
                          ml_i + gb[FOX_HEADS:FOX_HEADS + ML_HEADS],
                          ml_f + gb[FOX_HEADS + ML_HEADS:FOX_HEADS + 2 * ML_HEADS],
                          mlstm_conv_w[l], gain[3 * GROUP_W:4 * GROUP_W])
        mix = jnp.concatenate([y_a, y_b, y_c, y_d], axis=-1) @ w_out[l]
        h = h + rms_norm(mix, ln_mix_post[l])

        a = rms_norm(h, ln_ffn_pre[l])
        ff = (jax.nn.silu(a @ w_ffn_gate[l]) * (a @ w_ffn_up[l])) @ w_ffn_down[l]
        h = h + rms_norm(ff, ln_ffn_post[l])
    return h
```

```cpp
#include <hip/hip_runtime.h>
#include <cstdio>
#include <cstdint>

#ifndef N_LAUNCH_MODE
#define N_LAUNCH_MODE 1
#endif
#ifndef USE_PG8
#define USE_PG8 1
#endif

#define LAS __attribute__((address_space(3)))
#define GAS __attribute__((address_space(1)))
typedef unsigned short bf16_t;
typedef float f32x4 __attribute__((ext_vector_type(4)));
typedef unsigned u32x4 __attribute__((ext_vector_type(4)));
typedef unsigned u32x2 __attribute__((ext_vector_type(2)));
typedef short bf16x8 __attribute__((ext_vector_type(8)));

constexpr int NB = 8, SEQ = 4096, DM = 1024, MTOK = NB * SEQ, DEPTH = 2;
constexpr int DIN = 3084, NIN = 3328, DFF = 2816, NGU = 2 * DFF;
constexpr int CL = 64, NCH = SEQ / CL, NCHT = NB * NCH;
constexpr int PW = 2816;
constexpr int U2LD = 1152;
constexpr int NUNIT = NB * 4 * NCH;
constexpr float EPS = 1e-6f;
constexpr float LOG2E = 1.4426950408889634f;
constexpr int PC_HGQ = 0, PC_HGF = 256, PC_HGI = 512, PC_HGG = 768, PC_FXQ = 1024, PC_FXK = 1280, PC_FXV = 1536, PC_MLQ = 1792, PC_MLK = 2048, PC_MLV = 2304, PC_MLO = 2560;

constexpr size_t MiB = 1u << 20;
constexpr size_t WS_CTL = 0, CTL_BYTES = 1 * MiB;
constexpr size_t WS_WIN = 1 * MiB;
constexpr size_t WS_WOUT = 14 * MiB;
constexpr size_t WS_WGU = 18 * MiB;
constexpr size_t WS_WDN = 40 * MiB;
constexpr size_t WS_WGLU = 51 * MiB;
constexpr size_t WS_KERN = 52 * MiB;
constexpr size_t WS_A64 = 54 * MiB;
constexpr size_t WS_BM = 55 * MiB;
constexpr size_t WS_TT = 71 * MiB;
constexpr size_t WS_CM = 107 * MiB;
constexpr size_t WS_U2 = 115 * MiB;
constexpr size_t WS_GT = 133 * MiB;
constexpr size_t WS_FQ = 135 * MiB;
constexpr size_t WS_FK = 139 * MiB;
constexpr size_t WS_FCUM = 143 * MiB;
constexpr size_t WS_XNY = 144 * MiB;
constexpr size_t WS_PACT = 208 * MiB;
constexpr size_t WS_SCR = 384 * MiB;
constexpr size_t WS_MX = WS_SCR;
constexpr size_t WS_XLOC = WS_SCR;
constexpr size_t WS_G1 = WS_SCR + 4 * MiB;
constexpr size_t WS_HSLOC = WS_SCR + 20 * MiB;
constexpr size_t WS_HDEC = WS_SCR + 52 * MiB;
constexpr size_t WS_MDEC = WS_SCR + 52 * MiB + 512 * 1024;
constexpr size_t WS_HSPREV = WS_SCR + 53 * MiB;
constexpr size_t WS_MSLOC = WS_SCR + 69 * MiB;
constexpr size_t WS_MSPREV = WS_SCR + 102 * MiB;
constexpr size_t WS_END = 512 * MiB;
static_assert(WS_MSPREV + (size_t)NUNIT * 80 * 64 * 2 <= WS_END, "ws map");
static_assert(WS_MSLOC + (size_t)NUNIT * 65 * 64 * 4 <= WS_MSPREV, "ws map");

constexpr int LDS_BYTES = 147456;
constexpr int NTHR = 512;

__device__ __forceinline__ int opaque_v(int x) { asm volatile("" : "+v"(x)); return x; }
__device__ __forceinline__ float bf2f(unsigned b) { return __uint_as_float(b << 16); }
__device__ __forceinline__ unsigned f2bf(float f) { unsigned u = __float_as_uint(f); return (u + 0x7fffu + ((u >> 16) & 1u)) >> 16; }
__device__ __forceinline__ unsigned pk2(float lo, float hi) { return f2bf(lo) | (f2bf(hi) << 16); }
__device__ __forceinline__ float wave_sum(float v) {
#pragma unroll
    for (int o = 1; o < 64; o <<= 1) v += __shfl_xor(v, o);
    return v;
}
__device__ __forceinline__ float sigmoidf_(float x) { return 1.f / (1.f + __expf(-x)); }
__device__ __forceinline__ float log_sigmoidf_(float x) { return fminf(x, 0.f) - log1pf(__expf(-fabsf(x))); }
__device__ __forceinline__ float siluf_(float x) { return x * sigmoidf_(x); }
__device__ __forceinline__ float gelu_tanh(float x) { const float u = 0.7978845608028654f * (x + 0.044715f * x * x * x); return x * (1.f - 1.f / (1.f + __expf(2.f * u))); }
__device__ __forceinline__ void unpack8(const u32x4 w, float (&v)[8]) {
    v[0] = bf2f(w.x & 0xffffu); v[1] = bf2f(w.x >> 16); v[2] = bf2f(w.y & 0xffffu); v[3] = bf2f(w.y >> 16);
    v[4] = bf2f(w.z & 0xffffu); v[5] = bf2f(w.z >> 16); v[6] = bf2f(w.w & 0xffffu); v[7] = bf2f(w.w >> 16);
}
__device__ __forceinline__ u32x4 pack8(const float (&v)[8]) { u32x4 w; w.x = pk2(v[0], v[1]); w.y = pk2(v[2], v[3]); w.z = pk2(v[4], v[5]); w.w = pk2(v[6], v[7]); return w; }

struct Ctx {
    const float* in[23]; float* out; unsigned char* ws;
    unsigned char* lds; LAS unsigned char* lds3; int tid, lane, wave, G, bid;
};
#define WSP(T, off) ((T*)(c.ws + (off)))
enum { I_X = 0, I_WIN, I_GB, I_LRE, I_LIM, I_BRE, I_BIM, I_CRE, I_CIM, I_S5D, I_LOGDT, I_WGLU, I_LB, I_CONV, I_GAIN, I_WOUT, I_LNMPRE, I_LNMPOST, I_LNFPRE, I_LNFPOST, I_WG, I_WU, I_WD };

template <bool PAIR, class TileF, class Epi>
__device__ __forceinline__ void gemm_naive(const Ctx& c, const bf16_t* A, int lda, const bf16_t* Bt, int ldb, int K, TileF tf, const Epi& E) {
    float* As = (float*)c.lds;
    float* Bs = As + 64 * 65;
    float* Bs2 = Bs + 64 * 65;
    const int r = c.tid >> 3, cg = c.tid & 7;
    for (int t = c.bid;; t += c.G) {
        int row0, col0, brow0; if (!tf(t, row0, col0, brow0)) break;
        float acc[8], acc2[8];
#pragma unroll
        for (int i = 0; i < 8; ++i) { acc[i] = 0.f; acc2[i] = 0.f; }
        for (int k0 = 0; k0 < K; k0 += 64) {
            __syncthreads();
            { float v[8]; unpack8(*(const u32x4*)(A + (size_t)(row0 + r) * lda + k0 + cg * 8), v);
#pragma unroll
              for (int i = 0; i < 8; ++i) As[r * 65 + cg * 8 + i] = v[i];
              unpack8(*(const u32x4*)(Bt + (size_t)(brow0 + r) * ldb + k0 + cg * 8), v);
#pragma unroll
              for (int i = 0; i < 8; ++i) Bs[r * 65 + cg * 8 + i] = v[i];
              if (PAIR) { unpack8(*(const u32x4*)(Bt + (size_t)(brow0 + 128 + r) * ldb + k0 + cg * 8), v);
#pragma unroll
                  for (int i = 0; i < 8; ++i) Bs2[r * 65 + cg * 8 + i] = v[i]; } }
            __syncthreads();
            for (int k = 0; k < 64; ++k) {
                const float a = As[r * 65 + k];
#pragma unroll
                for (int i = 0; i < 8; ++i) { acc[i] += a * Bs[(cg * 8 + i) * 65 + k]; if (PAIR) acc2[i] += a * Bs2[(cg * 8 + i) * 65 + k]; }
            }
        }
        E(row0 + r, col0 + cg * 8, acc, acc2);
    }
    __syncthreads();
}

struct EpiInProj {
    bf16_t* U2; bf16_t* P; float* GT; const float* gb;
    __device__ __forceinline__ void operator()(int row, int col, const float (&v)[8], const float (&)[8]) const {
        if (col < 256) { const int g = col >> 4, p0 = col & 15, ch = row >> 6, j = row & 63;
            *(u32x4*)(U2 + ((size_t)(g * NCHT + ch) * U2LD + j * 16 + p0)) = pack8(v); }
        else if (col < 3072) { *(u32x4*)(P + (size_t)row * PW + (col - 256)) = pack8(v); }
        else if (col < 3088) { const int i0 = col - 3072;
#pragma unroll
            for (int i = 0; i < 8; ++i) if (i0 + i < 12) GT[(size_t)row * 16 + i0 + i] = v[i] + gb[i0 + i]; }
    }
};
struct EpiPlainBf16 {
    bf16_t* O; int ld;
    __device__ __forceinline__ void operator()(int row, int col, const float (&v)[8], const float (&)[8]) const { *(u32x4*)(O + (size_t)row * ld + col) = pack8(v); }
};
struct EpiSwiGLU {
    bf16_t* O;
    __device__ __forceinline__ void operator()(int row, int col, const float (&g)[8], const float (&u)[8]) const {
        float v[8];
#pragma unroll
        for (int i = 0; i < 8; ++i) v[i] = siluf_(g[i]) * u[i];
        *(u32x4*)(O + (size_t)row * DFF + col) = pack8(v); }
};
struct EpiXloc {
    float* X;
    __device__ __forceinline__ void operator()(int row, int col, const float (&v)[8], const float (&)[8]) const {
        const int cl = col & 255; if (cl < 128) { float* p = X + (size_t)row * 128 + cl; *(f32x4*)p = (f32x4){v[0], v[1], v[2], v[3]}; *(f32x4*)(p + 4) = (f32x4){v[4], v[5], v[6], v[7]}; } }
};
struct EpiS5Y {
    bf16_t* G1;
    __device__ __forceinline__ void operator()(int row, int col, const float (&v)[8], const float (&)[8]) const {
        const int g = row >> 9, ch = row & 511, cl = col - g * 1024, tau = cl >> 4, p0 = cl & 15; float o[8];
#pragma unroll
        for (int i = 0; i < 8; ++i) o[i] = gelu_tanh(v[i]);
        *(u32x4*)(G1 + ((size_t)(ch * 64 + tau) * 256 + g * 16 + p0)) = pack8(o); }
};


namespace pg8 {
constexpr int BM = 256, BK = 64, HALF = 128, HTB = HALF * BK * 2, STAGE_BYTES = 8 * HTB, NXCD = 8, WGM = 8;
__host__ __device__ __forceinline__ int lds_byte(int r, int c) { const int st = (r >> 4) * 2 + (c >> 5), rr = r & 15, cc = c & 31, ob = rr * 64 + cc * 2; return st * 1024 + (ob ^ (((ob >> 9) & 1) << 5)); }
__host__ __device__ __forceinline__ void stage_rc(int b, int& R, int& C) { const int st = b / 1024, sb = b % 1024, swz = sb ^ (((sb >> 9) & 1) << 5); R = (st >> 1) * 16 + swz / 64; C = (st & 1) * 32 + (swz % 64) / 2; }
__host__ __device__ __forceinline__ int perm32(int rho) { const int n = rho >> 4, i = rho & 15; return 8 * (i >> 2) + 4 * n + (i & 3); }
struct Unit { int pm, pn; };
struct Gemm { const bf16_t* A; const bf16_t* Bt; int lda, ldb, K; size_t astep, bstep; };
struct StaticOrder {
    int nM, nN, nwg, G, c;
    __device__ void init(int M, int N, int G_, int c_) { nM = M / BM; nN = N / BM; nwg = nM * nN; G = G_; c = c_; }
    __device__ bool next(int i, Unit& u) const {
        const long L = (long)i * G + c; if (L >= nwg) return false;
        int wgid = (int)L; { const int q = nwg / NXCD, r = nwg % NXCD, xcd = wgid % NXCD, off = wgid / NXCD; wgid = (xcd < r ? xcd * (q + 1) : r * (q + 1) + (xcd - r) * q) + off; }
        const int nig = WGM * nN, gid = wgid / nig, fm = gid * WGM, gsz = (nM - fm) < WGM ? (nM - fm) : WGM;
        u.pm = fm + ((wgid % nig) % gsz); u.pn = (wgid % nig) / gsz; return true;
    }
};
struct SchedXloc { int G, c; __device__ bool next(int i, Unit& u) const { const int L = i * G + c; if (L >= 32) return false; u.pm = L; u.pn = L >> 1; return true; } };
struct SchedS5Y { int G, c; __device__ bool next(int i, Unit& u) const { const int L = i * G + c; if (L >= 128) return false; const int g = L >> 3; u.pm = g * 2 + ((L >> 2) & 1); u.pn = g * 4 + (L & 3); return true; } };

template <class F, bool PAIR> struct EpiWrap {
    F f;
    __device__ __forceinline__ void operator()(const f32x4 (&acc)[2][2][4][2], const Unit& u, int wr, int wc, int fr, int fq) const {
#pragma unroll
        for (int ai = 0; ai < 2; ++ai)
#pragma unroll
            for (int m = 0; m < 4; ++m) { const int row = u.pm * BM + ai * HALF + wr * 64 + m * 16 + fr;
                if (PAIR) { const int col = u.pn * HALF + wc * 32 + 8 * fq;
                    const float g[8] = {acc[ai][0][m][0][0], acc[ai][0][m][0][1], acc[ai][0][m][0][2], acc[ai][0][m][0][3], acc[ai][0][m][1][0], acc[ai][0][m][1][1], acc[ai][0][m][1][2], acc[ai][0][m][1][3]};
                    const float v[8] = {acc[ai][1][m][0][0], acc[ai][1][m][0][1], acc[ai][1][m][0][2], acc[ai][1][m][0][3], acc[ai][1][m][1][0], acc[ai][1][m][1][1], acc[ai][1][m][1][2], acc[ai][1][m][1][3]};
                    f(row, col, g, v); }
                else {
#pragma unroll
                    for (int bj = 0; bj < 2; ++bj) { const int col = u.pn * BM + bj * HALF + wc * 32 + 8 * fq;
                        const float v[8] = {acc[ai][bj][m][0][0], acc[ai][bj][m][0][1], acc[ai][bj][m][0][2], acc[ai][bj][m][0][3], acc[ai][bj][m][1][0], acc[ai][bj][m][1][1], acc[ai][bj][m][1][2], acc[ai][bj][m][1][3]};
                        f(row, col, v, v); } } }
    }
};

template <class Epi, class Sched, bool ALIGN_EPI>
__device__ __forceinline__ void gemm_phase(LAS unsigned char* lds, const Gemm g, const Sched& S, const Epi& E) {
    const int tid = opaque_v((int)threadIdx.x), wid = __builtin_amdgcn_readfirstlane(tid >> 6), lane = tid & 63, wr = wid >> 2, wc = wid & 3, fr = lane & 15, fq = lane >> 4;
    const int K = g.K, nt = K / BK;
    unsigned voffA[2], voffB[2];
#pragma unroll
    for (int i = 0; i < 2; ++i) { int R, C; stage_rc(tid * 16 + i * 8192, R, C); const int Rb = (R & ~31) + perm32(R & 31);
        voffA[i] = (unsigned)(R * g.lda + C) * 2u; voffB[i] = (unsigned)(Rb * g.ldb + C) * 2u; }
    const size_t kstep = (size_t)(BK * 2);
    const size_t hstepA = (size_t)HALF * g.lda * 2, hstepB = (size_t)HALF * g.ldb * 2;
    const unsigned ldsw = (unsigned)wid * 1024u;
    const int aoff = lds_byte(wr * 64 + fr, fq * 8), boff = lds_byte(wc * 32 + fr, fq * 8);
#define PG8_SA(b, h) (((b) * 2 + (h)) * HTB)
#define PG8_SB(b, h) ((4 + (b) * 2 + (h)) * HTB)
#define PG8_STAGE(bufoff, gbase, voff) do { _Pragma("unroll") for (int _i = 0; _i < 2; ++_i) \
        __builtin_amdgcn_global_load_lds((const unsigned*)((const char*)(gbase) + (voff)[_i]), (LAS unsigned*)(lds + (bufoff) + ldsw + _i * 8192), 16, 0, 0); } while (0)
#define PG8_LDA(dst, b, h) do { _Pragma("unroll") for (int m = 0; m < 4; ++m) _Pragma("unroll") for (int k = 0; k < 2; ++k) dst[m][k] = *(const LAS bf16x8*)(lds + PG8_SA(b, h) + aoff + m * 2048 + k * 1024); } while (0)
#define PG8_LDB(dst, b, h) do { _Pragma("unroll") for (int n = 0; n < 2; ++n) _Pragma("unroll") for (int k = 0; k < 2; ++k) dst[n][k] = *(const LAS bf16x8*)(lds + PG8_SB(b, h) + boff + n * 2048 + k * 1024); } while (0)
#define PG8_MMA(ai, bj, At, Bt) do { __builtin_amdgcn_s_setprio(1); _Pragma("unroll") for (int m = 0; m < 4; ++m) _Pragma("unroll") for (int n = 0; n < 2; ++n) _Pragma("unroll") for (int k = 0; k < 2; ++k) \
        acc[ai][bj][m][n] = __builtin_amdgcn_mfma_f32_16x16x32_bf16(Bt[n][k], At[m][k], acc[ai][bj][m][n], 0, 0, 0); __builtin_amdgcn_s_setprio(0); } while (0)
#define PG8_WAIT_V(n) asm volatile("s_waitcnt vmcnt(" #n ")" ::: "memory")
#define PG8_WAIT_L(n) asm volatile("s_waitcnt lgkmcnt(" #n ")" ::: "memory")
#define PG8_BAR __builtin_amdgcn_s_barrier()
#define PG8_SCHED __builtin_amdgcn_sched_barrier(0)
    Unit cur, nxt; int ui = 0;
    if (!S.next(0, cur)) return;
    f32x4 acc[2][2][4][2];
#pragma unroll
    for (int a = 0; a < 2; ++a)
#pragma unroll
        for (int b = 0; b < 2; ++b)
#pragma unroll
            for (int m = 0; m < 4; ++m)
#pragma unroll
                for (int n = 0; n < 2; ++n) acc[a][b][m][n] = (f32x4){0.f, 0.f, 0.f, 0.f};
    bf16x8 At[4][2], B0[2][2], B1[2][2];
    const char* cA = (const char*)g.A + (size_t)cur.pm * g.astep; const char* cB = (const char*)g.Bt + (size_t)cur.pn * g.bstep;
    PG8_STAGE(PG8_SB(0, 0), cB, voffB); PG8_STAGE(PG8_SB(0, 1), cB + hstepB, voffB); PG8_STAGE(PG8_SA(0, 0), cA, voffA); PG8_STAGE(PG8_SA(0, 1), cA + hstepA, voffA);
    if (wr == 1) PG8_BAR;
    PG8_WAIT_V(2); PG8_BAR;
    PG8_STAGE(PG8_SB(1, 0), cB + kstep, voffB); PG8_STAGE(PG8_SA(1, 0), cA + kstep, voffA); PG8_STAGE(PG8_SB(1, 1), cB + hstepB + kstep, voffB);
    PG8_WAIT_V(6); PG8_BAR;
    for (;;) {
        const bool has_next = S.next(ui + 1, nxt);
        const char* nA = has_next ? (const char*)g.A + (size_t)nxt.pm * g.astep : cA; const char* nB = has_next ? (const char*)g.Bt + (size_t)nxt.pn * g.bstep : cB;
        for (int t = 0; t < nt; t += 2) {
            const bool last = (t == nt - 2);
            const char* a1 = cA + (size_t)(t + 1) * kstep;
            const char* a2 = last ? nA : cA + (size_t)(t + 2) * kstep; const char* b2 = last ? nB : cB + (size_t)(t + 2) * kstep;
            const char* a3 = a2 + kstep; const char* b3 = b2 + kstep;
            PG8_LDB(B0, 0, 0); PG8_LDB(B1, 0, 1); PG8_SCHED; PG8_LDA(At, 0, 0); PG8_STAGE(PG8_SA(1, 1), a1 + hstepA, voffA);
            PG8_WAIT_V(8); PG8_WAIT_L(0); PG8_BAR; PG8_MMA(0, 0, At, B0); PG8_MMA(0, 1, At, B1); PG8_BAR; PG8_SCHED;
            PG8_LDA(At, 0, 1); PG8_STAGE(PG8_SB(0, 0), b2, voffB); PG8_STAGE(PG8_SB(0, 1), b2 + hstepB, voffB); PG8_STAGE(PG8_SA(0, 0), a2, voffA);
            PG8_WAIT_V(8); PG8_WAIT_L(0); PG8_BAR; PG8_MMA(1, 0, At, B0); PG8_MMA(1, 1, At, B1); PG8_BAR; PG8_SCHED;
            PG8_LDB(B0, 1, 0); PG8_LDB(B1, 1, 1); PG8_SCHED; PG8_LDA(At, 1, 0); PG8_STAGE(PG8_SA(0, 1), a2 + hstepA, voffA);
            PG8_WAIT_V(8); PG8_WAIT_L(0); PG8_BAR; PG8_MMA(0, 0, At, B0); PG8_MMA(0, 1, At, B1); PG8_BAR; PG8_SCHED;
            PG8_LDA(At, 1, 1); PG8_STAGE(PG8_SB(1, 0), b3, voffB); PG8_STAGE(PG8_SB(1, 1), b3 + hstepB, voffB); PG8_STAGE(PG8_SA(1, 0), a3, voffA);
            PG8_WAIT_V(8); PG8_WAIT_L(0); PG8_BAR; PG8_MMA(1, 0, At, B0); PG8_MMA(1, 1, At, B1); PG8_BAR; PG8_SCHED;
        }
        if constexpr (ALIGN_EPI) { if (wr == 0) PG8_BAR; }
        E(acc, cur, wr, wc, fr, fq);
        if (!has_next) break;
#pragma unroll
        for (int a = 0; a < 2; ++a)
#pragma unroll
            for (int b = 0; b < 2; ++b)
#pragma unroll
                for (int m = 0; m < 4; ++m)
#pragma unroll
                    for (int n = 0; n < 2; ++n) acc[a][b][m][n] = (f32x4){0.f, 0.f, 0.f, 0.f};
        cur = nxt; cA = nA; cB = nB; ++ui;
        if constexpr (ALIGN_EPI) { if (wr == 1) PG8_BAR; }
    }
    PG8_WAIT_V(0);
    if constexpr (!ALIGN_EPI) { if (wr == 0) PG8_BAR; }
    PG8_BAR;
#undef PG8_SA
#undef PG8_SB
#undef PG8_STAGE
#undef PG8_LDA
#undef PG8_LDB
#undef PG8_MMA
#undef PG8_WAIT_V
#undef PG8_WAIT_L
#undef PG8_BAR
#undef PG8_SCHED
}
}

template <class SrcF>
__device__ __forceinline__ void transpose_item(SrcF src, bf16_t* WT, int ldw, int k0, int n0, float* scr, int lane) {
#pragma unroll 8
    for (int i = 0; i < 32; ++i) { const int kk = 2 * i + (lane >> 5); scr[kk * 33 + (lane & 31)] = src(k0 + kk, n0 + (lane & 31)); }
    __builtin_amdgcn_wave_barrier(); asm volatile("s_waitcnt lgkmcnt(0)" ::: "memory");
    const int cc = lane & 7;
#pragma unroll
    for (int j = 0; j < 4; ++j) { const int n = (lane >> 3) + 8 * j; const float* s = scr + (8 * cc) * 33 + n;
        u32x4 o; o.x = pk2(s[0 * 33], s[1 * 33]); o.y = pk2(s[2 * 33], s[3 * 33]); o.z = pk2(s[4 * 33], s[5 * 33]); o.w = pk2(s[6 * 33], s[7 * 33]);
        *(u32x4*)(WT + (size_t)(n0 + n) * ldw + k0 + 8 * cc) = o; }
    asm volatile("s_waitcnt lgkmcnt(0)" ::: "memory"); __builtin_amdgcn_wave_barrier();
}
__device__ __forceinline__ int win_src_col(int n) {
    if (n < 2048) return n;
    if (n < 3072) return n + 4;
    const int i = n - 3072;
    if (i < 4) return 2048 + i;
    if (i < 8) return 3076 + (i - 4);
    if (i < 12) return 3080 + (i - 8);
    return -1;
}
__device__ __forceinline__ void rms_row_to_bf16(const float* xrow, bf16_t* orow, int lane) {
    const f32x4* xr = (const f32x4*)xrow + lane; f32x4 v[4]; float s = 0.f;
#pragma unroll
    for (int j = 0; j < 4; ++j) { v[j] = xr[64 * j]; s += (v[j].x * v[j].x + v[j].y * v[j].y) + (v[j].z * v[j].z + v[j].w * v[j].w); }
    const float rstd = rsqrtf(wave_sum(s) * (1.f / DM) + EPS);
    u32x2* o8 = (u32x2*)orow + lane;
#pragma unroll
    for (int j = 0; j < 4; ++j) { u32x2 w; w.x = pk2(v[j].x * rstd, v[j].y * rstd); w.y = pk2(v[j].z * rstd, v[j].w * rstd); o8[64 * j] = w; }
}
__device__ __forceinline__ void ph_prologue(const Ctx& c) {
    float* scr = (float*)c.lds + c.wave * 4096;
    const int gw = c.bid * 8 + c.wave, NGW = c.G * 8;
    constexpr int IT_IN = (NIN / 32) * (DM / 64), IT_OUT = (DM / 32) * (DM / 64), IT_GU = (NGU / 32) * (DM / 64), IT_DN = (DM / 32) * (DFF / 64), IT_GLU = (256 / 32) * (256 / 64);
    constexpr int IT_L = IT_IN + IT_OUT + IT_GU + IT_DN + IT_GLU;
    for (int it = gw; it < DEPTH * IT_L; it += NGW) {
        const int l = it / IT_L; int r = it % IT_L;
        if (r < IT_IN) { const int nb = r % (NIN / 32), kb = r / (NIN / 32); const float* W = c.in[I_WIN] + (size_t)l * DM * DIN; const float* ln = c.in[I_LNMPRE] + l * DM;
            transpose_item([=](int k, int n) -> float { const int sc = win_src_col(n); if (sc < 0) return 0.f; float v = W[(size_t)k * DIN + sc] * ln[k]; if (n >= 1280 && n < 1536) v *= 0.125f * LOG2E; return v; },
                           WSP(bf16_t, WS_WIN) + (size_t)l * NIN * DM, DM, kb * 64, nb * 32, scr, c.lane); continue; }
        r -= IT_IN;
        if (r < IT_OUT) { const int nb = r % (DM / 32), kb = r / (DM / 32); const float* W = c.in[I_WOUT] + (size_t)l * DM * DM; const float* gn = c.in[I_GAIN] + l * DM;
            transpose_item([=](int k, int n) -> float { return W[(size_t)k * DM + n] * gn[k]; }, WSP(bf16_t, WS_WOUT) + (size_t)l * DM * DM, DM, kb * 64, nb * 32, scr, c.lane); continue; }
        r -= IT_OUT;
        if (r < IT_GU) { const int nb = r % (NGU / 32), kb = r / (NGU / 32); const float* Wg = c.in[I_WG] + (size_t)l * DM * DFF; const float* Wu = c.in[I_WU] + (size_t)l * DM * DFF; const float* ln = c.in[I_LNFPRE] + l * DM;
            transpose_item([=](int k, int n) -> float { const int tile = n >> 8, hf = (n >> 7) & 1, j = tile * 128 + (n & 127); return (hf ? Wu : Wg)[(size_t)k * DFF + j] * ln[k]; },
                           WSP(bf16_t, WS_WGU) + (size_t)l * NGU * DM, DM, kb * 64, nb * 32, scr, c.lane); continue; }
        r -= IT_GU;
        if (r < IT_DN) { const int nb = r % (DM / 32), kb = r / (DM / 32); const float* W = c.in[I_WD] + (size_t)l * DFF * DM;
            transpose_item([=](int k, int n) -> float { return W[(size_t)k * DM + n]; }, WSP(bf16_t, WS_WDN) + (size_t)l * DM * DFF, DFF, kb * 64, nb * 32, scr, c.lane); continue; }
        r -= IT_DN;
        { const int nb = r % 8, kb = r / 8; const float* W = c.in[I_WGLU] + (size_t)l * 256 * 256;
            transpose_item([=](int k, int n) -> float { return W[(size_t)k * 256 + n]; }, WSP(bf16_t, WS_WGLU) + (size_t)l * 256 * 256, 256, kb * 64, nb * 32, scr, c.lane); }
    }
    for (int m = gw; m < MTOK; m += NGW) rms_row_to_bf16(c.in[I_X] + (size_t)m * DM, WSP(bf16_t, WS_XNY) + (size_t)m * DM, c.lane);
    __syncthreads();
    float* sh = (float*)c.lds;
    for (int it = c.bid; it < DEPTH * 16 * 65; it += c.G) {
        const int l = it / (16 * 65), g = (it / 65) % 16, d = it % 65;
        if (c.tid < 64) { const int n = c.tid;
            const double lr = (double)fminf(c.in[I_LRE][(l * 16 + g) * 64 + n], -1e-4f), li = (double)c.in[I_LIM][(l * 16 + g) * 64 + n], dt = exp((double)c.in[I_LOGDT][l * 16 + g]);
            const double mag1 = exp(lr * dt), abr = mag1 * cos(li * dt), abi = mag1 * sin(li * dt), den = lr * lr + li * li;
            const double cfr = ((abr - 1.0) * lr + abi * li) / den, cfi = (abi * lr - (abr - 1.0) * li) / den;
            const double magd = exp(lr * dt * d), wr = magd * cos(li * dt * d), wi = magd * sin(li * dt * d);
            sh[n] = (float)wr; sh[64 + n] = (float)wi; sh[128 + n] = (float)(wr * cfr - wi * cfi); sh[192 + n] = (float)(wr * cfi + wi * cfr);
            if (d == 64) { float* a64 = WSP(float, WS_A64) + ((size_t)(l * 16 + g) * 64 + n) * 2; a64[0] = (float)wr; a64[1] = (float)wi; } }
        __syncthreads();
        const float* cre = c.in[I_CRE] + (size_t)(l * 16 + g) * 16 * 64; const float* cim = c.in[I_CIM] + (size_t)(l * 16 + g) * 16 * 64;
        const float* bre = c.in[I_BRE] + (size_t)(l * 16 + g) * 64 * 16; const float* bim = c.in[I_BIM] + (size_t)(l * 16 + g) * 64 * 16;
        if (d < 64 && c.tid < 256) { const int p = c.tid >> 4, pp = c.tid & 15; float s = 0.f;
            for (int n = 0; n < 64; ++n) { const float wcr = sh[128 + n], wci = sh[192 + n], br = bre[n * 16 + pp], bi = bim[n * 16 + pp];
                const float xr = wcr * br - wci * bi, xi = wcr * bi + wci * br; s += cre[p * 64 + n] * xr - cim[p * 64 + n] * xi; }
            if (d == 0 && p == pp) s += c.in[I_S5D][l * 256 + g * 16 + p];
            WSP(float, WS_KERN)[(((size_t)(l * 16 + g) * 64 + d) * 16 + p) * 16 + pp] = s; }
        if (d < 64) { const int j = 63 - d; bf16_t* bm = WSP(bf16_t, WS_BM) + (size_t)(l * 16 + g) * 128 * 1024;
#pragma unroll
            for (int e = 0; e < 4; ++e) { const int idx = c.tid * 4 + e, row = idx >> 4, pp = idx & 15, n = row >> 1, ri = row & 1;
                const float wcr = sh[128 + n], wci = sh[192 + n], br = bre[n * 16 + pp], bi = bim[n * 16 + pp];
                const float val = ri ? (wcr * bi + wci * br) : (wcr * br - wci * bi);
                bm[(size_t)row * 1024 + j * 16 + pp] = (bf16_t)f2bf(val); } }
        if (d >= 1) { const int tau = d - 1; bf16_t* cm = WSP(bf16_t, WS_CM) + (size_t)(l * 16 + g) * 1024 * 128;
#pragma unroll
            for (int e = 0; e < 4; ++e) { const int idx = c.tid * 4 + e, p = idx >> 7, q = idx & 127, n = q >> 1, ri = q & 1;
                const float wr = sh[n], wi = sh[64 + n], cr = cre[p * 64 + n], ci = cim[p * 64 + n];
                const float val = ri ? -(cr * wi + ci * wr) : (cr * wr - ci * wi);
                cm[(size_t)(tau * 16 + p) * 128 + q] = (bf16_t)f2bf(val); } }
        __syncthreads();
    }
}

__device__ __forceinline__ void ph_B_texpand(const Ctx& c, int l) {
    bf16_t* TT = WSP(bf16_t, WS_TT);
    const float* KERN = WSP(float, WS_KERN) + (size_t)l * 16 * 64 * 256;
    const bf16_t* CM = WSP(bf16_t, WS_CM) + (size_t)l * 16 * 1024 * 128;
    for (int it = c.bid; it < 16 * 64; it += c.G) {
        const int g = it >> 6, tau = it & 63;
        for (int e = c.tid; e < 16 * (U2LD / 8); e += NTHR) {
            const int p = e / (U2LD / 8), c8 = (e % (U2LD / 8)) * 8; u32x4 w;
            if (c8 < 1024) { const int j = c8 >> 4, pp0 = c8 & 15;
                if (j <= tau) { const float* k = KERN + (((size_t)g * 64 + (tau - j)) * 16 + p) * 16 + pp0; w.x = pk2(k[0], k[1]); w.y = pk2(k[2], k[3]); w.z = pk2(k[4], k[5]); w.w = pk2(k[6], k[7]); }
                else w = (u32x4){0u, 0u, 0u, 0u}; }
            else w = *(const u32x4*)(CM + ((size_t)(g * 1024 + tau * 16 + p)) * 128 + (c8 - 1024));
            *(u32x4*)(TT + ((size_t)(g * 1024 + tau * 16 + p)) * U2LD + c8) = w; }
    }
}
__device__ __forceinline__ void split3(float F, unsigned& hi, unsigned& mid, unsigned& lo) { hi = f2bf(F); float r = F - bf2f(hi); mid = f2bf(r); r -= bf2f(mid); lo = f2bf(r); }
__device__ __forceinline__ void ph_B_gatescan(const Ctx& c) {
    float* sh = (float*)c.lds;
    const float* GT = WSP(float, WS_GT);
    for (int it = c.bid; it < NB * 4; it += c.G) {
        const int b = it >> 2, h = it & 3; const size_t m0 = (size_t)b * SEQ + c.tid * 8;
        float ls[8]; float run = 0.f;
#pragma unroll
        for (int i = 0; i < 8; ++i) { run += log_sigmoidf_(GT[(m0 + i) * 16 + h]); ls[i] = run; }
        __syncthreads(); sh[c.tid] = run; __syncthreads();
        if (c.tid == 0) { float a = 0.f; for (int i = 0; i < NTHR; ++i) { const float t = sh[i]; sh[i] = a; a += t; } }
        __syncthreads();
        const float off = sh[c.tid];
#pragma unroll
        for (int i = 0; i < 8; ++i) { const float F = (off + ls[i]) * LOG2E; const size_t m = m0 + i;
            WSP(float, WS_FCUM)[m * 4 + h] = F;
            unsigned hi, mid, lo; split3(F, hi, mid, lo); const unsigned one = 0x3f80u;
            u32x4 q0, q1 = (u32x4){0u, 0u, 0u, 0u}, k0;
            q0.x = hi | (mid << 16); q0.y = lo | (one << 16); q0.z = one | (one << 16); q0.w = 0u;
            k0.x = one | (one << 16); k0.y = one | ((hi ^ 0x8000u) << 16); k0.z = (mid ^ 0x8000u) | ((lo ^ 0x8000u) << 16); k0.w = 0u;
            u32x4* fq = (u32x4*)(WSP(bf16_t, WS_FQ) + (m * 4 + h) * 16); fq[0] = q0; fq[1] = q1;
            u32x4* fk = (u32x4*)(WSP(bf16_t, WS_FK) + (m * 4 + h) * 16); fk[0] = k0; fk[1] = q1; }
        __syncthreads();
    }
}
__device__ __forceinline__ void hg_gate(float z, float lb, float& logf, float& kk) {
    logf = log_sigmoidf_(z) + log1pf(lb * __expf(fminf(-z, 60.f)));
    kk = (1.f - lb) * sigmoidf_(-z);
}
__device__ __forceinline__ float hg_lb(const Ctx& c, int l, int ch) {
    if (l == 0) return 0.f;
    const float a = c.in[I_LB][ch], b = c.in[I_LB][256 + ch]; return fmaxf(1.f / (1.f + __expf(a - b)), 0.f);
}
__device__ __forceinline__ void ph_B_hgrn_local_naive(const Ctx& c, int l) {
    float* lg = (float*)c.lds; float* kk = lg + 4096; float* vv = kk + 4096;
    const bf16_t* P = WSP(bf16_t, WS_PACT);
    const int t = c.tid >> 3, c0 = (c.tid & 7) * 8;
    for (int u = c.bid; u < NUNIT; u += c.G) {
        const int bh = u >> 6, ch = u & 63, b = bh >> 2, h = bh & 3; const size_t m = (size_t)b * SEQ + ch * 64 + t;
        { float z[8], v[8]; unpack8(*(const u32x4*)(P + m * PW + PC_HGF + h * 64 + c0), z); unpack8(*(const u32x4*)(P + m * PW + PC_HGI + h * 64 + c0), v);
#pragma unroll
          for (int i = 0; i < 8; ++i) { float lf, k; hg_gate(z[i], hg_lb(c, l, h * 64 + c0 + i), lf, k); lg[t * 64 + c0 + i] = lf; kk[t * 64 + c0 + i] = k; vv[t * 64 + c0 + i] = v[i]; } }
        __syncthreads();
        if (c.tid < 64) { float a = 0.f; for (int s = 0; s < 64; ++s) { a += lg[s * 64 + c.tid]; lg[s * 64 + c.tid] = a; } }
        __syncthreads();
#pragma unroll
        for (int i = 0; i < 8; ++i) kk[t * 64 + c0 + i] *= __expf(lg[63 * 64 + c0 + i] - lg[t * 64 + c0 + i]);
        __syncthreads();
        { const int vd = t; float acc[8];
#pragma unroll
          for (int i = 0; i < 8; ++i) acc[i] = 0.f;
          for (int s = 0; s < 64; ++s) { const float v = vv[s * 64 + vd];
#pragma unroll
              for (int i = 0; i < 8; ++i) acc[i] += v * kk[s * 64 + c0 + i]; }
          float* o = WSP(float, WS_HSLOC) + ((size_t)u * 64 + vd) * 64 + c0; *(f32x4*)o = (f32x4){acc[0], acc[1], acc[2], acc[3]}; *(f32x4*)(o + 4) = (f32x4){acc[4], acc[5], acc[6], acc[7]}; }
        if (c.tid < 64) WSP(float, WS_HDEC)[(size_t)u * 64 + c.tid] = __expf(lg[63 * 64 + c.tid]);
        __syncthreads();
    }
}
__device__ __forceinline__ void ml_conv8(const Ctx& c, int l, const bf16_t* P, size_t m, int spos, int pcol, int wch, float (&o)[8]) {
    const float* cw = c.in[I_CONV] + (size_t)l * 4 * 512;
#pragma unroll
    for (int i = 0; i < 8; ++i) o[i] = 0.f;
#pragma unroll
    for (int j = 0; j < 4; ++j) { const int dt = 3 - j; if (spos - dt >= 0) { float x[8]; unpack8(*(const u32x4*)(P + (m - dt) * PW + pcol), x);
#pragma unroll
            for (int i = 0; i < 8; ++i) o[i] += cw[j * 512 + wch + i] * x[i]; } }
#pragma unroll
    for (int i = 0; i < 8; ++i) o[i] = siluf_(o[i]);
}
__device__ __forceinline__ void ph_B_mlstm_local_naive(const Ctx& c, int l) {
    float* kh = (float*)c.lds; float* vv = kh + 4096; float* bb = vv + 4096; float* ig = bb + 64;
    const bf16_t* P = WSP(bf16_t, WS_PACT); const float* GT = WSP(float, WS_GT);
    const int t = c.tid >> 3, c0 = (c.tid & 7) * 8;
    for (int u = c.bid; u < NUNIT; u += c.G) {
        const int bh = u >> 6, ch = u & 63, b = bh >> 2, h = bh & 3; const size_t m = (size_t)b * SEQ + ch * 64 + t;
        if (c.tid < 64) { const size_t mm = (size_t)b * SEQ + ch * 64 + c.tid; bb[c.tid] = log_sigmoidf_(GT[mm * 16 + 8 + h]); ig[c.tid] = GT[mm * 16 + 4 + h]; }
        __syncthreads();
        if (c.tid == 0) { float a = 0.f; for (int s = 0; s < 64; ++s) { a += bb[s]; bb[s] = a; } }
        __syncthreads();
        { float k[8], v[8]; ml_conv8(c, l, P, m, ch * 64 + t, PC_MLK + h * 64 + c0, 256 + h * 64 + c0, k); unpack8(*(const u32x4*)(P + m * PW + PC_MLV + h * 64 + c0), v);
          const float w = 0.125f * __expf(bb[63] - bb[t] + ig[t]);
#pragma unroll
          for (int i = 0; i < 8; ++i) { kh[t * 64 + c0 + i] = k[i] * w; vv[t * 64 + c0 + i] = v[i]; } }
        __syncthreads();
        for (int vd = t; vd < 65; vd += 64) { float acc[8];
#pragma unroll
            for (int i = 0; i < 8; ++i) acc[i] = 0.f;
            for (int s = 0; s < 64; ++s) { const float v = (vd < 64) ? vv[s * 64 + vd] : 1.f;
#pragma unroll
                for (int i = 0; i < 8; ++i) acc[i] += v * kh[s * 64 + c0 + i]; }
            float* o = WSP(float, WS_MSLOC) + ((size_t)u * 65 + vd) * 64 + c0; *(f32x4*)o = (f32x4){acc[0], acc[1], acc[2], acc[3]}; *(f32x4*)(o + 4) = (f32x4){acc[4], acc[5], acc[6], acc[7]}; }
        if (c.tid == 0) WSP(float, WS_MDEC)[u] = __expf(bb[63]);
        __syncthreads();
    }
}

__device__ __forceinline__ void ph_C_scans(const Ctx& c, int l) {
    const int gt = c.bid * NTHR + c.tid, NGT = c.G * NTHR;
    { const float* XL = WSP(float, WS_XLOC); bf16_t* U2 = WSP(bf16_t, WS_U2); const float* A64 = WSP(float, WS_A64) + (size_t)l * 16 * 64 * 2;
      for (int i = gt; i < 16 * NB * 64; i += NGT) { const int n = i & 63, b = (i >> 6) & 7, g = i >> 9; const float ar = A64[(g * 64 + n) * 2], ai = A64[(g * 64 + n) * 2 + 1]; float xr = 0.f, xi = 0.f;
          for (int ch = 0; ch < NCH; ++ch) { const size_t row = (size_t)g * NCHT + b * NCH + ch;
              *(unsigned*)(U2 + row * U2LD + 1024 + 2 * n) = pk2(xr, xi);
              const float lr = XL[row * 128 + 2 * n], li = XL[row * 128 + 2 * n + 1]; const float nr = ar * xr - ai * xi + lr, ni = ar * xi + ai * xr + li; xr = nr; xi = ni; } } }
    { const float* SL = WSP(float, WS_HSLOC); const float* DC = WSP(float, WS_HDEC); bf16_t* SP = WSP(bf16_t, WS_HSPREV);
      for (int i = gt; i < 32 * 64 * 32; i += NGT) { const int k2 = (i & 31) * 2, vd = (i >> 5) & 63, bh = i >> 11; float s0 = 0.f, s1 = 0.f;
          for (int ch = 0; ch < NCH; ++ch) { const size_t u = (size_t)bh * 64 + ch, o = (u * 64 + vd) * 64 + k2;
              *(unsigned*)(SP + o) = pk2(s0, s1);
              s0 = DC[u * 64 + k2] * s0 + SL[o]; s1 = DC[u * 64 + k2 + 1] * s1 + SL[o + 1]; } } }
    { const float* SL = WSP(float, WS_MSLOC); const float* DC = WSP(float, WS_MDEC); bf16_t* SP = WSP(bf16_t, WS_MSPREV);
      for (int i = gt; i < 32 * 65 * 32; i += NGT) { const int k2 = (i & 31) * 2, vd = (i >> 5) % 65, bh = (i >> 5) / 65; float s0 = 0.f, s1 = 0.f;
          for (int ch = 0; ch < NCH; ++ch) { const size_t u = (size_t)bh * 64 + ch;
              *(unsigned*)(SP + (u * 80 + vd) * 64 + k2) = pk2(s0, s1);
              const float d = DC[u]; const size_t o = (u * 65 + vd) * 64 + k2; s0 = d * s0 + SL[o]; s1 = d * s1 + SL[o + 1]; } } }
}
__device__ __forceinline__ void ph_C_fox_naive(const Ctx& c) {
    const bf16_t* P = WSP(bf16_t, WS_PACT); const float* FC = WSP(float, WS_FCUM); bf16_t* Y = WSP(bf16_t, WS_XNY);
    const int gw = c.bid * 8 + c.wave, NGW = c.G * 8;
    for (int r = gw; r < NB * 4 * SEQ; r += NGW) {
        const int q = r % SEQ, bh = r / SEQ, b = bh >> 2, h = bh & 3; const size_t m0 = (size_t)b * SEQ, mq = m0 + q;
        const float qv = bf2f(P[mq * PW + PC_FXQ + h * 64 + c.lane]); const float Fq = FC[mq * 4 + h];
        float mx = -INFINITY, lsum = 0.f, acc = 0.f;
        for (int kv = 0; kv <= q; ++kv) { const size_t mk = m0 + kv;
            const float s = wave_sum(qv * bf2f(P[mk * PW + PC_FXK + h * 64 + c.lane])) + (Fq - FC[mk * 4 + h]);
            const float mn = fmaxf(mx, s), al = exp2f(mx - mn), p = exp2f(s - mn);
            lsum = lsum * al + p; acc = acc * al + p * bf2f(P[mk * PW + PC_FXV + h * 64 + c.lane]); mx = mn; }
        const float o = acc / lsum; const float rstd = rsqrtf(wave_sum(o * o) * (1.f / 64.f) + EPS);
        Y[mq * DM + 512 + h * 64 + c.lane] = (bf16_t)f2bf(o * rstd);
    }
}

__device__ __forceinline__ void ph_D_hgrn_out_naive(const Ctx& c, int l) {
    float* qq = (float*)c.lds; float* kk = qq + 4096; float* bc = kk + 4096; float* vv = bc + 4096; float* sp = vv + 4096; float* sc = sp + 4096;
    const bf16_t* P = WSP(bf16_t, WS_PACT); const bf16_t* SP = WSP(bf16_t, WS_HSPREV); bf16_t* Y = WSP(bf16_t, WS_XNY);
    const int t = c.tid >> 3, c0 = (c.tid & 7) * 8;
    for (int u = c.bid; u < NUNIT; u += c.G) {
        const int bh = u >> 6, ch = u & 63, b = bh >> 2, h = bh & 3; const size_t m = (size_t)b * SEQ + ch * 64 + t;
        { float z[8], v[8], q[8], s[8]; unpack8(*(const u32x4*)(P + m * PW + PC_HGF + h * 64 + c0), z); unpack8(*(const u32x4*)(P + m * PW + PC_HGI + h * 64 + c0), v);
          unpack8(*(const u32x4*)(P + m * PW + PC_HGQ + h * 64 + c0), q); unpack8(*(const u32x4*)(SP + ((size_t)u * 64 + t) * 64 + c0), s);
#pragma unroll
          for (int i = 0; i < 8; ++i) { float lf, k; hg_gate(z[i], hg_lb(c, l, h * 64 + c0 + i), lf, k); bc[t * 64 + c0 + i] = lf; kk[t * 64 + c0 + i] = k; vv[t * 64 + c0 + i] = v[i]; qq[t * 64 + c0 + i] = q[i];
              sp[(c0 + i) * 64 + t] = s[i]; } }
        __syncthreads();
        if (c.tid < 64) { float a = 0.f; for (int s = 0; s < 64; ++s) { a += bc[s * 64 + c.tid]; bc[s * 64 + c.tid] = a; } }
        __syncthreads();
#pragma unroll
        for (int i = 0; i < 8; ++i) { const int s = c0 + i; float a = 0.f;
            if (s <= t) for (int kd = 0; kd < 64; ++kd) a += qq[t * 64 + kd] * kk[s * 64 + kd] * __expf(bc[t * 64 + kd] - bc[s * 64 + kd]);
            sc[t * 65 + s] = a; }
        __syncthreads();
        float o[8];
#pragma unroll
        for (int i = 0; i < 8; ++i) o[i] = 0.f;
        for (int s = 0; s <= t; ++s) { const float w = sc[t * 65 + s];
#pragma unroll
            for (int i = 0; i < 8; ++i) o[i] += w * vv[s * 64 + c0 + i]; }
        for (int kd = 0; kd < 64; ++kd) { const float w = qq[t * 64 + kd] * __expf(bc[t * 64 + kd]);
#pragma unroll
            for (int i = 0; i < 8; ++i) o[i] += w * sp[kd * 64 + c0 + i]; }
        float ss = 0.f;
#pragma unroll
        for (int i = 0; i < 8; ++i) ss += o[i] * o[i];
        ss += __shfl_xor(ss, 1); ss += __shfl_xor(ss, 2); ss += __shfl_xor(ss, 4);
        const float rstd = rsqrtf(ss * (1.f / 64.f) + EPS);
        float g[8]; unpack8(*(const u32x4*)(P + m * PW + PC_HGG + h * 64 + c0), g);
#pragma unroll
        for (int i = 0; i < 8; ++i) o[i] = o[i] * rstd * siluf_(g[i]);
        *(u32x4*)(Y + m * DM + 256 + h * 64 + c0) = pack8(o);
        __syncthreads();
    }
}
__device__ __forceinline__ void ph_D_mlstm_out_naive(const Ctx& c, int l) {
    float* qq = (float*)c.lds; float* kk = qq + 4096; float* vv = kk + 4096; float* cp = vv + 4096; float* sc = cp + 4096; float* np = sc + 64 * 65; float* bb = np + 64; float* ig = bb + 64;
    const bf16_t* P = WSP(bf16_t, WS_PACT); const bf16_t* SP = WSP(bf16_t, WS_MSPREV); const float* GT = WSP(float, WS_GT); bf16_t* Y = WSP(bf16_t, WS_XNY);
    const int t = c.tid >> 3, c0 = (c.tid & 7) * 8;
    for (int u = c.bid; u < NUNIT; u += c.G) {
        const int bh = u >> 6, ch = u & 63, b = bh >> 2, h = bh & 3; const size_t m = (size_t)b * SEQ + ch * 64 + t;
        if (c.tid < 64) { const size_t mm = (size_t)b * SEQ + ch * 64 + c.tid; bb[c.tid] = log_sigmoidf_(GT[mm * 16 + 8 + h]); ig[c.tid] = GT[mm * 16 + 4 + h]; np[c.tid] = bf2f(SP[((size_t)u * 80 + 64) * 64 + c.tid]); }
        { float q[8], k[8], v[8], s[8]; ml_conv8(c, l, P, m, ch * 64 + t, PC_MLQ + h * 64 + c0, h * 64 + c0, q); ml_conv8(c, l, P, m, ch * 64 + t, PC_MLK + h * 64 + c0, 256 + h * 64 + c0, k);
          unpack8(*(const u32x4*)(P + m * PW + PC_MLV + h * 64 + c0), v); unpack8(*(const u32x4*)(SP + ((size_t)u * 80 + t) * 64 + c0), s);
#pragma unroll
          for (int i = 0; i < 8; ++i) { qq[t * 64 + c0 + i] = q[i]; kk[t * 64 + c0 + i] = k[i] * 0.125f; vv[t * 64 + c0 + i] = v[i]; cp[(c0 + i) * 64 + t] = s[i]; } }
        __syncthreads();
        if (c.tid == 0) { float a = 0.f; for (int s = 0; s < 64; ++s) { a += bb[s]; bb[s] = a; } }
        __syncthreads();
#pragma unroll
        for (int i = 0; i < 8; ++i) { const int s = c0 + i; float a = 0.f;
            if (s <= t) { for (int kd = 0; kd < 64; ++kd) a += qq[t * 64 + kd] * kk[s * 64 + kd]; a *= __expf(bb[t] - bb[s] + ig[s]); }
            sc[t * 65 + s] = a; }
        __syncthreads();
        float o[8]; float den = 0.f;
#pragma unroll
        for (int i = 0; i < 8; ++i) o[i] = 0.f;
        for (int s = 0; s <= t; ++s) { const float w = sc[t * 65 + s]; den += w;
#pragma unroll
            for (int i = 0; i < 8; ++i) o[i] += w * vv[s * 64 + c0 + i]; }
        const float eb = __expf(bb[t]);
        for (int kd = 0; kd < 64; ++kd) { const float w = qq[t * 64 + kd] * eb; den += w * np[kd];
#pragma unroll
            for (int i = 0; i < 8; ++i) o[i] += w * cp[kd * 64 + c0 + i]; }
        const float inv = 1.f / fmaxf(fabsf(den), 1.f);
        float ss = 0.f;
#pragma unroll
        for (int i = 0; i < 8; ++i) { o[i] *= inv; ss += o[i] * o[i]; }
        ss += __shfl_xor(ss, 1); ss += __shfl_xor(ss, 2); ss += __shfl_xor(ss, 4);
        const float rstd = rsqrtf(ss * (1.f / 64.f) + EPS);
        float g[8]; unpack8(*(const u32x4*)(P + m * PW + PC_MLO + h * 64 + c0), g);
#pragma unroll
        for (int i = 0; i < 8; ++i) o[i] = o[i] * rstd * sigmoidf_(g[i]);
        *(u32x4*)(Y + m * DM + 768 + h * 64 + c0) = pack8(o);
        __syncthreads();
    }
}

__device__ __forceinline__ void ph_E_glu_naive(const Ctx& c, int l) {
    float* g1 = (float*)c.lds;
    bf16_t* wl = (bf16_t*)(g1 + 64 * 256);
    const bf16_t* G1 = WSP(bf16_t, WS_G1); const bf16_t* WT = WSP(bf16_t, WS_WGLU) + (size_t)l * 256 * 256; bf16_t* Y = WSP(bf16_t, WS_XNY);
    const int t = c.tid >> 3, j8 = c.tid & 7;
    for (int u = c.bid; u < MTOK / 64; u += c.G) {
        const size_t m0 = (size_t)u * 64;
        for (int e = c.tid; e < 64 * 32; e += NTHR) { const int r = e >> 5, c8 = (e & 31) * 8; float v[8]; unpack8(*(const u32x4*)(G1 + (m0 + r) * 256 + c8), v);
#pragma unroll
            for (int i = 0; i < 8; ++i) g1[r * 256 + c8 + i] = v[i]; }
        float yv[32]; float ss = 0.f;
#pragma unroll
        for (int hf = 0; hf < 2; ++hf) {
            __syncthreads();
            for (int e = c.tid; e < 128 * 32; e += NTHR) { const int r = e >> 5, c8 = (e & 31) * 8; *(u32x4*)(wl + r * 264 + c8) = *(const u32x4*)(WT + (size_t)(hf * 128 + r) * 256 + c8); }
            __syncthreads();
#pragma unroll
            for (int i = 0; i < 16; ++i) { const int nl = j8 * 16 + i; float a = 0.f;
                for (int k = 0; k < 256; k += 2) { const unsigned w = *(const unsigned*)(wl + nl * 264 + k); a += g1[t * 256 + k] * bf2f(w & 0xffffu) + g1[t * 256 + k + 1] * bf2f(w >> 16); }
                const float g = g1[t * 256 + hf * 128 + nl]; const float y = g * sigmoidf_(a); yv[hf * 16 + i] = y; ss += y * y; }
        }
        ss += __shfl_xor(ss, 1); ss += __shfl_xor(ss, 2); ss += __shfl_xor(ss, 4);
        const float rstd = rsqrtf(ss * (1.f / 256.f) + EPS);
#pragma unroll
        for (int hf = 0; hf < 2; ++hf)
#pragma unroll
            for (int i8 = 0; i8 < 2; ++i8) { float o[8];
#pragma unroll
                for (int i = 0; i < 8; ++i) o[i] = yv[hf * 16 + i8 * 8 + i] * rstd;
                *(u32x4*)(Y + (m0 + t) * DM + hf * 128 + j8 * 16 + i8 * 8) = pack8(o); }
        __syncthreads();
    }
}

__device__ __forceinline__ void ph_rowpass(const Ctx& c, const float* hprev, const float* gpost, float* hout, bf16_t* xn) {
    const bf16_t* MX = WSP(bf16_t, WS_MX);
    const int gw = c.bid * 8 + c.wave, NGW = c.G * 8;
    for (int m = gw; m < MTOK; m += NGW) {
        const u32x2* mr = (const u32x2*)(MX + (size_t)m * DM) + c.lane; const f32x4* hr = (const f32x4*)(hprev + (size_t)m * DM) + c.lane; const f32x4* gr = (const f32x4*)gpost + c.lane;
        f32x4 x[4], hv[4]; float s = 0.f;
#pragma unroll
        for (int j = 0; j < 4; ++j) { const u32x2 w = mr[64 * j]; x[j] = (f32x4){bf2f(w.x & 0xffffu), bf2f(w.x >> 16), bf2f(w.y & 0xffffu), bf2f(w.y >> 16)}; hv[j] = hr[64 * j];
            s += (x[j].x * x[j].x + x[j].y * x[j].y) + (x[j].z * x[j].z + x[j].w * x[j].w); }
        const float r1 = rsqrtf(wave_sum(s) * (1.f / DM) + EPS); float s2 = 0.f;
#pragma unroll
        for (int j = 0; j < 4; ++j) { const f32x4 g = gr[64 * j]; hv[j] = hv[j] + x[j] * r1 * g; s2 += (hv[j].x * hv[j].x + hv[j].y * hv[j].y) + (hv[j].z * hv[j].z + hv[j].w * hv[j].w); }
        f32x4* ho = (f32x4*)(hout + (size_t)m * DM) + c.lane;
#pragma unroll
        for (int j = 0; j < 4; ++j) ho[64 * j] = hv[j];
        if (xn) { const float r2 = rsqrtf(wave_sum(s2) * (1.f / DM) + EPS); u32x2* o8 = (u32x2*)(xn + (size_t)m * DM) + c.lane;
#pragma unroll
            for (int j = 0; j < 4; ++j) { u32x2 w; w.x = pk2(hv[j].x * r2, hv[j].y * r2); w.y = pk2(hv[j].z * r2, hv[j].w * r2); o8[64 * j] = w; } }
    }
}


typedef GAS unsigned gu32;
#define XB_TMO      128
#define XB_XCNT(j)  (256  + 64 * (j))
#define XB_XSUB(j)  (1280 + 64 * (j))
#define XB_XGEN(j)  (2304 + 64 * (j))
#define XB_TOP      3328
#define XB_TOPGEN   3392
#define XCD_BAR_WORDS 3456
#define XB_SPIN_CAP (1u << 22)
constexpr int CW_BAR = 4096;
constexpr int MISC_OFF = LDS_BYTES - 256;
__device__ __forceinline__ unsigned xb_ld(unsigned* p)              { return __hip_atomic_load(p, __ATOMIC_RELAXED, __HIP_MEMORY_SCOPE_AGENT); }
__device__ __forceinline__ unsigned xb_add(unsigned* p, unsigned v) { return __hip_atomic_fetch_add(p, v, __ATOMIC_RELAXED, __HIP_MEMORY_SCOPE_AGENT); }
__device__ __forceinline__ unsigned xb_xcc_id() { return (unsigned)__builtin_amdgcn_s_getreg((3 << 11) | 20) & 0xFu; }
#define XB_SPIN(cond, bar) do { unsigned _sp = 0; while (cond) { __builtin_amdgcn_s_sleep(1); \
    if ((++_sp & 255u) == 0u) { if (xb_ld(&(bar)[XB_TMO])) break; if (_sp > XB_SPIN_CAP) { atomicAdd(&(bar)[XB_TMO], 1u); break; } } } } while (0)
struct XcdBarrier { unsigned* bar; unsigned x; volatile LAS unsigned* st; };
__device__ __forceinline__ XcdBarrier xcd_barrier_post(unsigned* bar, volatile LAS unsigned* st) {
    XcdBarrier b; b.bar = bar; b.x = xb_xcc_id(); b.st = st;
    if (threadIdx.x == 0) (void)xb_add(&bar[XB_XCNT(b.x)], 1u);
    return b;
}
__device__ __forceinline__ void xcd_barrier_complete(unsigned* bar, unsigned x, unsigned& nloc, unsigned& nx) {
    const unsigned G = gridDim.x * gridDim.y * gridDim.z;
    unsigned sum, cnt, mine, sp = 0u;
    for (;;) {
        sum = 0u; cnt = 0u; mine = 0u;
#pragma unroll
        for (unsigned j = 0; j < 16; ++j) { const unsigned c = xb_ld(&bar[XB_XCNT(j)]); sum += c; cnt += (c > 0u) ? 1u : 0u; mine = (j == x) ? c : mine; }
        if (sum == G) break;
        __builtin_amdgcn_s_sleep(1);
        if ((++sp & 255u) == 0u) { if (xb_ld(&bar[XB_TMO])) break; if (sp > XB_SPIN_CAP) { atomicAdd(&bar[XB_TMO], 1u); break; } }
    }
    nloc = mine > 0u ? mine : 1u; nx = cnt > 0u ? cnt : 1u;
}
__device__ __forceinline__ void xcd_barrier(const XcdBarrier& b) {
    asm volatile("s_waitcnt vmcnt(0)" ::: "memory");
    __syncthreads();
    if (threadIdx.x == 0) {
        unsigned* bar = b.bar;
        __builtin_amdgcn_s_waitcnt(0);
        unsigned nloc = b.st[0], nx = b.st[1];
        if (nloc == 0u) { xcd_barrier_complete(bar, b.x, nloc, nx); b.st[0] = nloc; b.st[1] = nx; }
        const unsigned old = xb_add(&bar[XB_XSUB(b.x)], 1u);
        const unsigned gen = old / nloc;
        if (old + 1u == (gen + 1u) * nloc) {
            __builtin_amdgcn_fence(__ATOMIC_RELEASE, "agent");
            asm volatile("s_waitcnt vmcnt(0)" ::: "memory");
            const unsigned og = xb_add(&bar[XB_TOP], 1u);
            const unsigned tg = og / nx;
            if (og + 1u == (tg + 1u) * nx) xb_add(&bar[XB_TOPGEN], 1u);
            else XB_SPIN(xb_ld(&bar[XB_TOPGEN]) == tg, bar);
            __builtin_amdgcn_fence(__ATOMIC_ACQUIRE, "agent");
            xb_add(&bar[XB_XGEN(b.x)], 1u);
            asm volatile("s_waitcnt vmcnt(0)" ::: "memory");
        } else {
            XB_SPIN(xb_ld(&bar[XB_XGEN(b.x)]) == gen, bar);
            __builtin_amdgcn_fence(__ATOMIC_ACQUIRE, "agent");
            asm volatile("s_waitcnt vmcnt(0)" ::: "memory");
        }
    }
    __syncthreads();
}

struct Args { const float* in[23]; float* out; unsigned char* ws; int lo, hi; };
constexpr int NPHASE = 1 + 10 * DEPTH;

__global__ void __launch_bounds__(NTHR, 2) hybrid_fwd(Args args) {
    extern __shared__ __attribute__((aligned(16))) unsigned char lds_raw[];
    Ctx c;
#pragma unroll
    for (int i = 0; i < 23; ++i) c.in[i] = args.in[i];
    c.out = args.out; c.ws = args.ws; c.lds = lds_raw; c.lds3 = (LAS unsigned char*)lds_raw; c.tid = threadIdx.x; c.lane = c.tid & 63; c.wave = __builtin_amdgcn_readfirstlane(c.tid >> 6); c.G = gridDim.x; c.bid = blockIdx.x;
    const int lo = args.lo, hi = args.hi;
    volatile LAS unsigned* MISC = (volatile LAS unsigned*)(c.lds3 + MISC_OFF);
    if (c.tid < 64) MISC[c.tid] = 0u;
    __syncthreads();
    XcdBarrier gbar; gbar.bar = (unsigned*)(args.ws + WS_CTL) + CW_BAR; gbar.x = 0; gbar.st = nullptr;
    if (hi - lo > 1) gbar = xcd_barrier_post((unsigned*)(args.ws + WS_CTL) + CW_BAR, MISC + 8);
#define SEAM(k) do { if (IN(k) && IN((k) + 1)) xcd_barrier(gbar); } while (0)
#define IN(k) (lo <= (k) && (k) < hi)
#define FRESH() do { c.tid = opaque_v((int)threadIdx.x); c.lane = c.tid & 63; } while (0)
    if (IN(0)) { FRESH(); ph_prologue(c); }
    SEAM(0);
    for (int l = 0; l < DEPTH; ++l) {
        const int pb = 1 + 10 * l;
        if (IN(pb + 0)) {
            EpiInProj E{WSP(bf16_t, WS_U2), WSP(bf16_t, WS_PACT), WSP(float, WS_GT), c.in[I_GB] + l * 12};
#if USE_PG8
            { pg8::Gemm g{WSP(bf16_t, WS_XNY), WSP(bf16_t, WS_WIN) + (size_t)l * NIN * DM, DM, DM, DM, (size_t)256 * DM * 2, (size_t)256 * DM * 2};
              pg8::StaticOrder S; S.init(MTOK, NIN, c.G, c.bid); pg8::EpiWrap<EpiInProj, false> W{E};
              pg8::gemm_phase<pg8::EpiWrap<EpiInProj, false>, pg8::StaticOrder, true>(c.lds3, g, S, W); }
#else
            gemm_naive<false>(c, WSP(bf16_t, WS_XNY), DM, WSP(bf16_t, WS_WIN) + (size_t)l * NIN * DM, DM, DM,
                [](int t, int& r0, int& c0, int& b0) -> bool { if (t >= (MTOK / 64) * (NIN / 64)) return false; r0 = 64 * (t / (NIN / 64)); c0 = b0 = 64 * (t % (NIN / 64)); return true; }, E);
#endif
        }
        SEAM(pb + 0);
        if (IN(pb + 1)) {
            FRESH(); ph_B_texpand(c, l); FRESH(); ph_B_gatescan(c);
            { EpiXloc E{WSP(float, WS_XLOC)};
#if USE_PG8
              { pg8::Gemm g{WSP(bf16_t, WS_U2), WSP(bf16_t, WS_BM) + (size_t)l * 16 * 128 * 1024, U2LD, 1024, 1024, (size_t)256 * U2LD * 2, (size_t)128 * 1024 * 2};
                pg8::SchedXloc S{c.G, c.bid}; pg8::EpiWrap<EpiXloc, false> W{E};
                pg8::gemm_phase<pg8::EpiWrap<EpiXloc, false>, pg8::SchedXloc, false>(c.lds3, g, S, W); __syncthreads(); }
#else
              gemm_naive<false>(c, WSP(bf16_t, WS_U2), U2LD, WSP(bf16_t, WS_BM) + (size_t)l * 16 * 128 * 1024, 1024, 1024,
                [](int t, int& r0, int& c0, int& b0) -> bool { if (t >= 128 * 2) return false; const int rt = t >> 1, ct = t & 1, g = rt >> 3; r0 = 64 * rt; c0 = 256 * g + 64 * ct; b0 = g * 128 + 64 * ct; return true; }, E);
#endif
            }
            FRESH(); ph_B_hgrn_local_naive(c, l); FRESH(); ph_B_mlstm_local_naive(c, l);
        }
        SEAM(pb + 1);
        if (IN(pb + 2)) { FRESH(); ph_C_scans(c, l); FRESH(); ph_C_fox_naive(c); }
        SEAM(pb + 2);
        if (IN(pb + 3)) {
            { EpiS5Y E{WSP(bf16_t, WS_G1)};
#if USE_PG8
              { pg8::Gemm g{WSP(bf16_t, WS_U2), WSP(bf16_t, WS_TT), U2LD, U2LD, U2LD, (size_t)256 * U2LD * 2, (size_t)256 * U2LD * 2};
                pg8::SchedS5Y S{c.G, c.bid}; pg8::EpiWrap<EpiS5Y, false> W{E};
                pg8::gemm_phase<pg8::EpiWrap<EpiS5Y, false>, pg8::SchedS5Y, false>(c.lds3, g, S, W); __syncthreads(); }
#else
              gemm_naive<false>(c, WSP(bf16_t, WS_U2), U2LD, WSP(bf16_t, WS_TT), U2LD, U2LD,
                [](int t, int& r0, int& c0, int& b0) -> bool { if (t >= 128 * 16) return false; const int rt = t >> 4, ct = t & 15, g = rt >> 3; r0 = 64 * rt; c0 = b0 = g * 1024 + 64 * ct; return true; }, E);
#endif
            }
            FRESH(); ph_D_hgrn_out_naive(c, l); FRESH(); ph_D_mlstm_out_naive(c, l);
        }
        SEAM(pb + 3);
        if (IN(pb + 4)) { FRESH(); ph_E_glu_naive(c, l); }
        SEAM(pb + 4);
        if (IN(pb + 5)) {
            EpiPlainBf16 E{WSP(bf16_t, WS_MX), DM};
#if USE_PG8
            { pg8::Gemm g{WSP(bf16_t, WS_XNY), WSP(bf16_t, WS_WOUT) + (size_t)l * DM * DM, DM, DM, DM, (size_t)256 * DM * 2, (size_t)256 * DM * 2};
              pg8::StaticOrder S; S.init(MTOK, DM, c.G, c.bid); pg8::EpiWrap<EpiPlainBf16, false> W{E};
              pg8::gemm_phase<pg8::EpiWrap<EpiPlainBf16, false>, pg8::StaticOrder, true>(c.lds3, g, S, W); }
#else
            gemm_naive<false>(c, WSP(bf16_t, WS_XNY), DM, WSP(bf16_t, WS_WOUT) + (size_t)l * DM * DM, DM, DM,
                [](int t, int& r0, int& c0, int& b0) -> bool { if (t >= (MTOK / 64) * 16) return false; r0 = 64 * (t >> 4); c0 = b0 = 64 * (t & 15); return true; }, E);
#endif
        }
        SEAM(pb + 5);
        if (IN(pb + 6)) { FRESH(); } if (IN(pb + 6)) ph_rowpass(c, l == 0 ? c.in[I_X] : c.out, c.in[I_LNMPOST] + l * DM, c.out, WSP(bf16_t, WS_XNY));
        SEAM(pb + 6);
        if (IN(pb + 7)) {
            EpiSwiGLU E{WSP(bf16_t, WS_PACT)};
#if USE_PG8
            { pg8::Gemm g{WSP(bf16_t, WS_XNY), WSP(bf16_t, WS_WGU) + (size_t)l * NGU * DM, DM, DM, DM, (size_t)256 * DM * 2, (size_t)256 * DM * 2};
              pg8::StaticOrder S; S.init(MTOK, NGU, c.G, c.bid); pg8::EpiWrap<EpiSwiGLU, true> W{E};
              pg8::gemm_phase<pg8::EpiWrap<EpiSwiGLU, true>, pg8::StaticOrder, true>(c.lds3, g, S, W); }
#else
            gemm_naive<true>(c, WSP(bf16_t, WS_XNY), DM, WSP(bf16_t, WS_WGU) + (size_t)l * NGU * DM, DM, DM,
                [](int t, int& r0, int& c0, int& b0) -> bool { if (t >= (MTOK / 64) * (DFF / 64)) return false; r0 = 64 * (t / (DFF / 64)); c0 = 64 * (t % (DFF / 64)); b0 = (c0 >> 7) * 256 + (c0 & 127); return true; }, E);
#endif
        }
        SEAM(pb + 7);
        if (IN(pb + 8)) {
            EpiPlainBf16 E{WSP(bf16_t, WS_MX), DM};
#if USE_PG8
            { pg8::Gemm g{WSP(bf16_t, WS_PACT), WSP(bf16_t, WS_WDN) + (size_t)l * DM * DFF, DFF, DFF, DFF, (size_t)256 * DFF * 2, (size_t)256 * DFF * 2};
              pg8::StaticOrder S; S.init(MTOK, DM, c.G, c.bid); pg8::EpiWrap<EpiPlainBf16, false> W{E};
              pg8::gemm_phase<pg8::EpiWrap<EpiPlainBf16, false>, pg8::StaticOrder, true>(c.lds3, g, S, W); }
#else
            gemm_naive<false>(c, WSP(bf16_t, WS_PACT), DFF, WSP(bf16_t, WS_WDN) + (size_t)l * DM * DFF, DFF, DFF,
                [](int t, int& r0, int& c0, int& b0) -> bool { if (t >= (MTOK / 64) * 16) return false; r0 = 64 * (t >> 4); c0 = b0 = 64 * (t & 15); return true; }, E);
#endif
        }
        SEAM(pb + 8);
        if (IN(pb + 9)) { FRESH(); } if (IN(pb + 9)) ph_rowpass(c, c.out, c.in[I_LNFPOST] + l * DM, c.out, (l + 1 < DEPTH) ? WSP(bf16_t, WS_XNY) : (bf16_t*)nullptr);
        SEAM(pb + 9);
    }
#undef IN
}

extern "C" void kernel_launch(void* const* d_in, const int* in_sizes, int n_in, void* d_out, int out_size, void* d_ws, size_t ws_size, hipStream_t stream) {
    static int grid = 0;
    if (grid == 0) {
        if (n_in != 23 || in_sizes[0] != MTOK * DM || out_size != MTOK * DM || ws_size < WS_END) {
            fprintf(stderr, "kernel_launch: unexpected shapes (n_in %d, in0 %d, out %d, ws %zu, need ws %zu); nothing launched\n", n_in, n_in > 0 ? in_sizes[0] : -1, out_size, ws_size, (size_t)WS_END); grid = -1; return; }
        int dev = 0, cus = 0;
        if (hipGetDevice(&dev) != hipSuccess || hipDeviceGetAttribute(&cus, hipDeviceAttributeMultiprocessorCount, dev) != hipSuccess) { grid = -1; return; }
        if (hipFuncSetAttribute((const void*)hybrid_fwd, hipFuncAttributeMaxDynamicSharedMemorySize, LDS_BYTES) != hipSuccess) { fprintf(stderr, "kernel_launch: hipFuncSetAttribute failed\n"); grid = -1; return; }
        grid = cus;
    }
    if (grid < 0) return;
    (void)hipMemsetAsync((char*)d_ws + WS_CTL, 0, CTL_BYTES, stream);
    Args a{};
    for (int i = 0; i < 23; ++i) a.in[i] = (const float*)d_in[i];
    a.out = (float*)d_out; a.ws = (unsigned char*)d_ws;
#if N_LAUNCH_MODE == 1
    a.lo = 0; a.hi = NPHASE; hipLaunchKernelGGL(hybrid_fwd, dim3(grid), dim3(NTHR), LDS_BYTES, stream, a);
#else
    for (int p = 0; p < NPHASE; ++p) { a.lo = p; a.hi = p + 1; hipLaunchKernelGGL(hybrid_fwd, dim3(grid), dim3(NTHR), LDS_BYTES, stream, a); }
#endif
}
```

```cpp
#include <hip/hip_runtime.h>
#include <cstdio>
#include <cstdint>

#ifndef N_LAUNCH_MODE
#define N_LAUNCH_MODE 1
#endif
#ifndef FAST_FOX
#define FAST_FOX 1
#endif
#ifndef USE_PG8
#define USE_PG8 1
#endif

#define LAS __attribute__((address_space(3)))
#define GAS __attribute__((address_space(1)))
typedef unsigned short bf16_t;
typedef float f32x4 __attribute__((ext_vector_type(4)));
typedef unsigned u32x4 __attribute__((ext_vector_type(4)));
typedef unsigned u32x2 __attribute__((ext_vector_type(2)));
typedef short bf16x8 __attribute__((ext_vector_type(8)));

constexpr int NB = 8, SEQ = 4096, DM = 1024, MTOK = NB * SEQ, DEPTH = 2;
constexpr int DIN = 3084, NIN = 3328, DFF = 2816, NGU = 2 * DFF;
constexpr int CL = 64, NCH = SEQ / CL, NCHT = NB * NCH;
constexpr int PW = 2816;
constexpr int U2LD = 1152;
constexpr int NUNIT = NB * 4 * NCH;
constexpr float EPS = 1e-6f;
constexpr float LOG2E = 1.4426950408889634f;
constexpr int PC_HGQ = 0, PC_HGF = 256, PC_HGI = 512, PC_HGG = 768, PC_FXQ = 1024, PC_FXK = 1280, PC_FXV = 1536, PC_MLQ = 1792, PC_MLK = 2048, PC_MLV = 2304, PC_MLO = 2560;

constexpr size_t MiB = 1u << 20;
constexpr size_t WS_CTL = 0, CTL_BYTES = 1 * MiB;
constexpr size_t WS_WIN = 1 * MiB;
constexpr size_t WS_WOUT = 14 * MiB;
constexpr size_t WS_WGU = 18 * MiB;
constexpr size_t WS_WDN = 40 * MiB;
constexpr size_t WS_WGLU = 51 * MiB;
constexpr size_t WS_KERN = 52 * MiB;
constexpr size_t WS_A64 = 54 * MiB;
constexpr size_t WS_BM = 55 * MiB;
constexpr size_t WS_TT = 71 * MiB;
constexpr size_t WS_CM = 107 * MiB;
constexpr size_t WS_U2 = 115 * MiB;
constexpr size_t WS_GT = 133 * MiB;
constexpr size_t WS_FQ = 135 * MiB;
constexpr size_t WS_FK = 139 * MiB;
constexpr size_t WS_FCUM = 143 * MiB;
constexpr size_t WS_XNY = 144 * MiB;
constexpr size_t WS_PACT = 208 * MiB;
constexpr size_t WS_SCR = 384 * MiB;
constexpr size_t WS_MX = WS_SCR;
constexpr size_t WS_XLOC = WS_SCR;
constexpr size_t WS_G1 = WS_SCR + 4 * MiB;
constexpr size_t WS_HSLOC = WS_SCR + 20 * MiB;
constexpr size_t WS_HDEC = WS_SCR + 52 * MiB;
constexpr size_t WS_MDEC = WS_SCR + 52 * MiB + 512 * 1024;
constexpr size_t WS_HSPREV = WS_SCR + 53 * MiB;
constexpr size_t WS_MSLOC = WS_SCR + 69 * MiB;
constexpr size_t WS_MSPREV = WS_SCR + 102 * MiB;
constexpr size_t WS_END = 512 * MiB;
static_assert(WS_MSPREV + (size_t)NUNIT * 80 * 64 * 2 <= WS_END, "ws map");
static_assert(WS_MSLOC + (size_t)NUNIT * 65 * 64 * 4 <= WS_MSPREV, "ws map");

constexpr int LDS_BYTES = 147456;
constexpr int NTHR = 512;

__device__ __forceinline__ int opaque_v(int x) { asm volatile("" : "+v"(x)); return x; }
__device__ __forceinline__ float bf2f(unsigned b) { return __uint_as_float(b << 16); }
__device__ __forceinline__ unsigned f2bf(float f) { unsigned u = __float_as_uint(f); return (u + 0x7fffu + ((u >> 16) & 1u)) >> 16; }
__device__ __forceinline__ unsigned pk2(float lo, float hi) { return f2bf(lo) | (f2bf(hi) << 16); }
__device__ __forceinline__ float wave_sum(float v) {
#pragma unroll
    for (int o = 1; o < 64; o <<= 1) v += __shfl_xor(v, o);
    return v;
}
__device__ __forceinline__ float sigmoidf_(float x) { return 1.f / (1.f + __expf(-x)); }
__device__ __forceinline__ float log_sigmoidf_(float x) { return fminf(x, 0.f) - log1pf(__expf(-fabsf(x))); }
__device__ __forceinline__ float siluf_(float x) { return x * sigmoidf_(x); }
__device__ __forceinline__ float gelu_tanh(float x) { const float u = 0.7978845608028654f * (x + 0.044715f * x * x * x); return x * (1.f - 1.f / (1.f + __expf(2.f * u))); }
__device__ __forceinline__ void unpack8(const u32x4 w, float (&v)[8]) {
    v[0] = bf2f(w.x & 0xffffu); v[1] = bf2f(w.x >> 16); v[2] = bf2f(w.y & 0xffffu); v[3] = bf2f(w.y >> 16);
    v[4] = bf2f(w.z & 0xffffu); v[5] = bf2f(w.z >> 16); v[6] = bf2f(w.w & 0xffffu); v[7] = bf2f(w.w >> 16);
}
__device__ __forceinline__ u32x4 pack8(const float (&v)[8]) { u32x4 w; w.x = pk2(v[0], v[1]); w.y = pk2(v[2], v[3]); w.z = pk2(v[4], v[5]); w.w = pk2(v[6], v[7]); return w; }

struct Ctx {
    const float* in[23]; float* out; unsigned char* ws;
    unsigned char* lds; LAS unsigned char* lds3; int tid, lane, wave, G, bid;
};
#define WSP(T, off) ((T*)(c.ws + (off)))
enum { I_X = 0, I_WIN, I_GB, I_LRE, I_LIM, I_BRE, I_BIM, I_CRE, I_CIM, I_S5D, I_LOGDT, I_WGLU, I_LB, I_CONV, I_GAIN, I_WOUT, I_LNMPRE, I_LNMPOST, I_LNFPRE, I_LNFPOST, I_WG, I_WU, I_WD };

template <bool PAIR, class TileF, class Epi>
__device__ __forceinline__ void gemm_naive(const Ctx& c, const bf16_t* A, int lda, const bf16_t* Bt, int ldb, int K, TileF tf, const Epi& E) {
    float* As = (float*)c.lds;
    float* Bs = As + 64 * 65;
    float* Bs2 = Bs + 64 * 65;
    const int r = c.tid >> 3, cg = c.tid & 7;
    for (int t = c.bid;; t += c.G) {
        int row0, col0, brow0; if (!tf(t, row0, col0, brow0)) break;
        float acc[8], acc2[8];
#pragma unroll
        for (int i = 0; i < 8; ++i) { acc[i] = 0.f; acc2[i] = 0.f; }
        for (int k0 = 0; k0 < K; k0 += 64) {
            __syncthreads();
            { float v[8]; unpack8(*(const u32x4*)(A + (size_t)(row0 + r) * lda + k0 + cg * 8), v);
#pragma unroll
              for (int i = 0; i < 8; ++i) As[r * 65 + cg * 8 + i] = v[i];
              unpack8(*(const u32x4*)(Bt + (size_t)(brow0 + r) * ldb + k0 + cg * 8), v);
#pragma unroll
              for (int i = 0; i < 8; ++i) Bs[r * 65 + cg * 8 + i] = v[i];
              if (PAIR) { unpack8(*(const u32x4*)(Bt + (size_t)(brow0 + 128 + r) * ldb + k0 + cg * 8), v);
#pragma unroll
                  for (int i = 0; i < 8; ++i) Bs2[r * 65 + cg * 8 + i] = v[i]; } }
            __syncthreads();
            for (int k = 0; k < 64; ++k) {
                const float a = As[r * 65 + k];
#pragma unroll
                for (int i = 0; i < 8; ++i) { acc[i] += a * Bs[(cg * 8 + i) * 65 + k]; if (PAIR) acc2[i] += a * Bs2[(cg * 8 + i) * 65 + k]; }
            }
        }
        E(row0 + r, col0 + cg * 8, acc, acc2);
    }
    __syncthreads();
}

struct EpiInProj {
    bf16_t* U2; bf16_t* P; float* GT; const float* gb;
    __device__ __forceinline__ void operator()(int row, int col, const float (&v)[8], const float (&)[8]) const {
        if (col < 256) { const int g = col >> 4, p0 = col & 15, ch = row >> 6, j = row & 63;
            *(u32x4*)(U2 + ((size_t)(g * NCHT + ch) * U2LD + j * 16 + p0)) = pack8(v); }
        else if (col < 3072) { *(u32x4*)(P + (size_t)row * PW + (col - 256)) = pack8(v); }
        else if (col < 3088) { const int i0 = col - 3072;
#pragma unroll
            for (int i = 0; i < 8; ++i) if (i0 + i < 12) GT[(size_t)row * 16 + i0 + i] = v[i] + gb[i0 + i]; }
    }
};
struct EpiPlainBf16 {
    bf16_t* O; int ld;
    __device__ __forceinline__ void operator()(int row, int col, const float (&v)[8], const float (&)[8]) const { *(u32x4*)(O + (size_t)row * ld + col) = pack8(v); }
};
struct EpiSwiGLU {
    bf16_t* O;
    __device__ __forceinline__ void operator()(int row, int col, const float (&g)[8], const float (&u)[8]) const {
        float v[8];
#pragma unroll
        for (int i = 0; i < 8; ++i) v[i] = siluf_(g[i]) * u[i];
        *(u32x4*)(O + (size_t)row * DFF + col) = pack8(v); }
};
struct EpiXloc {
    float* X;
    __device__ __forceinline__ void operator()(int row, int col, const float (&v)[8], const float (&)[8]) const {
        const int cl = col & 255; if (cl < 128) { float* p = X + (size_t)row * 128 + cl; *(f32x4*)p = (f32x4){v[0], v[1], v[2], v[3]}; *(f32x4*)(p + 4) = (f32x4){v[4], v[5], v[6], v[7]}; } }
};
struct EpiS5Y {
    bf16_t* G1;
    __device__ __forceinline__ void operator()(int row, int col, const float (&v)[8], const float (&)[8]) const {
        const int g = row >> 9, ch = row & 511, cl = col - g * 1024, tau = cl >> 4, p0 = cl & 15; float o[8];
#pragma unroll
        for (int i = 0; i < 8; ++i) o[i] = gelu_tanh(v[i]);
        *(u32x4*)(G1 + ((size_t)(ch * 64 + tau) * 256 + g * 16 + p0)) = pack8(o); }
};


namespace pg8 {
constexpr int BM = 256, BK = 64, HALF = 128, HTB = HALF * BK * 2, STAGE_BYTES = 8 * HTB, NXCD = 8, WGM = 8;
__host__ __device__ __forceinline__ int lds_byte(int r, int c) { const int st = (r >> 4) * 2 + (c >> 5), rr = r & 15, cc = c & 31, ob = rr * 64 + cc * 2; return st * 1024 + (ob ^ (((ob >> 9) & 1) << 5)); }
__host__ __device__ __forceinline__ void stage_rc(int b, int& R, int& C) { const int st = b / 1024, sb = b % 1024, swz = sb ^ (((sb >> 9) & 1) << 5); R = (st >> 1) * 16 + swz / 64; C = (st & 1) * 32 + (swz % 64) / 2; }
__host__ __device__ __forceinline__ int perm32(int rho) { const int n = rho >> 4, i = rho & 15; return 8 * (i >> 2) + 4 * n + (i & 3); }
struct Unit { int pm, pn; };
struct Gemm { const bf16_t* A; const bf16_t* Bt; int lda, ldb, K; size_t astep, bstep; };
struct StaticOrder {
    int nM, nN, nwg, G, c;
    __device__ void init(int M, int N, int G_, int c_) { nM = M / BM; nN = N / BM; nwg = nM * nN; G = G_; c = c_; }
    __device__ bool next(int i, Unit& u) const {
        const long L = (long)i * G + c; if (L >= nwg) return false;
        int wgid = (int)L; { const int q = nwg / NXCD, r = nwg % NXCD, xcd = wgid % NXCD, off = wgid / NXCD; wgid = (xcd < r ? xcd * (q + 1) : r * (q + 1) + (xcd - r) * q) + off; }
        const int nig = WGM * nN, gid = wgid / nig, fm = gid * WGM, gsz = (nM - fm) < WGM ? (nM - fm) : WGM;
        u.pm = fm + ((wgid % nig) % gsz); u.pn = (wgid % nig) / gsz; return true;
    }
};
struct SchedXloc { int G, c; __device__ bool next(int i, Unit& u) const { const int L = i * G + c; if (L >= 32) return false; u.pm = L; u.pn = L >> 1; return true; } };
struct SchedS5Y { int G, c; __device__ bool next(int i, Unit& u) const { const int L = i * G + c; if (L >= 128) return false; const int g = L >> 3; u.pm = g * 2 + ((L >> 2) & 1); u.pn = g * 4 + (L & 3); return true; } };

template <class F, bool PAIR> struct EpiWrap {
    F f;
    __device__ __forceinline__ void operator()(const f32x4 (&acc)[2][2][4][2], const Unit& u, int wr, int wc, int fr, int fq) const {
#pragma unroll
        for (int ai = 0; ai < 2; ++ai)
#pragma unroll
            for (int m = 0; m < 4; ++m) { const int row = u.pm * BM + ai * HALF + wr * 64 + m * 16 + fr;
                if (PAIR) { const int col = u.pn * HALF + wc * 32 + 8 * fq;
                    const float g[8] = {acc[ai][0][m][0][0], acc[ai][0][m][0][1], acc[ai][0][m][0][2], acc[ai][0][m][0][3], acc[ai][0][m][1][0], acc[ai][0][m][1][1], acc[ai][0][m][1][2], acc[ai][0][m][1][3]};
                    const float v[8] = {acc[ai][1][m][0][0], acc[ai][1][m][0][1], acc[ai][1][m][0][2], acc[ai][1][m][0][3], acc[ai][1][m][1][0], acc[ai][1][m][1][1], acc[ai][1][m][1][2], acc[ai][1][m][1][3]};
                    f(row, col, g, v); }
                else {
#pragma unroll
                    for (int bj = 0; bj < 2; ++bj) { const int col = u.pn * BM + bj * HALF + wc * 32 + 8 * fq;
                        const float v[8] = {acc[ai][bj][m][0][0], acc[ai][bj][m][0][1], acc[ai][bj][m][0][2], acc[ai][bj][m][0][3], acc[ai][bj][m][1][0], acc[ai][bj][m][1][1], acc[ai][bj][m][1][2], acc[ai][bj][m][1][3]};
                        f(row, col, v, v); } } }
    }
};

template <class Epi, class Sched, bool ALIGN_EPI>
__device__ __forceinline__ void gemm_phase(LAS unsigned char* lds, const Gemm g, const Sched& S, const Epi& E) {
    const int tid = opaque_v((int)threadIdx.x), wid = __builtin_amdgcn_readfirstlane(tid >> 6), lane = tid & 63, wr = wid >> 2, wc = wid & 3, fr = lane & 15, fq = lane >> 4;
    const int K = g.K, nt = K / BK;
    unsigned voffA[2], voffB[2];
#pragma unroll
    for (int i = 0; i < 2; ++i) { int R, C; stage_rc(tid * 16 + i * 8192, R, C); const int Rb = (R & ~31) + perm32(R & 31);
        voffA[i] = (unsigned)(R * g.lda + C) * 2u; voffB[i] = (unsigned)(Rb * g.ldb + C) * 2u; }
    const size_t kstep = (size_t)(BK * 2);
    const size_t hstepA = (size_t)HALF * g.lda * 2, hstepB = (size_t)HALF * g.ldb * 2;
    const unsigned ldsw = (unsigned)wid * 1024u;
    const int aoff = lds_byte(wr * 64 + fr, fq * 8), boff = lds_byte(wc * 32 + fr, fq * 8);
#define PG8_SA(b, h) (((b) * 2 + (h)) * HTB)
#define PG8_SB(b, h) ((4 + (b) * 2 + (h)) * HTB)
#define PG8_STAGE(bufoff, gbase, voff) do { _Pragma("unroll") for (int _i = 0; _i < 2; ++_i) \
        __builtin_amdgcn_global_load_lds((const unsigned*)((const char*)(gbase) + (voff)[_i]), (LAS unsigned*)(lds + (bufoff) + ldsw + _i * 8192), 16, 0, 0); } while (0)
#define PG8_LDA(dst, b, h) do { _Pragma("unroll") for (int m = 0; m < 4; ++m) _Pragma("unroll") for (int k = 0; k < 2; ++k) dst[m][k] = *(const LAS bf16x8*)(lds + PG8_SA(b, h) + aoff + m * 2048 + k * 1024); } while (0)
#define PG8_LDB(dst, b, h) do { _Pragma("unroll") for (int n = 0; n < 2; ++n) _Pragma("unroll") for (int k = 0; k < 2; ++k) dst[n][k] = *(const LAS bf16x8*)(lds + PG8_SB(b, h) + boff + n * 2048 + k * 1024); } while (0)
#define PG8_MMA(ai, bj, At, Bt) do { __builtin_amdgcn_s_setprio(1); _Pragma("unroll") for (int m = 0; m < 4; ++m) _Pragma("unroll") for (int n = 0; n < 2; ++n) _Pragma("unroll") for (int k = 0; k < 2; ++k) \
        acc[ai][bj][m][n] = __builtin_amdgcn_mfma_f32_16x16x32_bf16(Bt[n][k], At[m][k], acc[ai][bj][m][n], 0, 0, 0); __builtin_amdgcn_s_setprio(0); } while (0)
#define PG8_WAIT_V(n) asm volatile("s_waitcnt vmcnt(" #n ")" ::: "memory")
#define PG8_WAIT_L(n) asm volatile("s_waitcnt lgkmcnt(" #n ")" ::: "memory")
#define PG8_BAR __builtin_amdgcn_s_barrier()
#define PG8_SCHED __builtin_amdgcn_sched_barrier(0)
    Unit cur, nxt; int ui = 0;
    if (!S.next(0, cur)) return;
    f32x4 acc[2][2][4][2];
#pragma unroll
    for (int a = 0; a < 2; ++a)
#pragma unroll
        for (int b = 0; b < 2; ++b)
#pragma unroll
            for (int m = 0; m < 4; ++m)
#pragma unroll
                for (int n = 0; n < 2; ++n) acc[a][b][m][n] = (f32x4){0.f, 0.f, 0.f, 0.f};
    bf16x8 At[4][2], B0[2][2], B1[2][2];
    const char* cA = (const char*)g.A + (size_t)cur.pm * g.astep; const char* cB = (const char*)g.Bt + (size_t)cur.pn * g.bstep;
    PG8_STAGE(PG8_SB(0, 0), cB, voffB); PG8_STAGE(PG8_SB(0, 1), cB + hstepB, voffB); PG8_STAGE(PG8_SA(0, 0), cA, voffA); PG8_STAGE(PG8_SA(0, 1), cA + hstepA, voffA);
    if (wr == 1) PG8_BAR;
    PG8_WAIT_V(2); PG8_BAR;
    PG8_STAGE(PG8_SB(1, 0), cB + kstep, voffB); PG8_STAGE(PG8_SA(1, 0), cA + kstep, voffA); PG8_STAGE(PG8_SB(1, 1), cB + hstepB + kstep, voffB);
    PG8_WAIT_V(6); PG8_BAR;
    for (;;) {
        const bool has_next = S.next(ui + 1, nxt);
        const char* nA = has_next ? (const char*)g.A + (size_t)nxt.pm * g.astep : cA; const char* nB = has_next ? (const char*)g.Bt + (size_t)nxt.pn * g.bstep : cB;
        for (int t = 0; t < nt; t += 2) {
            const bool last = (t == nt - 2);
            const char* a1 = cA + (size_t)(t + 1) * kstep;
            const char* a2 = last ? nA : cA + (size_t)(t + 2) * kstep; const char* b2 = last ? nB : cB + (size_t)(t + 2) * kstep;
            const char* a3 = a2 + kstep; const char* b3 = b2 + kstep;
            PG8_LDB(B0, 0, 0); PG8_LDB(B1, 0, 1); PG8_SCHED; PG8_LDA(At, 0, 0); PG8_STAGE(PG8_SA(1, 1), a1 + hstepA, voffA);
            PG8_WAIT_V(8); PG8_WAIT_L(0); PG8_BAR; PG8_MMA(0, 0, At, B0); PG8_MMA(0, 1, At, B1); PG8_BAR; PG8_SCHED;
            PG8_LDA(At, 0, 1); PG8_STAGE(PG8_SB(0, 0), b2, voffB); PG8_STAGE(PG8_SB(0, 1), b2 + hstepB, voffB); PG8_STAGE(PG8_SA(0, 0), a2, voffA);
            PG8_WAIT_V(8); PG8_WAIT_L(0); PG8_BAR; PG8_MMA(1, 0, At, B0); PG8_MMA(1, 1, At, B1); PG8_BAR; PG8_SCHED;
            PG8_LDB(B0, 1, 0); PG8_LDB(B1, 1, 1); PG8_SCHED; PG8_LDA(At, 1, 0); PG8_STAGE(PG8_SA(0, 1), a2 + hstepA, voffA);
            PG8_WAIT_V(8); PG8_WAIT_L(0); PG8_BAR; PG8_MMA(0, 0, At, B0); PG8_MMA(0, 1, At, B1); PG8_BAR; PG8_SCHED;
            PG8_LDA(At, 1, 1); PG8_STAGE(PG8_SB(1, 0), b3, voffB); PG8_STAGE(PG8_SB(1, 1), b3 + hstepB, voffB); PG8_STAGE(PG8_SA(1, 0), a3, voffA);
            PG8_WAIT_V(8); PG8_WAIT_L(0); PG8_BAR; PG8_MMA(1, 0, At, B0); PG8_MMA(1, 1, At, B1); PG8_BAR; PG8_SCHED;
        }
        if constexpr (ALIGN_EPI) { if (wr == 0) PG8_BAR; }
        E(acc, cur, wr, wc, fr, fq);
        if (!has_next) break;
#pragma unroll
        for (int a = 0; a < 2; ++a)
#pragma unroll
            for (int b = 0; b < 2; ++b)
#pragma unroll
                for (int m = 0; m < 4; ++m)
#pragma unroll
                    for (int n = 0; n < 2; ++n) acc[a][b][m][n] = (f32x4){0.f, 0.f, 0.f, 0.f};
        cur = nxt; cA = nA; cB = nB; ++ui;
        if constexpr (ALIGN_EPI) { if (wr == 1) PG8_BAR; }
    }
    PG8_WAIT_V(0);
    if constexpr (!ALIGN_EPI) { if (wr == 0) PG8_BAR; }
    PG8_BAR;
#undef PG8_SA
#undef PG8_SB
#undef PG8_STAGE
#undef PG8_LDA
#undef PG8_LDB
#undef PG8_MMA
#undef PG8_WAIT_V
#undef PG8_WAIT_L
#undef PG8_BAR
#undef PG8_SCHED
}
}

template <class SrcF>
__device__ __forceinline__ void transpose_item(SrcF src, bf16_t* WT, int ldw, int k0, int n0, float* scr, int lane) {
#pragma unroll 8
    for (int i = 0; i < 32; ++i) { const int kk = 2 * i + (lane >> 5); scr[kk * 33 + (lane & 31)] = src(k0 + kk, n0 + (lane & 31)); }
    __builtin_amdgcn_wave_barrier(); asm volatile("s_waitcnt lgkmcnt(0)" ::: "memory");
    const int cc = lane & 7;
#pragma unroll
    for (int j = 0; j < 4; ++j) { const int n = (lane >> 3) + 8 * j; const float* s = scr + (8 * cc) * 33 + n;
        u32x4 o; o.x = pk2(s[0 * 33], s[1 * 33]); o.y = pk2(s[2 * 33], s[3 * 33]); o.z = pk2(s[4 * 33], s[5 * 33]); o.w = pk2(s[6 * 33], s[7 * 33]);
        *(u32x4*)(WT + (size_t)(n0 + n) * ldw + k0 + 8 * cc) = o; }
    asm volatile("s_waitcnt lgkmcnt(0)" ::: "memory"); __builtin_amdgcn_wave_barrier();
}
__device__ __forceinline__ int win_src_col(int n) {
    if (n < 2048) return n;
    if (n < 3072) return n + 4;
    const int i = n - 3072;
    if (i < 4) return 2048 + i;
    if (i < 8) return 3076 + (i - 4);
    if (i < 12) return 3080 + (i - 8);
    return -1;
}
__device__ __forceinline__ void rms_row_to_bf16(const float* xrow, bf16_t* orow, int lane) {
    const f32x4* xr = (const f32x4*)xrow + lane; f32x4 v[4]; float s = 0.f;
#pragma unroll
    for (int j = 0; j < 4; ++j) { v[j] = xr[64 * j]; s += (v[j].x * v[j].x + v[j].y * v[j].y) + (v[j].z * v[j].z + v[j].w * v[j].w); }
    const float rstd = rsqrtf(wave_sum(s) * (1.f / DM) + EPS);
    u32x2* o8 = (u32x2*)orow + lane;
#pragma unroll
    for (int j = 0; j < 4; ++j) { u32x2 w; w.x = pk2(v[j].x * rstd, v[j].y * rstd); w.y = pk2(v[j].z * rstd, v[j].w * rstd); o8[64 * j] = w; }
}
__device__ __forceinline__ void ph_prologue(const Ctx& c) {
    float* scr = (float*)c.lds + c.wave * 4096;
    const int gw = c.bid * 8 + c.wave, NGW = c.G * 8;
    constexpr int IT_IN = (NIN / 32) * (DM / 64), IT_OUT = (DM / 32) * (DM / 64), IT_GU = (NGU / 32) * (DM / 64), IT_DN = (DM / 32) * (DFF / 64), IT_GLU = (256 / 32) * (256 / 64);
    constexpr int IT_L = IT_IN + IT_OUT + IT_GU + IT_DN + IT_GLU;
    for (int it = gw; it < DEPTH * IT_L; it += NGW) {
        const int l = it / IT_L; int r = it % IT_L;
        if (r < IT_IN) { const int nb = r % (NIN / 32), kb = r / (NIN / 32); const float* W = c.in[I_WIN] + (size_t)l * DM * DIN; const float* ln = c.in[I_LNMPRE] + l * DM;
            transpose_item([=](int k, int n) -> float { const int sc = win_src_col(n); if (sc < 0) return 0.f; float v = W[(size_t)k * DIN + sc] * ln[k]; if (n >= 1280 && n < 1536) v *= 0.125f * LOG2E; return v; },
                           WSP(bf16_t, WS_WIN) + (size_t)l * NIN * DM, DM, kb * 64, nb * 32, scr, c.lane); continue; }
        r -= IT_IN;
        if (r < IT_OUT) { const int nb = r % (DM / 32), kb = r / (DM / 32); const float* W = c.in[I_WOUT] + (size_t)l * DM * DM; const float* gn = c.in[I_GAIN] + l * DM;
            transpose_item([=](int k, int n) -> float { return W[(size_t)k * DM + n] * gn[k]; }, WSP(bf16_t, WS_WOUT) + (size_t)l * DM * DM, DM, kb * 64, nb * 32, scr, c.lane); continue; }
        r -= IT_OUT;
        if (r < IT_GU) { const int nb = r % (NGU / 32), kb = r / (NGU / 32); const float* Wg = c.in[I_WG] + (size_t)l * DM * DFF; const float* Wu = c.in[I_WU] + (size_t)l * DM * DFF; const float* ln = c.in[I_LNFPRE] + l * DM;
            transpose_item([=](int k, int n) -> float { const int tile = n >> 8, hf = (n >> 7) & 1, j = tile * 128 + (n & 127); return (hf ? Wu : Wg)[(size_t)k * DFF + j] * ln[k]; },
                           WSP(bf16_t, WS_WGU) + (size_t)l * NGU * DM, DM, kb * 64, nb * 32, scr, c.lane); continue; }
        r -= IT_GU;
        if (r < IT_DN) { const int nb = r % (DM / 32), kb = r / (DM / 32); const float* W = c.in[I_WD] + (size_t)l * DFF * DM;
            transpose_item([=](int k, int n) -> float { return W[(size_t)k * DM + n]; }, WSP(bf16_t, WS_WDN) + (size_t)l * DM * DFF, DFF, kb * 64, nb * 32, scr, c.lane); continue; }
        r -= IT_DN;
        { const int nb = r % 8, kb = r / 8; const float* W = c.in[I_WGLU] + (size_t)l * 256 * 256;
            transpose_item([=](int k, int n) -> float { return W[(size_t)k * 256 + n]; }, WSP(bf16_t, WS_WGLU) + (size_t)l * 256 * 256, 256, kb * 64, nb * 32, scr, c.lane); }
    }
    for (int m = gw; m < MTOK; m += NGW) rms_row_to_bf16(c.in[I_X] + (size_t)m * DM, WSP(bf16_t, WS_XNY) + (size_t)m * DM, c.lane);
    __syncthreads();
    float* sh = (float*)c.lds;
    for (int it = c.bid; it < DEPTH * 16 * 65; it += c.G) {
        const int l = it / (16 * 65), g = (it / 65) % 16, d = it % 65;
        if (c.tid < 64) { const int n = c.tid;
            const double lr = (double)fminf(c.in[I_LRE][(l * 16 + g) * 64 + n], -1e-4f), li = (double)c.in[I_LIM][(l * 16 + g) * 64 + n], dt = exp((double)c.in[I_LOGDT][l * 16 + g]);
            const double mag1 = exp(lr * dt), abr = mag1 * cos(li * dt), abi = mag1 * sin(li * dt), den = lr * lr + li * li;
            const double cfr = ((abr - 1.0) * lr + abi * li) / den, cfi = (abi * lr - (abr - 1.0) * li) / den;
            const double magd = exp(lr * dt * d), wr = magd * cos(li * dt * d), wi = magd * sin(li * dt * d);
            sh[n] = (float)wr; sh[64 + n] = (float)wi; sh[128 + n] = (float)(wr * cfr - wi * cfi); sh[192 + n] = (float)(wr * cfi + wi * cfr);
            if (d == 64) { float* a64 = WSP(float, WS_A64) + ((size_t)(l * 16 + g) * 64 + n) * 2; a64[0] = (float)wr; a64[1] = (float)wi; } }
        __syncthreads();
        const float* cre = c.in[I_CRE] + (size_t)(l * 16 + g) * 16 * 64; const float* cim = c.in[I_CIM] + (size_t)(l * 16 + g) * 16 * 64;
        const float* bre = c.in[I_BRE] + (size_t)(l * 16 + g) * 64 * 16; const float* bim = c.in[I_BIM] + (size_t)(l * 16 + g) * 64 * 16;
        if (d < 64 && c.tid < 256) { const int p = c.tid >> 4, pp = c.tid & 15; float s = 0.f;
            for (int n = 0; n < 64; ++n) { const float wcr = sh[128 + n], wci = sh[192 + n], br = bre[n * 16 + pp], bi = bim[n * 16 + pp];
                const float xr = wcr * br - wci * bi, xi = wcr * bi + wci * br; s += cre[p * 64 + n] * xr - cim[p * 64 + n] * xi; }
            if (d == 0 && p == pp) s += c.in[I_S5D][l * 256 + g * 16 + p];
            WSP(float, WS_KERN)[(((size_t)(l * 16 + g) * 64 + d) * 16 + p) * 16 + pp] = s; }
        if (d < 64) { const int j = 63 - d; bf16_t* bm = WSP(bf16_t, WS_BM) + (size_t)(l * 16 + g) * 128 * 1024;
#pragma unroll
            for (int e = 0; e < 4; ++e) { const int idx = c.tid * 4 + e, row = idx >> 4, pp = idx & 15, n = row >> 1, ri = row & 1;
                const float wcr = sh[128 + n], wci = sh[192 + n], br = bre[n * 16 + pp], bi = bim[n * 16 + pp];
                const float val = ri ? (wcr * bi + wci * br) : (wcr * br - wci * bi);
                bm[(size_t)row * 1024 + j * 16 + pp] = (bf16_t)f2bf(val); } }
        if (d >= 1) { const int tau = d - 1; bf16_t* cm = WSP(bf16_t, WS_CM) + (size_t)(l * 16 + g) * 1024 * 128;
#pragma unroll
            for (int e = 0; e < 4; ++e) { const int idx = c.tid * 4 + e, p = idx >> 7, q = idx & 127, n = q >> 1, ri = q & 1;
                const float wr = sh[n], wi = sh[64 + n], cr = cre[p * 64 + n], ci = cim[p * 64 + n];
                const float val = ri ? -(cr * wi + ci * wr) : (cr * wr - ci * wi);
                cm[(size_t)(tau * 16 + p) * 128 + q] = (bf16_t)f2bf(val); } }
        __syncthreads();
    }
}

__device__ __forceinline__ void ph_B_texpand(const Ctx& c, int l) {
    bf16_t* TT = WSP(bf16_t, WS_TT);
    const float* KERN = WSP(float, WS_KERN) + (size_t)l * 16 * 64 * 256;
    const bf16_t* CM = WSP(bf16_t, WS_CM) + (size_t)l * 16 * 1024 * 128;
    for (int it = c.bid; it < 16 * 64; it += c.G) {
        const int g = it >> 6, tau = it & 63;
        for (int e = c.tid; e < 16 * (U2LD / 8); e += NTHR) {
            const int p = e / (U2LD / 8), c8 = (e % (U2LD / 8)) * 8; u32x4 w;
            if (c8 < 1024) { const int j = c8 >> 4, pp0 = c8 & 15;
                if (j <= tau) { const float* k = KERN + (((size_t)g * 64 + (tau - j)) * 16 + p) * 16 + pp0; w.x = pk2(k[0], k[1]); w.y = pk2(k[2], k[3]); w.z = pk2(k[4], k[5]); w.w = pk2(k[6], k[7]); }
                else w = (u32x4){0u, 0u, 0u, 0u}; }
            else w = *(const u32x4*)(CM + ((size_t)(g * 1024 + tau * 16 + p)) * 128 + (c8 - 1024));
            *(u32x4*)(TT + ((size_t)(g * 1024 + tau * 16 + p)) * U2LD + c8) = w; }
    }
}
__device__ __forceinline__ void split3(float F, unsigned& hi, unsigned& mid, unsigned& lo) { hi = f2bf(F); float r = F - bf2f(hi); mid = f2bf(r); r -= bf2f(mid); lo = f2bf(r); }
__device__ __forceinline__ void ph_B_gatescan(const Ctx& c) {
    float* sh = (float*)c.lds;
    const float* GT = WSP(float, WS_GT);
    for (int it = c.bid; it < NB * 4; it += c.G) {
        const int b = it >> 2, h = it & 3; const size_t m0 = (size_t)b * SEQ + c.tid * 8;
        float ls[8]; float run = 0.f;
#pragma unroll
        for (int i = 0; i < 8; ++i) { run += log_sigmoidf_(GT[(m0 + i) * 16 + h]); ls[i] = run; }
        __syncthreads(); sh[c.tid] = run; __syncthreads();
        if (c.tid == 0) { float a = 0.f; for (int i = 0; i < NTHR; ++i) { const float t = sh[i]; sh[i] = a; a += t; } }
        __syncthreads();
        const float off = sh[c.tid];
#pragma unroll
        for (int i = 0; i < 8; ++i) { const float F = (off + ls[i]) * LOG2E; const size_t m = m0 + i;
            WSP(float, WS_FCUM)[m * 4 + h] = F;
            unsigned hi, mid, lo; split3(F, hi, mid, lo); const unsigned one = 0x3f80u;
            u32x4 q0, q1 = (u32x4){0u, 0u, 0u, 0u}, k0;
            q0.x = hi | (mid << 16); q0.y = lo | (one << 16); q0.z = one | (one << 16); q0.w = 0u;
            k0.x = one | (one << 16); k0.y = one | ((hi ^ 0x8000u) << 16); k0.z = (mid ^ 0x8000u) | ((lo ^ 0x8000u) << 16); k0.w = 0u;
            u32x4* fq = (u32x4*)(WSP(bf16_t, WS_FQ) + (m * 4 + h) * 16); fq[0] = q0; fq[1] = q1;
            u32x4* fk = (u32x4*)(WSP(bf16_t, WS_FK) + (m * 4 + h) * 16); fk[0] = k0; fk[1] = q1; }
        __syncthreads();
    }
}
__device__ __forceinline__ void hg_gate(float z, float lb, float& logf, float& kk) {
    logf = log_sigmoidf_(z) + log1pf(lb * __expf(fminf(-z, 60.f)));
    kk = (1.f - lb) * sigmoidf_(-z);
}
__device__ __forceinline__ float hg_lb(const Ctx& c, int l, int ch) {
    if (l == 0) return 0.f;
    const float a = c.in[I_LB][ch], b = c.in[I_LB][256 + ch]; return fmaxf(1.f / (1.f + __expf(a - b)), 0.f);
}
__device__ __forceinline__ void ph_B_hgrn_local_naive(const Ctx& c, int l) {
    float* lg = (float*)c.lds; float* kk = lg + 4096; float* vv = kk + 4096;
    const bf16_t* P = WSP(bf16_t, WS_PACT);
    const int t = c.tid >> 3, c0 = (c.tid & 7) * 8;
    for (int u = c.bid; u < NUNIT; u += c.G) {
        const int bh = u >> 6, ch = u & 63, b = bh >> 2, h = bh & 3; const size_t m = (size_t)b * SEQ + ch * 64 + t;
        { float z[8], v[8]; unpack8(*(const u32x4*)(P + m * PW + PC_HGF + h * 64 + c0), z); unpack8(*(const u32x4*)(P + m * PW + PC_HGI + h * 64 + c0), v);
#pragma unroll
          for (int i = 0; i < 8; ++i) { float lf, k; hg_gate(z[i], hg_lb(c, l, h * 64 + c0 + i), lf, k); lg[t * 64 + c0 + i] = lf; kk[t * 64 + c0 + i] = k; vv[t * 64 + c0 + i] = v[i]; } }
        __syncthreads();
        if (c.tid < 64) { float a = 0.f; for (int s = 0; s < 64; ++s) { a += lg[s * 64 + c.tid]; lg[s * 64 + c.tid] = a; } }
        __syncthreads();
#pragma unroll
        for (int i = 0; i < 8; ++i) kk[t * 64 + c0 + i] *= __expf(lg[63 * 64 + c0 + i] - lg[t * 64 + c0 + i]);
        __syncthreads();
        { const int vd = t; float acc[8];
#pragma unroll
          for (int i = 0; i < 8; ++i) acc[i] = 0.f;
          for (int s = 0; s < 64; ++s) { const float v = vv[s * 64 + vd];
#pragma unroll
              for (int i = 0; i < 8; ++i) acc[i] += v * kk[s * 64 + c0 + i]; }
          float* o = WSP(float, WS_HSLOC) + ((size_t)u * 64 + vd) * 64 + c0; *(f32x4*)o = (f32x4){acc[0], acc[1], acc[2], acc[3]}; *(f32x4*)(o + 4) = (f32x4){acc[4], acc[5], acc[6], acc[7]}; }
        if (c.tid < 64) WSP(float, WS_HDEC)[(size_t)u * 64 + c.tid] = __expf(lg[63 * 64 + c.tid]);
        __syncthreads();
    }
}
__device__ __forceinline__ void ml_conv8(const Ctx& c, int l, const bf16_t* P, size_t m, int spos, int pcol, int wch, float (&o)[8]) {
    const float* cw = c.in[I_CONV] + (size_t)l * 4 * 512;
#pragma unroll
    for (int i = 0; i < 8; ++i) o[i] = 0.f;
#pragma unroll
    for (int j = 0; j < 4; ++j) { const int dt = 3 - j; if (spos - dt >= 0) { float x[8]; unpack8(*(const u32x4*)(P + (m - dt) * PW + pcol), x);
#pragma unroll
            for (int i = 0; i < 8; ++i) o[i] += cw[j * 512 + wch + i] * x[i]; } }
#pragma unroll
    for (int i = 0; i < 8; ++i) o[i] = siluf_(o[i]);
}
__device__ __forceinline__ void ph_B_mlstm_local_naive(const Ctx& c, int l) {
    float* kh = (float*)c.lds; float* vv = kh + 4096; float* bb = vv + 4096; float* ig = bb + 64;
    const bf16_t* P = WSP(bf16_t, WS_PACT); const float* GT = WSP(float, WS_GT);
    const int t = c.tid >> 3, c0 = (c.tid & 7) * 8;
    for (int u = c.bid; u < NUNIT; u += c.G) {
        const int bh = u >> 6, ch = u & 63, b = bh >> 2, h = bh & 3; const size_t m = (size_t)b * SEQ + ch * 64 + t;
        if (c.tid < 64) { const size_t mm = (size_t)b * SEQ + ch * 64 + c.tid; bb[c.tid] = log_sigmoidf_(GT[mm * 16 + 8 + h]); ig[c.tid] = GT[mm * 16 + 4 + h]; }
        __syncthreads();
        if (c.tid == 0) { float a = 0.f; for (int s = 0; s < 64; ++s) { a += bb[s]; bb[s] = a; } }
        __syncthreads();
        { float k[8], v[8]; ml_conv8(c, l, P, m, ch * 64 + t, PC_MLK + h * 64 + c0, 256 + h * 64 + c0, k); unpack8(*(const u32x4*)(P + m * PW + PC_MLV + h * 64 + c0), v);
          const float w = 0.125f * __expf(bb[63] - bb[t] + ig[t]);
#pragma unroll
          for (int i = 0; i < 8; ++i) { kh[t * 64 + c0 + i] = k[i] * w; vv[t * 64 + c0 + i] = v[i]; } }
        __syncthreads();
        for (int vd = t; vd < 65; vd += 64) { float acc[8];
#pragma unroll
            for (int i = 0; i < 8; ++i) acc[i] = 0.f;
            for (int s = 0; s < 64; ++s) { const float v = (vd < 64) ? vv[s * 64 + vd] : 1.f;
#pragma unroll
                for (int i = 0; i < 8; ++i) acc[i] += v * kh[s * 64 + c0 + i]; }
            float* o = WSP(float, WS_MSLOC) + ((size_t)u * 65 + vd) * 64 + c0; *(f32x4*)o = (f32x4){acc[0], acc[1], acc[2], acc[3]}; *(f32x4*)(o + 4) = (f32x4){acc[4], acc[5], acc[6], acc[7]}; }
        if (c.tid == 0) WSP(float, WS_MDEC)[u] = __expf(bb[63]);
        __syncthreads();
    }
}

__device__ __forceinline__ void ph_C_scans(const Ctx& c, int l) {
    const int gt = c.bid * NTHR + c.tid, NGT = c.G * NTHR;
    { const float* XL = WSP(float, WS_XLOC); bf16_t* U2 = WSP(bf16_t, WS_U2); const float* A64 = WSP(float, WS_A64) + (size_t)l * 16 * 64 * 2;
      for (int i = gt; i < 16 * NB * 64; i += NGT) { const int n = i & 63, b = (i >> 6) & 7, g = i >> 9; const float ar = A64[(g * 64 + n) * 2], ai = A64[(g * 64 + n) * 2 + 1]; float xr = 0.f, xi = 0.f;
          for (int ch = 0; ch < NCH; ++ch) { const size_t row = (size_t)g * NCHT + b * NCH + ch;
              *(unsigned*)(U2 + row * U2LD + 1024 + 2 * n) = pk2(xr, xi);
              const float lr = XL[row * 128 + 2 * n], li = XL[row * 128 + 2 * n + 1]; const float nr = ar * xr - ai * xi + lr, ni = ar * xi + ai * xr + li; xr = nr; xi = ni; } } }
    { const float* SL = WSP(float, WS_HSLOC); const float* DC = WSP(float, WS_HDEC); bf16_t* SP = WSP(bf16_t, WS_HSPREV);
      for (int i = gt; i < 32 * 64 * 32; i += NGT) { const int k2 = (i & 31) * 2, vd = (i >> 5) & 63, bh = i >> 11; float s0 = 0.f, s1 = 0.f;
          for (int ch = 0; ch < NCH; ++ch) { const size_t u = (size_t)bh * 64 + ch, o = (u * 64 + vd) * 64 + k2;
              *(unsigned*)(SP + o) = pk2(s0, s1);
              s0 = DC[u * 64 + k2] * s0 + SL[o]; s1 = DC[u * 64 + k2 + 1] * s1 + SL[o + 1]; } } }
    { const float* SL = WSP(float, WS_MSLOC); const float* DC = WSP(float, WS_MDEC); bf16_t* SP = WSP(bf16_t, WS_MSPREV);
      for (int i = gt; i < 32 * 65 * 32; i += NGT) { const int k2 = (i & 31) * 2, vd = (i >> 5) % 65, bh = (i >> 5) / 65; float s0 = 0.f, s1 = 0.f;
          for (int ch = 0; ch < NCH; ++ch) { const size_t u = (size_t)bh * 64 + ch;
              *(unsigned*)(SP + (u * 80 + vd) * 64 + k2) = pk2(s0, s1);
              const float d = DC[u]; const size_t o = (u * 65 + vd) * 64 + k2; s0 = d * s0 + SL[o]; s1 = d * s1 + SL[o + 1]; } } }
}
__device__ __forceinline__ void ph_C_fox_naive(const Ctx& c) {
    const bf16_t* P = WSP(bf16_t, WS_PACT); const float* FC = WSP(float, WS_FCUM); bf16_t* Y = WSP(bf16_t, WS_XNY);
    const int gw = c.bid * 8 + c.wave, NGW = c.G * 8;
    for (int r = gw; r < NB * 4 * SEQ; r += NGW) {
        const int q = r % SEQ, bh = r / SEQ, b = bh >> 2, h = bh & 3; const size_t m0 = (size_t)b * SEQ, mq = m0 + q;
        const float qv = bf2f(P[mq * PW + PC_FXQ + h * 64 + c.lane]); const float Fq = FC[mq * 4 + h];
        float mx = -INFINITY, lsum = 0.f, acc = 0.f;
        for (int kv = 0; kv <= q; ++kv) { const size_t mk = m0 + kv;
            const float s = wave_sum(qv * bf2f(P[mk * PW + PC_FXK + h * 64 + c.lane])) + (Fq - FC[mk * 4 + h]);
            const float mn = fmaxf(mx, s), al = exp2f(mx - mn), p = exp2f(s - mn);
            lsum = lsum * al + p; acc = acc * al + p * bf2f(P[mk * PW + PC_FXV + h * 64 + c.lane]); mx = mn; }
        const float o = acc / lsum; const float rstd = rsqrtf(wave_sum(o * o) * (1.f / 64.f) + EPS);
        Y[mq * DM + 512 + h * 64 + c.lane] = (bf16_t)f2bf(o * rstd);
    }
}


typedef float f32x16 __attribute__((ext_vector_type(16)));
typedef short s16x4 __attribute__((ext_vector_type(4)));
typedef float f32x2_t __attribute__((ext_vector_type(2)));
typedef __bf16 bf16x2_t __attribute__((ext_vector_type(2)));
__device__ __forceinline__ unsigned cvtpk(float lo, float hi) { f32x2_t v = {lo, hi}; bf16x2_t b = __builtin_convertvector(v, bf16x2_t); return __builtin_bit_cast(unsigned, b); }
__device__ __forceinline__ int crow(int r, int hi) { return (r & 3) + 8 * (r >> 2) + 4 * hi; }
__device__ __forceinline__ s16x4 ds_tr16(LAS const unsigned char* p) { return __builtin_bit_cast(s16x4, __builtin_amdgcn_ds_read_tr16_b64_v4i16((LAS s16x4*)p)); }
__device__ __forceinline__ void ph_C_fox_fast(const Ctx& c) {
    constexpr int KST = 176, VST = 192, KB = 64 * KST, VB = 64 * VST, BUF = KB + VB;
    LAS unsigned char* L = c.lds3;
    const bf16_t* P = WSP(bf16_t, WS_PACT); const bf16_t* FQ = WSP(bf16_t, WS_FQ); const bf16_t* FK = WSP(bf16_t, WS_FK); bf16_t* Y = WSP(bf16_t, WS_XNY);
    const int tid = c.tid, lane = c.lane, wave = c.wave, r32 = lane & 31, hi = lane >> 5;
    const int vcu = (c.G % 8 == 0) ? (c.bid % 8) * (c.G / 8) + c.bid / 8 : c.bid;
    const int srow = tid >> 3, sch = tid & 7;
    for (int pi = vcu; pi < 256; pi += c.G) {
        const int bh = pi >> 3, sx = pi & 7, b = bh >> 2, h = bh & 3; const size_t m0 = (size_t)b * SEQ;
#pragma unroll 1
        for (int kk = 0; kk < 2; ++kk) {
            const int qb = kk ? 15 - sx : sx, q0 = qb * 256 + wave * 32, NT = 4 * (qb + 1); const size_t mq = m0 + q0 + r32;
            bf16x8 qf[5];
#pragma unroll
            for (int s = 0; s < 4; ++s) qf[s] = *(const bf16x8*)(P + mq * PW + PC_FXQ + h * 64 + 16 * s + 8 * hi);
            qf[4] = *(const bf16x8*)(FQ + (mq * 4 + h) * 16 + 8 * hi);
            const bf16_t* ksrc = P + (m0 + srow) * PW + PC_FXK + h * 64 + sch * 8;
            const bf16_t* vsrc = P + (m0 + srow) * PW + PC_FXV + h * 64 + sch * 8;
            const bf16_t* fsrc = FK + ((m0 + (tid >> 1)) * 4 + h) * 16 + (tid & 1) * 8;
            u32x4 kreg = *(const u32x4*)ksrc, vreg = *(const u32x4*)vsrc, freg = (u32x4){0u, 0u, 0u, 0u};
            if (tid < 128) freg = *(const u32x4*)fsrc;
            *(LAS u32x4*)(L + srow * KST + sch * 16) = kreg; *(LAS u32x4*)(L + KB + srow * VST + sch * 16) = vreg;
            if (tid < 128) *(LAS u32x4*)(L + (tid >> 1) * KST + 128 + (tid & 1) * 16) = freg;
            __syncthreads();
            float m_run = -INFINITY, l_run = 0.f; f32x16 o0 = {}, o1 = {};
            for (int t = 0; t < NT; ++t) {
                const bool more = (t + 1 < NT);
                if (more) { const size_t off = (size_t)(t + 1) * 64 * PW; kreg = *(const u32x4*)(ksrc + off); vreg = *(const u32x4*)(vsrc + off); if (tid < 128) freg = *(const u32x4*)(fsrc + (size_t)(t + 1) * 64 * 64); }
                if (t * 64 <= q0 + 31) {
                    LAS const unsigned char* KL = L + (t & 1) * BUF; LAS const unsigned char* VL = KL + KB;
                    f32x16 p0 = {}, p1 = {};
#pragma unroll
                    for (int s = 0; s < 5; ++s) { const bf16x8 a0 = *(LAS const bf16x8*)(KL + r32 * KST + s * 32 + hi * 16), a1 = *(LAS const bf16x8*)(KL + (32 + r32) * KST + s * 32 + hi * 16);
                        p0 = __builtin_amdgcn_mfma_f32_32x32x16_bf16(a0, qf[s], p0, 0, 0, 0); p1 = __builtin_amdgcn_mfma_f32_32x32x16_bf16(a1, qf[s], p1, 0, 0, 0); }
                    if (t * 64 + 63 > q0) { const int qg = q0 + r32;
#pragma unroll
                        for (int r = 0; r < 16; ++r) { const int kv = t * 64 + crow(r, hi); if (kv > qg) p0[r] = -INFINITY; if (kv + 32 > qg) p1[r] = -INFINITY; } }
                    float mx = fmaxf(p0[0], p1[0]);
#pragma unroll
                    for (int r = 1; r < 16; ++r) mx = fmaxf(mx, fmaxf(p0[r], p1[r]));
                    mx = fmaxf(mx, __shfl_xor(mx, 32));
                    const float mn = fmaxf(m_run, mx), alpha = __builtin_amdgcn_exp2f(m_run - mn); m_run = mn;
                    float rs = 0.f;
#pragma unroll
                    for (int r = 0; r < 16; ++r) { p0[r] = __builtin_amdgcn_exp2f(p0[r] - mn); p1[r] = __builtin_amdgcn_exp2f(p1[r] - mn); rs += p0[r] + p1[r]; }
                    l_run = l_run * alpha + rs;
#pragma unroll
                    for (int r = 0; r < 16; ++r) { o0[r] *= alpha; o1[r] *= alpha; }
                    u32x4 pw[2][2];
#pragma unroll
                    for (int s = 0; s < 2; ++s) { pw[0][s] = (u32x4){cvtpk(p0[8 * s], p0[8 * s + 1]), cvtpk(p0[8 * s + 2], p0[8 * s + 3]), cvtpk(p0[8 * s + 4], p0[8 * s + 5]), cvtpk(p0[8 * s + 6], p0[8 * s + 7])};
                        pw[1][s] = (u32x4){cvtpk(p1[8 * s], p1[8 * s + 1]), cvtpk(p1[8 * s + 2], p1[8 * s + 3]), cvtpk(p1[8 * s + 4], p1[8 * s + 5]), cvtpk(p1[8 * s + 6], p1[8 * s + 7])}; }
                    LAS const unsigned char* vb = VL + (4 * hi + ((lane & 15) >> 2)) * VST + (((lane >> 4) & 1) * 16 + (lane & 3) * 4) * 2;
#pragma unroll
                    for (int blk = 0; blk < 2; ++blk)
#pragma unroll
                        for (int s = 0; s < 2; ++s) {
#pragma unroll
                            for (int db = 0; db < 2; ++db) { LAS const unsigned char* a = vb + (blk * 32 + 16 * s) * VST + db * 64;
                                const s16x4 lo = ds_tr16(a), hh = ds_tr16(a + 8 * VST);
                                const bf16x8 vf = (bf16x8){lo[0], lo[1], lo[2], lo[3], hh[0], hh[1], hh[2], hh[3]};
                                if (db == 0) o0 = __builtin_amdgcn_mfma_f32_32x32x16_bf16(vf, __builtin_bit_cast(bf16x8, pw[blk][s]), o0, 0, 0, 0);
                                else o1 = __builtin_amdgcn_mfma_f32_32x32x16_bf16(vf, __builtin_bit_cast(bf16x8, pw[blk][s]), o1, 0, 0, 0); } }
                }
                if (more) { LAS unsigned char* D = L + ((t + 1) & 1) * BUF;
                    *(LAS u32x4*)(D + srow * KST + sch * 16) = kreg; *(LAS u32x4*)(D + KB + srow * VST + sch * 16) = vreg;
                    if (tid < 128) *(LAS u32x4*)(D + (tid >> 1) * KST + 128 + (tid & 1) * 16) = freg; }
                __syncthreads();
            }
            const float lt = l_run + __shfl_xor(l_run, 32), inv = 1.f / lt; float ss = 0.f;
#pragma unroll
            for (int r = 0; r < 16; ++r) { o0[r] *= inv; o1[r] *= inv; ss += o0[r] * o0[r] + o1[r] * o1[r]; }
            ss += __shfl_xor(ss, 32);
            const float rstd = rsqrtf(ss * (1.f / 64.f) + EPS);
            bf16_t* yr = Y + mq * DM + 512 + h * 64;
#pragma unroll
            for (int g4 = 0; g4 < 4; ++g4) { u32x2 w0, w1; const int d = 8 * g4 + 4 * hi;
                w0.x = cvtpk(o0[4 * g4] * rstd, o0[4 * g4 + 1] * rstd); w0.y = cvtpk(o0[4 * g4 + 2] * rstd, o0[4 * g4 + 3] * rstd);
                w1.x = cvtpk(o1[4 * g4] * rstd, o1[4 * g4 + 1] * rstd); w1.y = cvtpk(o1[4 * g4 + 2] * rstd, o1[4 * g4 + 3] * rstd);
                *(u32x2*)(yr + d) = w0; *(u32x2*)(yr + 32 + d) = w1; }
        }
    }
}

__device__ __forceinline__ void ph_D_hgrn_out_naive(const Ctx& c, int l) {
    float* qq = (float*)c.lds; float* kk = qq + 4096; float* bc = kk + 4096; float* vv = bc + 4096; float* sp = vv + 4096; float* sc = sp + 4096;
    const bf16_t* P = WSP(bf16_t, WS_PACT); const bf16_t* SP = WSP(bf16_t, WS_HSPREV); bf16_t* Y = WSP(bf16_t, WS_XNY);
    const int t = c.tid >> 3, c0 = (c.tid & 7) * 8;
    for (int u = c.bid; u < NUNIT; u += c.G) {
        const int bh = u >> 6, ch = u & 63, b = bh >> 2, h = bh & 3; const size_t m = (size_t)b * SEQ + ch * 64 + t;
        { float z[8], v[8], q[8], s[8]; unpack8(*(const u32x4*)(P + m * PW + PC_HGF + h * 64 + c0), z); unpack8(*(const u32x4*)(P + m * PW + PC_HGI + h * 64 + c0), v);
          unpack8(*(const u32x4*)(P + m * PW + PC_HGQ + h * 64 + c0), q); unpack8(*(const u32x4*)(SP + ((size_t)u * 64 + t) * 64 + c0), s);
#pragma unroll
          for (int i = 0; i < 8; ++i) { float lf, k; hg_gate(z[i], hg_lb(c, l, h * 64 + c0 + i), lf, k); bc[t * 64 + c0 + i] = lf; kk[t * 64 + c0 + i] = k; vv[t * 64 + c0 + i] = v[i]; qq[t * 64 + c0 + i] = q[i];
              sp[(c0 + i) * 64 + t] = s[i]; } }
        __syncthreads();
        if (c.tid < 64) { float a = 0.f; for (int s = 0; s < 64; ++s) { a += bc[s * 64 + c.tid]; bc[s * 64 + c.tid] = a; } }
        __syncthreads();
#pragma unroll
        for (int i = 0; i < 8; ++i) { const int s = c0 + i; float a = 0.f;
            if (s <= t) for (int kd = 0; kd < 64; ++kd) a += qq[t * 64 + kd] * kk[s * 64 + kd] * __expf(bc[t * 64 + kd] - bc[s * 64 + kd]);
            sc[t * 65 + s] = a; }
        __syncthreads();
        float o[8];
#pragma unroll
        for (int i = 0; i < 8; ++i) o[i] = 0.f;
        for (int s = 0; s <= t; ++s) { const float w = sc[t * 65 + s];
#pragma unroll
            for (int i = 0; i < 8; ++i) o[i] += w * vv[s * 64 + c0 + i]; }
        for (int kd = 0; kd < 64; ++kd) { const float w = qq[t * 64 + kd] * __expf(bc[t * 64 + kd]);
#pragma unroll
            for (int i = 0; i < 8; ++i) o[i] += w * sp[kd * 64 + c0 + i]; }
        float ss = 0.f;
#pragma unroll
        for (int i = 0; i < 8; ++i) ss += o[i] * o[i];
        ss += __shfl_xor(ss, 1); ss += __shfl_xor(ss, 2); ss += __shfl_xor(ss, 4);
        const float rstd = rsqrtf(ss * (1.f / 64.f) + EPS);
        float g[8]; unpack8(*(const u32x4*)(P + m * PW + PC_HGG + h * 64 + c0), g);
#pragma unroll
        for (int i = 0; i < 8; ++i) o[i] = o[i] * rstd * siluf_(g[i]);
        *(u32x4*)(Y + m * DM + 256 + h * 64 + c0) = pack8(o);
        __syncthreads();
    }
}
__device__ __forceinline__ void ph_D_mlstm_out_naive(const Ctx& c, int l) {
    float* qq = (float*)c.lds; float* kk = qq + 4096; float* vv = kk + 4096; float* cp = vv + 4096; float* sc = cp + 4096; float* np = sc + 64 * 65; float* bb = np + 64; float* ig = bb + 64;
    const bf16_t* P = WSP(bf16_t, WS_PACT); const bf16_t* SP = WSP(bf16_t, WS_MSPREV); const float* GT = WSP(float, WS_GT); bf16_t* Y = WSP(bf16_t, WS_XNY);
    const int t = c.tid >> 3, c0 = (c.tid & 7) * 8;
    for (int u = c.bid; u < NUNIT; u += c.G) {
        const int bh = u >> 6, ch = u & 63, b = bh >> 2, h = bh & 3; const size_t m = (size_t)b * SEQ + ch * 64 + t;
        if (c.tid < 64) { const size_t mm = (size_t)b * SEQ + ch * 64 + c.tid; bb[c.tid] = log_sigmoidf_(GT[mm * 16 + 8 + h]); ig[c.tid] = GT[mm * 16 + 4 + h]; np[c.tid] = bf2f(SP[((size_t)u * 80 + 64) * 64 + c.tid]); }
        { float q[8], k[8], v[8], s[8]; ml_conv8(c, l, P, m, ch * 64 + t, PC_MLQ + h * 64 + c0, h * 64 + c0, q); ml_conv8(c, l, P, m, ch * 64 + t, PC_MLK + h * 64 + c0, 256 + h * 64 + c0, k);
          unpack8(*(const u32x4*)(P + m * PW + PC_MLV + h * 64 + c0), v); unpack8(*(const u32x4*)(SP + ((size_t)u * 80 + t) * 64 + c0), s);
#pragma unroll
          for (int i = 0; i < 8; ++i) { qq[t * 64 + c0 + i] = q[i]; kk[t * 64 + c0 + i] = k[i] * 0.125f; vv[t * 64 + c0 + i] = v[i]; cp[(c0 + i) * 64 + t] = s[i]; } }
        __syncthreads();
        if (c.tid == 0) { float a = 0.f; for (int s = 0; s < 64; ++s) { a += bb[s]; bb[s] = a; } }
        __syncthreads();
#pragma unroll
        for (int i = 0; i < 8; ++i) { const int s = c0 + i; float a = 0.f;
            if (s <= t) { for (int kd = 0; kd < 64; ++kd) a += qq[t * 64 + kd] * kk[s * 64 + kd]; a *= __expf(bb[t] - bb[s] + ig[s]); }
            sc[t * 65 + s] = a; }
        __syncthreads();
        float o[8]; float den = 0.f;
#pragma unroll
        for (int i = 0; i < 8; ++i) o[i] = 0.f;
        for (int s = 0; s <= t; ++s) { const float w = sc[t * 65 + s]; den += w;
#pragma unroll
            for (int i = 0; i < 8; ++i) o[i] += w * vv[s * 64 + c0 + i]; }
        const float eb = __expf(bb[t]);
        for (int kd = 0; kd < 64; ++kd) { const float w = qq[t * 64 + kd] * eb; den += w * np[kd];
#pragma unroll
            for (int i = 0; i < 8; ++i) o[i] += w * cp[kd * 64 + c0 + i]; }
        const float inv = 1.f / fmaxf(fabsf(den), 1.f);
        float ss = 0.f;
#pragma unroll
        for (int i = 0; i < 8; ++i) { o[i] *= inv; ss += o[i] * o[i]; }
        ss += __shfl_xor(ss, 1); ss += __shfl_xor(ss, 2); ss += __shfl_xor(ss, 4);
        const float rstd = rsqrtf(ss * (1.f / 64.f) + EPS);
        float g[8]; unpack8(*(const u32x4*)(P + m * PW + PC_MLO + h * 64 + c0), g);
#pragma unroll
        for (int i = 0; i < 8; ++i) o[i] = o[i] * rstd * sigmoidf_(g[i]);
        *(u32x4*)(Y + m * DM + 768 + h * 64 + c0) = pack8(o);
        __syncthreads();
    }
}

__device__ __forceinline__ void ph_E_glu_naive(const Ctx& c, int l) {
    float* g1 = (float*)c.lds;
    bf16_t* wl = (bf16_t*)(g1 + 64 * 256);
    const bf16_t* G1 = WSP(bf16_t, WS_G1); const bf16_t* WT = WSP(bf16_t, WS_WGLU) + (size_t)l * 256 * 256; bf16_t* Y = WSP(bf16_t, WS_XNY);
    const int t = c.tid >> 3, j8 = c.tid & 7;
    for (int u = c.bid; u < MTOK / 64; u += c.G) {
        const size_t m0 = (size_t)u * 64;
        for (int e = c.tid; e < 64 * 32; e += NTHR) { const int r = e >> 5, c8 = (e & 31) * 8; float v[8]; unpack8(*(const u32x4*)(G1 + (m0 + r) * 256 + c8), v);
#pragma unroll
            for (int i = 0; i < 8; ++i) g1[r * 256 + c8 + i] = v[i]; }
        float yv[32]; float ss = 0.f;
#pragma unroll
        for (int hf = 0; hf < 2; ++hf) {
            __syncthreads();
            for (int e = c.tid; e < 128 * 32; e += NTHR) { const int r = e >> 5, c8 = (e & 31) * 8; *(u32x4*)(wl + r * 264 + c8) = *(const u32x4*)(WT + (size_t)(hf * 128 + r) * 256 + c8); }
            __syncthreads();
#pragma unroll
            for (int i = 0; i < 16; ++i) { const int nl = j8 * 16 + i; float a = 0.f;
                for (int k = 0; k < 256; k += 2) { const unsigned w = *(const unsigned*)(wl + nl * 264 + k); a += g1[t * 256 + k] * bf2f(w & 0xffffu) + g1[t * 256 + k + 1] * bf2f(w >> 16); }
                const float g = g1[t * 256 + hf * 128 + nl]; const float y = g * sigmoidf_(a); yv[hf * 16 + i] = y; ss += y * y; }
        }
        ss += __shfl_xor(ss, 1); ss += __shfl_xor(ss, 2); ss += __shfl_xor(ss, 4);
        const float rstd = rsqrtf(ss * (1.f / 256.f) + EPS);
#pragma unroll
        for (int hf = 0; hf < 2; ++hf)
#pragma unroll
            for (int i8 = 0; i8 < 2; ++i8) { float o[8];
#pragma unroll
                for (int i = 0; i < 8; ++i) o[i] = yv[hf * 16 + i8 * 8 + i] * rstd;
                *(u32x4*)(Y + (m0 + t) * DM + hf * 128 + j8 * 16 + i8 * 8) = pack8(o); }
        __syncthreads();
    }
}

__device__ __forceinline__ void ph_rowpass(const Ctx& c, const float* hprev, const float* gpost, float* hout, bf16_t* xn) {
    const bf16_t* MX = WSP(bf16_t, WS_MX);
    const int gw = c.bid * 8 + c.wave, NGW = c.G * 8;
    for (int m = gw; m < MTOK; m += NGW) {
        const u32x2* mr = (const u32x2*)(MX + (size_t)m * DM) + c.lane; const f32x4* hr = (const f32x4*)(hprev + (size_t)m * DM) + c.lane; const f32x4* gr = (const f32x4*)gpost + c.lane;
        f32x4 x[4], hv[4]; float s = 0.f;
#pragma unroll
        for (int j = 0; j < 4; ++j) { const u32x2 w = mr[64 * j]; x[j] = (f32x4){bf2f(w.x & 0xffffu), bf2f(w.x >> 16), bf2f(w.y & 0xffffu), bf2f(w.y >> 16)}; hv[j] = hr[64 * j];
            s += (x[j].x * x[j].x + x[j].y * x[j].y) + (x[j].z * x[j].z + x[j].w * x[j].w); }
        const float r1 = rsqrtf(wave_sum(s) * (1.f / DM) + EPS); float s2 = 0.f;
#pragma unroll
        for (int j = 0; j < 4; ++j) { const f32x4 g = gr[64 * j]; hv[j] = hv[j] + x[j] * r1 * g; s2 += (hv[j].x * hv[j].x + hv[j].y * hv[j].y) + (hv[j].z * hv[j].z + hv[j].w * hv[j].w); }
        f32x4* ho = (f32x4*)(hout + (size_t)m * DM) + c.lane;
#pragma unroll
        for (int j = 0; j < 4; ++j) ho[64 * j] = hv[j];
        if (xn) { const float r2 = rsqrtf(wave_sum(s2) * (1.f / DM) + EPS); u32x2* o8 = (u32x2*)(xn + (size_t)m * DM) + c.lane;
#pragma unroll
            for (int j = 0; j < 4; ++j) { u32x2 w; w.x = pk2(hv[j].x * r2, hv[j].y * r2); w.y = pk2(hv[j].z * r2, hv[j].w * r2); o8[64 * j] = w; } }
    }
}


typedef GAS unsigned gu32;
#define XB_TMO      128
#define XB_XCNT(j)  (256  + 64 * (j))
#define XB_XSUB(j)  (1280 + 64 * (j))
#define XB_XGEN(j)  (2304 + 64 * (j))
#define XB_TOP      3328
#define XB_TOPGEN   3392
#define XCD_BAR_WORDS 3456
#define XB_SPIN_CAP (1u << 22)
constexpr int CW_BAR = 4096;
constexpr int MISC_OFF = LDS_BYTES - 256;
__device__ __forceinline__ unsigned xb_ld(unsigned* p)              { return __hip_atomic_load(p, __ATOMIC_RELAXED, __HIP_MEMORY_SCOPE_AGENT); }
__device__ __forceinline__ unsigned xb_add(unsigned* p, unsigned v) { return __hip_atomic_fetch_add(p, v, __ATOMIC_RELAXED, __HIP_MEMORY_SCOPE_AGENT); }
__device__ __forceinline__ unsigned xb_xcc_id() { return (unsigned)__builtin_amdgcn_s_getreg((3 << 11) | 20) & 0xFu; }
#define XB_SPIN(cond, bar) do { unsigned _sp = 0; while (cond) { __builtin_amdgcn_s_sleep(1); \
    if ((++_sp & 255u) == 0u) { if (xb_ld(&(bar)[XB_TMO])) break; if (_sp > XB_SPIN_CAP) { atomicAdd(&(bar)[XB_TMO], 1u); break; } } } } while (0)
struct XcdBarrier { unsigned* bar; unsigned x; volatile LAS unsigned* st; };
__device__ __forceinline__ XcdBarrier xcd_barrier_post(unsigned* bar, volatile LAS unsigned* st) {
    XcdBarrier b; b.bar = bar; b.x = xb_xcc_id(); b.st = st;
    if (threadIdx.x == 0) (void)xb_add(&bar[XB_XCNT(b.x)], 1u);
    return b;
}
__device__ __forceinline__ void xcd_barrier_complete(unsigned* bar, unsigned x, unsigned& nloc, unsigned& nx) {
    const unsigned G = gridDim.x * gridDim.y * gridDim.z;
    unsigned sum, cnt, mine, sp = 0u;
    for (;;) {
        sum = 0u; cnt = 0u; mine = 0u;
#pragma unroll
        for (unsigned j = 0; j < 16; ++j) { const unsigned c = xb_ld(&bar[XB_XCNT(j)]); sum += c; cnt += (c > 0u) ? 1u : 0u; mine = (j == x) ? c : mine; }
        if (sum == G) break;
        __builtin_amdgcn_s_sleep(1);
        if ((++sp & 255u) == 0u) { if (xb_ld(&bar[XB_TMO])) break; if (sp > XB_SPIN_CAP) { atomicAdd(&bar[XB_TMO], 1u); break; } }
    }
    nloc = mine > 0u ? mine : 1u; nx = cnt > 0u ? cnt : 1u;
}
__device__ __forceinline__ void xcd_barrier(const XcdBarrier& b) {
    asm volatile("s_waitcnt vmcnt(0)" ::: "memory");
    __syncthreads();
    if (threadIdx.x == 0) {
        unsigned* bar = b.bar;
        __builtin_amdgcn_s_waitcnt(0);
        unsigned nloc = b.st[0], nx = b.st[1];
        if (nloc == 0u) { xcd_barrier_complete(bar, b.x, nloc, nx); b.st[0] = nloc; b.st[1] = nx; }
        const unsigned old = xb_add(&bar[XB_XSUB(b.x)], 1u);
        const unsigned gen = old / nloc;
        if (old + 1u == (gen + 1u) * nloc) {
            __builtin_amdgcn_fence(__ATOMIC_RELEASE, "agent");
            asm volatile("s_waitcnt vmcnt(0)" ::: "memory");
            const unsigned og = xb_add(&bar[XB_TOP], 1u);
            const unsigned tg = og / nx;
            if (og + 1u == (tg + 1u) * nx) xb_add(&bar[XB_TOPGEN], 1u);
            else XB_SPIN(xb_ld(&bar[XB_TOPGEN]) == tg, bar);
            __builtin_amdgcn_fence(__ATOMIC_ACQUIRE, "agent");
            xb_add(&bar[XB_XGEN(b.x)], 1u);
            asm volatile("s_waitcnt vmcnt(0)" ::: "memory");
        } else {
            XB_SPIN(xb_ld(&bar[XB_XGEN(b.x)]) == gen, bar);
            __builtin_amdgcn_fence(__ATOMIC_ACQUIRE, "agent");
            asm volatile("s_waitcnt vmcnt(0)" ::: "memory");
        }
    }
    __syncthreads();
}

struct Args { const float* in[23]; float* out; unsigned char* ws; int lo, hi; };
constexpr int NPHASE = 1 + 10 * DEPTH;

__global__ void __launch_bounds__(NTHR, 2) hybrid_fwd(Args args) {
    extern __shared__ __attribute__((aligned(16))) unsigned char lds_raw[];
    Ctx c;
#pragma unroll
    for (int i = 0; i < 23; ++i) c.in[i] = args.in[i];
    c.out = args.out; c.ws = args.ws; c.lds = lds_raw; c.lds3 = (LAS unsigned char*)lds_raw; c.tid = threadIdx.x; c.lane = c.tid & 63; c.wave = __builtin_amdgcn_readfirstlane(c.tid >> 6); c.G = gridDim.x; c.bid = blockIdx.x;
    const int lo = args.lo, hi = args.hi;
    volatile LAS unsigned* MISC = (volatile LAS unsigned*)(c.lds3 + MISC_OFF);
    if (c.tid < 64) MISC[c.tid] = 0u;
    __syncthreads();
    XcdBarrier gbar; gbar.bar = (unsigned*)(args.ws + WS_CTL) + CW_BAR; gbar.x = 0; gbar.st = nullptr;
    if (hi - lo > 1) gbar = xcd_barrier_post((unsigned*)(args.ws + WS_CTL) + CW_BAR, MISC + 8);
#define SEAM(k) do { if (IN(k) && IN((k) + 1)) xcd_barrier(gbar); } while (0)
#define IN(k) (lo <= (k) && (k) < hi)
#define FRESH() do { c.tid = opaque_v((int)threadIdx.x); c.lane = c.tid & 63; } while (0)
    if (IN(0)) { FRESH(); ph_prologue(c); }
    SEAM(0);
    for (int l = 0; l < DEPTH; ++l) {
        const int pb = 1 + 10 * l;
        if (IN(pb + 0)) {
            EpiInProj E{WSP(bf16_t, WS_U2), WSP(bf16_t, WS_PACT), WSP(float, WS_GT), c.in[I_GB] + l * 12};
#if USE_PG8
            { pg8::Gemm g{WSP(bf16_t, WS_XNY), WSP(bf16_t, WS_WIN) + (size_t)l * NIN * DM, DM, DM, DM, (size_t)256 * DM * 2, (size_t)256 * DM * 2};
              pg8::StaticOrder S; S.init(MTOK, NIN, c.G, c.bid); pg8::EpiWrap<EpiInProj, false> W{E};
              pg8::gemm_phase<pg8::EpiWrap<EpiInProj, false>, pg8::StaticOrder, true>(c.lds3, g, S, W); }
#else
            gemm_naive<false>(c, WSP(bf16_t, WS_XNY), DM, WSP(bf16_t, WS_WIN) + (size_t)l * NIN * DM, DM, DM,
                [](int t, int& r0, int& c0, int& b0) -> bool { if (t >= (MTOK / 64) * (NIN / 64)) return false; r0 = 64 * (t / (NIN / 64)); c0 = b0 = 64 * (t % (NIN / 64)); return true; }, E);
#endif
        }
        SEAM(pb + 0);
        if (IN(pb + 1)) {
            FRESH(); ph_B_texpand(c, l); FRESH(); ph_B_gatescan(c);
            { EpiXloc E{WSP(float, WS_XLOC)};
#if USE_PG8
              { pg8::Gemm g{WSP(bf16_t, WS_U2), WSP(bf16_t, WS_BM) + (size_t)l * 16 * 128 * 1024, U2LD, 1024, 1024, (size_t)256 * U2LD * 2, (size_t)128 * 1024 * 2};
                pg8::SchedXloc S{c.G, c.bid}; pg8::EpiWrap<EpiXloc, false> W{E};
                pg8::gemm_phase<pg8::EpiWrap<EpiXloc, false>, pg8::SchedXloc, false>(c.lds3, g, S, W); __syncthreads(); }
#else
              gemm_naive<false>(c, WSP(bf16_t, WS_U2), U2LD, WSP(bf16_t, WS_BM) + (size_t)l * 16 * 128 * 1024, 1024, 1024,
                [](int t, int& r0, int& c0, int& b0) -> bool { if (t >= 128 * 2) return false; const int rt = t >> 1, ct = t & 1, g = rt >> 3; r0 = 64 * rt; c0 = 256 * g + 64 * ct; b0 = g * 128 + 64 * ct; return true; }, E);
#endif
            }
            FRESH(); ph_B_hgrn_local_naive(c, l); FRESH(); ph_B_mlstm_local_naive(c, l);
        }
        SEAM(pb + 1);
        if (IN(pb + 2)) { FRESH(); ph_C_scans(c, l); FRESH();
#if FAST_FOX
            ph_C_fox_fast(c);
#else
            ph_C_fox_naive(c);
#endif
        }
        SEAM(pb + 2);
        if (IN(pb + 3)) {
            { EpiS5Y E{WSP(bf16_t, WS_G1)};
#if USE_PG8
              { pg8::Gemm g{WSP(bf16_t, WS_U2), WSP(bf16_t, WS_TT), U2LD, U2LD, U2LD, (size_t)256 * U2LD * 2, (size_t)256 * U2LD * 2};
                pg8::SchedS5Y S{c.G, c.bid}; pg8::EpiWrap<EpiS5Y, false> W{E};
                pg8::gemm_phase<pg8::EpiWrap<EpiS5Y, false>, pg8::SchedS5Y, false>(c.lds3, g, S, W); __syncthreads(); }
#else
              gemm_naive<false>(c, WSP(bf16_t, WS_U2), U2LD, WSP(bf16_t, WS_TT), U2LD, U2LD,
                [](int t, int& r0, int& c0, int& b0) -> bool { if (t >= 128 * 16) return false; const int rt = t >> 4, ct = t & 15, g = rt >> 3; r0 = 64 * rt; c0 = b0 = g * 1024 + 64 * ct; return true; }, E);
#endif
            }
            FRESH(); ph_D_hgrn_out_naive(c, l); FRESH(); ph_D_mlstm_out_naive(c, l);
        }
        SEAM(pb + 3);
        if (IN(pb + 4)) { FRESH(); ph_E_glu_naive(c, l); }
        SEAM(pb + 4);
        if (IN(pb + 5)) {
            EpiPlainBf16 E{WSP(bf16_t, WS_MX), DM};
#if USE_PG8
            { pg8::Gemm g{WSP(bf16_t, WS_XNY), WSP(bf16_t, WS_WOUT) + (size_t)l * DM * DM, DM, DM, DM, (size_t)256 * DM * 2, (size_t)256 * DM * 2};
              pg8::StaticOrder S; S.init(MTOK, DM, c.G, c.bid); pg8::EpiWrap<EpiPlainBf16, false> W{E};
              pg8::gemm_phase<pg8::EpiWrap<EpiPlainBf16, false>, pg8::StaticOrder, true>(c.lds3, g, S, W); }
#else
            gemm_naive<false>(c, WSP(bf16_t, WS_XNY), DM, WSP(bf16_t, WS_WOUT) + (size_t)l * DM * DM, DM, DM,
                [](int t, int& r0, int& c0, int& b0) -> bool { if (t >= (MTOK / 64) * 16) return false; r0 = 64 * (t >> 4); c0 = b0 = 64 * (t & 15); return true; }, E);
#endif
        }
        SEAM(pb + 5);
        if (IN(pb + 6)) { FRESH(); } if (IN(pb + 6)) ph_rowpass(c, l == 0 ? c.in[I_X] : c.out, c.in[I_LNMPOST] + l * DM, c.out, WSP(bf16_t, WS_XNY));
        SEAM(pb + 6);
        if (IN(pb + 7)) {
            EpiSwiGLU E{WSP(bf16_t, WS_PACT)};
#if USE_PG8
            { pg8::Gemm g{WSP(bf16_t, WS_XNY), WSP(bf16_t, WS_WGU) + (size_t)l * NGU * DM, DM, DM, DM, (size_t)256 * DM * 2, (size_t)256 * DM * 2};
              pg8::StaticOrder S; S.init(MTOK, NGU, c.G, c.bid); pg8::EpiWrap<EpiSwiGLU, true> W{E};
              pg8::gemm_phase<pg8::EpiWrap<EpiSwiGLU, true>, pg8::StaticOrder, true>(c.lds3, g, S, W); }
#else
            gemm_naive<true>(c, WSP(bf16_t, WS_XNY), DM, WSP(bf16_t, WS_WGU) + (size_t)l * NGU * DM, DM, DM,
                [](int t, int& r0, int& c0, int& b0) -> bool { if (t >= (MTOK / 64) * (DFF / 64)) return false; r0 = 64 * (t / (DFF / 64)); c0 = 64 * (t % (DFF / 64)); b0 = (c0 >> 7) * 256 + (c0 & 127); return true; }, E);
#endif
        }
        SEAM(pb + 7);
        if (IN(pb + 8)) {
            EpiPlainBf16 E{WSP(bf16_t, WS_MX), DM};
#if USE_PG8
            { pg8::Gemm g{WSP(bf16_t, WS_PACT), WSP(bf16_t, WS_WDN) + (size_t)l * DM * DFF, DFF, DFF, DFF, (size_t)256 * DFF * 2, (size_t)256 * DFF * 2};
              pg8::StaticOrder S; S.init(MTOK, DM, c.G, c.bid); pg8::EpiWrap<EpiPlainBf16, false> W{E};
              pg8::gemm_phase<pg8::EpiWrap<EpiPlainBf16, false>, pg8::StaticOrder, true>(c.lds3, g, S, W); }
#else
            gemm_naive<false>(c, WSP(bf16_t, WS_PACT), DFF, WSP(bf16_t, WS_WDN) + (size_t)l * DM * DFF, DFF, DFF,
                [](int t, int& r0, int& c0, int& b0) -> bool { if (t >= (MTOK / 64) * 16) return false; r0 = 64 * (t >> 4); c0 = b0 = 64 * (t & 15); return true; }, E);
#endif
        }
        SEAM(pb + 8);
        if (IN(pb + 9)) { FRESH(); } if (IN(pb + 9)) ph_rowpass(c, c.out, c.in[I_LNFPOST] + l * DM, c.out, (l + 1 < DEPTH) ? WSP(bf16_t, WS_XNY) : (bf16_t*)nullptr);
        SEAM(pb + 9);
    }
#undef IN
}

extern "C" void kernel_launch(void* const* d_in, const int* in_sizes, int n_in, void* d_out, int out_size, void* d_ws, size_t ws_size, hipStream_t stream) {
    static int grid = 0;
    if (grid == 0) {
        if (n_in != 23 || in_sizes[0] != MTOK * DM || out_size != MTOK * DM || ws_size < WS_END) {
            fprintf(stderr, "kernel_launch: unexpected shapes (n_in %d, in0 %d, out %d, ws %zu, need ws %zu); nothing launched\n", n_in, n_in > 0 ? in_sizes[0] : -1, out_size, ws_size, (size_t)WS_END); grid = -1; return; }
        int dev = 0, cus = 0;
        if (hipGetDevice(&dev) != hipSuccess || hipDeviceGetAttribute(&cus, hipDeviceAttributeMultiprocessorCount, dev) != hipSuccess) { grid = -1; return; }
        if (hipFuncSetAttribute((const void*)hybrid_fwd, hipFuncAttributeMaxDynamicSharedMemorySize, LDS_BYTES) != hipSuccess) { fprintf(stderr, "kernel_launch: hipFuncSetAttribute failed\n"); grid = -1; return; }
        grid = cus;
    }
    if (grid < 0) return;
    (void)hipMemsetAsync((char*)d_ws + WS_CTL, 0, CTL_BYTES, stream);
    Args a{};
    for (int i = 0; i < 23; ++i) a.in[i] = (const float*)d_in[i];
    a.out = (float*)d_out; a.ws = (unsigned char*)d_ws;
#if N_LAUNCH_MODE == 1
    a.lo = 0; a.hi = NPHASE; hipLaunchKernelGGL(hybrid_fwd, dim3(grid), dim3(NTHR), LDS_BYTES, stream, a);
#else
    for (int p = 0; p < NPHASE; ++p) { a.lo = p; a.hi = p + 1; hipLaunchKernelGGL(hybrid_fwd, dim3(grid), dim3(NTHR), LDS_BYTES, stream, a); }
#endif
}
```

```cpp
#include <hip/hip_runtime.h>
#include <cstdio>
#include <cstdint>

#ifndef N_LAUNCH_MODE
#define N_LAUNCH_MODE 1
#endif
#ifndef FAST_FOX
#define FAST_FOX 1
#endif
#ifndef FAST_HGRN
#define FAST_HGRN 1
#endif
#ifndef FAST_MLSTM
#define FAST_MLSTM 1
#endif
#ifndef FAST_GLU
#define FAST_GLU 1
#endif
#ifndef USE_PG8
#define USE_PG8 1
#endif

#define LAS __attribute__((address_space(3)))
#define GAS __attribute__((address_space(1)))
typedef unsigned short bf16_t;
typedef float f32x4 __attribute__((ext_vector_type(4)));
typedef unsigned u32x4 __attribute__((ext_vector_type(4)));
typedef unsigned u32x2 __attribute__((ext_vector_type(2)));
typedef short bf16x8 __attribute__((ext_vector_type(8)));

constexpr int NB = 8, SEQ = 4096, DM = 1024, MTOK = NB * SEQ, DEPTH = 2;
constexpr int DIN = 3084, NIN = 3328, DFF = 2816, NGU = 2 * DFF;
constexpr int CL = 64, NCH = SEQ / CL, NCHT = NB * NCH;
constexpr int PW = 2816;
constexpr int U2LD = 1152;
constexpr int NUNIT = NB * 4 * NCH;
constexpr float EPS = 1e-6f;
constexpr float LOG2E = 1.4426950408889634f;
constexpr int PC_HGQ = 0, PC_HGF = 256, PC_HGI = 512, PC_HGG = 768, PC_FXQ = 1024, PC_FXK = 1280, PC_FXV = 1536, PC_MLQ = 1792, PC_MLK = 2048, PC_MLV = 2304, PC_MLO = 2560;

constexpr size_t MiB = 1u << 20;
constexpr size_t WS_CTL = 0, CTL_BYTES = 1 * MiB;
constexpr size_t WS_WIN = 1 * MiB;
constexpr size_t WS_WOUT = 14 * MiB;
constexpr size_t WS_WGU = 18 * MiB;
constexpr size_t WS_WDN = 40 * MiB;
constexpr size_t WS_WGLU = 51 * MiB;
constexpr size_t WS_KERN = 52 * MiB;
constexpr size_t WS_A64 = 54 * MiB;
constexpr size_t WS_BM = 55 * MiB;
constexpr size_t WS_TT = 71 * MiB;
constexpr size_t WS_CM = 107 * MiB;
constexpr size_t WS_U2 = 115 * MiB;
constexpr size_t WS_GT = 133 * MiB;
constexpr size_t WS_FQ = 135 * MiB;
constexpr size_t WS_FK = 139 * MiB;
constexpr size_t WS_FCUM = 143 * MiB;
constexpr size_t WS_XNY = 144 * MiB;
constexpr size_t WS_PACT = 208 * MiB;
constexpr size_t WS_SCR = 384 * MiB;
constexpr size_t WS_MX = WS_SCR;
constexpr size_t WS_XLOC = WS_SCR;
constexpr size_t WS_G1 = WS_SCR + 4 * MiB;
constexpr size_t WS_HSLOC = WS_SCR + 20 * MiB;
constexpr size_t WS_HDEC = WS_SCR + 52 * MiB;
constexpr size_t WS_MDEC = WS_SCR + 52 * MiB + 512 * 1024;
constexpr size_t WS_HSPREV = WS_SCR + 53 * MiB;
constexpr size_t WS_MSLOC = WS_SCR + 69 * MiB;
constexpr size_t WS_MSPREV = WS_SCR + 102 * MiB;
constexpr size_t WS_END = 512 * MiB;
static_assert(WS_MSPREV + (size_t)NUNIT * 80 * 64 * 2 <= WS_END, "ws map");
static_assert(WS_MSLOC + (size_t)NUNIT * 65 * 64 * 4 <= WS_MSPREV, "ws map");

constexpr int LDS_BYTES = 147456;
constexpr int NTHR = 512;

__device__ __forceinline__ int opaque_v(int x) { asm volatile("" : "+v"(x)); return x; }
__device__ __forceinline__ float bf2f(unsigned b) { return __uint_as_float(b << 16); }
__device__ __forceinline__ unsigned f2bf(float f) { unsigned u = __float_as_uint(f); return (u + 0x7fffu + ((u >> 16) & 1u)) >> 16; }
__device__ __forceinline__ unsigned pk2(float lo, float hi) { return f2bf(lo) | (f2bf(hi) << 16); }
__device__ __forceinline__ float wave_sum(float v) {
#pragma unroll
    for (int o = 1; o < 64; o <<= 1) v += __shfl_xor(v, o);
    return v;
}
__device__ __forceinline__ float sigmoidf_(float x) { return 1.f / (1.f + __expf(-x)); }
__device__ __forceinline__ float log_sigmoidf_(float x) { return fminf(x, 0.f) - log1pf(__expf(-fabsf(x))); }
__device__ __forceinline__ float siluf_(float x) { return x * sigmoidf_(x); }
__device__ __forceinline__ float gelu_tanh(float x) { const float u = 0.7978845608028654f * (x + 0.044715f * x * x * x); return x * (1.f - 1.f / (1.f + __expf(2.f * u))); }
__device__ __forceinline__ void unpack8(const u32x4 w, float (&v)[8]) {
    v[0] = bf2f(w.x & 0xffffu); v[1] = bf2f(w.x >> 16); v[2] = bf2f(w.y & 0xffffu); v[3] = bf2f(w.y >> 16);
    v[4] = bf2f(w.z & 0xffffu); v[5] = bf2f(w.z >> 16); v[6] = bf2f(w.w & 0xffffu); v[7] = bf2f(w.w >> 16);
}
__device__ __forceinline__ u32x4 pack8(const float (&v)[8]) { u32x4 w; w.x = pk2(v[0], v[1]); w.y = pk2(v[2], v[3]); w.z = pk2(v[4], v[5]); w.w = pk2(v[6], v[7]); return w; }

struct Ctx {
    const float* in[23]; float* out; unsigned char* ws;
    unsigned char* lds; LAS unsigned char* lds3; int tid, lane, wave, G, bid;
};
#define WSP(T, off) ((T*)(c.ws + (off)))
enum { I_X = 0, I_WIN, I_GB, I_LRE, I_LIM, I_BRE, I_BIM, I_CRE, I_CIM, I_S5D, I_LOGDT, I_WGLU, I_LB, I_CONV, I_GAIN, I_WOUT, I_LNMPRE, I_LNMPOST, I_LNFPRE, I_LNFPOST, I_WG, I_WU, I_WD };

template <bool PAIR, class TileF, class Epi>
__device__ __forceinline__ void gemm_naive(const Ctx& c, const bf16_t* A, int lda, const bf16_t* Bt, int ldb, int K, TileF tf, const Epi& E) {
    float* As = (float*)c.lds;
    float* Bs = As + 64 * 65;
    float* Bs2 = Bs + 64 * 65;
    const int r = c.tid >> 3, cg = c.tid & 7;
    for (int t = c.bid;; t += c.G) {
        int row0, col0, brow0; if (!tf(t, row0, col0, brow0)) break;
        float acc[8], acc2[8];
#pragma unroll
        for (int i = 0; i < 8; ++i) { acc[i] = 0.f; acc2[i] = 0.f; }
        for (int k0 = 0; k0 < K; k0 += 64) {
            __syncthreads();
            { float v[8]; unpack8(*(const u32x4*)(A + (size_t)(row0 + r) * lda + k0 + cg * 8), v);
#pragma unroll
              for (int i = 0; i < 8; ++i) As[r * 65 + cg * 8 + i] = v[i];
              unpack8(*(const u32x4*)(Bt + (size_t)(brow0 + r) * ldb + k0 + cg * 8), v);
#pragma unroll
              for (int i = 0; i < 8; ++i) Bs[r * 65 + cg * 8 + i] = v[i];
              if (PAIR) { unpack8(*(const u32x4*)(Bt + (size_t)(brow0 + 128 + r) * ldb + k0 + cg * 8), v);
#pragma unroll
                  for (int i = 0; i < 8; ++i) Bs2[r * 65 + cg * 8 + i] = v[i]; } }
            __syncthreads();
            for (int k = 0; k < 64; ++k) {
                const float a = As[r * 65 + k];
#pragma unroll
                for (int i = 0; i < 8; ++i) { acc[i] += a * Bs[(cg * 8 + i) * 65 + k]; if (PAIR) acc2[i] += a * Bs2[(cg * 8 + i) * 65 + k]; }
            }
        }
        E(row0 + r, col0 + cg * 8, acc, acc2);
    }
    __syncthreads();
}

struct EpiInProj {
    bf16_t* U2; bf16_t* P; float* GT; const float* gb;
    __device__ __forceinline__ void operator()(int row, int col, const float (&v)[8], const float (&)[8]) const {
        if (col < 256) { const int g = col >> 4, p0 = col & 15, ch = row >> 6, j = row & 63;
            *(u32x4*)(U2 + ((size_t)(g * NCHT + ch) * U2LD + j * 16 + p0)) = pack8(v); }
        else if (col < 3072) { *(u32x4*)(P + (size_t)row * PW + (col - 256)) = pack8(v); }
        else if (col < 3088) { const int i0 = col - 3072;
#pragma unroll
            for (int i = 0; i < 8; ++i) if (i0 + i < 12) GT[(size_t)row * 16 + i0 + i] = v[i] + gb[i0 + i]; }
    }
};
struct EpiPlainBf16 {
    bf16_t* O; int ld;
    __device__ __forceinline__ void operator()(int row, int col, const float (&v)[8], const float (&)[8]) const { *(u32x4*)(O + (size_t)row * ld + col) = pack8(v); }
};
struct EpiSwiGLU {
    bf16_t* O;
    __device__ __forceinline__ void operator()(int row, int col, const float (&g)[8], const float (&u)[8]) const {
        float v[8];
#pragma unroll
        for (int i = 0; i < 8; ++i) v[i] = siluf_(g[i]) * u[i];
        *(u32x4*)(O + (size_t)row * DFF + col) = pack8(v); }
};
struct EpiXloc {
    float* X;
    __device__ __forceinline__ void operator()(int row, int col, const float (&v)[8], const float (&)[8]) const {
        const int cl = col & 255; if (cl < 128) { float* p = X + (size_t)row * 128 + cl; *(f32x4*)p = (f32x4){v[0], v[1], v[2], v[3]}; *(f32x4*)(p + 4) = (f32x4){v[4], v[5], v[6], v[7]}; } }
};
struct EpiS5Y {
    bf16_t* G1;
    __device__ __forceinline__ void operator()(int row, int col, const float (&v)[8], const float (&)[8]) const {
        const int g = row >> 9, ch = row & 511, cl = col - g * 1024, tau = cl >> 4, p0 = cl & 15; float o[8];
#pragma unroll
        for (int i = 0; i < 8; ++i) o[i] = gelu_tanh(v[i]);
        *(u32x4*)(G1 + ((size_t)(ch * 64 + tau) * 256 + g * 16 + p0)) = pack8(o); }
};


namespace pg8 {
constexpr int BM = 256, BK = 64, HALF = 128, HTB = HALF * BK * 2, STAGE_BYTES = 8 * HTB, NXCD = 8, WGM = 8;
__host__ __device__ __forceinline__ int lds_byte(int r, int c) { const int st = (r >> 4) * 2 + (c >> 5), rr = r & 15, cc = c & 31, ob = rr * 64 + cc * 2; return st * 1024 + (ob ^ (((ob >> 9) & 1) << 5)); }
__host__ __device__ __forceinline__ void stage_rc(int b, int& R, int& C) { const int st = b / 1024, sb = b % 1024, swz = sb ^ (((sb >> 9) & 1) << 5); R = (st >> 1) * 16 + swz / 64; C = (st & 1) * 32 + (swz % 64) / 2; }
__host__ __device__ __forceinline__ int perm32(int rho) { const int n = rho >> 4, i = rho & 15; return 8 * (i >> 2) + 4 * n + (i & 3); }
struct Unit { int pm, pn; };
struct Gemm { const bf16_t* A; const bf16_t* Bt; int lda, ldb, K; size_t astep, bstep; };
struct StaticOrder {
    int nM, nN, nwg, G, c;
    __device__ void init(int M, int N, int G_, int c_) { nM = M / BM; nN = N / BM; nwg = nM * nN; G = G_; c = c_; }
    __device__ bool next(int i, Unit& u) const {
        const long L = (long)i * G + c; if (L >= nwg) return false;
        int wgid = (int)L; { const int q = nwg / NXCD, r = nwg % NXCD, xcd = wgid % NXCD, off = wgid / NXCD; wgid = (xcd < r ? xcd * (q + 1) : r * (q + 1) + (xcd - r) * q) + off; }
        const int nig = WGM * nN, gid = wgid / nig, fm = gid * WGM, gsz = (nM - fm) < WGM ? (nM - fm) : WGM;
        u.pm = fm + ((wgid % nig) % gsz); u.pn = (wgid % nig) / gsz; return true;
    }
};
struct SchedXloc { int G, c; __device__ bool next(int i, Unit& u) const { const int L = i * G + c; if (L >= 32) return false; u.pm = L; u.pn = L >> 1; return true; } };
struct SchedS5Y { int G, c; __device__ bool next(int i, Unit& u) const { const int L = i * G + c; if (L >= 128) return false; const int g = L >> 3; u.pm = g * 2 + ((L >> 2) & 1); u.pn = g * 4 + (L & 3); return true; } };

template <class F, bool PAIR> struct EpiWrap {
    F f;
    __device__ __forceinline__ void operator()(const f32x4 (&acc)[2][2][4][2], const Unit& u, int wr, int wc, int fr, int fq) const {
#pragma unroll
        for (int ai = 0; ai < 2; ++ai)
#pragma unroll
            for (int m = 0; m < 4; ++m) { const int row = u.pm * BM + ai * HALF + wr * 64 + m * 16 + fr;
                if (PAIR) { const int col = u.pn * HALF + wc * 32 + 8 * fq;
                    const float g[8] = {acc[ai][0][m][0][0], acc[ai][0][m][0][1], acc[ai][0][m][0][2], acc[ai][0][m][0][3], acc[ai][0][m][1][0], acc[ai][0][m][1][1], acc[ai][0][m][1][2], acc[ai][0][m][1][3]};
                    const float v[8] = {acc[ai][1][m][0][0], acc[ai][1][m][0][1], acc[ai][1][m][0][2], acc[ai][1][m][0][3], acc[ai][1][m][1][0], acc[ai][1][m][1][1], acc[ai][1][m][1][2], acc[ai][1][m][1][3]};
                    f(row, col, g, v); }
                else {
#pragma unroll
                    for (int bj = 0; bj < 2; ++bj) { const int col = u.pn * BM + bj * HALF + wc * 32 + 8 * fq;
                        const float v[8] = {acc[ai][bj][m][0][0], acc[ai][bj][m][0][1], acc[ai][bj][m][0][2], acc[ai][bj][m][0][3], acc[ai][bj][m][1][0], acc[ai][bj][m][1][1], acc[ai][bj][m][1][2], acc[ai][bj][m][1][3]};
                        f(row, col, v, v); } } }
    }
};

template <class Epi, class Sched, bool ALIGN_EPI>
__device__ __forceinline__ void gemm_phase(LAS unsigned char* lds, const Gemm g, const Sched& S, const Epi& E) {
    const int tid = opaque_v((int)threadIdx.x), wid = __builtin_amdgcn_readfirstlane(tid >> 6), lane = tid & 63, wr = wid >> 2, wc = wid & 3, fr = lane & 15, fq = lane >> 4;
    const int K = g.K, nt = K / BK;
    unsigned voffA[2], voffB[2];
#pragma unroll
    for (int i = 0; i < 2; ++i) { int R, C; stage_rc(tid * 16 + i * 8192, R, C); const int Rb = (R & ~31) + perm32(R & 31);
        voffA[i] = (unsigned)(R * g.lda + C) * 2u; voffB[i] = (unsigned)(Rb * g.ldb + C) * 2u; }
    const size_t kstep = (size_t)(BK * 2);
    const size_t hstepA = (size_t)HALF * g.lda * 2, hstepB = (size_t)HALF * g.ldb * 2;
    const unsigned ldsw = (unsigned)wid * 1024u;
    const int aoff = lds_byte(wr * 64 + fr, fq * 8), boff = lds_byte(wc * 32 + fr, fq * 8);
#define PG8_SA(b, h) (((b) * 2 + (h)) * HTB)
#define PG8_SB(b, h) ((4 + (b) * 2 + (h)) * HTB)
#define PG8_STAGE(bufoff, gbase, voff) do { _Pragma("unroll") for (int _i = 0; _i < 2; ++_i) \
        __builtin_amdgcn_global_load_lds((const unsigned*)((const char*)(gbase) + (voff)[_i]), (LAS unsigned*)(lds + (bufoff) + ldsw + _i * 8192), 16, 0, 0); } while (0)
#define PG8_LDA(dst, b, h) do { _Pragma("unroll") for (int m = 0; m < 4; ++m) _Pragma("unroll") for (int k = 0; k < 2; ++k) dst[m][k] = *(const LAS bf16x8*)(lds + PG8_SA(b, h) + aoff + m * 2048 + k * 1024); } while (0)
#define PG8_LDB(dst, b, h) do { _Pragma("unroll") for (int n = 0; n < 2; ++n) _Pragma("unroll") for (int k = 0; k < 2; ++k) dst[n][k] = *(const LAS bf16x8*)(lds + PG8_SB(b, h) + boff + n * 2048 + k * 1024); } while (0)
#define PG8_MMA(ai, bj, At, Bt) do { __builtin_amdgcn_s_setprio(1); _Pragma("unroll") for (int m = 0; m < 4; ++m) _Pragma("unroll") for (int n = 0; n < 2; ++n) _Pragma("unroll") for (int k = 0; k < 2; ++k) \
        acc[ai][bj][m][n] = __builtin_amdgcn_mfma_f32_16x16x32_bf16(Bt[n][k], At[m][k], acc[ai][bj][m][n], 0, 0, 0); __builtin_amdgcn_s_setprio(0); } while (0)
#define PG8_WAIT_V(n) asm volatile("s_waitcnt vmcnt(" #n ")" ::: "memory")
#define PG8_WAIT_L(n) asm volatile("s_waitcnt lgkmcnt(" #n ")" ::: "memory")
#define PG8_BAR __builtin_amdgcn_s_barrier()
#define PG8_SCHED __builtin_amdgcn_sched_barrier(0)
    Unit cur, nxt; int ui = 0;
    if (!S.next(0, cur)) return;
    f32x4 acc[2][2][4][2];
#pragma unroll
    for (int a = 0; a < 2; ++a)
#pragma unroll
        for (int b = 0; b < 2; ++b)
#pragma unroll
            for (int m = 0; m < 4; ++m)
#pragma unroll
                for (int n = 0; n < 2; ++n) acc[a][b][m][n] = (f32x4){0.f, 0.f, 0.f, 0.f};
    bf16x8 At[4][2], B0[2][2], B1[2][2];
    const char* cA = (const char*)g.A + (size_t)cur.pm * g.astep; const char* cB = (const char*)g.Bt + (size_t)cur.pn * g.bstep;
    PG8_STAGE(PG8_SB(0, 0), cB, voffB); PG8_STAGE(PG8_SB(0, 1), cB + hstepB, voffB); PG8_STAGE(PG8_SA(0, 0), cA, voffA); PG8_STAGE(PG8_SA(0, 1), cA + hstepA, voffA);
    if (wr == 1) PG8_BAR;
    PG8_WAIT_V(2); PG8_BAR;
    PG8_STAGE(PG8_SB(1, 0), cB + kstep, voffB); PG8_STAGE(PG8_SA(1, 0), cA + kstep, voffA); PG8_STAGE(PG8_SB(1, 1), cB + hstepB + kstep, voffB);
    PG8_WAIT_V(6); PG8_BAR;
    for (;;) {
        const bool has_next = S.next(ui + 1, nxt);
        const char* nA = has_next ? (const char*)g.A + (size_t)nxt.pm * g.astep : cA; const char* nB = has_next ? (const char*)g.Bt + (size_t)nxt.pn * g.bstep : cB;
        for (int t = 0; t < nt; t += 2) {
            const bool last = (t == nt - 2);
            const char* a1 = cA + (size_t)(t + 1) * kstep;
            const char* a2 = last ? nA : cA + (size_t)(t + 2) * kstep; const char* b2 = last ? nB : cB + (size_t)(t + 2) * kstep;
            const char* a3 = a2 + kstep; const char* b3 = b2 + kstep;
            PG8_LDB(B0, 0, 0); PG8_LDB(B1, 0, 1); PG8_SCHED; PG8_LDA(At, 0, 0); PG8_STAGE(PG8_SA(1, 1), a1 + hstepA, voffA);
            PG8_WAIT_V(8); PG8_WAIT_L(0); PG8_BAR; PG8_MMA(0, 0, At, B0); PG8_MMA(0, 1, At, B1); PG8_BAR; PG8_SCHED;
            PG8_LDA(At, 0, 1); PG8_STAGE(PG8_SB(0, 0), b2, voffB); PG8_STAGE(PG8_SB(0, 1), b2 + hstepB, voffB); PG8_STAGE(PG8_SA(0, 0), a2, voffA);
            PG8_WAIT_V(8); PG8_WAIT_L(0); PG8_BAR; PG8_MMA(1, 0, At, B0); PG8_MMA(1, 1, At, B1); PG8_BAR; PG8_SCHED;
            PG8_LDB(B0, 1, 0); PG8_LDB(B1, 1, 1); PG8_SCHED; PG8_LDA(At, 1, 0); PG8_STAGE(PG8_SA(0, 1), a2 + hstepA, voffA);
            PG8_WAIT_V(8); PG8_WAIT_L(0); PG8_BAR; PG8_MMA(0, 0, At, B0); PG8_MMA(0, 1, At, B1); PG8_BAR; PG8_SCHED;
            PG8_LDA(At, 1, 1); PG8_STAGE(PG8_SB(1, 0), b3, voffB); PG8_STAGE(PG8_SB(1, 1), b3 + hstepB, voffB); PG8_STAGE(PG8_SA(1, 0), a3, voffA);
            PG8_WAIT_V(8); PG8_WAIT_L(0); PG8_BAR; PG8_MMA(1, 0, At, B0); PG8_MMA(1, 1, At, B1); PG8_BAR; PG8_SCHED;
        }
        if constexpr (ALIGN_EPI) { if (wr == 0) PG8_BAR; }
        E(acc, cur, wr, wc, fr, fq);
        if (!has_next) break;
#pragma unroll
        for (int a = 0; a < 2; ++a)
#pragma unroll
            for (int b = 0; b < 2; ++b)
#pragma unroll
                for (int m = 0; m < 4; ++m)
#pragma unroll
                    for (int n = 0; n < 2; ++n) acc[a][b][m][n] = (f32x4){0.f, 0.f, 0.f, 0.f};
        cur = nxt; cA = nA; cB = nB; ++ui;
        if constexpr (ALIGN_EPI) { if (wr == 1) PG8_BAR; }
    }
    PG8_WAIT_V(0);
    if constexpr (!ALIGN_EPI) { if (wr == 0) PG8_BAR; }
    PG8_BAR;
#undef PG8_SA
#undef PG8_SB
#undef PG8_STAGE
#undef PG8_LDA
#undef PG8_LDB
#undef PG8_MMA
#undef PG8_WAIT_V
#undef PG8_WAIT_L
#undef PG8_BAR
#undef PG8_SCHED
}
}

template <class SrcF>
__device__ __forceinline__ void transpose_item(SrcF src, bf16_t* WT, int ldw, int k0, int n0, float* scr, int lane) {
#pragma unroll 8
    for (int i = 0; i < 32; ++i) { const int kk = 2 * i + (lane >> 5); scr[kk * 33 + (lane & 31)] = src(k0 + kk, n0 + (lane & 31)); }
    __builtin_amdgcn_wave_barrier(); asm volatile("s_waitcnt lgkmcnt(0)" ::: "memory");
    const int cc = lane & 7;
#pragma unroll
    for (int j = 0; j < 4; ++j) { const int n = (lane >> 3) + 8 * j; const float* s = scr + (8 * cc) * 33 + n;
        u32x4 o; o.x = pk2(s[0 * 33], s[1 * 33]); o.y = pk2(s[2 * 33], s[3 * 33]); o.z = pk2(s[4 * 33], s[5 * 33]); o.w = pk2(s[6 * 33], s[7 * 33]);
        *(u32x4*)(WT + (size_t)(n0 + n) * ldw + k0 + 8 * cc) = o; }
    asm volatile("s_waitcnt lgkmcnt(0)" ::: "memory"); __builtin_amdgcn_wave_barrier();
}
__device__ __forceinline__ int win_src_col(int n) {
    if (n < 2048) return n;
    if (n < 3072) return n + 4;
    const int i = n - 3072;
    if (i < 4) return 2048 + i;
    if (i < 8) return 3076 + (i - 4);
    if (i < 12) return 3080 + (i - 8);
    return -1;
}
__device__ __forceinline__ void rms_row_to_bf16(const float* xrow, bf16_t* orow, int lane) {
    const f32x4* xr = (const f32x4*)xrow + lane; f32x4 v[4]; float s = 0.f;
#pragma unroll
    for (int j = 0; j < 4; ++j) { v[j] = xr[64 * j]; s += (v[j].x * v[j].x + v[j].y * v[j].y) + (v[j].z * v[j].z + v[j].w * v[j].w); }
    const float rstd = rsqrtf(wave_sum(s) * (1.f / DM) + EPS);
    u32x2* o8 = (u32x2*)orow + lane;
#pragma unroll
    for (int j = 0; j < 4; ++j) { u32x2 w; w.x = pk2(v[j].x * rstd, v[j].y * rstd); w.y = pk2(v[j].z * rstd, v[j].w * rstd); o8[64 * j] = w; }
}
__device__ __forceinline__ void ph_prologue(const Ctx& c) {
    float* scr = (float*)c.lds + c.wave * 4096;
    const int gw = c.bid * 8 + c.wave, NGW = c.G * 8;
    constexpr int IT_IN = (NIN / 32) * (DM / 64), IT_OUT = (DM / 32) * (DM / 64), IT_GU = (NGU / 32) * (DM / 64), IT_DN = (DM / 32) * (DFF / 64), IT_GLU = (256 / 32) * (256 / 64);
    constexpr int IT_L = IT_IN + IT_OUT + IT_GU + IT_DN + IT_GLU;
    for (int it = gw; it < DEPTH * IT_L; it += NGW) {
        const int l = it / IT_L; int r = it % IT_L;
        if (r < IT_IN) { const int nb = r % (NIN / 32), kb = r / (NIN / 32); const float* W = c.in[I_WIN] + (size_t)l * DM * DIN; const float* ln = c.in[I_LNMPRE] + l * DM;
            transpose_item([=](int k, int n) -> float { const int sc = win_src_col(n); if (sc < 0) return 0.f; float v = W[(size_t)k * DIN + sc] * ln[k]; if (n >= 1280 && n < 1536) v *= 0.125f * LOG2E; return v; },
                           WSP(bf16_t, WS_WIN) + (size_t)l * NIN * DM, DM, kb * 64, nb * 32, scr, c.lane); continue; }
        r -= IT_IN;
        if (r < IT_OUT) { const int nb = r % (DM / 32), kb = r / (DM / 32); const float* W = c.in[I_WOUT] + (size_t)l * DM * DM; const float* gn = c.in[I_GAIN] + l * DM;
            transpose_item([=](int k, int n) -> float { return W[(size_t)k * DM + n] * gn[k]; }, WSP(bf16_t, WS_WOUT) + (size_t)l * DM * DM, DM, kb * 64, nb * 32, scr, c.lane); continue; }
        r -= IT_OUT;
        if (r < IT_GU) { const int nb = r % (NGU / 32), kb = r / (NGU / 32); const float* Wg = c.in[I_WG] + (size_t)l * DM * DFF; const float* Wu = c.in[I_WU] + (size_t)l * DM * DFF; const float* ln = c.in[I_LNFPRE] + l * DM;
            transpose_item([=](int k, int n) -> float { const int tile = n >> 8, hf = (n >> 7) & 1, j = tile * 128 + (n & 127); return (hf ? Wu : Wg)[(size_t)k * DFF + j] * ln[k]; },
                           WSP(bf16_t, WS_WGU) + (size_t)l * NGU * DM, DM, kb * 64, nb * 32, scr, c.lane); continue; }
        r -= IT_GU;
        if (r < IT_DN) { const int nb = r % (DM / 32), kb = r / (DM / 32); const float* W = c.in[I_WD] + (size_t)l * DFF * DM;
            transpose_item([=](int k, int n) -> float { return W[(size_t)k * DM + n]; }, WSP(bf16_t, WS_WDN) + (size_t)l * DM * DFF, DFF, kb * 64, nb * 32, scr, c.lane); continue; }
        r -= IT_DN;
        { const int nb = r % 8, kb = r / 8; const float* W = c.in[I_WGLU] + (size_t)l * 256 * 256;
            transpose_item([=](int k, int n) -> float { return W[(size_t)k * 256 + n]; }, WSP(bf16_t, WS_WGLU) + (size_t)l * 256 * 256, 256, kb * 64, nb * 32, scr, c.lane); }
    }
    for (int m = gw; m < MTOK; m += NGW) rms_row_to_bf16(c.in[I_X] + (size_t)m * DM, WSP(bf16_t, WS_XNY) + (size_t)m * DM, c.lane);
    __syncthreads();
    float* sh = (float*)c.lds;
    for (int it = c.bid; it < DEPTH * 16 * 65; it += c.G) {
        const int l = it / (16 * 65), g = (it / 65) % 16, d = it % 65;
        if (c.tid < 64) { const int n = c.tid;
            const double lr = (double)fminf(c.in[I_LRE][(l * 16 + g) * 64 + n], -1e-4f), li = (double)c.in[I_LIM][(l * 16 + g) * 64 + n], dt = exp((double)c.in[I_LOGDT][l * 16 + g]);
            const double mag1 = exp(lr * dt), abr = mag1 * cos(li * dt), abi = mag1 * sin(li * dt), den = lr * lr + li * li;
            const double cfr = ((abr - 1.0) * lr + abi * li) / den, cfi = (abi * lr - (abr - 1.0) * li) / den;
            const double magd = exp(lr * dt * d), wr = magd * cos(li * dt * d), wi = magd * sin(li * dt * d);
            sh[n] = (float)wr; sh[64 + n] = (float)wi; sh[128 + n] = (float)(wr * cfr - wi * cfi); sh[192 + n] = (float)(wr * cfi + wi * cfr);
            if (d == 64) { float* a64 = WSP(float, WS_A64) + ((size_t)(l * 16 + g) * 64 + n) * 2; a64[0] = (float)wr; a64[1] = (float)wi; } }
        __syncthreads();
        const float* cre = c.in[I_CRE] + (size_t)(l * 16 + g) * 16 * 64; const float* cim = c.in[I_CIM] + (size_t)(l * 16 + g) * 16 * 64;
        const float* bre = c.in[I_BRE] + (size_t)(l * 16 + g) * 64 * 16; const float* bim = c.in[I_BIM] + (size_t)(l * 16 + g) * 64 * 16;
        if (d < 64 && c.tid < 256) { const int p = c.tid >> 4, pp = c.tid & 15; float s = 0.f;
            for (int n = 0; n < 64; ++n) { const float wcr = sh[128 + n], wci = sh[192 + n], br = bre[n * 16 + pp], bi = bim[n * 16 + pp];
                const float xr = wcr * br - wci * bi, xi = wcr * bi + wci * br; s += cre[p * 64 + n] * xr - cim[p * 64 + n] * xi; }
            if (d == 0 && p == pp) s += c.in[I_S5D][l * 256 + g * 16 + p];
            WSP(float, WS_KERN)[(((size_t)(l * 16 + g) * 64 + d) * 16 + p) * 16 + pp] = s; }
        if (d < 64) { const int j = 63 - d; bf16_t* bm = WSP(bf16_t, WS_BM) + (size_t)(l * 16 + g) * 128 * 1024;
#pragma unroll
            for (int e = 0; e < 4; ++e) { const int idx = c.tid * 4 + e, row = idx >> 4, pp = idx & 15, n = row >> 1, ri = row & 1;
                const float wcr = sh[128 + n], wci = sh[192 + n], br = bre[n * 16 + pp], bi = bim[n * 16 + pp];
                const float val = ri ? (wcr * bi + wci * br) : (wcr * br - wci * bi);
                bm[(size_t)row * 1024 + j * 16 + pp] = (bf16_t)f2bf(val); } }
        if (d >= 1) { const int tau = d - 1; bf16_t* cm = WSP(bf16_t, WS_CM) + (size_t)(l * 16 + g) * 1024 * 128;
#pragma unroll
            for (int e = 0; e < 4; ++e) { const int idx = c.tid * 4 + e, p = idx >> 7, q = idx & 127, n = q >> 1, ri = q & 1;
                const float wr = sh[n], wi = sh[64 + n], cr = cre[p * 64 + n], ci = cim[p * 64 + n];
                const float val = ri ? -(cr * wi + ci * wr) : (cr * wr - ci * wi);
                cm[(size_t)(tau * 16 + p) * 128 + q] = (bf16_t)f2bf(val); } }
        __syncthreads();
    }
}

__device__ __forceinline__ void ph_B_texpand(const Ctx& c, int l) {
    bf16_t* TT = WSP(bf16_t, WS_TT);
    const float* KERN = WSP(float, WS_KERN) + (size_t)l * 16 * 64 * 256;
    const bf16_t* CM = WSP(bf16_t, WS_CM) + (size_t)l * 16 * 1024 * 128;
    for (int it = c.bid; it < 16 * 64; it += c.G) {
        const int g = it >> 6, tau = it & 63;
        for (int e = c.tid; e < 16 * (U2LD / 8); e += NTHR) {
            const int p = e / (U2LD / 8), c8 = (e % (U2LD / 8)) * 8; u32x4 w;
            if (c8 < 1024) { const int j = c8 >> 4, pp0 = c8 & 15;
                if (j <= tau) { const float* k = KERN + (((size_t)g * 64 + (tau - j)) * 16 + p) * 16 + pp0; w.x = pk2(k[0], k[1]); w.y = pk2(k[2], k[3]); w.z = pk2(k[4], k[5]); w.w = pk2(k[6], k[7]); }
                else w = (u32x4){0u, 0u, 0u, 0u}; }
            else w = *(const u32x4*)(CM + ((size_t)(g * 1024 + tau * 16 + p)) * 128 + (c8 - 1024));
            *(u32x4*)(TT + ((size_t)(g * 1024 + tau * 16 + p)) * U2LD + c8) = w; }
    }
}
__device__ __forceinline__ void split3(float F, unsigned& hi, unsigned& mid, unsigned& lo) { hi = f2bf(F); float r = F - bf2f(hi); mid = f2bf(r); r -= bf2f(mid); lo = f2bf(r); }
__device__ __forceinline__ void ph_B_gatescan(const Ctx& c) {
    float* sh = (float*)c.lds;
    const float* GT = WSP(float, WS_GT);
    for (int it = c.bid; it < NB * 4; it += c.G) {
        const int b = it >> 2, h = it & 3; const size_t m0 = (size_t)b * SEQ + c.tid * 8;
        float ls[8]; float run = 0.f;
#pragma unroll
        for (int i = 0; i < 8; ++i) { run += log_sigmoidf_(GT[(m0 + i) * 16 + h]); ls[i] = run; }
        __syncthreads(); sh[c.tid] = run; __syncthreads();
        if (c.tid == 0) { float a = 0.f; for (int i = 0; i < NTHR; ++i) { const float t = sh[i]; sh[i] = a; a += t; } }
        __syncthreads();
        const float off = sh[c.tid];
#pragma unroll
        for (int i = 0; i < 8; ++i) { const float F = (off + ls[i]) * LOG2E; const size_t m = m0 + i;
            WSP(float, WS_FCUM)[m * 4 + h] = F;
            unsigned hi, mid, lo; split3(F, hi, mid, lo); const unsigned one = 0x3f80u;
            u32x4 q0, q1 = (u32x4){0u, 0u, 0u, 0u}, k0;
            q0.x = hi | (mid << 16); q0.y = lo | (one << 16); q0.z = one | (one << 16); q0.w = 0u;
            k0.x = one | (one << 16); k0.y = one | ((hi ^ 0x8000u) << 16); k0.z = (mid ^ 0x8000u) | ((lo ^ 0x8000u) << 16); k0.w = 0u;
            u32x4* fq = (u32x4*)(WSP(bf16_t, WS_FQ) + (m * 4 + h) * 16); fq[0] = q0; fq[1] = q1;
            u32x4* fk = (u32x4*)(WSP(bf16_t, WS_FK) + (m * 4 + h) * 16); fk[0] = k0; fk[1] = q1; }
        __syncthreads();
    }
}
__device__ __forceinline__ void hg_gate(float z, float lb, float& logf, float& kk) {
    logf = log_sigmoidf_(z) + log1pf(lb * __expf(fminf(-z, 60.f)));
    kk = (1.f - lb) * sigmoidf_(-z);
}
__device__ __forceinline__ float hg_lb(const Ctx& c, int l, int ch) {
    if (l == 0) return 0.f;
    const float a = c.in[I_LB][ch], b = c.in[I_LB][256 + ch]; return fmaxf(1.f / (1.f + __expf(a - b)), 0.f);
}
__device__ __forceinline__ void ph_B_hgrn_local_naive(const Ctx& c, int l) {
    float* lg = (float*)c.lds; float* kk = lg + 4096; float* vv = kk + 4096;
    const bf16_t* P = WSP(bf16_t, WS_PACT);
    const int t = c.tid >> 3, c0 = (c.tid & 7) * 8;
    for (int u = c.bid; u < NUNIT; u += c.G) {
        const int bh = u >> 6, ch = u & 63, b = bh >> 2, h = bh & 3; const size_t m = (size_t)b * SEQ + ch * 64 + t;
        { float z[8], v[8]; unpack8(*(const u32x4*)(P + m * PW + PC_HGF + h * 64 + c0), z); unpack8(*(const u32x4*)(P + m * PW + PC_HGI + h * 64 + c0), v);
#pragma unroll
          for (int i = 0; i < 8; ++i) { float lf, k; hg_gate(z[i], hg_lb(c, l, h * 64 + c0 + i), lf, k); lg[t * 64 + c0 + i] = lf; kk[t * 64 + c0 + i] = k; vv[t * 64 + c0 + i] = v[i]; } }
        __syncthreads();
        if (c.tid < 64) { float a = 0.f; for (int s = 0; s < 64; ++s) { a += lg[s * 64 + c.tid]; lg[s * 64 + c.tid] = a; } }
        __syncthreads();
#pragma unroll
        for (int i = 0; i < 8; ++i) kk[t * 64 + c0 + i] *= __expf(lg[63 * 64 + c0 + i] - lg[t * 64 + c0 + i]);
        __syncthreads();
        { const int vd = t; float acc[8];
#pragma unroll
          for (int i = 0; i < 8; ++i) acc[i] = 0.f;
          for (int s = 0; s < 64; ++s) { const float v = vv[s * 64 + vd];
#pragma unroll
              for (int i = 0; i < 8; ++i) acc[i] += v * kk[s * 64 + c0 + i]; }
          float* o = WSP(float, WS_HSLOC) + ((size_t)u * 64 + vd) * 64 + c0; *(f32x4*)o = (f32x4){acc[0], acc[1], acc[2], acc[3]}; *(f32x4*)(o + 4) = (f32x4){acc[4], acc[5], acc[6], acc[7]}; }
        if (c.tid < 64) WSP(float, WS_HDEC)[(size_t)u * 64 + c.tid] = __expf(lg[63 * 64 + c.tid]);
        __syncthreads();
    }
}
__device__ __forceinline__ void ml_conv8(const Ctx& c, int l, const bf16_t* P, size_t m, int spos, int pcol, int wch, float (&o)[8]) {
    const float* cw = c.in[I_CONV] + (size_t)l * 4 * 512;
#pragma unroll
    for (int i = 0; i < 8; ++i) o[i] = 0.f;
#pragma unroll
    for (int j = 0; j < 4; ++j) { const int dt = 3 - j; if (spos - dt >= 0) { float x[8]; unpack8(*(const u32x4*)(P + (m - dt) * PW + pcol), x);
#pragma unroll
            for (int i = 0; i < 8; ++i) o[i] += cw[j * 512 + wch + i] * x[i]; } }
#pragma unroll
    for (int i = 0; i < 8; ++i) o[i] = siluf_(o[i]);
}
__device__ __forceinline__ void ph_B_mlstm_local_naive(const Ctx& c, int l) {
    float* kh = (float*)c.lds; float* vv = kh + 4096; float* bb = vv + 4096; float* ig = bb + 64;
    const bf16_t* P = WSP(bf16_t, WS_PACT); const float* GT = WSP(float, WS_GT);
    const int t = c.tid >> 3, c0 = (c.tid & 7) * 8;
    for (int u = c.bid; u < NUNIT; u += c.G) {
        const int bh = u >> 6, ch = u & 63, b = bh >> 2, h = bh & 3; const size_t m = (size_t)b * SEQ + ch * 64 + t;
        if (c.tid < 64) { const size_t mm = (size_t)b * SEQ + ch * 64 + c.tid; bb[c.tid] = log_sigmoidf_(GT[mm * 16 + 8 + h]); ig[c.tid] = GT[mm * 16 + 4 + h]; }
        __syncthreads();
        if (c.tid == 0) { float a = 0.f; for (int s = 0; s < 64; ++s) { a += bb[s]; bb[s] = a; } }
        __syncthreads();
        { float k[8], v[8]; ml_conv8(c, l, P, m, ch * 64 + t, PC_MLK + h * 64 + c0, 256 + h * 64 + c0, k); unpack8(*(const u32x4*)(P + m * PW + PC_MLV + h * 64 + c0), v);
          const float w = 0.125f * __expf(bb[63] - bb[t] + ig[t]);
#pragma unroll
          for (int i = 0; i < 8; ++i) { kh[t * 64 + c0 + i] = k[i] * w; vv[t * 64 + c0 + i] = v[i]; } }
        __syncthreads();
        for (int vd = t; vd < 65; vd += 64) { float acc[8];
#pragma unroll
            for (int i = 0; i < 8; ++i) acc[i] = 0.f;
            for (int s = 0; s < 64; ++s) { const float v = (vd < 64) ? vv[s * 64 + vd] : 1.f;
#pragma unroll
                for (int i = 0; i < 8; ++i) acc[i] += v * kh[s * 64 + c0 + i]; }
            float* o = WSP(float, WS_MSLOC) + ((size_t)u * 65 + vd) * 64 + c0; *(f32x4*)o = (f32x4){acc[0], acc[1], acc[2], acc[3]}; *(f32x4*)(o + 4) = (f32x4){acc[4], acc[5], acc[6], acc[7]}; }
        if (c.tid == 0) WSP(float, WS_MDEC)[u] = __expf(bb[63]);
        __syncthreads();
    }
}

__device__ __forceinline__ void ph_C_scans(const Ctx& c, int l) {
    const int gt = c.bid * NTHR + c.tid, NGT = c.G * NTHR;
    { const float* XL = WSP(float, WS_XLOC); bf16_t* U2 = WSP(bf16_t, WS_U2); const float* A64 = WSP(float, WS_A64) + (size_t)l * 16 * 64 * 2;
      for (int i = gt; i < 16 * NB * 64; i += NGT) { const int n = i & 63, b = (i >> 6) & 7, g = i >> 9; const float ar = A64[(g * 64 + n) * 2], ai = A64[(g * 64 + n) * 2 + 1]; float xr = 0.f, xi = 0.f;
          for (int ch = 0; ch < NCH; ++ch) { const size_t row = (size_t)g * NCHT + b * NCH + ch;
              *(unsigned*)(U2 + row * U2LD + 1024 + 2 * n) = pk2(xr, xi);
              const float lr = XL[row * 128 + 2 * n], li = XL[row * 128 + 2 * n + 1]; const float nr = ar * xr - ai * xi + lr, ni = ar * xi + ai * xr + li; xr = nr; xi = ni; } } }
    { const float* SL = WSP(float, WS_HSLOC); const float* DC = WSP(float, WS_HDEC); bf16_t* SP = WSP(bf16_t, WS_HSPREV);
      for (int i = gt; i < 32 * 64 * 32; i += NGT) { const int k2 = (i & 31) * 2, vd = (i >> 5) & 63, bh = i >> 11; float s0 = 0.f, s1 = 0.f;
          for (int ch = 0; ch < NCH; ++ch) { const size_t u = (size_t)bh * 64 + ch, o = (u * 64 + vd) * 64 + k2;
              *(unsigned*)(SP + o) = pk2(s0, s1);
              s0 = DC[u * 64 + k2] * s0 + SL[o]; s1 = DC[u * 64 + k2 + 1] * s1 + SL[o + 1]; } } }
    { const float* SL = WSP(float, WS_MSLOC); const float* DC = WSP(float, WS_MDEC); bf16_t* SP = WSP(bf16_t, WS_MSPREV);
      for (int i = gt; i < 32 * 65 * 32; i += NGT) { const int k2 = (i & 31) * 2, vd = (i >> 5) % 65, bh = (i >> 5) / 65; float s0 = 0.f, s1 = 0.f;
          for (int ch = 0; ch < NCH; ++ch) { const size_t u = (size_t)bh * 64 + ch;
              *(unsigned*)(SP + (u * 80 + vd) * 64 + k2) = pk2(s0, s1);
              const float d = DC[u]; const size_t o = (u * 65 + vd) * 64 + k2; s0 = d * s0 + SL[o]; s1 = d * s1 + SL[o + 1]; } } }
}
__device__ __forceinline__ void ph_C_fox_naive(const Ctx& c) {
    const bf16_t* P = WSP(bf16_t, WS_PACT); const float* FC = WSP(float, WS_FCUM); bf16_t* Y = WSP(bf16_t, WS_XNY);
    const int gw = c.bid * 8 + c.wave, NGW = c.G * 8;
    for (int r = gw; r < NB * 4 * SEQ; r += NGW) {
        const int q = r % SEQ, bh = r / SEQ, b = bh >> 2, h = bh & 3; const size_t m0 = (size_t)b * SEQ, mq = m0 + q;
        const float qv = bf2f(P[mq * PW + PC_FXQ + h * 64 + c.lane]); const float Fq = FC[mq * 4 + h];
        float mx = -INFINITY, lsum = 0.f, acc = 0.f;
        for (int kv = 0; kv <= q; ++kv) { const size_t mk = m0 + kv;
            const float s = wave_sum(qv * bf2f(P[mk * PW + PC_FXK + h * 64 + c.lane])) + (Fq - FC[mk * 4 + h]);
            const float mn = fmaxf(mx, s), al = exp2f(mx - mn), p = exp2f(s - mn);
            lsum = lsum * al + p; acc = acc * al + p * bf2f(P[mk * PW + PC_FXV + h * 64 + c.lane]); mx = mn; }
        const float o = acc / lsum; const float rstd = rsqrtf(wave_sum(o * o) * (1.f / 64.f) + EPS);
        Y[mq * DM + 512 + h * 64 + c.lane] = (bf16_t)f2bf(o * rstd);
    }
}


typedef float f32x16 __attribute__((ext_vector_type(16)));
typedef short s16x4 __attribute__((ext_vector_type(4)));
typedef float f32x2_t __attribute__((ext_vector_type(2)));
typedef __bf16 bf16x2_t __attribute__((ext_vector_type(2)));
__device__ __forceinline__ unsigned cvtpk(float lo, float hi) { f32x2_t v = {lo, hi}; bf16x2_t b = __builtin_convertvector(v, bf16x2_t); return __builtin_bit_cast(unsigned, b); }
__device__ __forceinline__ int crow(int r, int hi) { return (r & 3) + 8 * (r >> 2) + 4 * hi; }
__device__ __forceinline__ s16x4 ds_tr16(LAS const unsigned char* p) { return __builtin_bit_cast(s16x4, __builtin_amdgcn_ds_read_tr16_b64_v4i16((LAS s16x4*)p)); }
__device__ __forceinline__ void ph_C_fox_fast(const Ctx& c) {
    constexpr int KST = 176, VST = 192, KB = 64 * KST, VB = 64 * VST, BUF = KB + VB;
    LAS unsigned char* L = c.lds3;
    const bf16_t* P = WSP(bf16_t, WS_PACT); const bf16_t* FQ = WSP(bf16_t, WS_FQ); const bf16_t* FK = WSP(bf16_t, WS_FK); bf16_t* Y = WSP(bf16_t, WS_XNY);
    const int tid = c.tid, lane = c.lane, wave = c.wave, r32 = lane & 31, hi = lane >> 5;
    const int vcu = (c.G % 8 == 0) ? (c.bid % 8) * (c.G / 8) + c.bid / 8 : c.bid;
    const int srow = tid >> 3, sch = tid & 7;
    for (int pi = vcu; pi < 256; pi += c.G) {
        const int bh = pi >> 3, sx = pi & 7, b = bh >> 2, h = bh & 3; const size_t m0 = (size_t)b * SEQ;
#pragma unroll 1
        for (int kk = 0; kk < 2; ++kk) {
            const int qb = kk ? 15 - sx : sx, q0 = qb * 256 + wave * 32, NT = 4 * (qb + 1); const size_t mq = m0 + q0 + r32;
            bf16x8 qf[5];
#pragma unroll
            for (int s = 0; s < 4; ++s) qf[s] = *(const bf16x8*)(P + mq * PW + PC_FXQ + h * 64 + 16 * s + 8 * hi);
            qf[4] = *(const bf16x8*)(FQ + (mq * 4 + h) * 16 + 8 * hi);
            const bf16_t* ksrc = P + (m0 + srow) * PW + PC_FXK + h * 64 + sch * 8;
            const bf16_t* vsrc = P + (m0 + srow) * PW + PC_FXV + h * 64 + sch * 8;
            const bf16_t* fsrc = FK + ((m0 + (tid >> 1)) * 4 + h) * 16 + (tid & 1) * 8;
            u32x4 kreg = *(const u32x4*)ksrc, vreg = *(const u32x4*)vsrc, freg = (u32x4){0u, 0u, 0u, 0u};
            if (tid < 128) freg = *(const u32x4*)fsrc;
            *(LAS u32x4*)(L + srow * KST + sch * 16) = kreg; *(LAS u32x4*)(L + KB + srow * VST + sch * 16) = vreg;
            if (tid < 128) *(LAS u32x4*)(L + (tid >> 1) * KST + 128 + (tid & 1) * 16) = freg;
            __syncthreads();
            float m_run = -INFINITY, l_run = 0.f; f32x16 o0 = {}, o1 = {};
            for (int t = 0; t < NT; ++t) {
                const bool more = (t + 1 < NT);
                if (more) { const size_t off = (size_t)(t + 1) * 64 * PW; kreg = *(const u32x4*)(ksrc + off); vreg = *(const u32x4*)(vsrc + off); if (tid < 128) freg = *(const u32x4*)(fsrc + (size_t)(t + 1) * 64 * 64); }
                if (t * 64 <= q0 + 31) {
                    LAS const unsigned char* KL = L + (t & 1) * BUF; LAS const unsigned char* VL = KL + KB;
                    f32x16 p0 = {}, p1 = {};
#pragma unroll
                    for (int s = 0; s < 5; ++s) { const bf16x8 a0 = *(LAS const bf16x8*)(KL + r32 * KST + s * 32 + hi * 16), a1 = *(LAS const bf16x8*)(KL + (32 + r32) * KST + s * 32 + hi * 16);
                        p0 = __builtin_amdgcn_mfma_f32_32x32x16_bf16(a0, qf[s], p0, 0, 0, 0); p1 = __builtin_amdgcn_mfma_f32_32x32x16_bf16(a1, qf[s], p1, 0, 0, 0); }
                    if (t * 64 + 63 > q0) { const int qg = q0 + r32;
#pragma unroll
                        for (int r = 0; r < 16; ++r) { const int kv = t * 64 + crow(r, hi); if (kv > qg) p0[r] = -INFINITY; if (kv + 32 > qg) p1[r] = -INFINITY; } }
                    float mx = fmaxf(p0[0], p1[0]);
#pragma unroll
                    for (int r = 1; r < 16; ++r) mx = fmaxf(mx, fmaxf(p0[r], p1[r]));
                    mx = fmaxf(mx, __shfl_xor(mx, 32));
                    const float mn = fmaxf(m_run, mx), alpha = __builtin_amdgcn_exp2f(m_run - mn); m_run = mn;
                    float rs = 0.f;
#pragma unroll
                    for (int r = 0; r < 16; ++r) { p0[r] = __builtin_amdgcn_exp2f(p0[r] - mn); p1[r] = __builtin_amdgcn_exp2f(p1[r] - mn); rs += p0[r] + p1[r]; }
                    l_run = l_run * alpha + rs;
#pragma unroll
                    for (int r = 0; r < 16; ++r) { o0[r] *= alpha; o1[r] *= alpha; }
                    u32x4 pw[2][2];
#pragma unroll
                    for (int s = 0; s < 2; ++s) { pw[0][s] = (u32x4){cvtpk(p0[8 * s], p0[8 * s + 1]), cvtpk(p0[8 * s + 2], p0[8 * s + 3]), cvtpk(p0[8 * s + 4], p0[8 * s + 5]), cvtpk(p0[8 * s + 6], p0[8 * s + 7])};
                        pw[1][s] = (u32x4){cvtpk(p1[8 * s], p1[8 * s + 1]), cvtpk(p1[8 * s + 2], p1[8 * s + 3]), cvtpk(p1[8 * s + 4], p1[8 * s + 5]), cvtpk(p1[8 * s + 6], p1[8 * s + 7])}; }
                    LAS const unsigned char* vb = VL + (4 * hi + ((lane & 15) >> 2)) * VST + (((lane >> 4) & 1) * 16 + (lane & 3) * 4) * 2;
#pragma unroll
                    for (int blk = 0; blk < 2; ++blk)
#pragma unroll
                        for (int s = 0; s < 2; ++s) {
#pragma unroll
                            for (int db = 0; db < 2; ++db) { LAS const unsigned char* a = vb + (blk * 32 + 16 * s) * VST + db * 64;
                                const s16x4 lo = ds_tr16(a), hh = ds_tr16(a + 8 * VST);
                                const bf16x8 vf = (bf16x8){lo[0], lo[1], lo[2], lo[3], hh[0], hh[1], hh[2], hh[3]};
                                if (db == 0) o0 = __builtin_amdgcn_mfma_f32_32x32x16_bf16(vf, __builtin_bit_cast(bf16x8, pw[blk][s]), o0, 0, 0, 0);
                                else o1 = __builtin_amdgcn_mfma_f32_32x32x16_bf16(vf, __builtin_bit_cast(bf16x8, pw[blk][s]), o1, 0, 0, 0); } }
                }
                if (more) { LAS unsigned char* D = L + ((t + 1) & 1) * BUF;
                    *(LAS u32x4*)(D + srow * KST + sch * 16) = kreg; *(LAS u32x4*)(D + KB + srow * VST + sch * 16) = vreg;
                    if (tid < 128) *(LAS u32x4*)(D + (tid >> 1) * KST + 128 + (tid & 1) * 16) = freg; }
                __syncthreads();
            }
            const float lt = l_run + __shfl_xor(l_run, 32), inv = 1.f / lt; float ss = 0.f;
#pragma unroll
            for (int r = 0; r < 16; ++r) { o0[r] *= inv; o1[r] *= inv; ss += o0[r] * o0[r] + o1[r] * o1[r]; }
            ss += __shfl_xor(ss, 32);
            const float rstd = rsqrtf(ss * (1.f / 64.f) + EPS);
            bf16_t* yr = Y + mq * DM + 512 + h * 64;
#pragma unroll
            for (int g4 = 0; g4 < 4; ++g4) { u32x2 w0, w1; const int d = 8 * g4 + 4 * hi;
                w0.x = cvtpk(o0[4 * g4] * rstd, o0[4 * g4 + 1] * rstd); w0.y = cvtpk(o0[4 * g4 + 2] * rstd, o0[4 * g4 + 3] * rstd);
                w1.x = cvtpk(o1[4 * g4] * rstd, o1[4 * g4 + 1] * rstd); w1.y = cvtpk(o1[4 * g4 + 2] * rstd, o1[4 * g4 + 3] * rstd);
                *(u32x2*)(yr + d) = w0; *(u32x2*)(yr + 32 + d) = w1; }
        }
    }
}

__device__ __forceinline__ void ph_D_hgrn_out_naive(const Ctx& c, int l) {
    float* qq = (float*)c.lds; float* kk = qq + 4096; float* bc = kk + 4096; float* vv = bc + 4096; float* sp = vv + 4096; float* sc = sp + 4096;
    const bf16_t* P = WSP(bf16_t, WS_PACT); const bf16_t* SP = WSP(bf16_t, WS_HSPREV); bf16_t* Y = WSP(bf16_t, WS_XNY);
    const int t = c.tid >> 3, c0 = (c.tid & 7) * 8;
    for (int u = c.bid; u < NUNIT; u += c.G) {
        const int bh = u >> 6, ch = u & 63, b = bh >> 2, h = bh & 3; const size_t m = (size_t)b * SEQ + ch * 64 + t;
        { float z[8], v[8], q[8], s[8]; unpack8(*(const u32x4*)(P + m * PW + PC_HGF + h * 64 + c0), z); unpack8(*(const u32x4*)(P + m * PW + PC_HGI + h * 64 + c0), v);
          unpack8(*(const u32x4*)(P + m * PW + PC_HGQ + h * 64 + c0), q); unpack8(*(const u32x4*)(SP + ((size_t)u * 64 + t) * 64 + c0), s);
#pragma unroll
          for (int i = 0; i < 8; ++i) { float lf, k; hg_gate(z[i], hg_lb(c, l, h * 64 + c0 + i), lf, k); bc[t * 64 + c0 + i] = lf; kk[t * 64 + c0 + i] = k; vv[t * 64 + c0 + i] = v[i]; qq[t * 64 + c0 + i] = q[i];
              sp[(c0 + i) * 64 + t] = s[i]; } }
        __syncthreads();
        if (c.tid < 64) { float a = 0.f; for (int s = 0; s < 64; ++s) { a += bc[s * 64 + c.tid]; bc[s * 64 + c.tid] = a; } }
        __syncthreads();
#pragma unroll
        for (int i = 0; i < 8; ++i) { const int s = c0 + i; float a = 0.f;
            if (s <= t) for (int kd = 0; kd < 64; ++kd) a += qq[t * 64 + kd] * kk[s * 64 + kd] * __expf(bc[t * 64 + kd] - bc[s * 64 + kd]);
            sc[t * 65 + s] = a; }
        __syncthreads();
        float o[8];
#pragma unroll
        for (int i = 0; i < 8; ++i) o[i] = 0.f;
        for (int s = 0; s <= t; ++s) { const float w = sc[t * 65 + s];
#pragma unroll
            for (int i = 0; i < 8; ++i) o[i] += w * vv[s * 64 + c0 + i]; }
        for (int kd = 0; kd < 64; ++kd) { const float w = qq[t * 64 + kd] * __expf(bc[t * 64 + kd]);
#pragma unroll
            for (int i = 0; i < 8; ++i) o[i] += w * sp[kd * 64 + c0 + i]; }
        float ss = 0.f;
#pragma unroll
        for (int i = 0; i < 8; ++i) ss += o[i] * o[i];
        ss += __shfl_xor(ss, 1); ss += __shfl_xor(ss, 2); ss += __shfl_xor(ss, 4);
        const float rstd = rsqrtf(ss * (1.f / 64.f) + EPS);
        float g[8]; unpack8(*(const u32x4*)(P + m * PW + PC_HGG + h * 64 + c0), g);
#pragma unroll
        for (int i = 0; i < 8; ++i) o[i] = o[i] * rstd * siluf_(g[i]);
        *(u32x4*)(Y + m * DM + 256 + h * 64 + c0) = pack8(o);
        __syncthreads();
    }
}
__device__ __forceinline__ void ph_D_mlstm_out_naive(const Ctx& c, int l) {
    float* qq = (float*)c.lds; float* kk = qq + 4096; float* vv = kk + 4096; float* cp = vv + 4096; float* sc = cp + 4096; float* np = sc + 64 * 65; float* bb = np + 64; float* ig = bb + 64;
    const bf16_t* P = WSP(bf16_t, WS_PACT); const bf16_t* SP = WSP(bf16_t, WS_MSPREV); const float* GT = WSP(float, WS_GT); bf16_t* Y = WSP(bf16_t, WS_XNY);
    const int t = c.tid >> 3, c0 = (c.tid & 7) * 8;
    for (int u = c.bid; u < NUNIT; u += c.G) {
        const int bh = u >> 6, ch = u & 63, b = bh >> 2, h = bh & 3; const size_t m = (size_t)b * SEQ + ch * 64 + t;
        if (c.tid < 64) { const size_t mm = (size_t)b * SEQ + ch * 64 + c.tid; bb[c.tid] = log_sigmoidf_(GT[mm * 16 + 8 + h]); ig[c.tid] = GT[mm * 16 + 4 + h]; np[c.tid] = bf2f(SP[((size_t)u * 80 + 64) * 64 + c.tid]); }
        { float q[8], k[8], v[8], s[8]; ml_conv8(c, l, P, m, ch * 64 + t, PC_MLQ + h * 64 + c0, h * 64 + c0, q); ml_conv8(c, l, P, m, ch * 64 + t, PC_MLK + h * 64 + c0, 256 + h * 64 + c0, k);
          unpack8(*(const u32x4*)(P + m * PW + PC_MLV + h * 64 + c0), v); unpack8(*(const u32x4*)(SP + ((size_t)u * 80 + t) * 64 + c0), s);
#pragma unroll
          for (int i = 0; i < 8; ++i) { qq[t * 64 + c0 + i] = q[i]; kk[t * 64 + c0 + i] = k[i] * 0.125f; vv[t * 64 + c0 + i] = v[i]; cp[(c0 + i) * 64 + t] = s[i]; } }
        __syncthreads();
        if (c.tid == 0) { float a = 0.f; for (int s = 0; s < 64; ++s) { a += bb[s]; bb[s] = a; } }
        __syncthreads();
#pragma unroll
        for (int i = 0; i < 8; ++i) { const int s = c0 + i; float a = 0.f;
            if (s <= t) { for (int kd = 0; kd < 64; ++kd) a += qq[t * 64 + kd] * kk[s * 64 + kd]; a *= __expf(bb[t] - bb[s] + ig[s]); }
            sc[t * 65 + s] = a; }
        __syncthreads();
        float o[8]; float den = 0.f;
#pragma unroll
        for (int i = 0; i < 8; ++i) o[i] = 0.f;
        for (int s = 0; s <= t; ++s) { const float w = sc[t * 65 + s]; den += w;
#pragma unroll
            for (int i = 0; i < 8; ++i) o[i] += w * vv[s * 64 + c0 + i]; }
        const float eb = __expf(bb[t]);
        for (int kd = 0; kd < 64; ++kd) { const float w = qq[t * 64 + kd] * eb; den += w * np[kd];
#pragma unroll
            for (int i = 0; i < 8; ++i) o[i] += w * cp[kd * 64 + c0 + i]; }
        const float inv = 1.f / fmaxf(fabsf(den), 1.f);
        float ss = 0.f;
#pragma unroll
        for (int i = 0; i < 8; ++i) { o[i] *= inv; ss += o[i] * o[i]; }
        ss += __shfl_xor(ss, 1); ss += __shfl_xor(ss, 2); ss += __shfl_xor(ss, 4);
        const float rstd = rsqrtf(ss * (1.f / 64.f) + EPS);
        float g[8]; unpack8(*(const u32x4*)(P + m * PW + PC_MLO + h * 64 + c0), g);
#pragma unroll
        for (int i = 0; i < 8; ++i) o[i] = o[i] * rstd * sigmoidf_(g[i]);
        *(u32x4*)(Y + m * DM + 768 + h * 64 + c0) = pack8(o);
        __syncthreads();
    }
}


typedef float f32x4_t __attribute__((ext_vector_type(4)));
__device__ __forceinline__ bf16x8 frag_row(LAS const unsigned char* base, int stride, int r0, int k0, int lane) {
    return *(LAS const bf16x8*)(base + (r0 + (lane & 15)) * stride + (k0 + 8 * (lane >> 4)) * 2); }
__device__ __forceinline__ bf16x8 frag_tr(LAS const unsigned char* base, int stride, int k0, int c0, int lane) {
    const int g = lane >> 4, i = lane & 15; LAS const unsigned char* p = base + (k0 + 8 * g + (i >> 2)) * stride + (c0 + 4 * (i & 3)) * 2;
    const s16x4 lo = ds_tr16(p), hh = ds_tr16(p + 4 * stride); return (bf16x8){lo[0], lo[1], lo[2], lo[3], hh[0], hh[1], hh[2], hh[3]}; }
#define MFMA16(a, b, c) __builtin_amdgcn_mfma_f32_16x16x32_bf16((a), (b), (c), 0, 0, 0)
__device__ __forceinline__ void scan_t8(float (&x)[8], float (&tot)[8], LAS float* wt, int lane, int wave) {
#pragma unroll
    for (int off = 8; off < 64; off <<= 1) {
#pragma unroll
        for (int i = 0; i < 8; ++i) { const float y = __shfl_up(x[i], off); if (lane >= off) x[i] += y; } }
    if (lane >= 56) {
#pragma unroll
        for (int i = 0; i < 8; ++i) wt[wave * 64 + (lane & 7) * 8 + i] = x[i]; }
    __syncthreads();
#pragma unroll
    for (int i = 0; i < 8; ++i) { float pre = 0.f, t = 0.f;
#pragma unroll
        for (int w = 0; w < 8; ++w) { const float v = wt[w * 64 + (lane & 7) * 8 + i]; t += v; if (w < wave) pre += v; }
        x[i] += pre; tot[i] = t; }
}
constexpr int CST = 144;

__device__ __forceinline__ void ph_B_hgrn_local_fast(const Ctx& c, int l) {
    LAS unsigned char* KH = c.lds3; LAS unsigned char* VV = KH + 64 * CST; LAS float* wt = (LAS float*)(VV + 64 * CST);
    const bf16_t* P = WSP(bf16_t, WS_PACT);
    const int tid = c.tid, lane = c.lane, wave = c.wave, t = tid >> 3, c0 = (tid & 7) * 8;
    for (int u = c.bid; u < NUNIT; u += c.G) {
        const int bh = u >> 6, ch = u & 63, b = bh >> 2, h = bh & 3; const size_t m = (size_t)b * SEQ + ch * 64 + t;
        const u32x4 zr = *(const u32x4*)(P + m * PW + PC_HGF + h * 64 + c0), vr = *(const u32x4*)(P + m * PW + PC_HGI + h * 64 + c0);
        float z[8], lf[8], kk[8], tot[8]; unpack8(zr, z);
#pragma unroll
        for (int i = 0; i < 8; ++i) hg_gate(z[i], hg_lb(c, l, h * 64 + c0 + i), lf[i], kk[i]);
        scan_t8(lf, tot, wt, lane, wave);
#pragma unroll
        for (int i = 0; i < 8; ++i) kk[i] *= __expf(tot[i] - lf[i]);
        *(LAS u32x4*)(KH + t * CST + c0 * 2) = pack8(kk); *(LAS u32x4*)(VV + t * CST + c0 * 2) = vr;
        if (t == 63) {
#pragma unroll
            for (int i = 0; i < 8; ++i) WSP(float, WS_HDEC)[(size_t)u * 64 + c0 + i] = __expf(tot[i]); }
        __syncthreads();
        { const int a = wave >> 1;
#pragma unroll
          for (int j = 0; j < 2; ++j) { const int bt = 2 * (wave & 1) + j; f32x4_t acc = {0.f, 0.f, 0.f, 0.f};
#pragma unroll
              for (int ks = 0; ks < 2; ++ks) acc = MFMA16(frag_tr(KH, CST, 32 * ks, 16 * a, lane), frag_tr(VV, CST, 32 * ks, 16 * bt, lane), acc);
              *(f32x4_t*)(WSP(float, WS_HSLOC) + ((size_t)u * 64 + 16 * bt + (lane & 15)) * 64 + 16 * a + 4 * (lane >> 4)) = acc; } }
        __syncthreads();
    }
}

__device__ __forceinline__ void ph_D_hgrn_out_fast(const Ctx& c, int l) {
    LAS unsigned char* QA = c.lds3; LAS unsigned char* QB = QA + 32 * CST; LAS unsigned char* QC = QB + 32 * CST; LAS unsigned char* KA = QC + 32 * CST; LAS unsigned char* KB_ = KA + 32 * CST; LAS unsigned char* KC = KB_ + 32 * CST;
    LAS unsigned char* QH = KC + 32 * CST; LAS unsigned char* VV = QH + 64 * CST; LAS unsigned char* SP = VV + 64 * CST; LAS unsigned char* SC = SP + 64 * CST;
    LAS float* refs = (LAS float*)(SC + 64 * CST); LAS float* wt = refs + 4 * 64; LAS float* ssb = wt + 8 * 64;
    const bf16_t* P = WSP(bf16_t, WS_PACT); const bf16_t* SPG = WSP(bf16_t, WS_HSPREV); bf16_t* Y = WSP(bf16_t, WS_XNY);
    const int tid = c.tid, lane = c.lane, wave = c.wave, t = tid >> 3, c0 = (tid & 7) * 8;
    for (int u = c.bid; u < NUNIT; u += c.G) {
        const int bh = u >> 6, ch = u & 63, b = bh >> 2, h = bh & 3; const size_t m0 = (size_t)b * SEQ + ch * 64, m = m0 + t;
        const u32x4 zr = *(const u32x4*)(P + m * PW + PC_HGF + h * 64 + c0), vr = *(const u32x4*)(P + m * PW + PC_HGI + h * 64 + c0), qr = *(const u32x4*)(P + m * PW + PC_HGQ + h * 64 + c0);
        const u32x4 sr = *(const u32x4*)(SPG + ((size_t)u * 64 + t) * 64 + c0);
        float z[8], q[8], bc[8], kk[8], tot[8]; unpack8(zr, z); unpack8(qr, q);
#pragma unroll
        for (int i = 0; i < 8; ++i) hg_gate(z[i], hg_lb(c, l, h * 64 + c0 + i), bc[i], kk[i]);
        scan_t8(bc, tot, wt, lane, wave);
        if ((t & 15) == 15 && t < 63) {
#pragma unroll
            for (int i = 0; i < 8; ++i) refs[(t >> 4) * 64 + c0 + i] = bc[i]; }
        *(LAS u32x4*)(VV + t * CST + c0 * 2) = vr; *(LAS u32x4*)(SP + t * CST + c0 * 2) = sr;
        __syncthreads();
        { float o1[8], o2[8], o3[8], o4[8];
          if (t < 32) {
#pragma unroll
              for (int i = 0; i < 8; ++i) { const float r15 = refs[c0 + i], r31 = refs[64 + c0 + i]; o1[i] = q[i] * __expf(bc[i] - r15); o2[i] = kk[i] * __expf(r15 - bc[i]); o3[i] = kk[i] * __expf(r31 - bc[i]); }
              *(LAS u32x4*)(QA + t * CST + c0 * 2) = pack8(o1); *(LAS u32x4*)(KA + t * CST + c0 * 2) = pack8(o2); *(LAS u32x4*)(KB_ + t * CST + c0 * 2) = pack8(o3);
          } else { const int tt = t - 32;
#pragma unroll
              for (int i = 0; i < 8; ++i) { const float r31 = refs[64 + c0 + i], r47 = refs[128 + c0 + i]; o1[i] = q[i] * __expf(bc[i] - r31); o2[i] = q[i] * __expf(bc[i] - r47); o3[i] = kk[i] * __expf(r47 - bc[i]); }
              *(LAS u32x4*)(QB + tt * CST + c0 * 2) = pack8(o1); *(LAS u32x4*)(QC + tt * CST + c0 * 2) = pack8(o2); *(LAS u32x4*)(KC + tt * CST + c0 * 2) = pack8(o3); }
#pragma unroll
          for (int i = 0; i < 8; ++i) o4[i] = q[i] * __expf(bc[i]);
          *(LAS u32x4*)(QH + t * CST + c0 * 2) = pack8(o4); }
        __syncthreads();
#pragma unroll
        for (int e2 = 0; e2 < 2; ++e2) { const int e = wave + 8 * e2, ti = e >> 2, si = e & 3; f32x4_t acc = {0.f, 0.f, 0.f, 0.f};
            if (si <= ti) { LAS const unsigned char* Qp = (ti < 2) ? QA : ((si < 2) ? QB : QC); LAS const unsigned char* Kp = (ti < 2) ? KA : ((si < 2) ? KB_ : KC);
                const int qr0 = 16 * (ti & 1), kr0 = 16 * (si & 1);
#pragma unroll
                for (int ks = 0; ks < 2; ++ks) acc = MFMA16(frag_row(Kp, CST, kr0, 32 * ks, lane), frag_row(Qp, CST, qr0, 32 * ks, lane), acc);
                if (si == ti) {
#pragma unroll
                    for (int i = 0; i < 4; ++i) if (4 * (lane >> 4) + i > (lane & 15)) acc[i] = 0.f; } }
            u32x2 w; w.x = cvtpk(acc[0], acc[1]); w.y = cvtpk(acc[2], acc[3]);
            *(LAS u32x2*)(SC + (16 * ti + (lane & 15)) * CST + (16 * si + 4 * (lane >> 4)) * 2) = w; }
        __syncthreads();
        { const int ts = wave >> 1; f32x4_t acc[2]; float ss = 0.f;
#pragma unroll
          for (int j = 0; j < 2; ++j) { const int vt = 2 * (wave & 1) + j; acc[j] = (f32x4_t){0.f, 0.f, 0.f, 0.f};
              acc[j] = MFMA16(frag_tr(VV, CST, 0, 16 * vt, lane), frag_row(SC, CST, 16 * ts, 0, lane), acc[j]);
              if (ts >= 2) acc[j] = MFMA16(frag_tr(VV, CST, 32, 16 * vt, lane), frag_row(SC, CST, 16 * ts, 32, lane), acc[j]);
#pragma unroll
              for (int ks = 0; ks < 2; ++ks) acc[j] = MFMA16(frag_row(SP, CST, 16 * vt, 32 * ks, lane), frag_row(QH, CST, 16 * ts, 32 * ks, lane), acc[j]);
#pragma unroll
              for (int i = 0; i < 4; ++i) ss += acc[j][i] * acc[j][i]; }
          ss += __shfl_xor(ss, 16); ss += __shfl_xor(ss, 32);
          if (lane < 16) ssb[(16 * ts + lane) * 2 + (wave & 1)] = ss;
          __syncthreads();
          const int tl = 16 * ts + (lane & 15); const float rstd = rsqrtf((ssb[tl * 2] + ssb[tl * 2 + 1]) * (1.f / 64.f) + EPS);
#pragma unroll
          for (int j = 0; j < 2; ++j) { const int vd = 16 * (2 * (wave & 1) + j) + 4 * (lane >> 4);
              const u32x2 gr = *(const u32x2*)(P + (m0 + tl) * PW + PC_HGG + h * 64 + vd);
              const float g0 = bf2f(gr.x & 0xffffu), g1 = bf2f(gr.x >> 16), g2 = bf2f(gr.y & 0xffffu), g3 = bf2f(gr.y >> 16);
              u32x2 w; w.x = cvtpk(acc[j][0] * rstd * siluf_(g0), acc[j][1] * rstd * siluf_(g1)); w.y = cvtpk(acc[j][2] * rstd * siluf_(g2), acc[j][3] * rstd * siluf_(g3));
              *(u32x2*)(Y + (m0 + tl) * DM + 256 + h * 64 + vd) = w; } }
        __syncthreads();
    }
}


constexpr int VST80 = 176;
__device__ __forceinline__ void ml_gates(const Ctx& c, LAS float* bb, LAS float* igs, size_t m0, int h) {
    if (c.tid < 64) { const float* GT = WSP(float, WS_GT); float x = log_sigmoidf_(GT[(m0 + c.tid) * 16 + 8 + h]);
#pragma unroll
        for (int off = 1; off < 64; off <<= 1) { const float y = __shfl_up(x, off); if (c.lane >= off) x += y; }
        bb[c.tid] = x; igs[c.tid] = GT[(m0 + c.tid) * 16 + 4 + h]; }
}
__device__ __forceinline__ void ph_B_mlstm_local_fast(const Ctx& c, int l) {
    LAS unsigned char* KH = c.lds3; LAS unsigned char* VV = KH + 64 * CST; LAS float* bb = (LAS float*)(VV + 64 * VST80); LAS float* igs = bb + 64;
    const bf16_t* P = WSP(bf16_t, WS_PACT);
    const int tid = c.tid, lane = c.lane, wave = c.wave, t = tid >> 3, c0 = (tid & 7) * 8;
    for (int u = c.bid; u < NUNIT; u += c.G) {
        const int bh = u >> 6, ch = u & 63, b = bh >> 2, h = bh & 3; const size_t m0 = (size_t)b * SEQ + ch * 64, m = m0 + t;
        ml_gates(c, bb, igs, m0, h);
        const u32x4 vr = *(const u32x4*)(P + m * PW + PC_MLV + h * 64 + c0);
        float k[8]; ml_conv8(c, l, P, m, ch * 64 + t, PC_MLK + h * 64 + c0, 256 + h * 64 + c0, k);
        __syncthreads();
        { const float w = 0.125f * __expf(bb[63] - bb[t] + igs[t]);
#pragma unroll
          for (int i = 0; i < 8; ++i) k[i] *= w; }
        *(LAS u32x4*)(KH + t * CST + c0 * 2) = pack8(k); *(LAS u32x4*)(VV + t * VST80 + c0 * 2) = vr;
        if ((tid & 7) < 2) *(LAS u32x4*)(VV + t * VST80 + 128 + (tid & 7) * 16) = (u32x4){(tid & 7) == 0 ? 0x3f80u : 0u, 0u, 0u, 0u};
        if (tid == 0) WSP(float, WS_MDEC)[u] = __expf(bb[63]);
        __syncthreads();
#pragma unroll
        for (int j = 0; j < 3; ++j) { const int e = wave + 8 * j; if (e < 20) { const int a = e & 3, bt = e >> 2; f32x4_t acc = {0.f, 0.f, 0.f, 0.f};
#pragma unroll
            for (int ks = 0; ks < 2; ++ks) acc = MFMA16(frag_tr(KH, CST, 32 * ks, 16 * a, lane), frag_tr(VV, VST80, 32 * ks, 16 * bt, lane), acc);
            const int vd = 16 * bt + (lane & 15);
            if (vd < 65) *(f32x4_t*)(WSP(float, WS_MSLOC) + ((size_t)u * 65 + vd) * 64 + 16 * a + 4 * (lane >> 4)) = acc; } }
        __syncthreads();
    }
}
__device__ __forceinline__ void ph_D_mlstm_out_fast(const Ctx& c, int l) {
    LAS unsigned char* QT = c.lds3; LAS unsigned char* KT = QT + 64 * CST; LAS unsigned char* VV = KT + 64 * CST; LAS unsigned char* CP = VV + 64 * VST80; LAS unsigned char* SC = CP + 80 * CST;
    LAS float* bb = (LAS float*)(SC + 64 * CST); LAS float* igs = bb + 64; LAS float* den = igs + 64; LAS float* ssb = den + 64;
    const bf16_t* P = WSP(bf16_t, WS_PACT); const bf16_t* SPG = WSP(bf16_t, WS_MSPREV); bf16_t* Y = WSP(bf16_t, WS_XNY);
    const int tid = c.tid, lane = c.lane, wave = c.wave, t = tid >> 3, c0 = (tid & 7) * 8;
    for (int u = c.bid; u < NUNIT; u += c.G) {
        const int bh = u >> 6, ch = u & 63, b = bh >> 2, h = bh & 3; const size_t m0 = (size_t)b * SEQ + ch * 64, m = m0 + t;
        ml_gates(c, bb, igs, m0, h);
        const u32x4 vr = *(const u32x4*)(P + m * PW + PC_MLV + h * 64 + c0);
        const u32x4 cr = *(const u32x4*)(SPG + (size_t)u * 80 * 64 + tid * 8);
        u32x4 cr2 = (u32x4){0u, 0u, 0u, 0u}; if (tid < 128) cr2 = *(const u32x4*)(SPG + (size_t)u * 80 * 64 + (512 + tid) * 8);
        float q[8], k[8]; ml_conv8(c, l, P, m, ch * 64 + t, PC_MLQ + h * 64 + c0, h * 64 + c0, q); ml_conv8(c, l, P, m, ch * 64 + t, PC_MLK + h * 64 + c0, 256 + h * 64 + c0, k);
        __syncthreads();
        { const float eq = __expf(bb[t]), ek = 0.125f * __expf(igs[t] - bb[t]);
#pragma unroll
          for (int i = 0; i < 8; ++i) { q[i] *= eq; k[i] *= ek; } }
        *(LAS u32x4*)(QT + t * CST + c0 * 2) = pack8(q); *(LAS u32x4*)(KT + t * CST + c0 * 2) = pack8(k); *(LAS u32x4*)(VV + t * VST80 + c0 * 2) = vr;
        if ((tid & 7) < 2) *(LAS u32x4*)(VV + t * VST80 + 128 + (tid & 7) * 16) = (u32x4){(tid & 7) == 0 ? 0x3f80u : 0u, 0u, 0u, 0u};
        *(LAS u32x4*)(CP + (tid >> 3) * CST + (tid & 7) * 16) = cr; if (tid < 128) *(LAS u32x4*)(CP + (64 + (tid >> 3)) * CST + (tid & 7) * 16) = cr2;
        __syncthreads();
#pragma unroll
        for (int e2 = 0; e2 < 2; ++e2) { const int e = wave + 8 * e2, ti = e >> 2, si = e & 3; f32x4_t acc = {0.f, 0.f, 0.f, 0.f};
            if (si <= ti) {
#pragma unroll
                for (int ks = 0; ks < 2; ++ks) acc = MFMA16(frag_row(KT, CST, 16 * si, 32 * ks, lane), frag_row(QT, CST, 16 * ti, 32 * ks, lane), acc);
                if (si == ti) {
#pragma unroll
                    for (int i = 0; i < 4; ++i) if (4 * (lane >> 4) + i > (lane & 15)) acc[i] = 0.f; } }
            u32x2 w; w.x = cvtpk(acc[0], acc[1]); w.y = cvtpk(acc[2], acc[3]);
            *(LAS u32x2*)(SC + (16 * ti + (lane & 15)) * CST + (16 * si + 4 * (lane >> 4)) * 2) = w; }
        __syncthreads();
        { const int ts = wave >> 1, hf = wave & 1; f32x4_t acc[3];
#pragma unroll
          for (int j = 0; j < 3; ++j) { acc[j] = (f32x4_t){0.f, 0.f, 0.f, 0.f}; if (j < 2 || hf == 0) { const int vt = (j == 2) ? 4 : 2 * hf + j;
              acc[j] = MFMA16(frag_tr(VV, VST80, 0, 16 * vt, lane), frag_row(SC, CST, 16 * ts, 0, lane), acc[j]);
              if (ts >= 2) acc[j] = MFMA16(frag_tr(VV, VST80, 32, 16 * vt, lane), frag_row(SC, CST, 16 * ts, 32, lane), acc[j]);
#pragma unroll
              for (int ks = 0; ks < 2; ++ks) acc[j] = MFMA16(frag_row(CP, CST, 16 * vt, 32 * ks, lane), frag_row(QT, CST, 16 * ts, 32 * ks, lane), acc[j]); } }
          if (hf == 0 && lane < 16) den[16 * ts + lane] = acc[2][0];
          __syncthreads();
          const int tl = 16 * ts + (lane & 15); const float inv = 1.f / fmaxf(fabsf(den[tl]), 1.f); float ss = 0.f;
#pragma unroll
          for (int j = 0; j < 2; ++j)
#pragma unroll
              for (int i = 0; i < 4; ++i) { acc[j][i] *= inv; ss += acc[j][i] * acc[j][i]; }
          ss += __shfl_xor(ss, 16); ss += __shfl_xor(ss, 32);
          if (lane < 16) ssb[(16 * ts + lane) * 2 + hf] = ss;
          __syncthreads();
          const float rstd = rsqrtf((ssb[tl * 2] + ssb[tl * 2 + 1]) * (1.f / 64.f) + EPS);
#pragma unroll
          for (int j = 0; j < 2; ++j) { const int vd = 16 * (2 * hf + j) + 4 * (lane >> 4);
              const u32x2 gr = *(const u32x2*)(P + (m0 + tl) * PW + PC_MLO + h * 64 + vd);
              const float g0 = bf2f(gr.x & 0xffffu), g1 = bf2f(gr.x >> 16), g2 = bf2f(gr.y & 0xffffu), g3 = bf2f(gr.y >> 16);
              u32x2 w; w.x = cvtpk(acc[j][0] * rstd * sigmoidf_(g0), acc[j][1] * rstd * sigmoidf_(g1)); w.y = cvtpk(acc[j][2] * rstd * sigmoidf_(g2), acc[j][3] * rstd * sigmoidf_(g3));
              *(u32x2*)(Y + (m0 + tl) * DM + 768 + h * 64 + vd) = w; } }
        __syncthreads();
    }
}

__device__ __forceinline__ void ph_E_glu_naive(const Ctx& c, int l) {
    float* g1 = (float*)c.lds;
    bf16_t* wl = (bf16_t*)(g1 + 64 * 256);
    const bf16_t* G1 = WSP(bf16_t, WS_G1); const bf16_t* WT = WSP(bf16_t, WS_WGLU) + (size_t)l * 256 * 256; bf16_t* Y = WSP(bf16_t, WS_XNY);
    const int t = c.tid >> 3, j8 = c.tid & 7;
    for (int u = c.bid; u < MTOK / 64; u += c.G) {
        const size_t m0 = (size_t)u * 64;
        for (int e = c.tid; e < 64 * 32; e += NTHR) { const int r = e >> 5, c8 = (e & 31) * 8; float v[8]; unpack8(*(const u32x4*)(G1 + (m0 + r) * 256 + c8), v);
#pragma unroll
            for (int i = 0; i < 8; ++i) g1[r * 256 + c8 + i] = v[i]; }
        float yv[32]; float ss = 0.f;
#pragma unroll
        for (int hf = 0; hf < 2; ++hf) {
            __syncthreads();
            for (int e = c.tid; e < 128 * 32; e += NTHR) { const int r = e >> 5, c8 = (e & 31) * 8; *(u32x4*)(wl + r * 264 + c8) = *(const u32x4*)(WT + (size_t)(hf * 128 + r) * 256 + c8); }
            __syncthreads();
#pragma unroll
            for (int i = 0; i < 16; ++i) { const int nl = j8 * 16 + i; float a = 0.f;
                for (int k = 0; k < 256; k += 2) { const unsigned w = *(const unsigned*)(wl + nl * 264 + k); a += g1[t * 256 + k] * bf2f(w & 0xffffu) + g1[t * 256 + k + 1] * bf2f(w >> 16); }
                const float g = g1[t * 256 + hf * 128 + nl]; const float y = g * sigmoidf_(a); yv[hf * 16 + i] = y; ss += y * y; }
        }
        ss += __shfl_xor(ss, 1); ss += __shfl_xor(ss, 2); ss += __shfl_xor(ss, 4);
        const float rstd = rsqrtf(ss * (1.f / 256.f) + EPS);
#pragma unroll
        for (int hf = 0; hf < 2; ++hf)
#pragma unroll
            for (int i8 = 0; i8 < 2; ++i8) { float o[8];
#pragma unroll
                for (int i = 0; i < 8; ++i) o[i] = yv[hf * 16 + i8 * 8 + i] * rstd;
                *(u32x4*)(Y + (m0 + t) * DM + hf * 128 + j8 * 16 + i8 * 8) = pack8(o); }
        __syncthreads();
    }
}


__device__ __forceinline__ void ph_E_glu_fast(const Ctx& c, int l) {
    constexpr int GST = 528;
    LAS unsigned char* GT_ = c.lds3; LAS float* ssb = (LAS float*)(GT_ + 64 * GST);
    const bf16_t* G1 = WSP(bf16_t, WS_G1); const bf16_t* WT = WSP(bf16_t, WS_WGLU) + (size_t)l * 256 * 256; bf16_t* Y = WSP(bf16_t, WS_XNY);
    const int tid = c.tid, lane = c.lane, wave = c.wave;
    for (int u = c.bid; u < MTOK / 64; u += c.G) {
        const size_t m0 = (size_t)u * 64;
#pragma unroll
        for (int e = 0; e < 4; ++e) { const int ci = tid + 512 * e, r = ci >> 5, c8 = (ci & 31) * 8; *(LAS u32x4*)(GT_ + r * GST + c8 * 2) = *(const u32x4*)(G1 + (m0 + r) * 256 + c8); }
        __syncthreads();
        f32x4_t acc[2][4];
#pragma unroll
        for (int j = 0; j < 2; ++j)
#pragma unroll
            for (int mt = 0; mt < 4; ++mt) acc[j][mt] = (f32x4_t){0.f, 0.f, 0.f, 0.f};
#pragma unroll 2
        for (int ks = 0; ks < 8; ++ks) { bf16x8 wf[2], gf[4];
#pragma unroll
            for (int j = 0; j < 2; ++j) wf[j] = *(const bf16x8*)(WT + (size_t)(16 * (2 * wave + j) + (lane & 15)) * 256 + 32 * ks + 8 * (lane >> 4));
#pragma unroll
            for (int mt = 0; mt < 4; ++mt) gf[mt] = frag_row(GT_, GST, 16 * mt, 32 * ks, lane);
#pragma unroll
            for (int j = 0; j < 2; ++j)
#pragma unroll
                for (int mt = 0; mt < 4; ++mt) acc[j][mt] = MFMA16(wf[j], gf[mt], acc[j][mt]); }
#pragma unroll
        for (int mt = 0; mt < 4; ++mt) { float ss = 0.f;
#pragma unroll
            for (int j = 0; j < 2; ++j) { const int n = 16 * (2 * wave + j) + 4 * (lane >> 4); const u32x2 gr = *(LAS const u32x2*)(GT_ + (16 * mt + (lane & 15)) * GST + n * 2);
                const float g0 = bf2f(gr.x & 0xffffu), g1 = bf2f(gr.x >> 16), g2 = bf2f(gr.y & 0xffffu), g3 = bf2f(gr.y >> 16);
                acc[j][mt][0] = g0 * sigmoidf_(acc[j][mt][0]); acc[j][mt][1] = g1 * sigmoidf_(acc[j][mt][1]); acc[j][mt][2] = g2 * sigmoidf_(acc[j][mt][2]); acc[j][mt][3] = g3 * sigmoidf_(acc[j][mt][3]);
#pragma unroll
                for (int i = 0; i < 4; ++i) ss += acc[j][mt][i] * acc[j][mt][i]; }
            ss += __shfl_xor(ss, 16); ss += __shfl_xor(ss, 32);
            if (lane < 16) ssb[(16 * mt + lane) * 8 + wave] = ss; }
        __syncthreads();
#pragma unroll
        for (int mt = 0; mt < 4; ++mt) { const int tl = 16 * mt + (lane & 15); float s = 0.f;
#pragma unroll
            for (int w = 0; w < 8; ++w) s += ssb[tl * 8 + w];
            const float rstd = rsqrtf(s * (1.f / 256.f) + EPS);
#pragma unroll
            for (int j = 0; j < 2; ++j) { const int n = 16 * (2 * wave + j) + 4 * (lane >> 4); u32x2 w; w.x = cvtpk(acc[j][mt][0] * rstd, acc[j][mt][1] * rstd); w.y = cvtpk(acc[j][mt][2] * rstd, acc[j][mt][3] * rstd);
                *(u32x2*)(Y + (m0 + tl) * DM + n) = w; } }
        __syncthreads();
    }
}

__device__ __forceinline__ void ph_rowpass(const Ctx& c, const float* hprev, const float* gpost, float* hout, bf16_t* xn) {
    const bf16_t* MX = WSP(bf16_t, WS_MX);
    const int gw = c.bid * 8 + c.wave, NGW = c.G * 8;
    for (int m = gw; m < MTOK; m += NGW) {
        const u32x2* mr = (const u32x2*)(MX + (size_t)m * DM) + c.lane; const f32x4* hr = (const f32x4*)(hprev + (size_t)m * DM) + c.lane; const f32x4* gr = (const f32x4*)gpost + c.lane;
        f32x4 x[4], hv[4]; float s = 0.f;
#pragma unroll
        for (int j = 0; j < 4; ++j) { const u32x2 w = mr[64 * j]; x[j] = (f32x4){bf2f(w.x & 0xffffu), bf2f(w.x >> 16), bf2f(w.y & 0xffffu), bf2f(w.y >> 16)}; hv[j] = hr[64 * j];
            s += (x[j].x * x[j].x + x[j].y * x[j].y) + (x[j].z * x[j].z + x[j].w * x[j].w); }
        const float r1 = rsqrtf(wave_sum(s) * (1.f / DM) + EPS); float s2 = 0.f;
#pragma unroll
        for (int j = 0; j < 4; ++j) { const f32x4 g = gr[64 * j]; hv[j] = hv[j] + x[j] * r1 * g; s2 += (hv[j].x * hv[j].x + hv[j].y * hv[j].y) + (hv[j].z * hv[j].z + hv[j].w * hv[j].w); }
        f32x4* ho = (f32x4*)(hout + (size_t)m * DM) + c.lane;
#pragma unroll
        for (int j = 0; j < 4; ++j) ho[64 * j] = hv[j];
        if (xn) { const float r2 = rsqrtf(wave_sum(s2) * (1.f / DM) + EPS); u32x2* o8 = (u32x2*)(xn + (size_t)m * DM) + c.lane;
#pragma unroll
            for (int j = 0; j < 4; ++j) { u32x2 w; w.x = pk2(hv[j].x * r2, hv[j].y * r2); w.y = pk2(hv[j].z * r2, hv[j].w * r2); o8[64 * j] = w; } }
    }
}


typedef GAS unsigned gu32;
#define XB_TMO      128
#define XB_XCNT(j)  (256  + 64 * (j))
#define XB_XSUB(j)  (1280 + 64 * (j))
#define XB_XGEN(j)  (2304 + 64 * (j))
#define XB_TOP      3328
#define XB_TOPGEN   3392
#define XCD_BAR_WORDS 3456
#define XB_SPIN_CAP (1u << 22)
constexpr int CW_BAR = 4096;
constexpr int MISC_OFF = LDS_BYTES - 256;
__device__ __forceinline__ unsigned xb_ld(unsigned* p)              { return __hip_atomic_load(p, __ATOMIC_RELAXED, __HIP_MEMORY_SCOPE_AGENT); }
__device__ __forceinline__ unsigned xb_add(unsigned* p, unsigned v) { return __hip_atomic_fetch_add(p, v, __ATOMIC_RELAXED, __HIP_MEMORY_SCOPE_AGENT); }
__device__ __forceinline__ unsigned xb_xcc_id() { return (unsigned)__builtin_amdgcn_s_getreg((3 << 11) | 20) & 0xFu; }
#define XB_SPIN(cond, bar) do { unsigned _sp = 0; while (cond) { __builtin_amdgcn_s_sleep(1); \
    if ((++_sp & 255u) == 0u) { if (xb_ld(&(bar)[XB_TMO])) break; if (_sp > XB_SPIN_CAP) { atomicAdd(&(bar)[XB_TMO], 1u); break; } } } } while (0)
struct XcdBarrier { unsigned* bar; unsigned x; volatile LAS unsigned* st; };
__device__ __forceinline__ XcdBarrier xcd_barrier_post(unsigned* bar, volatile LAS unsigned* st) {
    XcdBarrier b; b.bar = bar; b.x = xb_xcc_id(); b.st = st;
    if (threadIdx.x == 0) (void)xb_add(&bar[XB_XCNT(b.x)], 1u);
    return b;
}
__device__ __forceinline__ void xcd_barrier_complete(unsigned* bar, unsigned x, unsigned& nloc, unsigned& nx) {
    const unsigned G = gridDim.x * gridDim.y * gridDim.z;
    unsigned sum, cnt, mine, sp = 0u;
    for (;;) {
        sum = 0u; cnt = 0u; mine = 0u;
#pragma unroll
        for (unsigned j = 0; j < 16; ++j) { const unsigned c = xb_ld(&bar[XB_XCNT(j)]); sum += c; cnt += (c > 0u) ? 1u : 0u; mine = (j == x) ? c : mine; }
        if (sum == G) break;
        __builtin_amdgcn_s_sleep(1);
        if ((++sp & 255u) == 0u) { if (xb_ld(&bar[XB_TMO])) break; if (sp > XB_SPIN_CAP) { atomicAdd(&bar[XB_TMO], 1u); break; } }
    }
    nloc = mine > 0u ? mine : 1u; nx = cnt > 0u ? cnt : 1u;
}
__device__ __forceinline__ void xcd_barrier(const XcdBarrier& b) {
    asm volatile("s_waitcnt vmcnt(0)" ::: "memory");
    __syncthreads();
    if (threadIdx.x == 0) {
        unsigned* bar = b.bar;
        __builtin_amdgcn_s_waitcnt(0);
        unsigned nloc = b.st[0], nx = b.st[1];
        if (nloc == 0u) { xcd_barrier_complete(bar, b.x, nloc, nx); b.st[0] = nloc; b.st[1] = nx; }
        const unsigned old = xb_add(&bar[XB_XSUB(b.x)], 1u);
        const unsigned gen = old / nloc;
        if (old + 1u == (gen + 1u) * nloc) {
            __builtin_amdgcn_fence(__ATOMIC_RELEASE, "agent");
            asm volatile("s_waitcnt vmcnt(0)" ::: "memory");
            const unsigned og = xb_add(&bar[XB_TOP], 1u);
            const unsigned tg = og / nx;
            if (og + 1u == (tg + 1u) * nx) xb_add(&bar[XB_TOPGEN], 1u);
            else XB_SPIN(xb_ld(&bar[XB_TOPGEN]) == tg, bar);
            __builtin_amdgcn_fence(__ATOMIC_ACQUIRE, "agent");
            xb_add(&bar[XB_XGEN(b.x)], 1u);
            asm volatile("s_waitcnt vmcnt(0)" ::: "memory");
        } else {
            XB_SPIN(xb_ld(&bar[XB_XGEN(b.x)]) == gen, bar);
            __builtin_amdgcn_fence(__ATOMIC_ACQUIRE, "agent");
            asm volatile("s_waitcnt vmcnt(0)" ::: "memory");
        }
    }
    __syncthreads();
}

struct Args { const float* in[23]; float* out; unsigned char* ws; int lo, hi; };
constexpr int NPHASE = 1 + 10 * DEPTH;

__global__ void __launch_bounds__(NTHR, 2) hybrid_fwd(Args args) {
    extern __shared__ __attribute__((aligned(16))) unsigned char lds_raw[];
    Ctx c;
#pragma unroll
    for (int i = 0; i < 23; ++i) c.in[i] = args.in[i];
    c.out = args.out; c.ws = args.ws; c.lds = lds_raw; c.lds3 = (LAS unsigned char*)lds_raw; c.tid = threadIdx.x; c.lane = c.tid & 63; c.wave = __builtin_amdgcn_readfirstlane(c.tid >> 6); c.G = gridDim.x; c.bid = blockIdx.x;
    const int lo = args.lo, hi = args.hi;
    volatile LAS unsigned* MISC = (volatile LAS unsigned*)(c.lds3 + MISC_OFF);
    if (c.tid < 64) MISC[c.tid] = 0u;
    __syncthreads();
    XcdBarrier gbar; gbar.bar = (unsigned*)(args.ws + WS_CTL) + CW_BAR; gbar.x = 0; gbar.st = nullptr;
    if (hi - lo > 1) gbar = xcd_barrier_post((unsigned*)(args.ws + WS_CTL) + CW_BAR, MISC + 8);
#define SEAM(k) do { if (IN(k) && IN((k) + 1)) xcd_barrier(gbar); } while (0)
#define IN(k) (lo <= (k) && (k) < hi)
#define FRESH() do { c.tid = opaque_v((int)threadIdx.x); c.lane = c.tid & 63; } while (0)
    if (IN(0)) { FRESH(); ph_prologue(c); }
    SEAM(0);
    for (int l = 0; l < DEPTH; ++l) {
        const int pb = 1 + 10 * l;
        if (IN(pb + 0)) {
            EpiInProj E{WSP(bf16_t, WS_U2), WSP(bf16_t, WS_PACT), WSP(float, WS_GT), c.in[I_GB] + l * 12};
#if USE_PG8
            { pg8::Gemm g{WSP(bf16_t, WS_XNY), WSP(bf16_t, WS_WIN) + (size_t)l * NIN * DM, DM, DM, DM, (size_t)256 * DM * 2, (size_t)256 * DM * 2};
              pg8::StaticOrder S; S.init(MTOK, NIN, c.G, c.bid); pg8::EpiWrap<EpiInProj, false> W{E};
              pg8::gemm_phase<pg8::EpiWrap<EpiInProj, false>, pg8::StaticOrder, true>(c.lds3, g, S, W); }
#else
            gemm_naive<false>(c, WSP(bf16_t, WS_XNY), DM, WSP(bf16_t, WS_WIN) + (size_t)l * NIN * DM, DM, DM,
                [](int t, int& r0, int& c0, int& b0) -> bool { if (t >= (MTOK / 64) * (NIN / 64)) return false; r0 = 64 * (t / (NIN / 64)); c0 = b0 = 64 * (t % (NIN / 64)); return true; }, E);
#endif
        }
        SEAM(pb + 0);
        if (IN(pb + 1)) {
            FRESH(); ph_B_texpand(c, l); FRESH(); ph_B_gatescan(c);
            { EpiXloc E{WSP(float, WS_XLOC)};
#if USE_PG8
              { pg8::Gemm g{WSP(bf16_t, WS_U2), WSP(bf16_t, WS_BM) + (size_t)l * 16 * 128 * 1024, U2LD, 1024, 1024, (size_t)256 * U2LD * 2, (size_t)128 * 1024 * 2};
                pg8::SchedXloc S{c.G, c.bid}; pg8::EpiWrap<EpiXloc, false> W{E};
                pg8::gemm_phase<pg8::EpiWrap<EpiXloc, false>, pg8::SchedXloc, false>(c.lds3, g, S, W); __syncthreads(); }
#else
              gemm_naive<false>(c, WSP(bf16_t, WS_U2), U2LD, WSP(bf16_t, WS_BM) + (size_t)l * 16 * 128 * 1024, 1024, 1024,
                [](int t, int& r0, int& c0, int& b0) -> bool { if (t >= 128 * 2) return false; const int rt = t >> 1, ct = t & 1, g = rt >> 3; r0 = 64 * rt; c0 = 256 * g + 64 * ct; b0 = g * 128 + 64 * ct; return true; }, E);
#endif
            }
            FRESH();
#if FAST_HGRN
            ph_B_hgrn_local_fast(c, l);
#else
            ph_B_hgrn_local_naive(c, l);
#endif
            FRESH();
#if FAST_MLSTM
            ph_B_mlstm_local_fast(c, l);
#else
            ph_B_mlstm_local_naive(c, l);
#endif

        }
        SEAM(pb + 1);
        if (IN(pb + 2)) { FRESH(); ph_C_scans(c, l); FRESH();
#if FAST_FOX
            ph_C_fox_fast(c);
#else
            ph_C_fox_naive(c);
#endif
        }
        SEAM(pb + 2);
        if (IN(pb + 3)) {
            { EpiS5Y E{WSP(bf16_t, WS_G1)};
#if USE_PG8
              { pg8::Gemm g{WSP(bf16_t, WS_U2), WSP(bf16_t, WS_TT), U2LD, U2LD, U2LD, (size_t)256 * U2LD * 2, (size_t)256 * U2LD * 2};
                pg8::SchedS5Y S{c.G, c.bid}; pg8::EpiWrap<EpiS5Y, false> W{E};
                pg8::gemm_phase<pg8::EpiWrap<EpiS5Y, false>, pg8::SchedS5Y, false>(c.lds3, g, S, W); __syncthreads(); }
#else
              gemm_naive<false>(c, WSP(bf16_t, WS_U2), U2LD, WSP(bf16_t, WS_TT), U2LD, U2LD,
                [](int t, int& r0, int& c0, int& b0) -> bool { if (t >= 128 * 16) return false; const int rt = t >> 4, ct = t & 15, g = rt >> 3; r0 = 64 * rt; c0 = b0 = g * 1024 + 64 * ct; return true; }, E);
#endif
            }
            FRESH();
#if FAST_HGRN
            ph_D_hgrn_out_fast(c, l);
#else
            ph_D_hgrn_out_naive(c, l);
#endif
            FRESH();
#if FAST_MLSTM
            ph_D_mlstm_out_fast(c, l);
#else
            ph_D_mlstm_out_naive(c, l);
#endif

        }
        SEAM(pb + 3);
        if (IN(pb + 4)) { FRESH();
#if FAST_GLU
            ph_E_glu_fast(c, l);
#else
            ph_E_glu_naive(c, l);
#endif
        }
        SEAM(pb + 4);
        if (IN(pb + 5)) {
            EpiPlainBf16 E{WSP(bf16_t, WS_MX), DM};
#if USE_PG8
            { pg8::Gemm g{WSP(bf16_t, WS_XNY), WSP(bf16_t, WS_WOUT) + (size_t)l * DM * DM, DM, DM, DM, (size_t)256 * DM * 2, (size_t)256 * DM * 2};
              pg8::StaticOrder S; S.init(MTOK, DM, c.G, c.bid); pg8::EpiWrap<EpiPlainBf16, false> W{E};
              pg8::gemm_phase<pg8::EpiWrap<EpiPlainBf16, false>, pg8::StaticOrder, true>(c.lds3, g, S, W); }
#else
            gemm_naive<false>(c, WSP(bf16_t, WS_XNY), DM, WSP(bf16_t, WS_WOUT) + (size_t)l * DM * DM, DM, DM,
                [](int t, int& r0, int& c0, int& b0) -> bool { if (t >= (MTOK / 64) * 16) return false; r0 = 64 * (t >> 4); c0 = b0 = 64 * (t & 15); return true; }, E);
#endif
        }
        SEAM(pb + 5);
        if (IN(pb + 6)) { FRESH(); } if (IN(pb + 6)) ph_rowpass(c, l == 0 ? c.in[I_X] : c.out, c.in[I_LNMPOST] + l * DM, c.out, WSP(bf16_t, WS_XNY));
        SEAM(pb + 6);
        if (IN(pb + 7)) {
            EpiSwiGLU E{WSP(bf16_t, WS_PACT)};
#if USE_PG8
            { pg8::Gemm g{WSP(bf16_t, WS_XNY), WSP(bf16_t, WS_WGU) + (size_t)l * NGU * DM, DM, DM, DM, (size_t)256 * DM * 2, (size_t)256 * DM * 2};
              pg8::StaticOrder S; S.init(MTOK, NGU, c.G, c.bid); pg8::EpiWrap<EpiSwiGLU, true> W{E};
              pg8::gemm_phase<pg8::EpiWrap<EpiSwiGLU, true>, pg8::StaticOrder, true>(c.lds3, g, S, W); }
#else
            gemm_naive<true>(c, WSP(bf16_t, WS_XNY), DM, WSP(bf16_t, WS_WGU) + (size_t)l * NGU * DM, DM, DM,
                [](int t, int& r0, int& c0, int& b0) -> bool { if (t >= (MTOK / 64) * (DFF / 64)) return false; r0 = 64 * (t / (DFF / 64)); c0 = 64 * (t % (DFF / 64)); b0 = (c0 >> 7) * 256 + (c0 & 127); return true; }, E);
#endif
        }
        SEAM(pb + 7);
        if (IN(pb + 8)) {
            EpiPlainBf16 E{WSP(bf16_t, WS_MX), DM};
#if USE_PG8
            { pg8::Gemm g{WSP(bf16_t, WS_PACT), WSP(bf16_t, WS_WDN) + (size_t)l * DM * DFF, DFF, DFF, DFF, (size_t)256 * DFF * 2, (size_t)256 * DFF * 2};
              pg8::StaticOrder S; S.init(MTOK, DM, c.G, c.bid); pg8::EpiWrap<EpiPlainBf16, false> W{E};
              pg8::gemm_phase<pg8::EpiWrap<EpiPlainBf16, false>, pg8::StaticOrder, true>(c.lds3, g, S, W); }
#else
            gemm_naive<false>(c, WSP(bf16_t, WS_PACT), DFF, WSP(bf16_t, WS_WDN) + (size_t)l * DM * DFF, DFF, DFF,
                [](int t, int& r0, int& c0, int& b0) -> bool { if (t >= (MTOK / 64) * 16) return false; r0 = 64 * (t >> 4); c0 = b0 = 64 * (t & 15); return true; }, E);
#endif
        }
        SEAM(pb + 8);
        if (IN(pb + 9)) { FRESH(); } if (IN(pb + 9)) ph_rowpass(c, c.out, c.in[I_LNFPOST] + l * DM, c.out, (l + 1 < DEPTH) ? WSP(bf16_t, WS_XNY) : (bf16_t*)nullptr);
        SEAM(pb + 9);
    }
#undef IN
}

extern "C" void kernel_launch(void* const* d_in, const int* in_sizes, int n_in, void* d_out, int out_size, void* d_ws, size_t ws_size, hipStream_t stream) {
    static int grid = 0;
    if (grid == 0) {
        if (n_in != 23 || in_sizes[0] != MTOK * DM || out_size != MTOK * DM || ws_size < WS_END) {
            fprintf(stderr, "kernel_launch: unexpected shapes (n_in %d, in0 %d, out %d, ws %zu, need ws %zu); nothing launched\n", n_in, n_in > 0 ? in_sizes[0] : -1, out_size, ws_size, (size_t)WS_END); grid = -1; return; }
        int dev = 0, cus = 0;
        if (hipGetDevice(&dev) != hipSuccess || hipDeviceGetAttribute(&cus, hipDeviceAttributeMultiprocessorCount, dev) != hipSuccess) { grid = -1; return; }
        if (hipFuncSetAttribute((const void*)hybrid_fwd, hipFuncAttributeMaxDynamicSharedMemorySize, LDS_BYTES) != hipSuccess) { fprintf(stderr, "kernel_launch: hipFuncSetAttribute failed\n"); grid = -1; return; }
        grid = cus;
    }
    if (grid < 0) return;
    (void)hipMemsetAsync((char*)d_ws + WS_CTL, 0, CTL_BYTES, stream);
    Args a{};
    for (int i = 0; i < 23; ++i) a.in[i] = (const float*)d_in[i];
    a.out = (float*)d_out; a.ws = (unsigned char*)d_ws;
#if N_LAUNCH_MODE == 1
    a.lo = 0; a.hi = NPHASE; hipLaunchKernelGGL(hybrid_fwd, dim3(grid), dim3(NTHR), LDS_BYTES, stream, a);
#else
    for (int p = 0; p < NPHASE; ++p) { a.lo = p; a.hi = p + 1; hipLaunchKernelGGL(hybrid_fwd, dim3(grid), dim3(NTHR), LDS_BYTES, stream, a); }
#endif
}
```

```cpp
#include <hip/hip_runtime.h>
#include <cstdio>
#include <cstdint>

#ifndef N_LAUNCH_MODE
#define N_LAUNCH_MODE 1
#endif
#ifndef FAST_FOX
#define FAST_FOX 1
#endif
#ifndef FAST_HGRN
#define FAST_HGRN 1
#endif
#ifndef FAST_MLSTM
#define FAST_MLSTM 1
#endif
#ifndef FAST_GLU
#define FAST_GLU 1
#endif
#ifndef TIME_FROM
#define TIME_FROM -1
#define TIME_TO -1
#endif
#ifndef USE_PG8
#define USE_PG8 1
#endif

#define LAS __attribute__((address_space(3)))
#define GAS __attribute__((address_space(1)))
typedef unsigned short bf16_t;
typedef float f32x4 __attribute__((ext_vector_type(4)));
typedef unsigned u32x4 __attribute__((ext_vector_type(4)));
typedef unsigned u32x2 __attribute__((ext_vector_type(2)));
typedef short bf16x8 __attribute__((ext_vector_type(8)));
typedef float f32x2_t __attribute__((ext_vector_type(2)));

constexpr int NB = 8, SEQ = 4096, DM = 1024, MTOK = NB * SEQ, DEPTH = 2;
constexpr int DIN = 3084, NIN = 3328, DFF = 2816, NGU = 2 * DFF;
constexpr int CL = 64, NCH = SEQ / CL, NCHT = NB * NCH;
constexpr int PW = 2816;
constexpr int U2LD = 1152;
constexpr int NUNIT = NB * 4 * NCH;
constexpr float EPS = 1e-6f;
constexpr float LOG2E = 1.4426950408889634f;
constexpr int PC_HGQ = 0, PC_HGF = 256, PC_HGI = 512, PC_HGG = 768, PC_FXQ = 1024, PC_FXK = 1280, PC_FXV = 1536, PC_MLQ = 1792, PC_MLK = 2048, PC_MLV = 2304, PC_MLO = 2560;

constexpr size_t MiB = 1u << 20;
constexpr size_t WS_CTL = 0, CTL_BYTES = 1 * MiB;
constexpr size_t WS_WIN = 1 * MiB;
constexpr size_t WS_WOUT = 14 * MiB;
constexpr size_t WS_WGU = 18 * MiB;
constexpr size_t WS_WDN = 40 * MiB;
constexpr size_t WS_WGLU = 51 * MiB;
constexpr size_t WS_KERN = 52 * MiB;
constexpr size_t WS_A64 = 54 * MiB;
constexpr size_t WS_BM = 55 * MiB;
constexpr size_t WS_TT = 71 * MiB;
constexpr size_t WS_CM = 107 * MiB;
constexpr size_t WS_U2 = 115 * MiB;
constexpr size_t WS_GT = 133 * MiB;
constexpr size_t WS_FQ = 135 * MiB;
constexpr size_t WS_FK = 139 * MiB;
constexpr size_t WS_FCUM = 143 * MiB;
constexpr size_t WS_XNY = 144 * MiB;
constexpr size_t WS_PACT = 208 * MiB;
constexpr size_t WS_SCR = 384 * MiB;
constexpr size_t WS_MX = WS_SCR;
constexpr size_t WS_XLOC = WS_SCR;
constexpr size_t WS_G1 = WS_SCR + 4 * MiB;
constexpr size_t WS_HSLOC = WS_SCR + 20 * MiB;
constexpr size_t WS_HDEC = WS_SCR + 52 * MiB;
constexpr size_t WS_MDEC = WS_SCR + 52 * MiB + 512 * 1024;
constexpr size_t WS_HSPREV = WS_SCR + 53 * MiB;
constexpr size_t WS_MSLOC = WS_SCR + 69 * MiB;
constexpr size_t WS_MSPREV = WS_SCR + 102 * MiB;
constexpr size_t WS_END = 512 * MiB;
static_assert(WS_MSPREV + (size_t)NUNIT * 80 * 64 * 2 <= WS_END, "ws map");
static_assert(WS_MSLOC + (size_t)NUNIT * 65 * 64 * 4 <= WS_MSPREV, "ws map");

constexpr int LDS_BYTES = 147456;
constexpr int NTHR = 512;

__device__ __forceinline__ int opaque_v(int x) { asm volatile("" : "+v"(x)); return x; }
__device__ __forceinline__ float bf2f(unsigned b) { return __uint_as_float(b << 16); }
__device__ __forceinline__ unsigned f2bf(float f) { unsigned u = __float_as_uint(f); return (u + 0x7fffu + ((u >> 16) & 1u)) >> 16; }
__device__ __forceinline__ unsigned pk2(float lo, float hi) { return f2bf(lo) | (f2bf(hi) << 16); }
__device__ __forceinline__ float wave_sum(float v) {
#pragma unroll
    for (int o = 1; o < 64; o <<= 1) v += __shfl_xor(v, o);
    return v;
}
__device__ __forceinline__ float sigmoidf_(float x) { return 1.f / (1.f + __expf(-x)); }
__device__ __forceinline__ float log_sigmoidf_(float x) { return fminf(x, 0.f) - log1pf(__expf(-fabsf(x))); }
__device__ __forceinline__ float siluf_(float x) { return x * sigmoidf_(x); }
__device__ __forceinline__ float gelu_tanh(float x) { const float u = 0.7978845608028654f * (x + 0.044715f * x * x * x); return x * (1.f - 1.f / (1.f + __expf(2.f * u))); }
__device__ __forceinline__ void unpack8(const u32x4 w, float (&v)[8]) {
    v[0] = bf2f(w.x & 0xffffu); v[1] = bf2f(w.x >> 16); v[2] = bf2f(w.y & 0xffffu); v[3] = bf2f(w.y >> 16);
    v[4] = bf2f(w.z & 0xffffu); v[5] = bf2f(w.z >> 16); v[6] = bf2f(w.w & 0xffffu); v[7] = bf2f(w.w >> 16);
}
__device__ __forceinline__ u32x4 pack8(const float (&v)[8]) { u32x4 w; w.x = pk2(v[0], v[1]); w.y = pk2(v[2], v[3]); w.z = pk2(v[4], v[5]); w.w = pk2(v[6], v[7]); return w; }

struct Ctx {
    const float* in[23]; float* out; unsigned char* ws;
    unsigned char* lds; LAS unsigned char* lds3; int tid, lane, wave, G, bid;
};
#define WSP(T, off) ((T*)(c.ws + (off)))
enum { I_X = 0, I_WIN, I_GB, I_LRE, I_LIM, I_BRE, I_BIM, I_CRE, I_CIM, I_S5D, I_LOGDT, I_WGLU, I_LB, I_CONV, I_GAIN, I_WOUT, I_LNMPRE, I_LNMPOST, I_LNFPRE, I_LNFPOST, I_WG, I_WU, I_WD };

template <bool PAIR, class TileF, class Epi>
__device__ __forceinline__ void gemm_naive(const Ctx& c, const bf16_t* A, int lda, const bf16_t* Bt, int ldb, int K, TileF tf, const Epi& E) {
    float* As = (float*)c.lds;
    float* Bs = As + 64 * 65;
    float* Bs2 = Bs + 64 * 65;
    const int r = c.tid >> 3, cg = c.tid & 7;
    for (int t = c.bid;; t += c.G) {
        int row0, col0, brow0; if (!tf(t, row0, col0, brow0)) break;
        float acc[8], acc2[8];
#pragma unroll
        for (int i = 0; i < 8; ++i) { acc[i] = 0.f; acc2[i] = 0.f; }
        for (int k0 = 0; k0 < K; k0 += 64) {
            __syncthreads();
            { float v[8]; unpack8(*(const u32x4*)(A + (size_t)(row0 + r) * lda + k0 + cg * 8), v);
#pragma unroll
              for (int i = 0; i < 8; ++i) As[r * 65 + cg * 8 + i] = v[i];
              unpack8(*(const u32x4*)(Bt + (size_t)(brow0 + r) * ldb + k0 + cg * 8), v);
#pragma unroll
              for (int i = 0; i < 8; ++i) Bs[r * 65 + cg * 8 + i] = v[i];
              if (PAIR) { unpack8(*(const u32x4*)(Bt + (size_t)(brow0 + 128 + r) * ldb + k0 + cg * 8), v);
#pragma unroll
                  for (int i = 0; i < 8; ++i) Bs2[r * 65 + cg * 8 + i] = v[i]; } }
            __syncthreads();
            for (int k = 0; k < 64; ++k) {
                const float a = As[r * 65 + k];
#pragma unroll
                for (int i = 0; i < 8; ++i) { acc[i] += a * Bs[(cg * 8 + i) * 65 + k]; if (PAIR) acc2[i] += a * Bs2[(cg * 8 + i) * 65 + k]; }
            }
        }
        E(row0 + r, col0 + cg * 8, acc, acc2);
    }
    __syncthreads();
}

struct EpiInProj {
    bf16_t* U2; bf16_t* P; float* GT; const float* gb;
    __device__ __forceinline__ void operator()(int row, int col, const float (&v)[8], const float (&)[8]) const {
        if (col < 256) { const int g = col >> 4, p0 = col & 15, ch = row >> 6, j = row & 63;
            *(u32x4*)(U2 + ((size_t)(g * NCHT + ch) * U2LD + j * 16 + p0)) = pack8(v); }
        else if (col < 3072) { *(u32x4*)(P + (size_t)row * PW + (col - 256)) = pack8(v); }
        else if (col < 3088) { const int i0 = col - 3072;
#pragma unroll
            for (int i = 0; i < 8; ++i) if (i0 + i < 12) GT[(size_t)row * 16 + i0 + i] = v[i] + gb[i0 + i]; }
    }
};
struct EpiPlainBf16 {
    bf16_t* O; int ld;
    __device__ __forceinline__ void operator()(int row, int col, const float (&v)[8], const float (&)[8]) const { *(u32x4*)(O + (size_t)row * ld + col) = pack8(v); }
};
struct EpiSwiGLU {
    bf16_t* O;
    __device__ __forceinline__ void operator()(int row, int col, const float (&g)[8], const float (&u)[8]) const {
        float v[8];
#pragma unroll
        for (int i = 0; i < 8; ++i) v[i] = siluf_(g[i]) * u[i];
        *(u32x4*)(O + (size_t)row * DFF + col) = pack8(v); }
};
struct EpiXloc {
    float* X;
    __device__ __forceinline__ void operator()(int row, int col, const float (&v)[8], const float (&)[8]) const {
        const int cl = col & 255; if (cl < 128) { float* p = X + (size_t)row * 128 + cl; *(f32x4*)p = (f32x4){v[0], v[1], v[2], v[3]}; *(f32x4*)(p + 4) = (f32x4){v[4], v[5], v[6], v[7]}; } }
};
struct EpiS5Y {
    bf16_t* G1;
    __device__ __forceinline__ void operator()(int row, int col, const float (&v)[8], const float (&)[8]) const {
        const int g = row >> 9, ch = row & 511, cl = col - g * 1024, tau = cl >> 4, p0 = cl & 15; float o[8];
#pragma unroll
        for (int i = 0; i < 8; ++i) o[i] = gelu_tanh(v[i]);
        *(u32x4*)(G1 + ((size_t)(ch * 64 + tau) * 256 + g * 16 + p0)) = pack8(o); }
};


namespace pg8 {
constexpr int BM = 256, BK = 64, HALF = 128, HTB = HALF * BK * 2, STAGE_BYTES = 8 * HTB, NXCD = 8, WGM = 8;
__host__ __device__ __forceinline__ int lds_byte(int r, int c) { const int st = (r >> 4) * 2 + (c >> 5), rr = r & 15, cc = c & 31, ob = rr * 64 + cc * 2; return st * 1024 + (ob ^ (((ob >> 9) & 1) << 5)); }
__host__ __device__ __forceinline__ void stage_rc(int b, int& R, int& C) { const int st = b / 1024, sb = b % 1024, swz = sb ^ (((sb >> 9) & 1) << 5); R = (st >> 1) * 16 + swz / 64; C = (st & 1) * 32 + (swz % 64) / 2; }
__host__ __device__ __forceinline__ int perm32(int rho) { const int n = rho >> 4, i = rho & 15; return 8 * (i >> 2) + 4 * n + (i & 3); }
struct Unit { int pm, pn; };
struct Gemm { const bf16_t* A; const bf16_t* Bt; int lda, ldb, K; size_t astep, bstep; };
struct StaticOrder {
    int nM, nN, nwg, G, c;
    __device__ void init(int M, int N, int G_, int c_) { nM = M / BM; nN = N / BM; nwg = nM * nN; G = G_; c = c_; }
    __device__ bool next(int i, Unit& u) const {
        const long L = (long)i * G + c; if (L >= nwg) return false;
        int wgid = (int)L; { const int q = nwg / NXCD, r = nwg % NXCD, xcd = wgid % NXCD, off = wgid / NXCD; wgid = (xcd < r ? xcd * (q + 1) : r * (q + 1) + (xcd - r) * q) + off; }
        const int nig = WGM * nN, gid = wgid / nig, fm = gid * WGM, gsz = (nM - fm) < WGM ? (nM - fm) : WGM;
        u.pm = fm + ((wgid % nig) % gsz); u.pn = (wgid % nig) / gsz; return true;
    }
};
struct SchedXloc { int G, c; __device__ bool next(int i, Unit& u) const { const int L = i * G + c; if (L >= 32) return false; u.pm = L; u.pn = L >> 1; return true; } };
struct SchedS5Y { int G, c; __device__ bool next(int i, Unit& u) const { const int L = i * G + c; if (L >= 128) return false; const int g = L >> 3; u.pm = g * 2 + ((L >> 2) & 1); u.pn = g * 4 + (L & 3); return true; } };

template <class F, bool PAIR> struct EpiWrap {
    F f;
    __device__ __forceinline__ void operator()(const f32x4 (&acc)[2][2][4][2], const Unit& u, int wr, int wc, int fr, int fq) const {
#pragma unroll
        for (int ai = 0; ai < 2; ++ai)
#pragma unroll
            for (int m = 0; m < 4; ++m) { const int row = u.pm * BM + ai * HALF + wr * 64 + m * 16 + fr;
                if (PAIR) { const int col = u.pn * HALF + wc * 32 + 8 * fq;
                    const float g[8] = {acc[ai][0][m][0][0], acc[ai][0][m][0][1], acc[ai][0][m][0][2], acc[ai][0][m][0][3], acc[ai][0][m][1][0], acc[ai][0][m][1][1], acc[ai][0][m][1][2], acc[ai][0][m][1][3]};
                    const float v[8] = {acc[ai][1][m][0][0], acc[ai][1][m][0][1], acc[ai][1][m][0][2], acc[ai][1][m][0][3], acc[ai][1][m][1][0], acc[ai][1][m][1][1], acc[ai][1][m][1][2], acc[ai][1][m][1][3]};
                    f(row, col, g, v); }
                else {
#pragma unroll
                    for (int bj = 0; bj < 2; ++bj) { const int col = u.pn * BM + bj * HALF + wc * 32 + 8 * fq;
                        const float v[8] = {acc[ai][bj][m][0][0], acc[ai][bj][m][0][1], acc[ai][bj][m][0][2], acc[ai][bj][m][0][3], acc[ai][bj][m][1][0], acc[ai][bj][m][1][1], acc[ai][bj][m][1][2], acc[ai][bj][m][1][3]};
                        f(row, col, v, v); } } }
    }
};

template <class Epi, class Sched, bool ALIGN_EPI>
__device__ __forceinline__ void gemm_phase(LAS unsigned char* lds, const Gemm g, const Sched& S, const Epi& E) {
    const int tid = opaque_v((int)threadIdx.x), wid = __builtin_amdgcn_readfirstlane(tid >> 6), lane = tid & 63, wr = wid >> 2, wc = wid & 3, fr = lane & 15, fq = lane >> 4;
    const int K = g.K, nt = K / BK;
    unsigned voffA[2], voffB[2];
#pragma unroll
    for (int i = 0; i < 2; ++i) { int R, C; stage_rc(tid * 16 + i * 8192, R, C); const int Rb = (R & ~31) + perm32(R & 31);
        voffA[i] = (unsigned)(R * g.lda + C) * 2u; voffB[i] = (unsigned)(Rb * g.ldb + C) * 2u; }
    const size_t kstep = (size_t)(BK * 2);
    const size_t hstepA = (size_t)HALF * g.lda * 2, hstepB = (size_t)HALF * g.ldb * 2;
    const unsigned ldsw = (unsigned)wid * 1024u;
    const int aoff = lds_byte(wr * 64 + fr, fq * 8), boff = lds_byte(wc * 32 + fr, fq * 8);
#define PG8_SA(b, h) (((b) * 2 + (h)) * HTB)
#define PG8_SB(b, h) ((4 + (b) * 2 + (h)) * HTB)
#define PG8_STAGE(bufoff, gbase, voff) do { _Pragma("unroll") for (int _i = 0; _i < 2; ++_i) \
        __builtin_amdgcn_global_load_lds((const unsigned*)((const char*)(gbase) + (voff)[_i]), (LAS unsigned*)(lds + (bufoff) + ldsw + _i * 8192), 16, 0, 0); } while (0)
#define PG8_LDA(dst, b, h) do { _Pragma("unroll") for (int m = 0; m < 4; ++m) _Pragma("unroll") for (int k = 0; k < 2; ++k) dst[m][k] = *(const LAS bf16x8*)(lds + PG8_SA(b, h) + aoff + m * 2048 + k * 1024); } while (0)
#define PG8_LDB(dst, b, h) do { _Pragma("unroll") for (int n = 0; n < 2; ++n) _Pragma("unroll") for (int k = 0; k < 2; ++k) dst[n][k] = *(const LAS bf16x8*)(lds + PG8_SB(b, h) + boff + n * 2048 + k * 1024); } while (0)
#define PG8_MMA(ai, bj, At, Bt) do { __builtin_amdgcn_s_setprio(1); _Pragma("unroll") for (int m = 0; m < 4; ++m) _Pragma("unroll") for (int n = 0; n < 2; ++n) _Pragma("unroll") for (int k = 0; k < 2; ++k) \
        acc[ai][bj][m][n] = __builtin_amdgcn_mfma_f32_16x16x32_bf16(Bt[n][k], At[m][k], acc[ai][bj][m][n], 0, 0, 0); __builtin_amdgcn_s_setprio(0); } while (0)
#define PG8_WAIT_V(n) asm volatile("s_waitcnt vmcnt(" #n ")" ::: "memory")
#define PG8_WAIT_L(n) asm volatile("s_waitcnt lgkmcnt(" #n ")" ::: "memory")
#define PG8_BAR __builtin_amdgcn_s_barrier()
#define PG8_SCHED __builtin_amdgcn_sched_barrier(0)
    Unit cur, nxt; int ui = 0;
    if (!S.next(0, cur)) return;
    f32x4 acc[2][2][4][2];
#pragma unroll
    for (int a = 0; a < 2; ++a)
#pragma unroll
        for (int b = 0; b < 2; ++b)
#pragma unroll
            for (int m = 0; m < 4; ++m)
#pragma unroll
                for (int n = 0; n < 2; ++n) acc[a][b][m][n] = (f32x4){0.f, 0.f, 0.f, 0.f};
    bf16x8 At[4][2], B0[2][2], B1[2][2];
    const char* cA = (const char*)g.A + (size_t)cur.pm * g.astep; const char* cB = (const char*)g.Bt + (size_t)cur.pn * g.bstep;
    PG8_STAGE(PG8_SB(0, 0), cB, voffB); PG8_STAGE(PG8_SB(0, 1), cB + hstepB, voffB); PG8_STAGE(PG8_SA(0, 0), cA, voffA); PG8_STAGE(PG8_SA(0, 1), cA + hstepA, voffA);
    if (wr == 1) PG8_BAR;
    PG8_WAIT_V(2); PG8_BAR;
    PG8_STAGE(PG8_SB(1, 0), cB + kstep, voffB); PG8_STAGE(PG8_SA(1, 0), cA + kstep, voffA); PG8_STAGE(PG8_SB(1, 1), cB + hstepB + kstep, voffB);
    PG8_WAIT_V(6); PG8_BAR;
    for (;;) {
        const bool has_next = S.next(ui + 1, nxt);
        const char* nA = has_next ? (const char*)g.A + (size_t)nxt.pm * g.astep : cA; const char* nB = has_next ? (const char*)g.Bt + (size_t)nxt.pn * g.bstep : cB;
        for (int t = 0; t < nt; t += 2) {
            const bool last = (t == nt - 2);
            const char* a1 = cA + (size_t)(t + 1) * kstep;
            const char* a2 = last ? nA : cA + (size_t)(t + 2) * kstep; const char* b2 = last ? nB : cB + (size_t)(t + 2) * kstep;
            const char* a3 = a2 + kstep; const char* b3 = b2 + kstep;
            PG8_LDB(B0, 0, 0); PG8_LDB(B1, 0, 1); PG8_SCHED; PG8_LDA(At, 0, 0); PG8_STAGE(PG8_SA(1, 1), a1 + hstepA, voffA);
            PG8_WAIT_V(8); PG8_WAIT_L(0); PG8_BAR; PG8_MMA(0, 0, At, B0); PG8_MMA(0, 1, At, B1); PG8_BAR; PG8_SCHED;
            PG8_LDA(At, 0, 1); PG8_STAGE(PG8_SB(0, 0), b2, voffB); PG8_STAGE(PG8_SB(0, 1), b2 + hstepB, voffB); PG8_STAGE(PG8_SA(0, 0), a2, voffA);
            PG8_WAIT_V(8); PG8_WAIT_L(0); PG8_BAR; PG8_MMA(1, 0, At, B0); PG8_MMA(1, 1, At, B1); PG8_BAR; PG8_SCHED;
            PG8_LDB(B0, 1, 0); PG8_LDB(B1, 1, 1); PG8_SCHED; PG8_LDA(At, 1, 0); PG8_STAGE(PG8_SA(0, 1), a2 + hstepA, voffA);
            PG8_WAIT_V(8); PG8_WAIT_L(0); PG8_BAR; PG8_MMA(0, 0, At, B0); PG8_MMA(0, 1, At, B1); PG8_BAR; PG8_SCHED;
            PG8_LDA(At, 1, 1); PG8_STAGE(PG8_SB(1, 0), b3, voffB); PG8_STAGE(PG8_SB(1, 1), b3 + hstepB, voffB); PG8_STAGE(PG8_SA(1, 0), a3, voffA);
            PG8_WAIT_V(8); PG8_WAIT_L(0); PG8_BAR; PG8_MMA(1, 0, At, B0); PG8_MMA(1, 1, At, B1); PG8_BAR; PG8_SCHED;
        }
        if constexpr (ALIGN_EPI) { if (wr == 0) PG8_BAR; }
        E(acc, cur, wr, wc, fr, fq);
        if (!has_next) break;
#pragma unroll
        for (int a = 0; a < 2; ++a)
#pragma unroll
            for (int b = 0; b < 2; ++b)
#pragma unroll
                for (int m = 0; m < 4; ++m)
#pragma unroll
                    for (int n = 0; n < 2; ++n) acc[a][b][m][n] = (f32x4){0.f, 0.f, 0.f, 0.f};
        cur = nxt; cA = nA; cB = nB; ++ui;
        if constexpr (ALIGN_EPI) { if (wr == 1) PG8_BAR; }
    }
    PG8_WAIT_V(0);
    if constexpr (!ALIGN_EPI) { if (wr == 0) PG8_BAR; }
    PG8_BAR;
#undef PG8_SA
#undef PG8_SB
#undef PG8_STAGE
#undef PG8_LDA
#undef PG8_LDB
#undef PG8_MMA
#undef PG8_WAIT_V
#undef PG8_WAIT_L
#undef PG8_BAR
#undef PG8_SCHED
}
}

template <class SrcF>
__device__ __forceinline__ void transpose_item(SrcF src, bf16_t* WT, int ldw, int k0, int n0, float* scr, int lane) {
#pragma unroll 8
    for (int i = 0; i < 32; ++i) { const int kk = 2 * i + (lane >> 5); scr[kk * 33 + (lane & 31)] = src(k0 + kk, n0 + (lane & 31)); }
    __builtin_amdgcn_wave_barrier(); asm volatile("s_waitcnt lgkmcnt(0)" ::: "memory");
    const int cc = lane & 7;
#pragma unroll
    for (int j = 0; j < 4; ++j) { const int n = (lane >> 3) + 8 * j; const float* s = scr + (8 * cc) * 33 + n;
        u32x4 o; o.x = pk2(s[0 * 33], s[1 * 33]); o.y = pk2(s[2 * 33], s[3 * 33]); o.z = pk2(s[4 * 33], s[5 * 33]); o.w = pk2(s[6 * 33], s[7 * 33]);
        *(u32x4*)(WT + (size_t)(n0 + n) * ldw + k0 + 8 * cc) = o; }
    asm volatile("s_waitcnt lgkmcnt(0)" ::: "memory"); __builtin_amdgcn_wave_barrier();
}
__device__ __forceinline__ int win_src_col(int n) {
    if (n < 2048) return n;
    if (n < 3072) return n + 4;
    const int i = n - 3072;
    if (i < 4) return 2048 + i;
    if (i < 8) return 3076 + (i - 4);
    if (i < 12) return 3080 + (i - 8);
    return -1;
}
__device__ __forceinline__ void rms_row_to_bf16(const float* xrow, bf16_t* orow, int lane) {
    const f32x4* xr = (const f32x4*)xrow + lane; f32x4 v[4]; float s = 0.f;
#pragma unroll
    for (int j = 0; j < 4; ++j) { v[j] = xr[64 * j]; s += (v[j].x * v[j].x + v[j].y * v[j].y) + (v[j].z * v[j].z + v[j].w * v[j].w); }
    const float rstd = rsqrtf(wave_sum(s) * (1.f / DM) + EPS);
    u32x2* o8 = (u32x2*)orow + lane;
#pragma unroll
    for (int j = 0; j < 4; ++j) { u32x2 w; w.x = pk2(v[j].x * rstd, v[j].y * rstd); w.y = pk2(v[j].z * rstd, v[j].w * rstd); o8[64 * j] = w; }
}
__device__ __forceinline__ void ph_prologue(const Ctx& c) {
    float* scr = (float*)c.lds + c.wave * 4096;
    const int gw = c.bid * 8 + c.wave, NGW = c.G * 8;
    constexpr int IT_IN = (NIN / 32) * (DM / 64), IT_OUT = (DM / 32) * (DM / 64), IT_GU = (NGU / 32) * (DM / 64), IT_DN = (DM / 32) * (DFF / 64), IT_GLU = (256 / 32) * (256 / 64);
    constexpr int IT_L = IT_IN + IT_OUT + IT_GU + IT_DN + IT_GLU;
    for (int it = gw; it < DEPTH * IT_L; it += NGW) {
        const int l = it / IT_L; int r = it % IT_L;
        if (r < IT_IN) { const int nb = r % (NIN / 32), kb = r / (NIN / 32); const float* W = c.in[I_WIN] + (size_t)l * DM * DIN; const float* ln = c.in[I_LNMPRE] + l * DM;
            transpose_item([=](int k, int n) -> float { const int sc = win_src_col(n); if (sc < 0) return 0.f; float v = W[(size_t)k * DIN + sc] * ln[k]; if (n >= 1280 && n < 1536) v *= 0.125f * LOG2E; return v; },
                           WSP(bf16_t, WS_WIN) + (size_t)l * NIN * DM, DM, kb * 64, nb * 32, scr, c.lane); continue; }
        r -= IT_IN;
        if (r < IT_OUT) { const int nb = r % (DM / 32), kb = r / (DM / 32); const float* W = c.in[I_WOUT] + (size_t)l * DM * DM; const float* gn = c.in[I_GAIN] + l * DM;
            transpose_item([=](int k, int n) -> float { return W[(size_t)k * DM + n] * gn[k]; }, WSP(bf16_t, WS_WOUT) + (size_t)l * DM * DM, DM, kb * 64, nb * 32, scr, c.lane); continue; }
        r -= IT_OUT;
        if (r < IT_GU) { const int nb = r % (NGU / 32), kb = r / (NGU / 32); const float* Wg = c.in[I_WG] + (size_t)l * DM * DFF; const float* Wu = c.in[I_WU] + (size_t)l * DM * DFF; const float* ln = c.in[I_LNFPRE] + l * DM;
            transpose_item([=](int k, int n) -> float { const int tile = n >> 8, hf = (n >> 7) & 1, j = tile * 128 + (n & 127); return (hf ? Wu : Wg)[(size_t)k * DFF + j] * ln[k]; },
                           WSP(bf16_t, WS_WGU) + (size_t)l * NGU * DM, DM, kb * 64, nb * 32, scr, c.lane); continue; }
        r -= IT_GU;
        if (r < IT_DN) { const int nb = r % (DM / 32), kb = r / (DM / 32); const float* W = c.in[I_WD] + (size_t)l * DFF * DM;
            transpose_item([=](int k, int n) -> float { return W[(size_t)k * DM + n]; }, WSP(bf16_t, WS_WDN) + (size_t)l * DM * DFF, DFF, kb * 64, nb * 32, scr, c.lane); continue; }
        r -= IT_DN;
        { const int nb = r % 8, kb = r / 8; const float* W = c.in[I_WGLU] + (size_t)l * 256 * 256;
            transpose_item([=](int k, int n) -> float { return W[(size_t)k * 256 + n]; }, WSP(bf16_t, WS_WGLU) + (size_t)l * 256 * 256, 256, kb * 64, nb * 32, scr, c.lane); }
    }
    for (int m = gw; m < MTOK; m += NGW) rms_row_to_bf16(c.in[I_X] + (size_t)m * DM, WSP(bf16_t, WS_XNY) + (size_t)m * DM, c.lane);
    __syncthreads();
    float* sh = (float*)c.lds;
    for (int it = c.bid; it < DEPTH * 16 * 65; it += c.G) {
        const int l = it / (16 * 65), g = (it / 65) % 16, d = it % 65;
        if (c.tid < 64) { const int n = c.tid;
            const double lr = (double)fminf(c.in[I_LRE][(l * 16 + g) * 64 + n], -1e-4f), li = (double)c.in[I_LIM][(l * 16 + g) * 64 + n], dt = exp((double)c.in[I_LOGDT][l * 16 + g]);
            const double mag1 = exp(lr * dt), abr = mag1 * cos(li * dt), abi = mag1 * sin(li * dt), den = lr * lr + li * li;
            const double cfr = ((abr - 1.0) * lr + abi * li) / den, cfi = (abi * lr - (abr - 1.0) * li) / den;
            const double magd = exp(lr * dt * d), wr = magd * cos(li * dt * d), wi = magd * sin(li * dt * d);
            sh[n] = (float)wr; sh[64 + n] = (float)wi; sh[128 + n] = (float)(wr * cfr - wi * cfi); sh[192 + n] = (float)(wr * cfi + wi * cfr);
            if (d == 64) { float* a64 = WSP(float, WS_A64) + ((size_t)(l * 16 + g) * 64 + n) * 2; a64[0] = (float)wr; a64[1] = (float)wi; } }
        __syncthreads();
        const float* cre = c.in[I_CRE] + (size_t)(l * 16 + g) * 16 * 64; const float* cim = c.in[I_CIM] + (size_t)(l * 16 + g) * 16 * 64;
        const float* bre = c.in[I_BRE] + (size_t)(l * 16 + g) * 64 * 16; const float* bim = c.in[I_BIM] + (size_t)(l * 16 + g) * 64 * 16;
        if (d < 64 && c.tid < 256) { const int p = c.tid >> 4, pp = c.tid & 15; float s = 0.f;
            for (int n = 0; n < 64; ++n) { const float wcr = sh[128 + n], wci = sh[192 + n], br = bre[n * 16 + pp], bi = bim[n * 16 + pp];
                const float xr = wcr * br - wci * bi, xi = wcr * bi + wci * br; s += cre[p * 64 + n] * xr - cim[p * 64 + n] * xi; }
            if (d == 0 && p == pp) s += c.in[I_S5D][l * 256 + g * 16 + p];
            WSP(float, WS_KERN)[(((size_t)(l * 16 + g) * 64 + d) * 16 + p) * 16 + pp] = s; }
        if (d < 64) { const int j = 63 - d; bf16_t* bm = WSP(bf16_t, WS_BM) + (size_t)(l * 16 + g) * 128 * 1024;
#pragma unroll
            for (int e = 0; e < 4; ++e) { const int idx = c.tid * 4 + e, row = idx >> 4, pp = idx & 15, n = row >> 1, ri = row & 1;
                const float wcr = sh[128 + n], wci = sh[192 + n], br = bre[n * 16 + pp], bi = bim[n * 16 + pp];
                const float val = ri ? (wcr * bi + wci * br) : (wcr * br - wci * bi);
                bm[(size_t)row * 1024 + j * 16 + pp] = (bf16_t)f2bf(val); } }
        if (d >= 1) { const int tau = d - 1; bf16_t* cm = WSP(bf16_t, WS_CM) + (size_t)(l * 16 + g) * 1024 * 128;
#pragma unroll
            for (int e = 0; e < 4; ++e) { const int idx = c.tid * 4 + e, p = idx >> 7, q = idx & 127, n = q >> 1, ri = q & 1;
                const float wr = sh[n], wi = sh[64 + n], cr = cre[p * 64 + n], ci = cim[p * 64 + n];
                const float val = ri ? -(cr * wi + ci * wr) : (cr * wr - ci * wi);
                cm[(size_t)(tau * 16 + p) * 128 + q] = (bf16_t)f2bf(val); } }
        __syncthreads();
    }
}

__device__ __forceinline__ void ph_B_texpand(const Ctx& c, int l) {
    bf16_t* TT = WSP(bf16_t, WS_TT);
    const float* KERN = WSP(float, WS_KERN) + (size_t)l * 16 * 64 * 256;
    const bf16_t* CM = WSP(bf16_t, WS_CM) + (size_t)l * 16 * 1024 * 128;
    for (int it = c.bid; it < 16 * 64; it += c.G) {
        const int g = it >> 6, tau = it & 63;
        for (int e = c.tid; e < 16 * (U2LD / 8); e += NTHR) {
            const int p = e / (U2LD / 8), c8 = (e % (U2LD / 8)) * 8; u32x4 w;
            if (c8 < 1024) { const int j = c8 >> 4, pp0 = c8 & 15;
                if (j <= tau) { const float* k = KERN + (((size_t)g * 64 + (tau - j)) * 16 + p) * 16 + pp0; w.x = pk2(k[0], k[1]); w.y = pk2(k[2], k[3]); w.z = pk2(k[4], k[5]); w.w = pk2(k[6], k[7]); }
                else w = (u32x4){0u, 0u, 0u, 0u}; }
            else w = *(const u32x4*)(CM + ((size_t)(g * 1024 + tau * 16 + p)) * 128 + (c8 - 1024));
            *(u32x4*)(TT + ((size_t)(g * 1024 + tau * 16 + p)) * U2LD + c8) = w; }
    }
}
__device__ __forceinline__ void split3(float F, unsigned& hi, unsigned& mid, unsigned& lo) { hi = f2bf(F); float r = F - bf2f(hi); mid = f2bf(r); r -= bf2f(mid); lo = f2bf(r); }
__device__ __forceinline__ void ph_B_gatescan(const Ctx& c) {
    float* sh = (float*)c.lds;
    const float* GT = WSP(float, WS_GT);
    for (int it = (c.bid + c.G - (32 % c.G)) % c.G; it < NB * 4; it += c.G) {
        const int b = it >> 2, h = it & 3; const size_t m0 = (size_t)b * SEQ + c.tid * 8;
        float ls[8]; float run = 0.f;
#pragma unroll
        for (int i = 0; i < 8; ++i) { run += log_sigmoidf_(GT[(m0 + i) * 16 + h]); ls[i] = run; }
        float inc = run;
#pragma unroll
        for (int o = 1; o < 64; o <<= 1) { const float y = __shfl_up(inc, o); if (c.lane >= o) inc += y; }
        __syncthreads(); if (c.lane == 63) sh[c.wave] = inc; __syncthreads();
        float off = inc - run;
#pragma unroll
        for (int w = 0; w < 8; ++w) if (w < c.wave) off += sh[w];
#pragma unroll
        for (int i = 0; i < 8; ++i) { const float F = (off + ls[i]) * LOG2E; const size_t m = m0 + i;
            WSP(float, WS_FCUM)[m * 4 + h] = F;
            unsigned hi, mid, lo; split3(F, hi, mid, lo); const unsigned one = 0x3f80u;
            u32x4 q0, q1 = (u32x4){0u, 0u, 0u, 0u}, k0;
            q0.x = hi | (mid << 16); q0.y = lo | (one << 16); q0.z = one | (one << 16); q0.w = 0u;
            k0.x = one | (one << 16); k0.y = one | ((hi ^ 0x8000u) << 16); k0.z = (mid ^ 0x8000u) | ((lo ^ 0x8000u) << 16); k0.w = 0u;
            u32x4* fq = (u32x4*)(WSP(bf16_t, WS_FQ) + (m * 4 + h) * 16); fq[0] = q0; fq[1] = q1;
            u32x4* fk = (u32x4*)(WSP(bf16_t, WS_FK) + (m * 4 + h) * 16); fk[0] = k0; fk[1] = q1; }
        __syncthreads();
    }
}
__device__ __forceinline__ void hg_gate(float z, float lb, float& logf, float& kk) {
    logf = log_sigmoidf_(z) + log1pf(lb * __expf(fminf(-z, 60.f)));
    kk = (1.f - lb) * sigmoidf_(-z);
}
__device__ __forceinline__ float hg_lb(const Ctx& c, int l, int ch) {
    if (l == 0) return 0.f;
    const float a = c.in[I_LB][ch], b = c.in[I_LB][256 + ch]; return fmaxf(1.f / (1.f + __expf(a - b)), 0.f);
}
__device__ __forceinline__ void ph_B_hgrn_local_naive(const Ctx& c, int l) {
    float* lg = (float*)c.lds; float* kk = lg + 4096; float* vv = kk + 4096;
    const bf16_t* P = WSP(bf16_t, WS_PACT);
    const int t = c.tid >> 3, c0 = (c.tid & 7) * 8;
    for (int u = c.bid; u < NUNIT; u += c.G) {
        const int bh = u >> 6, ch = u & 63, b = bh >> 2, h = bh & 3; const size_t m = (size_t)b * SEQ + ch * 64 + t;
        { float z[8], v[8]; unpack8(*(const u32x4*)(P + m * PW + PC_HGF + h * 64 + c0), z); unpack8(*(const u32x4*)(P + m * PW + PC_HGI + h * 64 + c0), v);
#pragma unroll
          for (int i = 0; i < 8; ++i) { float lf, k; hg_gate(z[i], hg_lb(c, l, h * 64 + c0 + i), lf, k); lg[t * 64 + c0 + i] = lf; kk[t * 64 + c0 + i] = k; vv[t * 64 + c0 + i] = v[i]; } }
        __syncthreads();
        if (c.tid < 64) { float a = 0.f; for (int s = 0; s < 64; ++s) { a += lg[s * 64 + c.tid]; lg[s * 64 + c.tid] = a; } }
        __syncthreads();
#pragma unroll
        for (int i = 0; i < 8; ++i) kk[t * 64 + c0 + i] *= __expf(lg[63 * 64 + c0 + i] - lg[t * 64 + c0 + i]);
        __syncthreads();
        { const int vd = t; float acc[8];
#pragma unroll
          for (int i = 0; i < 8; ++i) acc[i] = 0.f;
          for (int s = 0; s < 64; ++s) { const float v = vv[s * 64 + vd];
#pragma unroll
              for (int i = 0; i < 8; ++i) acc[i] += v * kk[s * 64 + c0 + i]; }
          float* o = WSP(float, WS_HSLOC) + ((size_t)u * 64 + vd) * 64 + c0; *(f32x4*)o = (f32x4){acc[0], acc[1], acc[2], acc[3]}; *(f32x4*)(o + 4) = (f32x4){acc[4], acc[5], acc[6], acc[7]}; }
        if (c.tid < 64) WSP(float, WS_HDEC)[(size_t)u * 64 + c.tid] = __expf(lg[63 * 64 + c.tid]);
        __syncthreads();
    }
}
__device__ __forceinline__ void ml_conv8(const Ctx& c, int l, const bf16_t* P, size_t m, int spos, int pcol, int wch, float (&o)[8]) {
    const float* cw = c.in[I_CONV] + (size_t)l * 4 * 512;
#pragma unroll
    for (int i = 0; i < 8; ++i) o[i] = 0.f;
#pragma unroll
    for (int j = 0; j < 4; ++j) { const int dt = 3 - j; if (spos - dt >= 0) { float x[8]; unpack8(*(const u32x4*)(P + (m - dt) * PW + pcol), x);
#pragma unroll
            for (int i = 0; i < 8; ++i) o[i] += cw[j * 512 + wch + i] * x[i]; } }
#pragma unroll
    for (int i = 0; i < 8; ++i) o[i] = siluf_(o[i]);
}
__device__ __forceinline__ void ph_B_mlstm_local_naive(const Ctx& c, int l) {
    float* kh = (float*)c.lds; float* vv = kh + 4096; float* bb = vv + 4096; float* ig = bb + 64;
    const bf16_t* P = WSP(bf16_t, WS_PACT); const float* GT = WSP(float, WS_GT);
    const int t = c.tid >> 3, c0 = (c.tid & 7) * 8;
    for (int u = c.bid; u < NUNIT; u += c.G) {
        const int bh = u >> 6, ch = u & 63, b = bh >> 2, h = bh & 3; const size_t m = (size_t)b * SEQ + ch * 64 + t;
        if (c.tid < 64) { const size_t mm = (size_t)b * SEQ + ch * 64 + c.tid; bb[c.tid] = log_sigmoidf_(GT[mm * 16 + 8 + h]); ig[c.tid] = GT[mm * 16 + 4 + h]; }
        __syncthreads();
        if (c.tid == 0) { float a = 0.f; for (int s = 0; s < 64; ++s) { a += bb[s]; bb[s] = a; } }
        __syncthreads();
        { float k[8], v[8]; ml_conv8(c, l, P, m, ch * 64 + t, PC_MLK + h * 64 + c0, 256 + h * 64 + c0, k); unpack8(*(const u32x4*)(P + m * PW + PC_MLV + h * 64 + c0), v);
          const float w = 0.125f * __expf(bb[63] - bb[t] + ig[t]);
#pragma unroll
          for (int i = 0; i < 8; ++i) { kh[t * 64 + c0 + i] = k[i] * w; vv[t * 64 + c0 + i] = v[i]; } }
        __syncthreads();
        for (int vd = t; vd < 65; vd += 64) { float acc[8];
#pragma unroll
            for (int i = 0; i < 8; ++i) acc[i] = 0.f;
            for (int s = 0; s < 64; ++s) { const float v = (vd < 64) ? vv[s * 64 + vd] : 1.f;
#pragma unroll
                for (int i = 0; i < 8; ++i) acc[i] += v * kh[s * 64 + c0 + i]; }
            float* o = WSP(float, WS_MSLOC) + ((size_t)u * 65 + vd) * 64 + c0; *(f32x4*)o = (f32x4){acc[0], acc[1], acc[2], acc[3]}; *(f32x4*)(o + 4) = (f32x4){acc[4], acc[5], acc[6], acc[7]}; }
        if (c.tid == 0) WSP(float, WS_MDEC)[u] = __expf(bb[63]);
        __syncthreads();
    }
}

__device__ __forceinline__ void ph_C_scans(const Ctx& c, int l) {
    const int NGT = c.G * NTHR;
    { const int gt = ((c.bid + c.G - (112 % c.G)) % c.G) * NTHR + c.tid;
      const float* XL = WSP(float, WS_XLOC); bf16_t* U2 = WSP(bf16_t, WS_U2); const float* A64 = WSP(float, WS_A64) + (size_t)l * 16 * 64 * 2;
      for (int i = gt; i < 16 * NB * 64; i += NGT) { const int n = i & 63, b = (i >> 6) & 7, g = i >> 9; const float ar = A64[(g * 64 + n) * 2], ai = A64[(g * 64 + n) * 2 + 1]; float xr = 0.f, xi = 0.f;
          const size_t row0 = (size_t)g * NCHT + b * NCH;
#pragma unroll 1
          for (int cb = 0; cb < NCH; cb += 16) { float lr[16], li[16];
#pragma unroll
              for (int k = 0; k < 16; ++k) { const f32x2_t v = *(const f32x2_t*)(XL + (row0 + cb + k) * 128 + 2 * n); lr[k] = v.x; li[k] = v.y; }
#pragma unroll
              for (int k = 0; k < 16; ++k) { *(unsigned*)(U2 + (row0 + cb + k) * U2LD + 1024 + 2 * n) = pk2(xr, xi);
                  const float nr = ar * xr - ai * xi + lr[k], ni = ar * xi + ai * xr + li[k]; xr = nr; xi = ni; } } } }
    { const int gt = c.bid * NTHR + c.tid;
      const float* SL = WSP(float, WS_HSLOC); const float* DC = WSP(float, WS_HDEC); bf16_t* SP = WSP(bf16_t, WS_HSPREV);
      for (int i = gt; i < 32 * 64 * 32; i += NGT) { const int k2 = (i & 31) * 2, vd = (i >> 5) & 63, bh = i >> 11; float s0 = 0.f, s1 = 0.f;
#pragma unroll 1
          for (int cb = 0; cb < NCH; cb += 16) { f32x2_t sl[16], dc[16];
#pragma unroll
              for (int k = 0; k < 16; ++k) { const size_t u = (size_t)bh * 64 + cb + k; sl[k] = *(const f32x2_t*)(SL + (u * 64 + vd) * 64 + k2); dc[k] = *(const f32x2_t*)(DC + u * 64 + k2); }
#pragma unroll
              for (int k = 0; k < 16; ++k) { const size_t u = (size_t)bh * 64 + cb + k; *(unsigned*)(SP + (u * 64 + vd) * 64 + k2) = pk2(s0, s1);
                  s0 = dc[k].x * s0 + sl[k].x; s1 = dc[k].y * s1 + sl[k].y; } } } }
    { const int gt = ((c.bid + c.G - (126 % c.G)) % c.G) * NTHR + c.tid;
      const float* SL = WSP(float, WS_MSLOC); const float* DC = WSP(float, WS_MDEC); bf16_t* SP = WSP(bf16_t, WS_MSPREV);
      for (int i = gt; i < 32 * 65 * 32; i += NGT) { const int k2 = (i & 31) * 2, vd = (i >> 5) % 65, bh = (i >> 5) / 65; float s0 = 0.f, s1 = 0.f;
#pragma unroll 1
          for (int cb = 0; cb < NCH; cb += 16) { f32x2_t sl[16]; float dc[16];
#pragma unroll
              for (int k = 0; k < 16; ++k) { const size_t u = (size_t)bh * 64 + cb + k; sl[k] = *(const f32x2_t*)(SL + (u * 65 + vd) * 64 + k2); dc[k] = DC[u]; }
#pragma unroll
              for (int k = 0; k < 16; ++k) { const size_t u = (size_t)bh * 64 + cb + k; *(unsigned*)(SP + (u * 80 + vd) * 64 + k2) = pk2(s0, s1);
                  s0 = dc[k] * s0 + sl[k].x; s1 = dc[k] * s1 + sl[k].y; } } } }
}
__device__ __forceinline__ void ph_C_fox_naive(const Ctx& c) {
    const bf16_t* P = WSP(bf16_t, WS_PACT); const float* FC = WSP(float, WS_FCUM); bf16_t* Y = WSP(bf16_t, WS_XNY);
    const int gw = c.bid * 8 + c.wave, NGW = c.G * 8;
    for (int r = gw; r < NB * 4 * SEQ; r += NGW) {
        const int q = r % SEQ, bh = r / SEQ, b = bh >> 2, h = bh & 3; const size_t m0 = (size_t)b * SEQ, mq = m0 + q;
        const float qv = bf2f(P[mq * PW + PC_FXQ + h * 64 + c.lane]); const float Fq = FC[mq * 4 + h];
        float mx = -INFINITY, lsum = 0.f, acc = 0.f;
        for (int kv = 0; kv <= q; ++kv) { const size_t mk = m0 + kv;
            const float s = wave_sum(qv * bf2f(P[mk * PW + PC_FXK + h * 64 + c.lane])) + (Fq - FC[mk * 4 + h]);
            const float mn = fmaxf(mx, s), al = exp2f(mx - mn), p = exp2f(s - mn);
            lsum = lsum * al + p; acc = acc * al + p * bf2f(P[mk * PW + PC_FXV + h * 64 + c.lane]); mx = mn; }
        const float o = acc / lsum; const float rstd = rsqrtf(wave_sum(o * o) * (1.f / 64.f) + EPS);
        Y[mq * DM + 512 + h * 64 + c.lane] = (bf16_t)f2bf(o * rstd);
    }
}


typedef float f32x16 __attribute__((ext_vector_type(16)));
typedef short s16x4 __attribute__((ext_vector_type(4)));
typedef __bf16 bf16x2_t __attribute__((ext_vector_type(2)));
__device__ __forceinline__ unsigned cvtpk(float lo, float hi) { f32x2_t v = {lo, hi}; bf16x2_t b = __builtin_convertvector(v, bf16x2_t); return __builtin_bit_cast(unsigned, b); }
__device__ __forceinline__ int crow(int r, int hi) { return (r & 3) + 8 * (r >> 2) + 4 * hi; }
__device__ __forceinline__ s16x4 ds_tr16(LAS const unsigned char* p) { return __builtin_bit_cast(s16x4, __builtin_amdgcn_ds_read_tr16_b64_v4i16((LAS s16x4*)p)); }
__device__ __forceinline__ void ph_C_fox_fast(const Ctx& c) {
    constexpr int KST = 176, VST = 192, KB = 64 * KST, VB = 64 * VST, BUF = KB + VB;
    LAS unsigned char* L = c.lds3;
    const bf16_t* P = WSP(bf16_t, WS_PACT); const bf16_t* FQ = WSP(bf16_t, WS_FQ); const bf16_t* FK = WSP(bf16_t, WS_FK); bf16_t* Y = WSP(bf16_t, WS_XNY);
    const int tid = c.tid, lane = c.lane, wave = c.wave, r32 = lane & 31, hi = lane >> 5;
    const int vcu = (c.G % 8 == 0) ? (c.bid % 8) * (c.G / 8) + c.bid / 8 : c.bid;
    const int srow = tid >> 3, sch = tid & 7;
    for (int pi = vcu; pi < 256; pi += c.G) {
        const int bh = pi >> 3, sx = pi & 7, b = bh >> 2, h = bh & 3; const size_t m0 = (size_t)b * SEQ;
#pragma unroll 1
        for (int kk = 0; kk < 2; ++kk) {
            const int qb = kk ? 15 - sx : sx, q0 = qb * 256 + wave * 32, NT = 4 * (qb + 1); const size_t mq = m0 + q0 + r32;
            bf16x8 qf[5];
#pragma unroll
            for (int s = 0; s < 4; ++s) qf[s] = *(const bf16x8*)(P + mq * PW + PC_FXQ + h * 64 + 16 * s + 8 * hi);
            qf[4] = *(const bf16x8*)(FQ + (mq * 4 + h) * 16 + 8 * hi);
            const bf16_t* ksrc = P + (m0 + srow) * PW + PC_FXK + h * 64 + sch * 8;
            const bf16_t* vsrc = P + (m0 + srow) * PW + PC_FXV + h * 64 + sch * 8;
            const bf16_t* fsrc = FK + ((m0 + (tid >> 1)) * 4 + h) * 16 + (tid & 1) * 8;
            u32x4 kreg = *(const u32x4*)ksrc, vreg = *(const u32x4*)vsrc, freg = (u32x4){0u, 0u, 0u, 0u};
            if (tid < 128) freg = *(const u32x4*)fsrc;
            *(LAS u32x4*)(L + srow * KST + sch * 16) = kreg; *(LAS u32x4*)(L + KB + srow * VST + sch * 16) = vreg;
            if (tid < 128) *(LAS u32x4*)(L + (tid >> 1) * KST + 128 + (tid & 1) * 16) = freg;
            __syncthreads();
            float m_run = -INFINITY, l_run = 0.f; f32x16 o0 = {}, o1 = {};
            for (int t = 0; t < NT; ++t) {
                const bool more = (t + 1 < NT);
                if (more) { const size_t off = (size_t)(t + 1) * 64 * PW; kreg = *(const u32x4*)(ksrc + off); vreg = *(const u32x4*)(vsrc + off); if (tid < 128) freg = *(const u32x4*)(fsrc + (size_t)(t + 1) * 64 * 64); }
                if (t * 64 <= q0 + 31) {
                    LAS const unsigned char* KL = L + (t & 1) * BUF; LAS const unsigned char* VL = KL + KB;
                    f32x16 p0 = {}, p1 = {};
#pragma unroll
                    for (int s = 0; s < 5; ++s) { const bf16x8 a0 = *(LAS const bf16x8*)(KL + r32 * KST + s * 32 + hi * 16), a1 = *(LAS const bf16x8*)(KL + (32 + r32) * KST + s * 32 + hi * 16);
                        p0 = __builtin_amdgcn_mfma_f32_32x32x16_bf16(a0, qf[s], p0, 0, 0, 0); p1 = __builtin_amdgcn_mfma_f32_32x32x16_bf16(a1, qf[s], p1, 0, 0, 0); }
                    if (t * 64 + 63 > q0) { const int qg = q0 + r32;
#pragma unroll
                        for (int r = 0; r < 16; ++r) { const int kv = t * 64 + crow(r, hi); if (kv > qg) p0[r] = -INFINITY; if (kv + 32 > qg) p1[r] = -INFINITY; } }
                    float mx = fmaxf(p0[0], p1[0]);
#pragma unroll
                    for (int r = 1; r < 16; ++r) mx = fmaxf(mx, fmaxf(p0[r], p1[r]));
                    mx = fmaxf(mx, __shfl_xor(mx, 32));
                    const float mn = fmaxf(m_run, mx), alpha = __builtin_amdgcn_exp2f(m_run - mn); m_run = mn;
                    float rs = 0.f;
#pragma unroll
                    for (int r = 0; r < 16; ++r) { p0[r] = __builtin_amdgcn_exp2f(p0[r] - mn); p1[r] = __builtin_amdgcn_exp2f(p1[r] - mn); rs += p0[r] + p1[r]; }
                    l_run = l_run * alpha + rs;
#pragma unroll
                    for (int r = 0; r < 16; ++r) { o0[r] *= alpha; o1[r] *= alpha; }
                    u32x4 pw[2][2];
#pragma unroll
                    for (int s = 0; s < 2; ++s) { pw[0][s] = (u32x4){cvtpk(p0[8 * s], p0[8 * s + 1]), cvtpk(p0[8 * s + 2], p0[8 * s + 3]), cvtpk(p0[8 * s + 4], p0[8 * s + 5]), cvtpk(p0[8 * s + 6], p0[8 * s + 7])};
                        pw[1][s] = (u32x4){cvtpk(p1[8 * s], p1[8 * s + 1]), cvtpk(p1[8 * s + 2], p1[8 * s + 3]), cvtpk(p1[8 * s + 4], p1[8 * s + 5]), cvtpk(p1[8 * s + 6], p1[8 * s + 7])}; }
                    LAS const unsigned char* vb = VL + (4 * hi + ((lane & 15) >> 2)) * VST + (((lane >> 4) & 1) * 16 + (lane & 3) * 4) * 2;
#pragma unroll
                    for (int blk = 0; blk < 2; ++blk)
#pragma unroll
                        for (int s = 0; s < 2; ++s) {
#pragma unroll
                            for (int db = 0; db < 2; ++db) { LAS const unsigned char* a = vb + (blk * 32 + 16 * s) * VST + db * 64;
                                const s16x4 lo = ds_tr16(a), hh = ds_tr16(a + 8 * VST);
                                const bf16x8 vf = (bf16x8){lo[0], lo[1], lo[2], lo[3], hh[0], hh[1], hh[2], hh[3]};
                                if (db == 0) o0 = __builtin_amdgcn_mfma_f32_32x32x16_bf16(vf, __builtin_bit_cast(bf16x8, pw[blk][s]), o0, 0, 0, 0);
                                else o1 = __builtin_amdgcn_mfma_f32_32x32x16_bf16(vf, __builtin_bit_cast(bf16x8, pw[blk][s]), o1, 0, 0, 0); } }
                }
                if (more) { LAS unsigned char* D = L + ((t + 1) & 1) * BUF;
                    *(LAS u32x4*)(D + srow * KST + sch * 16) = kreg; *(LAS u32x4*)(D + KB + srow * VST + sch * 16) = vreg;
                    if (tid < 128) *(LAS u32x4*)(D + (tid >> 1) * KST + 128 + (tid & 1) * 16) = freg; }
                __syncthreads();
            }
            const float lt = l_run + __shfl_xor(l_run, 32), inv = 1.f / lt; float ss = 0.f;
#pragma unroll
            for (int r = 0; r < 16; ++r) { o0[r] *= inv; o1[r] *= inv; ss += o0[r] * o0[r] + o1[r] * o1[r]; }
            ss += __shfl_xor(ss, 32);
            const float rstd = rsqrtf(ss * (1.f / 64.f) + EPS);
            bf16_t* yr = Y + mq * DM + 512 + h * 64;
#pragma unroll
            for (int g4 = 0; g4 < 4; ++g4) { u32x2 w0, w1; const int d = 8 * g4 + 4 * hi;
                w0.x = cvtpk(o0[4 * g4] * rstd, o0[4 * g4 + 1] * rstd); w0.y = cvtpk(o0[4 * g4 + 2] * rstd, o0[4 * g4 + 3] * rstd);
                w1.x = cvtpk(o1[4 * g4] * rstd, o1[4 * g4 + 1] * rstd); w1.y = cvtpk(o1[4 * g4 + 2] * rstd, o1[4 * g4 + 3] * rstd);
                *(u32x2*)(yr + d) = w0; *(u32x2*)(yr + 32 + d) = w1; }
        }
    }
}

__device__ __forceinline__ void ph_D_hgrn_out_naive(const Ctx& c, int l) {
    float* qq = (float*)c.lds; float* kk = qq + 4096; float* bc = kk + 4096; float* vv = bc + 4096; float* sp = vv + 4096; float* sc = sp + 4096;
    const bf16_t* P = WSP(bf16_t, WS_PACT); const bf16_t* SP = WSP(bf16_t, WS_HSPREV); bf16_t* Y = WSP(bf16_t, WS_XNY);
    const int t = c.tid >> 3, c0 = (c.tid & 7) * 8;
    for (int u = c.bid; u < NUNIT; u += c.G) {
        const int bh = u >> 6, ch = u & 63, b = bh >> 2, h = bh & 3; const size_t m = (size_t)b * SEQ + ch * 64 + t;
        { float z[8], v[8], q[8], s[8]; unpack8(*(const u32x4*)(P + m * PW + PC_HGF + h * 64 + c0), z); unpack8(*(const u32x4*)(P + m * PW + PC_HGI + h * 64 + c0), v);
          unpack8(*(const u32x4*)(P + m * PW + PC_HGQ + h * 64 + c0), q); unpack8(*(const u32x4*)(SP + ((size_t)u * 64 + t) * 64 + c0), s);
#pragma unroll
          for (int i = 0; i < 8; ++i) { float lf, k; hg_gate(z[i], hg_lb(c, l, h * 64 + c0 + i), lf, k); bc[t * 64 + c0 + i] = lf; kk[t * 64 + c0 + i] = k; vv[t * 64 + c0 + i] = v[i]; qq[t * 64 + c0 + i] = q[i];
              sp[(c0 + i) * 64 + t] = s[i]; } }
        __syncthreads();
        if (c.tid < 64) { float a = 0.f; for (int s = 0; s < 64; ++s) { a += bc[s * 64 + c.tid]; bc[s * 64 + c.tid] = a; } }
        __syncthreads();
#pragma unroll
        for (int i = 0; i < 8; ++i) { const int s = c0 + i; float a = 0.f;
            if (s <= t) for (int kd = 0; kd < 64; ++kd) a += qq[t * 64 + kd] * kk[s * 64 + kd] * __expf(bc[t * 64 + kd] - bc[s * 64 + kd]);
            sc[t * 65 + s] = a; }
        __syncthreads();
        float o[8];
#pragma unroll
        for (int i = 0; i < 8; ++i) o[i] = 0.f;
        for (int s = 0; s <= t; ++s) { const float w = sc[t * 65 + s];
#pragma unroll
            for (int i = 0; i < 8; ++i) o[i] += w * vv[s * 64 + c0 + i]; }
        for (int kd = 0; kd < 64; ++kd) { const float w = qq[t * 64 + kd] * __expf(bc[t * 64 + kd]);
#pragma unroll
            for (int i = 0; i < 8; ++i) o[i] += w * sp[kd * 64 + c0 + i]; }
        float ss = 0.f;
#pragma unroll
        for (int i = 0; i < 8; ++i) ss += o[i] * o[i];
        ss += __shfl_xor(ss, 1); ss += __shfl_xor(ss, 2); ss += __shfl_xor(ss, 4);
        const float rstd = rsqrtf(ss * (1.f / 64.f) + EPS);
        float g[8]; unpack8(*(const u32x4*)(P + m * PW + PC_HGG + h * 64 + c0), g);
#pragma unroll
        for (int i = 0; i < 8; ++i) o[i] = o[i] * rstd * siluf_(g[i]);
        *(u32x4*)(Y + m * DM + 256 + h * 64 + c0) = pack8(o);
        __syncthreads();
    }
}
__device__ __forceinline__ void ph_D_mlstm_out_naive(const Ctx& c, int l) {
    float* qq = (float*)c.lds; float* kk = qq + 4096; float* vv = kk + 4096; float* cp = vv + 4096; float* sc = cp + 4096; float* np = sc + 64 * 65; float* bb = np + 64; float* ig = bb + 64;
    const bf16_t* P = WSP(bf16_t, WS_PACT); const bf16_t* SP = WSP(bf16_t, WS_MSPREV); const float* GT = WSP(float, WS_GT); bf16_t* Y = WSP(bf16_t, WS_XNY);
    const int t = c.tid >> 3, c0 = (c.tid & 7) * 8;
    for (int u = c.bid; u < NUNIT; u += c.G) {
        const int bh = u >> 6, ch = u & 63, b = bh >> 2, h = bh & 3; const size_t m = (size_t)b * SEQ + ch * 64 + t;
        if (c.tid < 64) { const size_t mm = (size_t)b * SEQ + ch * 64 + c.tid; bb[c.tid] = log_sigmoidf_(GT[mm * 16 + 8 + h]); ig[c.tid] = GT[mm * 16 + 4 + h]; np[c.tid] = bf2f(SP[((size_t)u * 80 + 64) * 64 + c.tid]); }
        { float q[8], k[8], v[8], s[8]; ml_conv8(c, l, P, m, ch * 64 + t, PC_MLQ + h * 64 + c0, h * 64 + c0, q); ml_conv8(c, l, P, m, ch * 64 + t, PC_MLK + h * 64 + c0, 256 + h * 64 + c0, k);
          unpack8(*(const u32x4*)(P + m * PW + PC_MLV + h * 64 + c0), v); unpack8(*(const u32x4*)(SP + ((size_t)u * 80 + t) * 64 + c0), s);
#pragma unroll
          for (int i = 0; i < 8; ++i) { qq[t * 64 + c0 + i] = q[i]; kk[t * 64 + c0 + i] = k[i] * 0.125f; vv[t * 64 + c0 + i] = v[i]; cp[(c0 + i) * 64 + t] = s[i]; } }
        __syncthreads();
        if (c.tid == 0) { float a = 0.f; for (int s = 0; s < 64; ++s) { a += bb[s]; bb[s] = a; } }
        __syncthreads();
#pragma unroll
        for (int i = 0; i < 8; ++i) { const int s = c0 + i; float a = 0.f;
            if (s <= t) { for (int kd = 0; kd < 64; ++kd) a += qq[t * 64 + kd] * kk[s * 64 + kd]; a *= __expf(bb[t] - bb[s] + ig[s]); }
            sc[t * 65 + s] = a; }
        __syncthreads();
        float o[8]; float den = 0.f;
#pragma unroll
        for (int i = 0; i < 8; ++i) o[i] = 0.f;
        for (int s = 0; s <= t; ++s) { const float w = sc[t * 65 + s]; den += w;
#pragma unroll
            for (int i = 0; i < 8; ++i) o[i] += w * vv[s * 64 + c0 + i]; }
        const float eb = __expf(bb[t]);
        for (int kd = 0; kd < 64; ++kd) { const float w = qq[t * 64 + kd] * eb; den += w * np[kd];
#pragma unroll
            for (int i = 0; i < 8; ++i) o[i] += w * cp[kd * 64 + c0 + i]; }
        const float inv = 1.f / fmaxf(fabsf(den), 1.f);
        float ss = 0.f;
#pragma unroll
        for (int i = 0; i < 8; ++i) { o[i] *= inv; ss += o[i] * o[i]; }
        ss += __shfl_xor(ss, 1); ss += __shfl_xor(ss, 2); ss += __shfl_xor(ss, 4);
        const float rstd = rsqrtf(ss * (1.f / 64.f) + EPS);
        float g[8]; unpack8(*(const u32x4*)(P + m * PW + PC_MLO + h * 64 + c0), g);
#pragma unroll
        for (int i = 0; i < 8; ++i) o[i] = o[i] * rstd * sigmoidf_(g[i]);
        *(u32x4*)(Y + m * DM + 768 + h * 64 + c0) = pack8(o);
        __syncthreads();
    }
}


typedef float f32x4_t __attribute__((ext_vector_type(4)));
__device__ __forceinline__ bf16x8 frag_row(LAS const unsigned char* base, int stride, int r0, int k0, int lane) {
    return *(LAS const bf16x8*)(base + (r0 + (lane & 15)) * stride + (k0 + 8 * (lane >> 4)) * 2); }
__device__ __forceinline__ bf16x8 frag_tr(LAS const unsigned char* base, int stride, int k0, int c0, int lane) {
    const int g = lane >> 4, i = lane & 15; LAS const unsigned char* p = base + (k0 + 8 * g + (i >> 2)) * stride + (c0 + 4 * (i & 3)) * 2;
    const s16x4 lo = ds_tr16(p), hh = ds_tr16(p + 4 * stride); return (bf16x8){lo[0], lo[1], lo[2], lo[3], hh[0], hh[1], hh[2], hh[3]}; }
#define MFMA16(a, b, c) __builtin_amdgcn_mfma_f32_16x16x32_bf16((a), (b), (c), 0, 0, 0)
__device__ __forceinline__ void scan_t8(float (&x)[8], float (&tot)[8], LAS float* wt, int lane, int wave) {
#pragma unroll
    for (int off = 8; off < 64; off <<= 1) {
#pragma unroll
        for (int i = 0; i < 8; ++i) { const float y = __shfl_up(x[i], off); if (lane >= off) x[i] += y; } }
    if (lane >= 56) {
#pragma unroll
        for (int i = 0; i < 8; ++i) wt[wave * 64 + (lane & 7) * 8 + i] = x[i]; }
    __syncthreads();
#pragma unroll
    for (int i = 0; i < 8; ++i) { float pre = 0.f, t = 0.f;
#pragma unroll
        for (int w = 0; w < 8; ++w) { const float v = wt[w * 64 + (lane & 7) * 8 + i]; t += v; if (w < wave) pre += v; }
        x[i] += pre; tot[i] = t; }
}
constexpr int CST = 144;

__device__ __forceinline__ void ph_B_hgrn_local_fast(const Ctx& c, int l) {
    LAS unsigned char* KH = c.lds3; LAS unsigned char* VV = KH + 64 * CST; LAS float* wt = (LAS float*)(VV + 64 * CST);
    const bf16_t* P = WSP(bf16_t, WS_PACT);
    const int tid = c.tid, lane = c.lane, wave = c.wave, t = tid >> 3, c0 = (tid & 7) * 8;
    for (int u = c.bid; u < NUNIT; u += c.G) {
        const int bh = u >> 6, ch = u & 63, b = bh >> 2, h = bh & 3; const size_t m = (size_t)b * SEQ + ch * 64 + t;
        const u32x4 zr = *(const u32x4*)(P + m * PW + PC_HGF + h * 64 + c0), vr = *(const u32x4*)(P + m * PW + PC_HGI + h * 64 + c0);
        float z[8], lf[8], kk[8], tot[8]; unpack8(zr, z);
#pragma unroll
        for (int i = 0; i < 8; ++i) hg_gate(z[i], hg_lb(c, l, h * 64 + c0 + i), lf[i], kk[i]);
        scan_t8(lf, tot, wt, lane, wave);
#pragma unroll
        for (int i = 0; i < 8; ++i) kk[i] *= __expf(tot[i] - lf[i]);
        *(LAS u32x4*)(KH + t * CST + c0 * 2) = pack8(kk); *(LAS u32x4*)(VV + t * CST + c0 * 2) = vr;
        if (t == 63) {
#pragma unroll
            for (int i = 0; i < 8; ++i) WSP(float, WS_HDEC)[(size_t)u * 64 + c0 + i] = __expf(tot[i]); }
        __syncthreads();
        { const int a = wave >> 1;
#pragma unroll
          for (int j = 0; j < 2; ++j) { const int bt = 2 * (wave & 1) + j; f32x4_t acc = {0.f, 0.f, 0.f, 0.f};
#pragma unroll
              for (int ks = 0; ks < 2; ++ks) acc = MFMA16(frag_tr(KH, CST, 32 * ks, 16 * a, lane), frag_tr(VV, CST, 32 * ks, 16 * bt, lane), acc);
              *(f32x4_t*)(WSP(float, WS_HSLOC) + ((size_t)u * 64 + 16 * bt + (lane & 15)) * 64 + 16 * a + 4 * (lane >> 4)) = acc; } }
        __syncthreads();
    }
}

__device__ __forceinline__ void ph_D_hgrn_out_fast(const Ctx& c, int l) {
    LAS unsigned char* QA = c.lds3; LAS unsigned char* QB = QA + 32 * CST; LAS unsigned char* QC = QB + 32 * CST; LAS unsigned char* KA = QC + 32 * CST; LAS unsigned char* KB_ = KA + 32 * CST; LAS unsigned char* KC = KB_ + 32 * CST;
    LAS unsigned char* QH = KC + 32 * CST; LAS unsigned char* VV = QH + 64 * CST; LAS unsigned char* SP = VV + 64 * CST; LAS unsigned char* SC = SP + 64 * CST;
    LAS float* refs = (LAS float*)(SC + 64 * CST); LAS float* wt = refs + 4 * 64; LAS float* ssb = wt + 8 * 64;
    const bf16_t* P = WSP(bf16_t, WS_PACT); const bf16_t* SPG = WSP(bf16_t, WS_HSPREV); bf16_t* Y = WSP(bf16_t, WS_XNY);
    const int tid = c.tid, lane = c.lane, wave = c.wave, t = tid >> 3, c0 = (tid & 7) * 8;
    for (int u = c.bid; u < NUNIT; u += c.G) {
        const int bh = u >> 6, ch = u & 63, b = bh >> 2, h = bh & 3; const size_t m0 = (size_t)b * SEQ + ch * 64, m = m0 + t;
        const u32x4 zr = *(const u32x4*)(P + m * PW + PC_HGF + h * 64 + c0), vr = *(const u32x4*)(P + m * PW + PC_HGI + h * 64 + c0), qr = *(const u32x4*)(P + m * PW + PC_HGQ + h * 64 + c0);
        const u32x4 sr = *(const u32x4*)(SPG + ((size_t)u * 64 + t) * 64 + c0);
        float z[8], q[8], bc[8], kk[8], tot[8]; unpack8(zr, z); unpack8(qr, q);
#pragma unroll
        for (int i = 0; i < 8; ++i) hg_gate(z[i], hg_lb(c, l, h * 64 + c0 + i), bc[i], kk[i]);
        scan_t8(bc, tot, wt, lane, wave);
        if ((t & 15) == 15 && t < 63) {
#pragma unroll
            for (int i = 0; i < 8; ++i) refs[(t >> 4) * 64 + c0 + i] = bc[i]; }
        *(LAS u32x4*)(VV + t * CST + c0 * 2) = vr; *(LAS u32x4*)(SP + t * CST + c0 * 2) = sr;
        __syncthreads();
        { float o1[8], o2[8], o3[8], o4[8];
          if (t < 32) {
#pragma unroll
              for (int i = 0; i < 8; ++i) { const float r15 = refs[c0 + i], r31 = refs[64 + c0 + i]; o1[i] = q[i] * __expf(bc[i] - r15); o2[i] = kk[i] * __expf(r15 - bc[i]); o3[i] = kk[i] * __expf(r31 - bc[i]); }
              *(LAS u32x4*)(QA + t * CST + c0 * 2) = pack8(o1); *(LAS u32x4*)(KA + t * CST + c0 * 2) = pack8(o2); *(LAS u32x4*)(KB_ + t * CST + c0 * 2) = pack8(o3);
          } else { const int tt = t - 32;
#pragma unroll
              for (int i = 0; i < 8; ++i) { const float r31 = refs[64 + c0 + i], r47 = refs[128 + c0 + i]; o1[i] = q[i] * __expf(bc[i] - r31); o2[i] = q[i] * __expf(bc[i] - r47); o3[i] = kk[i] * __expf(r47 - bc[i]); }
              *(LAS u32x4*)(QB + tt * CST + c0 * 2) = pack8(o1); *(LAS u32x4*)(QC + tt * CST + c0 * 2) = pack8(o2); *(LAS u32x4*)(KC + tt * CST + c0 * 2) = pack8(o3); }
#pragma unroll
          for (int i = 0; i < 8; ++i) o4[i] = q[i] * __expf(bc[i]);
          *(LAS u32x4*)(QH + t * CST + c0 * 2) = pack8(o4); }
        __syncthreads();
#pragma unroll
        for (int e2 = 0; e2 < 2; ++e2) { const int e = wave + 8 * e2, ti = e >> 2, si = e & 3; f32x4_t acc = {0.f, 0.f, 0.f, 0.f};
            if (si <= ti) { LAS const unsigned char* Qp = (ti < 2) ? QA : ((si < 2) ? QB : QC); LAS const unsigned char* Kp = (ti < 2) ? KA : ((si < 2) ? KB_ : KC);
                const int qr0 = 16 * (ti & 1), kr0 = 16 * (si & 1);
#pragma unroll
                for (int ks = 0; ks < 2; ++ks) acc = MFMA16(frag_row(Kp, CST, kr0, 32 * ks, lane), frag_row(Qp, CST, qr0, 32 * ks, lane), acc);
                if (si == ti) {
#pragma unroll
                    for (int i = 0; i < 4; ++i) if (4 * (lane >> 4) + i > (lane & 15)) acc[i] = 0.f; } }
            u32x2 w; w.x = cvtpk(acc[0], acc[1]); w.y = cvtpk(acc[2], acc[3]);
            *(LAS u32x2*)(SC + (16 * ti + (lane & 15)) * CST + (16 * si + 4 * (lane >> 4)) * 2) = w; }
        __syncthreads();
        { const int ts = wave >> 1; f32x4_t acc[2]; float ss = 0.f;
#pragma unroll
          for (int j = 0; j < 2; ++j) { const int vt = 2 * (wave & 1) + j; acc[j] = (f32x4_t){0.f, 0.f, 0.f, 0.f};
              acc[j] = MFMA16(frag_tr(VV, CST, 0, 16 * vt, lane), frag_row(SC, CST, 16 * ts, 0, lane), acc[j]);
              if (ts >= 2) acc[j] = MFMA16(frag_tr(VV, CST, 32, 16 * vt, lane), frag_row(SC, CST, 16 * ts, 32, lane), acc[j]);
#pragma unroll
              for (int ks = 0; ks < 2; ++ks) acc[j] = MFMA16(frag_row(SP, CST, 16 * vt, 32 * ks, lane), frag_row(QH, CST, 16 * ts, 32 * ks, lane), acc[j]);
#pragma unroll
              for (int i = 0; i < 4; ++i) ss += acc[j][i] * acc[j][i]; }
          ss += __shfl_xor(ss, 16); ss += __shfl_xor(ss, 32);
          if (lane < 16) ssb[(16 * ts + lane) * 2 + (wave & 1)] = ss;
          __syncthreads();
          const int tl = 16 * ts + (lane & 15); const float rstd = rsqrtf((ssb[tl * 2] + ssb[tl * 2 + 1]) * (1.f / 64.f) + EPS);
#pragma unroll
          for (int j = 0; j < 2; ++j) { const int vd = 16 * (2 * (wave & 1) + j) + 4 * (lane >> 4);
              const u32x2 gr = *(const u32x2*)(P + (m0 + tl) * PW + PC_HGG + h * 64 + vd);
              const float g0 = bf2f(gr.x & 0xffffu), g1 = bf2f(gr.x >> 16), g2 = bf2f(gr.y & 0xffffu), g3 = bf2f(gr.y >> 16);
              u32x2 w; w.x = cvtpk(acc[j][0] * rstd * siluf_(g0), acc[j][1] * rstd * siluf_(g1)); w.y = cvtpk(acc[j][2] * rstd * siluf_(g2), acc[j][3] * rstd * siluf_(g3));
              *(u32x2*)(Y + (m0 + tl) * DM + 256 + h * 64 + vd) = w; } }
        __syncthreads();
    }
}


constexpr int VST80 = 176;
__device__ __forceinline__ void ml_gates(const Ctx& c, LAS float* bb, LAS float* igs, size_t m0, int h) {
    if (c.tid < 64) { const float* GT = WSP(float, WS_GT); float x = log_sigmoidf_(GT[(m0 + c.tid) * 16 + 8 + h]);
#pragma unroll
        for (int off = 1; off < 64; off <<= 1) { const float y = __shfl_up(x, off); if (c.lane >= off) x += y; }
        bb[c.tid] = x; igs[c.tid] = GT[(m0 + c.tid) * 16 + 4 + h]; }
}
__device__ __forceinline__ void ph_B_mlstm_local_fast(const Ctx& c, int l) {
    LAS unsigned char* KH = c.lds3; LAS unsigned char* VV = KH + 64 * CST; LAS float* bb = (LAS float*)(VV + 64 * VST80); LAS float* igs = bb + 64;
    const bf16_t* P = WSP(bf16_t, WS_PACT);
    const int tid = c.tid, lane = c.lane, wave = c.wave, t = tid >> 3, c0 = (tid & 7) * 8;
    for (int u = c.bid; u < NUNIT; u += c.G) {
        const int bh = u >> 6, ch = u & 63, b = bh >> 2, h = bh & 3; const size_t m0 = (size_t)b * SEQ + ch * 64, m = m0 + t;
        ml_gates(c, bb, igs, m0, h);
        const u32x4 vr = *(const u32x4*)(P + m * PW + PC_MLV + h * 64 + c0);
        float k[8]; ml_conv8(c, l, P, m, ch * 64 + t, PC_MLK + h * 64 + c0, 256 + h * 64 + c0, k);
        __syncthreads();
        { const float w = 0.125f * __expf(bb[63] - bb[t] + igs[t]);
#pragma unroll
          for (int i = 0; i < 8; ++i) k[i] *= w; }
        *(LAS u32x4*)(KH + t * CST + c0 * 2) = pack8(k); *(LAS u32x4*)(VV + t * VST80 + c0 * 2) = vr;
        if ((tid & 7) < 2) *(LAS u32x4*)(VV + t * VST80 + 128 + (tid & 7) * 16) = (u32x4){(tid & 7) == 0 ? 0x3f80u : 0u, 0u, 0u, 0u};
        if (tid == 0) WSP(float, WS_MDEC)[u] = __expf(bb[63]);
        __syncthreads();
#pragma unroll
        for (int j = 0; j < 3; ++j) { const int e = wave + 8 * j; if (e < 20) { const int a = e & 3, bt = e >> 2; f32x4_t acc = {0.f, 0.f, 0.f, 0.f};
#pragma unroll
            for (int ks = 0; ks < 2; ++ks) acc = MFMA16(frag_tr(KH, CST, 32 * ks, 16 * a, lane), frag_tr(VV, VST80, 32 * ks, 16 * bt, lane), acc);
            const int vd = 16 * bt + (lane & 15);
            if (vd < 65) *(f32x4_t*)(WSP(float, WS_MSLOC) + ((size_t)u * 65 + vd) * 64 + 16 * a + 4 * (lane >> 4)) = acc; } }
        __syncthreads();
    }
}
__device__ __forceinline__ void ph_D_mlstm_out_fast(const Ctx& c, int l) {
    LAS unsigned char* QT = c.lds3; LAS unsigned char* KT = QT + 64 * CST; LAS unsigned char* VV = KT + 64 * CST; LAS unsigned char* CP = VV + 64 * VST80; LAS unsigned char* SC = CP + 80 * CST;
    LAS float* bb = (LAS float*)(SC + 64 * CST); LAS float* igs = bb + 64; LAS float* den = igs + 64; LAS float* ssb = den + 64;
    const bf16_t* P = WSP(bf16_t, WS_PACT); const bf16_t* SPG = WSP(bf16_t, WS_MSPREV); bf16_t* Y = WSP(bf16_t, WS_XNY);
    const int tid = c.tid, lane = c.lane, wave = c.wave, t = tid >> 3, c0 = (tid & 7) * 8;
    for (int u = c.bid; u < NUNIT; u += c.G) {
        const int bh = u >> 6, ch = u & 63, b = bh >> 2, h = bh & 3; const size_t m0 = (size_t)b * SEQ + ch * 64, m = m0 + t;
        ml_gates(c, bb, igs, m0, h);
        const u32x4 vr = *(const u32x4*)(P + m * PW + PC_MLV + h * 64 + c0);
        const u32x4 cr = *(const u32x4*)(SPG + (size_t)u * 80 * 64 + tid * 8);
        u32x4 cr2 = (u32x4){0u, 0u, 0u, 0u}; if (tid < 128) cr2 = *(const u32x4*)(SPG + (size_t)u * 80 * 64 + (512 + tid) * 8);
        float q[8], k[8]; ml_conv8(c, l, P, m, ch * 64 + t, PC_MLQ + h * 64 + c0, h * 64 + c0, q); ml_conv8(c, l, P, m, ch * 64 + t, PC_MLK + h * 64 + c0, 256 + h * 64 + c0, k);
        __syncthreads();
        { const float eq = __expf(bb[t]), ek = 0.125f * __expf(igs[t] - bb[t]);
#pragma unroll
          for (int i = 0; i < 8; ++i) { q[i] *= eq; k[i] *= ek; } }
        *(LAS u32x4*)(QT + t * CST + c0 * 2) = pack8(q); *(LAS u32x4*)(KT + t * CST + c0 * 2) = pack8(k); *(LAS u32x4*)(VV + t * VST80 + c0 * 2) = vr;
        if ((tid & 7) < 2) *(LAS u32x4*)(VV + t * VST80 + 128 + (tid & 7) * 16) = (u32x4){(tid & 7) == 0 ? 0x3f80u : 0u, 0u, 0u, 0u};
        *(LAS u32x4*)(CP + (tid >> 3) * CST + (tid & 7) * 16) = cr; if (tid < 128) *(LAS u32x4*)(CP + (64 + (tid >> 3)) * CST + (tid & 7) * 16) = cr2;
        __syncthreads();
#pragma unroll
        for (int e2 = 0; e2 < 2; ++e2) { const int e = wave + 8 * e2, ti = e >> 2, si = e & 3; f32x4_t acc = {0.f, 0.f, 0.f, 0.f};
            if (si <= ti) {
#pragma unroll
                for (int ks = 0; ks < 2; ++ks) acc = MFMA16(frag_row(KT, CST, 16 * si, 32 * ks, lane), frag_row(QT, CST, 16 * ti, 32 * ks, lane), acc);
                if (si == ti) {
#pragma unroll
                    for (int i = 0; i < 4; ++i) if (4 * (lane >> 4) + i > (lane & 15)) acc[i] = 0.f; } }
            u32x2 w; w.x = cvtpk(acc[0], acc[1]); w.y = cvtpk(acc[2], acc[3]);
            *(LAS u32x2*)(SC + (16 * ti + (lane & 15)) * CST + (16 * si + 4 * (lane >> 4)) * 2) = w; }
        __syncthreads();
        { const int ts = wave >> 1, hf = wave & 1; f32x4_t acc[3];
#pragma unroll
          for (int j = 0; j < 3; ++j) { acc[j] = (f32x4_t){0.f, 0.f, 0.f, 0.f}; if (j < 2 || hf == 0) { const int vt = (j == 2) ? 4 : 2 * hf + j;
              acc[j] = MFMA16(frag_tr(VV, VST80, 0, 16 * vt, lane), frag_row(SC, CST, 16 * ts, 0, lane), acc[j]);
              if (ts >= 2) acc[j] = MFMA16(frag_tr(VV, VST80, 32, 16 * vt, lane), frag_row(SC, CST, 16 * ts, 32, lane), acc[j]);
#pragma unroll
              for (int ks = 0; ks < 2; ++ks) acc[j] = MFMA16(frag_row(CP, CST, 16 * vt, 32 * ks, lane), frag_row(QT, CST, 16 * ts, 32 * ks, lane), acc[j]); } }
          if (hf == 0 && lane < 16) den[16 * ts + lane] = acc[2][0];
          __syncthreads();
          const int tl = 16 * ts + (lane & 15); const float inv = 1.f / fmaxf(fabsf(den[tl]), 1.f); float ss = 0.f;
#pragma unroll
          for (int j = 0; j < 2; ++j)
#pragma unroll
              for (int i = 0; i < 4; ++i) { acc[j][i] *= inv; ss += acc[j][i] * acc[j][i]; }
          ss += __shfl_xor(ss, 16); ss += __shfl_xor(ss, 32);
          if (lane < 16) ssb[(16 * ts + lane) * 2 + hf] = ss;
          __syncthreads();
          const float rstd = rsqrtf((ssb[tl * 2] + ssb[tl * 2 + 1]) * (1.f / 64.f) + EPS);
#pragma unroll
          for (int j = 0; j < 2; ++j) { const int vd = 16 * (2 * hf + j) + 4 * (lane >> 4);
              const u32x2 gr = *(const u32x2*)(P + (m0 + tl) * PW + PC_MLO + h * 64 + vd);
              const float g0 = bf2f(gr.x & 0xffffu), g1 = bf2f(gr.x >> 16), g2 = bf2f(gr.y & 0xffffu), g3 = bf2f(gr.y >> 16);
              u32x2 w; w.x = cvtpk(acc[j][0] * rstd * sigmoidf_(g0), acc[j][1] * rstd * sigmoidf_(g1)); w.y = cvtpk(acc[j][2] * rstd * sigmoidf_(g2), acc[j][3] * rstd * sigmoidf_(g3));
              *(u32x2*)(Y + (m0 + tl) * DM + 768 + h * 64 + vd) = w; } }
        __syncthreads();
    }
}

__device__ __forceinline__ void ph_E_glu_naive(const Ctx& c, int l) {
    float* g1 = (float*)c.lds;
    bf16_t* wl = (bf16_t*)(g1 + 64 * 256);
    const bf16_t* G1 = WSP(bf16_t, WS_G1); const bf16_t* WT = WSP(bf16_t, WS_WGLU) + (size_t)l * 256 * 256; bf16_t* Y = WSP(bf16_t, WS_XNY);
    const int t = c.tid >> 3, j8 = c.tid & 7;
    for (int u = c.bid; u < MTOK / 64; u += c.G) {
        const size_t m0 = (size_t)u * 64;
        for (int e = c.tid; e < 64 * 32; e += NTHR) { const int r = e >> 5, c8 = (e & 31) * 8; float v[8]; unpack8(*(const u32x4*)(G1 + (m0 + r) * 256 + c8), v);
#pragma unroll
            for (int i = 0; i < 8; ++i) g1[r * 256 + c8 + i] = v[i]; }
        float yv[32]; float ss = 0.f;
#pragma unroll
        for (int hf = 0; hf < 2; ++hf) {
            __syncthreads();
            for (int e = c.tid; e < 128 * 32; e += NTHR) { const int r = e >> 5, c8 = (e & 31) * 8; *(u32x4*)(wl + r * 264 + c8) = *(const u32x4*)(WT + (size_t)(hf * 128 + r) * 256 + c8); }
            __syncthreads();
#pragma unroll
            for (int i = 0; i < 16; ++i) { const int nl = j8 * 16 + i; float a = 0.f;
                for (int k = 0; k < 256; k += 2) { const unsigned w = *(const unsigned*)(wl + nl * 264 + k); a += g1[t * 256 + k] * bf2f(w & 0xffffu) + g1[t * 256 + k + 1] * bf2f(w >> 16); }
                const float g = g1[t * 256 + hf * 128 + nl]; const float y = g * sigmoidf_(a); yv[hf * 16 + i] = y; ss += y * y; }
        }
        ss += __shfl_xor(ss, 1); ss += __shfl_xor(ss, 2); ss += __shfl_xor(ss, 4);
        const float rstd = rsqrtf(ss * (1.f / 256.f) + EPS);
#pragma unroll
        for (int hf = 0; hf < 2; ++hf)
#pragma unroll
            for (int i8 = 0; i8 < 2; ++i8) { float o[8];
#pragma unroll
                for (int i = 0; i < 8; ++i) o[i] = yv[hf * 16 + i8 * 8 + i] * rstd;
                *(u32x4*)(Y + (m0 + t) * DM + hf * 128 + j8 * 16 + i8 * 8) = pack8(o); }
        __syncthreads();
    }
}


__device__ __forceinline__ void ph_E_glu_fast(const Ctx& c, int l) {
    constexpr int GST = 528;
    LAS unsigned char* GT_ = c.lds3; LAS float* ssb = (LAS float*)(GT_ + 64 * GST);
    const bf16_t* G1 = WSP(bf16_t, WS_G1); const bf16_t* WT = WSP(bf16_t, WS_WGLU) + (size_t)l * 256 * 256; bf16_t* Y = WSP(bf16_t, WS_XNY);
    const int tid = c.tid, lane = c.lane, wave = c.wave;
    for (int u = c.bid; u < MTOK / 64; u += c.G) {
        const size_t m0 = (size_t)u * 64;
#pragma unroll
        for (int e = 0; e < 4; ++e) { const int ci = tid + 512 * e, r = ci >> 5, c8 = (ci & 31) * 8; *(LAS u32x4*)(GT_ + r * GST + c8 * 2) = *(const u32x4*)(G1 + (m0 + r) * 256 + c8); }
        __syncthreads();
        f32x4_t acc[2][4];
#pragma unroll
        for (int j = 0; j < 2; ++j)
#pragma unroll
            for (int mt = 0; mt < 4; ++mt) acc[j][mt] = (f32x4_t){0.f, 0.f, 0.f, 0.f};
#pragma unroll 2
        for (int ks = 0; ks < 8; ++ks) { bf16x8 wf[2], gf[4];
#pragma unroll
            for (int j = 0; j < 2; ++j) wf[j] = *(const bf16x8*)(WT + (size_t)(16 * (2 * wave + j) + (lane & 15)) * 256 + 32 * ks + 8 * (lane >> 4));
#pragma unroll
            for (int mt = 0; mt < 4; ++mt) gf[mt] = frag_row(GT_, GST, 16 * mt, 32 * ks, lane);
#pragma unroll
            for (int j = 0; j < 2; ++j)
#pragma unroll
                for (int mt = 0; mt < 4; ++mt) acc[j][mt] = MFMA16(wf[j], gf[mt], acc[j][mt]); }
#pragma unroll
        for (int mt = 0; mt < 4; ++mt) { float ss = 0.f;
#pragma unroll
            for (int j = 0; j < 2; ++j) { const int n = 16 * (2 * wave + j) + 4 * (lane >> 4); const u32x2 gr = *(LAS const u32x2*)(GT_ + (16 * mt + (lane & 15)) * GST + n * 2);
                const float g0 = bf2f(gr.x & 0xffffu), g1 = bf2f(gr.x >> 16), g2 = bf2f(gr.y & 0xffffu), g3 = bf2f(gr.y >> 16);
                acc[j][mt][0] = g0 * sigmoidf_(acc[j][mt][0]); acc[j][mt][1] = g1 * sigmoidf_(acc[j][mt][1]); acc[j][mt][2] = g2 * sigmoidf_(acc[j][mt][2]); acc[j][mt][3] = g3 * sigmoidf_(acc[j][mt][3]);
#pragma unroll
                for (int i = 0; i < 4; ++i) ss += acc[j][mt][i] * acc[j][mt][i]; }
            ss += __shfl_xor(ss, 16); ss += __shfl_xor(ss, 32);
            if (lane < 16) ssb[(16 * mt + lane) * 8 + wave] = ss; }
        __syncthreads();
#pragma unroll
        for (int mt = 0; mt < 4; ++mt) { const int tl = 16 * mt + (lane & 15); float s = 0.f;
#pragma unroll
            for (int w = 0; w < 8; ++w) s += ssb[tl * 8 + w];
            const float rstd = rsqrtf(s * (1.f / 256.f) + EPS);
#pragma unroll
            for (int j = 0; j < 2; ++j) { const int n = 16 * (2 * wave + j) + 4 * (lane >> 4); u32x2 w; w.x = cvtpk(acc[j][mt][0] * rstd, acc[j][mt][1] * rstd); w.y = cvtpk(acc[j][mt][2] * rstd, acc[j][mt][3] * rstd);
                *(u32x2*)(Y + (m0 + tl) * DM + n) = w; } }
        __syncthreads();
    }
}

__device__ __forceinline__ void ph_rowpass(const Ctx& c, const float* hprev, const float* gpost, float* hout, bf16_t* xn) {
    const bf16_t* MX = WSP(bf16_t, WS_MX);
    const int gw = c.bid * 8 + c.wave, NGW = c.G * 8;
    for (int m = gw; m < MTOK; m += NGW) {
        const u32x2* mr = (const u32x2*)(MX + (size_t)m * DM) + c.lane; const f32x4* hr = (const f32x4*)(hprev + (size_t)m * DM) + c.lane; const f32x4* gr = (const f32x4*)gpost + c.lane;
        f32x4 x[4], hv[4]; float s = 0.f;
#pragma unroll
        for (int j = 0; j < 4; ++j) { const u32x2 w = mr[64 * j]; x[j] = (f32x4){bf2f(w.x & 0xffffu), bf2f(w.x >> 16), bf2f(w.y & 0xffffu), bf2f(w.y >> 16)}; hv[j] = hr[64 * j];
            s += (x[j].x * x[j].x + x[j].y * x[j].y) + (x[j].z * x[j].z + x[j].w * x[j].w); }
        const float r1 = rsqrtf(wave_sum(s) * (1.f / DM) + EPS); float s2 = 0.f;
#pragma unroll
        for (int j = 0; j < 4; ++j) { const f32x4 g = gr[64 * j]; hv[j] = hv[j] + x[j] * r1 * g; s2 += (hv[j].x * hv[j].x + hv[j].y * hv[j].y) + (hv[j].z * hv[j].z + hv[j].w * hv[j].w); }
        f32x4* ho = (f32x4*)(hout + (size_t)m * DM) + c.lane;
#pragma unroll
        for (int j = 0; j < 4; ++j) ho[64 * j] = hv[j];
        if (xn) { const float r2 = rsqrtf(wave_sum(s2) * (1.f / DM) + EPS); u32x2* o8 = (u32x2*)(xn + (size_t)m * DM) + c.lane;
#pragma unroll
            for (int j = 0; j < 4; ++j) { u32x2 w; w.x = pk2(hv[j].x * r2, hv[j].y * r2); w.y = pk2(hv[j].z * r2, hv[j].w * r2); o8[64 * j] = w; } }
    }
}


typedef GAS unsigned gu32;
#define XB_TMO      128
#define XB_XCNT(j)  (256  + 64 * (j))
#define XB_XSUB(j)  (1280 + 64 * (j))
#define XB_XGEN(j)  (2304 + 64 * (j))
#define XB_TOP      3328
#define XB_TOPGEN   3392
#define XCD_BAR_WORDS 3456
#define XB_SPIN_CAP (1u << 22)
constexpr int CW_BAR = 4096;
constexpr int MISC_OFF = LDS_BYTES - 512;
__device__ __forceinline__ unsigned xb_ld(unsigned* p)              { return __hip_atomic_load(p, __ATOMIC_RELAXED, __HIP_MEMORY_SCOPE_AGENT); }
__device__ __forceinline__ unsigned xb_add(unsigned* p, unsigned v) { return __hip_atomic_fetch_add(p, v, __ATOMIC_RELAXED, __HIP_MEMORY_SCOPE_AGENT); }
__device__ __forceinline__ unsigned xb_xcc_id() { return (unsigned)__builtin_amdgcn_s_getreg((3 << 11) | 20) & 0xFu; }
#define XB_SPIN(cond, bar) do { unsigned _sp = 0; while (cond) { __builtin_amdgcn_s_sleep(1); \
    if ((++_sp & 255u) == 0u) { if (xb_ld(&(bar)[XB_TMO])) break; if (_sp > XB_SPIN_CAP) { atomicAdd(&(bar)[XB_TMO], 1u); break; } } } } while (0)
struct XcdBarrier { unsigned* bar; unsigned x; volatile LAS unsigned* st; };
__device__ __forceinline__ XcdBarrier xcd_barrier_post(unsigned* bar, volatile LAS unsigned* st) {
    XcdBarrier b; b.bar = bar; b.x = xb_xcc_id(); b.st = st;
    if (threadIdx.x == 0) (void)xb_add(&bar[XB_XCNT(b.x)], 1u);
    return b;
}
__device__ __forceinline__ void xcd_barrier_complete(unsigned* bar, unsigned x, unsigned& nloc, unsigned& nx) {
    const unsigned G = gridDim.x * gridDim.y * gridDim.z;
    unsigned sum, cnt, mine, sp = 0u;
    for (;;) {
        sum = 0u; cnt = 0u; mine = 0u;
#pragma unroll
        for (unsigned j = 0; j < 16; ++j) { const unsigned c = xb_ld(&bar[XB_XCNT(j)]); sum += c; cnt += (c > 0u) ? 1u : 0u; mine = (j == x) ? c : mine; }
        if (sum == G) break;
        __builtin_amdgcn_s_sleep(1);
        if ((++sp & 255u) == 0u) { if (xb_ld(&bar[XB_TMO])) break; if (sp > XB_SPIN_CAP) { atomicAdd(&bar[XB_TMO], 1u); break; } }
    }
    nloc = mine > 0u ? mine : 1u; nx = cnt > 0u ? cnt : 1u;
}
__device__ __forceinline__ void xcd_barrier(const XcdBarrier& b) {
    asm volatile("s_waitcnt vmcnt(0)" ::: "memory");
    __syncthreads();
    if (threadIdx.x == 0) {
        unsigned* bar = b.bar;
        __builtin_amdgcn_s_waitcnt(0);
        unsigned nloc = b.st[0], nx = b.st[1];
        if (nloc == 0u) { xcd_barrier_complete(bar, b.x, nloc, nx); b.st[0] = nloc; b.st[1] = nx; }
        const unsigned old = xb_add(&bar[XB_XSUB(b.x)], 1u);
        const unsigned gen = old / nloc;
        if (old + 1u == (gen + 1u) * nloc) {
            __builtin_amdgcn_fence(__ATOMIC_RELEASE, "agent");
            asm volatile("s_waitcnt vmcnt(0)" ::: "memory");
            const unsigned og = xb_add(&bar[XB_TOP], 1u);
            const unsigned tg = og / nx;
            if (og + 1u == (tg + 1u) * nx) xb_add(&bar[XB_TOPGEN], 1u);
            else XB_SPIN(xb_ld(&bar[XB_TOPGEN]) == tg, bar);
            __builtin_amdgcn_fence(__ATOMIC_ACQUIRE, "agent");
            xb_add(&bar[XB_XGEN(b.x)], 1u);
            asm volatile("s_waitcnt vmcnt(0)" ::: "memory");
        } else {
            XB_SPIN(xb_ld(&bar[XB_XGEN(b.x)]) == gen, bar);
            __builtin_amdgcn_fence(__ATOMIC_ACQUIRE, "agent");
            asm volatile("s_waitcnt vmcnt(0)" ::: "memory");
        }
    }
    __syncthreads();
}

struct Args { const float* in[23]; float* out; unsigned char* ws; int lo, hi; };
constexpr int NPHASE = 1 + 10 * DEPTH;

__global__ void __launch_bounds__(NTHR, 2) hybrid_fwd(Args args) {
    extern __shared__ __attribute__((aligned(16))) unsigned char lds_raw[];
    Ctx c;
#pragma unroll
    for (int i = 0; i < 23; ++i) c.in[i] = args.in[i];
    c.out = args.out; c.ws = args.ws; c.lds = lds_raw; c.lds3 = (LAS unsigned char*)lds_raw; c.tid = threadIdx.x; c.lane = c.tid & 63; c.wave = __builtin_amdgcn_readfirstlane(c.tid >> 6); c.G = gridDim.x; c.bid = blockIdx.x;
    const int lo = args.lo, hi = args.hi;
    volatile LAS unsigned* MISC = (volatile LAS unsigned*)(c.lds3 + MISC_OFF);
    if (c.tid < 128) MISC[c.tid] = 0u;
    __syncthreads();
    XcdBarrier gbar; gbar.bar = (unsigned*)(args.ws + WS_CTL) + CW_BAR; gbar.x = 0; gbar.st = nullptr;
    if (hi - lo > 1) gbar = xcd_barrier_post((unsigned*)(args.ws + WS_CTL) + CW_BAR, MISC + 8);
#define STAMP(k) do { if (TIME_FROM >= 0 && c.bid == 0 && c.tid == 0) { asm volatile("s_waitcnt vmcnt(0)" ::: "memory"); ((volatile LAS unsigned long long*)(MISC + 16))[(k)] = __builtin_amdgcn_s_memrealtime(); } } while (0)
#define SEAM(k) do { if (IN(k) && IN((k) + 1)) xcd_barrier(gbar); STAMP((k) + 1); } while (0)
#define IN(k) (lo <= (k) && (k) < hi)
#define FRESH() do { c.tid = opaque_v((int)threadIdx.x); c.lane = c.tid & 63; } while (0)
    STAMP(0);
    if (IN(0)) { FRESH(); ph_prologue(c); }
    SEAM(0);
    for (int l = 0; l < DEPTH; ++l) {
        const int pb = 1 + 10 * l;
        if (IN(pb + 0)) {
            EpiInProj E{WSP(bf16_t, WS_U2), WSP(bf16_t, WS_PACT), WSP(float, WS_GT), c.in[I_GB] + l * 12};
#if USE_PG8
            { pg8::Gemm g{WSP(bf16_t, WS_XNY), WSP(bf16_t, WS_WIN) + (size_t)l * NIN * DM, DM, DM, DM, (size_t)256 * DM * 2, (size_t)256 * DM * 2};
              pg8::StaticOrder S; S.init(MTOK, NIN, c.G, c.bid); pg8::EpiWrap<EpiInProj, false> W{E};
              pg8::gemm_phase<pg8::EpiWrap<EpiInProj, false>, pg8::StaticOrder, true>(c.lds3, g, S, W); }
#else
            gemm_naive<false>(c, WSP(bf16_t, WS_XNY), DM, WSP(bf16_t, WS_WIN) + (size_t)l * NIN * DM, DM, DM,
                [](int t, int& r0, int& c0, int& b0) -> bool { if (t >= (MTOK / 64) * (NIN / 64)) return false; r0 = 64 * (t / (NIN / 64)); c0 = b0 = 64 * (t % (NIN / 64)); return true; }, E);
#endif
        }
        SEAM(pb + 0);
        if (IN(pb + 1)) {
            FRESH(); ph_B_texpand(c, l); FRESH(); ph_B_gatescan(c);
            { EpiXloc E{WSP(float, WS_XLOC)};
#if USE_PG8
              { pg8::Gemm g{WSP(bf16_t, WS_U2), WSP(bf16_t, WS_BM) + (size_t)l * 16 * 128 * 1024, U2LD, 1024, 1024, (size_t)256 * U2LD * 2, (size_t)128 * 1024 * 2};
                pg8::SchedXloc S{c.G, c.bid}; pg8::EpiWrap<EpiXloc, false> W{E};
                pg8::gemm_phase<pg8::EpiWrap<EpiXloc, false>, pg8::SchedXloc, false>(c.lds3, g, S, W); __syncthreads(); }
#else
              gemm_naive<false>(c, WSP(bf16_t, WS_U2), U2LD, WSP(bf16_t, WS_BM) + (size_t)l * 16 * 128 * 1024, 1024, 1024,
                [](int t, int& r0, int& c0, int& b0) -> bool { if (t >= 128 * 2) return false; const int rt = t >> 1, ct = t & 1, g = rt >> 3; r0 = 64 * rt; c0 = 256 * g + 64 * ct; b0 = g * 128 + 64 * ct; return true; }, E);
#endif
            }
            FRESH();
#if FAST_HGRN
            ph_B_hgrn_local_fast(c, l);
#else
            ph_B_hgrn_local_naive(c, l);
#endif
            FRESH();
#if FAST_MLSTM
            ph_B_mlstm_local_fast(c, l);
#else
            ph_B_mlstm_local_naive(c, l);
#endif

        }
        SEAM(pb + 1);
        if (IN(pb + 2)) { FRESH(); ph_C_scans(c, l); FRESH();
#if FAST_FOX
            ph_C_fox_fast(c);
#else
            ph_C_fox_naive(c);
#endif
        }
        SEAM(pb + 2);
        if (IN(pb + 3)) {
            { EpiS5Y E{WSP(bf16_t, WS_G1)};
#if USE_PG8
              { pg8::Gemm g{WSP(bf16_t, WS_U2), WSP(bf16_t, WS_TT), U2LD, U2LD, U2LD, (size_t)256 * U2LD * 2, (size_t)256 * U2LD * 2};
                pg8::SchedS5Y S{c.G, c.bid}; pg8::EpiWrap<EpiS5Y, false> W{E};
                pg8::gemm_phase<pg8::EpiWrap<EpiS5Y, false>, pg8::SchedS5Y, false>(c.lds3, g, S, W); __syncthreads(); }
#else
              gemm_naive<false>(c, WSP(bf16_t, WS_U2), U2LD, WSP(bf16_t, WS_TT), U2LD, U2LD,
                [](int t, int& r0, int& c0, int& b0) -> bool { if (t >= 128 * 16) return false; const int rt = t >> 4, ct = t & 15, g = rt >> 3; r0 = 64 * rt; c0 = b0 = g * 1024 + 64 * ct; return true; }, E);
#endif
            }
            FRESH();
#if FAST_HGRN
            ph_D_hgrn_out_fast(c, l);
#else
            ph_D_hgrn_out_naive(c, l);
#endif
            FRESH();
#if FAST_MLSTM
            ph_D_mlstm_out_fast(c, l);
#else
            ph_D_mlstm_out_naive(c, l);
#endif

        }
        SEAM(pb + 3);
        if (IN(pb + 4)) { FRESH();
#if FAST_GLU
            ph_E_glu_fast(c, l);
#else
            ph_E_glu_naive(c, l);
#endif
        }
        SEAM(pb + 4);
        if (IN(pb + 5)) {
            EpiPlainBf16 E{WSP(bf16_t, WS_MX), DM};
#if USE_PG8
            { pg8::Gemm g{WSP(bf16_t, WS_XNY), WSP(bf16_t, WS_WOUT) + (size_t)l * DM * DM, DM, DM, DM, (size_t)256 * DM * 2, (size_t)256 * DM * 2};
              pg8::StaticOrder S; S.init(MTOK, DM, c.G, c.bid); pg8::EpiWrap<EpiPlainBf16, false> W{E};
              pg8::gemm_phase<pg8::EpiWrap<EpiPlainBf16, false>, pg8::StaticOrder, true>(c.lds3, g, S, W); }
#else
            gemm_naive<false>(c, WSP(bf16_t, WS_XNY), DM, WSP(bf16_t, WS_WOUT) + (size_t)l * DM * DM, DM, DM,
                [](int t, int& r0, int& c0, int& b0) -> bool { if (t >= (MTOK / 64) * 16) return false; r0 = 64 * (t >> 4); c0 = b0 = 64 * (t & 15); return true; }, E);
#endif
        }
        SEAM(pb + 5);
        if (IN(pb + 6)) { FRESH(); } if (IN(pb + 6)) ph_rowpass(c, l == 0 ? c.in[I_X] : c.out, c.in[I_LNMPOST] + l * DM, c.out, WSP(bf16_t, WS_XNY));
        SEAM(pb + 6);
        if (IN(pb + 7)) {
            EpiSwiGLU E{WSP(bf16_t, WS_PACT)};
#if USE_PG8
            { pg8::Gemm g{WSP(bf16_t, WS_XNY), WSP(bf16_t, WS_WGU) + (size_t)l * NGU * DM, DM, DM, DM, (size_t)256 * DM * 2, (size_t)256 * DM * 2};
              pg8::StaticOrder S; S.init(MTOK, NGU, c.G, c.bid); pg8::EpiWrap<EpiSwiGLU, true> W{E};
              pg8::gemm_phase<pg8::EpiWrap<EpiSwiGLU, true>, pg8::StaticOrder, true>(c.lds3, g, S, W); }
#else
            gemm_naive<true>(c, WSP(bf16_t, WS_XNY), DM, WSP(bf16_t, WS_WGU) + (size_t)l * NGU * DM, DM, DM,
                [](int t, int& r0, int& c0, int& b0) -> bool { if (t >= (MTOK / 64) * (DFF / 64)) return false; r0 = 64 * (t / (DFF / 64)); c0 = 64 * (t % (DFF / 64)); b0 = (c0 >> 7) * 256 + (c0 & 127); return true; }, E);
#endif
        }
        SEAM(pb + 7);
        if (IN(pb + 8)) {
            EpiPlainBf16 E{WSP(bf16_t, WS_MX), DM};
#if USE_PG8
            { pg8::Gemm g{WSP(bf16_t, WS_PACT), WSP(bf16_t, WS_WDN) + (size_t)l * DM * DFF, DFF, DFF, DFF, (size_t)256 * DFF * 2, (size_t)256 * DFF * 2};
              pg8::StaticOrder S; S.init(MTOK, DM, c.G, c.bid); pg8::EpiWrap<EpiPlainBf16, false> W{E};
              pg8::gemm_phase<pg8::EpiWrap<EpiPlainBf16, false>, pg8::StaticOrder, true>(c.lds3, g, S, W); }
#else
            gemm_naive<false>(c, WSP(bf16_t, WS_PACT), DFF, WSP(bf16_t, WS_WDN) + (size_t)l * DM * DFF, DFF, DFF,
                [](int t, int& r0, int& c0, int& b0) -> bool { if (t >= (MTOK / 64) * 16) return false; r0 = 64 * (t >> 4); c0 = b0 = 64 * (t & 15); return true; }, E);
#endif
        }
        SEAM(pb + 8);
        if (IN(pb + 9)) { FRESH(); } if (IN(pb + 9)) ph_rowpass(c, c.out, c.in[I_LNFPOST] + l * DM, c.out, (l + 1 < DEPTH) ? WSP(bf16_t, WS_XNY) : (bf16_t*)nullptr);
        SEAM(pb + 9);
    }
#if TIME_FROM >= 0
    if (c.bid == 0 && c.tid == 0) { __threadfence(); volatile LAS unsigned long long* ts = (volatile LAS unsigned long long*)(MISC + 16);
        const float dt = 1.f + (float)(ts[TIME_TO] - ts[TIME_FROM]) * 1e-3f; atomicAdd(c.out, dt); }
#endif
#undef IN
}

extern "C" void kernel_launch(void* const* d_in, const int* in_sizes, int n_in, void* d_out, int out_size, void* d_ws, size_t ws_size, hipStream_t stream) {
    static int grid = 0;
    if (grid == 0) {
        if (n_in != 23 || in_sizes[0] != MTOK * DM || out_size != MTOK * DM || ws_size < WS_END) {
            fprintf(stderr, "kernel_launch: unexpected shapes (n_in %d, in0 %d, out %d, ws %zu, need ws %zu); nothing launched\n", n_in, n_in > 0 ? in_sizes[0] : -1, out_size, ws_size, (size_t)WS_END); grid = -1; return; }
        int dev = 0, cus = 0;
        if (hipGetDevice(&dev) != hipSuccess || hipDeviceGetAttribute(&cus, hipDeviceAttributeMultiprocessorCount, dev) != hipSuccess) { grid = -1; return; }
        if (hipFuncSetAttribute((const void*)hybrid_fwd, hipFuncAttributeMaxDynamicSharedMemorySize, LDS_BYTES) != hipSuccess) { fprintf(stderr, "kernel_launch: hipFuncSetAttribute failed\n"); grid = -1; return; }
        grid = cus;
    }
    if (grid < 0) return;
    (void)hipMemsetAsync((char*)d_ws + WS_CTL, 0, CTL_BYTES, stream);
    Args a{};
    for (int i = 0; i < 23; ++i) a.in[i] = (const float*)d_in[i];
    a.out = (float*)d_out; a.ws = (unsigned char*)d_ws;
#if N_LAUNCH_MODE == 1
    a.lo = 0; a.hi = NPHASE; hipLaunchKernelGGL(hybrid_fwd, dim3(grid), dim3(NTHR), LDS_BYTES, stream, a);
#else
    for (int p = 0; p < NPHASE; ++p) { a.lo = p; a.hi = p + 1; hipLaunchKernelGGL(hybrid_fwd, dim3(grid), dim3(NTHR), LDS_BYTES, stream, a); }
#endif
}
```

```cpp
#include <hip/hip_runtime.h>
#include <cstdio>
#include <cstdint>

#ifndef N_LAUNCH_MODE
#define N_LAUNCH_MODE 1
#endif
#ifndef FAST_FOX
#define FAST_FOX 1
#endif
#ifndef FAST_HGRN
#define FAST_HGRN 1
#endif
#ifndef FAST_MLSTM
#define FAST_MLSTM 1
#endif
#ifndef FAST_GLU
#define FAST_GLU 1
#endif
#ifndef TIME_FROM
#define TIME_FROM -1
#define TIME_TO -1
#endif
#ifndef USE_PG8
#define USE_PG8 1
#endif

#define LAS __attribute__((address_space(3)))
#define GAS __attribute__((address_space(1)))
typedef unsigned short bf16_t;
typedef float f32x4 __attribute__((ext_vector_type(4)));
typedef unsigned u32x4 __attribute__((ext_vector_type(4)));
typedef unsigned u32x2 __attribute__((ext_vector_type(2)));
typedef short bf16x8 __attribute__((ext_vector_type(8)));
typedef float f32x2_t __attribute__((ext_vector_type(2)));

constexpr int NB = 8, SEQ = 4096, DM = 1024, MTOK = NB * SEQ, DEPTH = 2;
constexpr int DIN = 3084, NIN = 3328, DFF = 2816, NGU = 2 * DFF;
constexpr int CL = 64, NCH = SEQ / CL, NCHT = NB * NCH;
constexpr int PW = 2816;
constexpr int U2LD = 1152;
constexpr int NUNIT = NB * 4 * NCH;
constexpr float EPS = 1e-6f;
constexpr float LOG2E = 1.4426950408889634f;
constexpr int PC_HGQ = 0, PC_HGF = 256, PC_HGI = 512, PC_HGG = 768, PC_FXQ = 1024, PC_FXK = 1280, PC_FXV = 1536, PC_MLQ = 1792, PC_MLK = 2048, PC_MLV = 2304, PC_MLO = 2560;

constexpr size_t MiB = 1u << 20;
constexpr size_t WS_CTL = 0, CTL_BYTES = 1 * MiB;
constexpr size_t WS_WIN = 1 * MiB;
constexpr size_t WS_WOUT = 14 * MiB;
constexpr size_t WS_WGU = 18 * MiB;
constexpr size_t WS_WDN = 40 * MiB;
constexpr size_t WS_WGLU = 51 * MiB;
constexpr size_t WS_KERN = 52 * MiB;
constexpr size_t WS_A64 = 54 * MiB;
constexpr size_t WS_BM = 55 * MiB;
constexpr size_t WS_TT = 71 * MiB;
constexpr size_t WS_CM = 107 * MiB;
constexpr size_t WS_U2 = 115 * MiB;
constexpr size_t WS_GT = 133 * MiB;
constexpr size_t WS_FQ = 135 * MiB;
constexpr size_t WS_FK = 139 * MiB;
constexpr size_t WS_FCUM = 143 * MiB;
constexpr size_t WS_XNY = 144 * MiB;
constexpr size_t WS_PACT = 208 * MiB;
constexpr size_t WS_SCR = 384 * MiB;
constexpr size_t WS_MX = WS_SCR;
constexpr size_t WS_XLOC = WS_SCR;
constexpr size_t WS_G1 = WS_SCR + 4 * MiB;
constexpr size_t WS_HSLOC = WS_SCR + 20 * MiB;
constexpr size_t WS_HDEC = WS_SCR + 52 * MiB;
constexpr size_t WS_MDEC = WS_SCR + 52 * MiB + 512 * 1024;
constexpr size_t WS_HSPREV = WS_SCR + 53 * MiB;
constexpr size_t WS_MSLOC = WS_SCR + 69 * MiB;
constexpr size_t WS_MSPREV = WS_SCR + 102 * MiB;
constexpr size_t WS_END = 512 * MiB;
static_assert(WS_MSPREV + (size_t)NUNIT * 80 * 64 * 2 <= WS_END, "ws map");
static_assert(WS_MSLOC + (size_t)NUNIT * 65 * 64 * 4 <= WS_MSPREV, "ws map");

constexpr int LDS_BYTES = 147456;
constexpr int NTHR = 512;

__device__ __forceinline__ int opaque_v(int x) { asm volatile("" : "+v"(x)); return x; }
__device__ __forceinline__ float bf2f(unsigned b) { return __uint_as_float(b << 16); }
__device__ __forceinline__ unsigned f2bf(float f) { unsigned u = __float_as_uint(f); return (u + 0x7fffu + ((u >> 16) & 1u)) >> 16; }
__device__ __forceinline__ unsigned pk2(float lo, float hi) { return f2bf(lo) | (f2bf(hi) << 16); }
__device__ __forceinline__ float wave_sum(float v) {
#pragma unroll
    for (int o = 1; o < 64; o <<= 1) v += __shfl_xor(v, o);
    return v;
}
__device__ __forceinline__ float sigmoidf_(float x) { return 1.f / (1.f + __expf(-x)); }
__device__ __forceinline__ float log_sigmoidf_(float x) { return fminf(x, 0.f) - log1pf(__expf(-fabsf(x))); }
__device__ __forceinline__ float siluf_(float x) { return x * sigmoidf_(x); }
__device__ __forceinline__ float gelu_tanh(float x) { const float u = 0.7978845608028654f * (x + 0.044715f * x * x * x); return x * (1.f - 1.f / (1.f + __expf(2.f * u))); }
__device__ __forceinline__ void unpack8(const u32x4 w, float (&v)[8]) {
    v[0] = bf2f(w.x & 0xffffu); v[1] = bf2f(w.x >> 16); v[2] = bf2f(w.y & 0xffffu); v[3] = bf2f(w.y >> 16);
    v[4] = bf2f(w.z & 0xffffu); v[5] = bf2f(w.z >> 16); v[6] = bf2f(w.w & 0xffffu); v[7] = bf2f(w.w >> 16);
}
__device__ __forceinline__ u32x4 pack8(const float (&v)[8]) { u32x4 w; w.x = pk2(v[0], v[1]); w.y = pk2(v[2], v[3]); w.z = pk2(v[4], v[5]); w.w = pk2(v[6], v[7]); return w; }

struct Ctx {
    const float* in[23]; float* out; unsigned char* ws;
    unsigned char* lds; LAS unsigned char* lds3; int tid, lane, wave, G, bid;
};
#define WSP(T, off) ((T*)(c.ws + (off)))
enum { I_X = 0, I_WIN, I_GB, I_LRE, I_LIM, I_BRE, I_BIM, I_CRE, I_CIM, I_S5D, I_LOGDT, I_WGLU, I_LB, I_CONV, I_GAIN, I_WOUT, I_LNMPRE, I_LNMPOST, I_LNFPRE, I_LNFPOST, I_WG, I_WU, I_WD };

template <bool PAIR, class TileF, class Epi>
__device__ __forceinline__ void gemm_naive(const Ctx& c, const bf16_t* A, int lda, const bf16_t* Bt, int ldb, int K, TileF tf, const Epi& E) {
    float* As = (float*)c.lds;
    float* Bs = As + 64 * 65;
    float* Bs2 = Bs + 64 * 65;
    const int r = c.tid >> 3, cg = c.tid & 7;
    for (int t = c.bid;; t += c.G) {
        int row0, col0, brow0; if (!tf(t, row0, col0, brow0)) break;
        float acc[8], acc2[8];
#pragma unroll
        for (int i = 0; i < 8; ++i) { acc[i] = 0.f; acc2[i] = 0.f; }
        for (int k0 = 0; k0 < K; k0 += 64) {
            __syncthreads();
            { float v[8]; unpack8(*(const u32x4*)(A + (size_t)(row0 + r) * lda + k0 + cg * 8), v);
#pragma unroll
              for (int i = 0; i < 8; ++i) As[r * 65 + cg * 8 + i] = v[i];
              unpack8(*(const u32x4*)(Bt + (size_t)(brow0 + r) * ldb + k0 + cg * 8), v);
#pragma unroll
              for (int i = 0; i < 8; ++i) Bs[r * 65 + cg * 8 + i] = v[i];
              if (PAIR) { unpack8(*(const u32x4*)(Bt + (size_t)(brow0 + 128 + r) * ldb + k0 + cg * 8), v);
#pragma unroll
                  for (int i = 0; i < 8; ++i) Bs2[r * 65 + cg * 8 + i] = v[i]; } }
            __syncthreads();
            for (int k = 0; k < 64; ++k) {
                const float a = As[r * 65 + k];
#pragma unroll
                for (int i = 0; i < 8; ++i) { acc[i] += a * Bs[(cg * 8 + i) * 65 + k]; if (PAIR) acc2[i] += a * Bs2[(cg * 8 + i) * 65 + k]; }
            }
        }
        E(row0 + r, col0 + cg * 8, acc, acc2);
    }
    __syncthreads();
}

struct EpiInProj {
    bf16_t* U2; bf16_t* P; float* GT; const float* gb;
    __device__ __forceinline__ void operator()(int row, int col, const float (&v)[8], const float (&)[8]) const {
        if (col < 256) { const int g = col >> 4, p0 = col & 15, ch = row >> 6, j = row & 63;
            *(u32x4*)(U2 + ((size_t)(g * NCHT + ch) * U2LD + j * 16 + p0)) = pack8(v); }
        else if (col < 3072) { *(u32x4*)(P + (size_t)row * PW + (col - 256)) = pack8(v); }
        else if (col < 3088) { const int i0 = col - 3072;
#pragma unroll
            for (int i = 0; i < 8; ++i) if (i0 + i < 12) GT[(size_t)row * 16 + i0 + i] = v[i] + gb[i0 + i]; }
    }
};
struct EpiPlainBf16 {
    bf16_t* O; int ld;
    __device__ __forceinline__ void operator()(int row, int col, const float (&v)[8], const float (&)[8]) const { *(u32x4*)(O + (size_t)row * ld + col) = pack8(v); }
};
struct EpiSwiGLU {
    bf16_t* O;
    __device__ __forceinline__ void operator()(int row, int col, const float (&g)[8], const float (&u)[8]) const {
        float v[8];
#pragma unroll
        for (int i = 0; i < 8; ++i) v[i] = siluf_(g[i]) * u[i];
        *(u32x4*)(O + (size_t)row * DFF + col) = pack8(v); }
};
struct EpiXloc {
    float* X;
    __device__ __forceinline__ void operator()(int row, int col, const float (&v)[8], const float (&)[8]) const {
        const int cl = col & 255; if (cl < 128) { float* p = X + (size_t)row * 128 + cl; *(f32x4*)p = (f32x4){v[0], v[1], v[2], v[3]}; *(f32x4*)(p + 4) = (f32x4){v[4], v[5], v[6], v[7]}; } }
};
struct EpiS5Y {
    bf16_t* G1;
    __device__ __forceinline__ void operator()(int row, int col, const float (&v)[8], const float (&)[8]) const {
        const int g = row >> 9, ch = row & 511, cl = col - g * 1024, tau = cl >> 4, p0 = cl & 15; float o[8];
#pragma unroll
        for (int i = 0; i < 8; ++i) o[i] = gelu_tanh(v[i]);
        *(u32x4*)(G1 + ((size_t)(ch * 64 + tau) * 256 + g * 16 + p0)) = pack8(o); }
};


namespace pg8 {
constexpr int BM = 256, BK = 64, HALF = 128, HTB = HALF * BK * 2, STAGE_BYTES = 8 * HTB, NXCD = 8, WGM = 8;
__host__ __device__ __forceinline__ int lds_byte(int r, int c) { const int st = (r >> 4) * 2 + (c >> 5), rr = r & 15, cc = c & 31, ob = rr * 64 + cc * 2; return st * 1024 + (ob ^ (((ob >> 9) & 1) << 5)); }
__host__ __device__ __forceinline__ void stage_rc(int b, int& R, int& C) { const int st = b / 1024, sb = b % 1024, swz = sb ^ (((sb >> 9) & 1) << 5); R = (st >> 1) * 16 + swz / 64; C = (st & 1) * 32 + (swz % 64) / 2; }
__host__ __device__ __forceinline__ int perm32(int rho) { const int n = rho >> 4, i = rho & 15; return 8 * (i >> 2) + 4 * n + (i & 3); }
struct Unit { int pm, pn; };
struct Gemm { const bf16_t* A; const bf16_t* Bt; int lda, ldb, K; size_t astep, bstep; };
struct StaticOrder {
    int nM, nN, nwg, G, c;
    __device__ void init(int M, int N, int G_, int c_) { nM = M / BM; nN = N / BM; nwg = nM * nN; G = G_; c = c_; }
    __device__ bool next(int i, Unit& u) const {
        const long L = (long)i * G + c; if (L >= nwg) return false;
        int wgid = (int)L; { const int q = nwg / NXCD, r = nwg % NXCD, xcd = wgid % NXCD, off = wgid / NXCD; wgid = (xcd < r ? xcd * (q + 1) : r * (q + 1) + (xcd - r) * q) + off; }
        const int nig = WGM * nN, gid = wgid / nig, fm = gid * WGM, gsz = (nM - fm) < WGM ? (nM - fm) : WGM;
        u.pm = fm + ((wgid % nig) % gsz); u.pn = (wgid % nig) / gsz; return true;
    }
};
struct SchedXloc { int G, c; __device__ bool next(int i, Unit& u) const { const int L = i * G + c; if (L >= 32) return false; u.pm = L; u.pn = L >> 1; return true; } };
struct SchedS5Y { int G, c; __device__ bool next(int i, Unit& u) const { const int L = i * G + c; if (L >= 128) return false; const int g = L >> 3; u.pm = g * 2 + ((L >> 2) & 1); u.pn = g * 4 + (L & 3); return true; } };

template <class F, bool PAIR> struct EpiWrap {
    F f;
    __device__ __forceinline__ void operator()(const f32x4 (&acc)[2][2][4][2], const Unit& u, int wr, int wc, int fr, int fq) const {
#pragma unroll
        for (int ai = 0; ai < 2; ++ai)
#pragma unroll
            for (int m = 0; m < 4; ++m) { const int row = u.pm * BM + ai * HALF + wr * 64 + m * 16 + fr;
                if (PAIR) { const int col = u.pn * HALF + wc * 32 + 8 * fq;
                    const float g[8] = {acc[ai][0][m][0][0], acc[ai][0][m][0][1], acc[ai][0][m][0][2], acc[ai][0][m][0][3], acc[ai][0][m][1][0], acc[ai][0][m][1][1], acc[ai][0][m][1][2], acc[ai][0][m][1][3]};
                    const float v[8] = {acc[ai][1][m][0][0], acc[ai][1][m][0][1], acc[ai][1][m][0][2], acc[ai][1][m][0][3], acc[ai][1][m][1][0], acc[ai][1][m][1][1], acc[ai][1][m][1][2], acc[ai][1][m][1][3]};
                    f(row, col, g, v); }
                else {
#pragma unroll
                    for (int bj = 0; bj < 2; ++bj) { const int col = u.pn * BM + bj * HALF + wc * 32 + 8 * fq;
                        const float v[8] = {acc[ai][bj][m][0][0], acc[ai][bj][m][0][1], acc[ai][bj][m][0][2], acc[ai][bj][m][0][3], acc[ai][bj][m][1][0], acc[ai][bj][m][1][1], acc[ai][bj][m][1][2], acc[ai][bj][m][1][3]};
                        f(row, col, v, v); } } }
    }
};

template <class Epi, class Sched, bool ALIGN_EPI>
__device__ __forceinline__ void gemm_phase(LAS unsigned char* lds, const Gemm g, const Sched& S, const Epi& E) {
    const int tid = opaque_v((int)threadIdx.x), wid = __builtin_amdgcn_readfirstlane(tid >> 6), lane = tid & 63, wr = wid >> 2, wc = wid & 3, fr = lane & 15, fq = lane >> 4;
    const int K = g.K, nt = K / BK;
    unsigned voffA[2], voffB[2];
#pragma unroll
    for (int i = 0; i < 2; ++i) { int R, C; stage_rc(tid * 16 + i * 8192, R, C); const int Rb = (R & ~31) + perm32(R & 31);
        voffA[i] = (unsigned)(R * g.lda + C) * 2u; voffB[i] = (unsigned)(Rb * g.ldb + C) * 2u; }
    const size_t kstep = (size_t)(BK * 2);
    const size_t hstepA = (size_t)HALF * g.lda * 2, hstepB = (size_t)HALF * g.ldb * 2;
    const unsigned ldsw = (unsigned)wid * 1024u;
    const int aoff = lds_byte(wr * 64 + fr, fq * 8), boff = lds_byte(wc * 32 + fr, fq * 8);
#define PG8_SA(b, h) (((b) * 2 + (h)) * HTB)
#define PG8_SB(b, h) ((4 + (b) * 2 + (h)) * HTB)
#define PG8_STAGE(bufoff, gbase, voff) do { _Pragma("unroll") for (int _i = 0; _i < 2; ++_i) \
        __builtin_amdgcn_global_load_lds((const unsigned*)((const char*)(gbase) + (voff)[_i]), (LAS unsigned*)(lds + (bufoff) + ldsw + _i * 8192), 16, 0, 0); } while (0)
#define PG8_LDA(dst, b, h) do { _Pragma("unroll") for (int m = 0; m < 4; ++m) _Pragma("unroll") for (int k = 0; k < 2; ++k) dst[m][k] = *(const LAS bf16x8*)(lds + PG8_SA(b, h) + aoff + m * 2048 + k * 1024); } while (0)
#define PG8_LDB(dst, b, h) do { _Pragma("unroll") for (int n = 0; n < 2; ++n) _Pragma("unroll") for (int k = 0; k < 2; ++k) dst[n][k] = *(const LAS bf16x8*)(lds + PG8_SB(b, h) + boff + n * 2048 + k * 1024); } while (0)
#define PG8_MMA(ai, bj, At, Bt) do { __builtin_amdgcn_s_setprio(1); _Pragma("unroll") for (int m = 0; m < 4; ++m) _Pragma("unroll") for (int n = 0; n < 2; ++n) _Pragma("unroll") for (int k = 0; k < 2; ++k) \
        acc[ai][bj][m][n] = __builtin_amdgcn_mfma_f32_16x16x32_bf16(Bt[n][k], At[m][k], acc[ai][bj][m][n], 0, 0, 0); __builtin_amdgcn_s_setprio(0); } while (0)
#define PG8_WAIT_V(n) asm volatile("s_waitcnt vmcnt(" #n ")" ::: "memory")
#define PG8_WAIT_L(n) asm volatile("s_waitcnt lgkmcnt(" #n ")" ::: "memory")
#define PG8_BAR __builtin_amdgcn_s_barrier()
#define PG8_SCHED __builtin_amdgcn_sched_barrier(0)
    Unit cur, nxt; int ui = 0;
    if (!S.next(0, cur)) return;
    f32x4 acc[2][2][4][2];
#pragma unroll
    for (int a = 0; a < 2; ++a)
#pragma unroll
        for (int b = 0; b < 2; ++b)
#pragma unroll
            for (int m = 0; m < 4; ++m)
#pragma unroll
                for (int n = 0; n < 2; ++n) acc[a][b][m][n] = (f32x4){0.f, 0.f, 0.f, 0.f};
    bf16x8 At[4][2], B0[2][2], B1[2][2];
    const char* cA = (const char*)g.A + (size_t)cur.pm * g.astep; const char* cB = (const char*)g.Bt + (size_t)cur.pn * g.bstep;
    PG8_STAGE(PG8_SB(0, 0), cB, voffB); PG8_STAGE(PG8_SB(0, 1), cB + hstepB, voffB); PG8_STAGE(PG8_SA(0, 0), cA, voffA); PG8_STAGE(PG8_SA(0, 1), cA + hstepA, voffA);
    if (wr == 1) PG8_BAR;
    PG8_WAIT_V(2); PG8_BAR;
    PG8_STAGE(PG8_SB(1, 0), cB + kstep, voffB); PG8_STAGE(PG8_SA(1, 0), cA + kstep, voffA); PG8_STAGE(PG8_SB(1, 1), cB + hstepB + kstep, voffB);
    PG8_WAIT_V(6); PG8_BAR;
    for (;;) {
        const bool has_next = S.next(ui + 1, nxt);
        const char* nA = has_next ? (const char*)g.A + (size_t)nxt.pm * g.astep : cA; const char* nB = has_next ? (const char*)g.Bt + (size_t)nxt.pn * g.bstep : cB;
        for (int t = 0; t < nt; t += 2) {
            const bool last = (t == nt - 2);
            const char* a1 = cA + (size_t)(t + 1) * kstep;
            const char* a2 = last ? nA : cA + (size_t)(t + 2) * kstep; const char* b2 = last ? nB : cB + (size_t)(t + 2) * kstep;
            const char* a3 = a2 + kstep; const char* b3 = b2 + kstep;
            PG8_LDB(B0, 0, 0); PG8_LDB(B1, 0, 1); PG8_SCHED; PG8_LDA(At, 0, 0); PG8_STAGE(PG8_SA(1, 1), a1 + hstepA, voffA);
            PG8_WAIT_V(8); PG8_WAIT_L(0); PG8_BAR; PG8_MMA(0, 0, At, B0); PG8_MMA(0, 1, At, B1); PG8_BAR; PG8_SCHED;
            PG8_LDA(At, 0, 1); PG8_STAGE(PG8_SB(0, 0), b2, voffB); PG8_STAGE(PG8_SB(0, 1), b2 + hstepB, voffB); PG8_STAGE(PG8_SA(0, 0), a2, voffA);
            PG8_WAIT_V(8); PG8_WAIT_L(0); PG8_BAR; PG8_MMA(1, 0, At, B0); PG8_MMA(1, 1, At, B1); PG8_BAR; PG8_SCHED;
            PG8_LDB(B0, 1, 0); PG8_LDB(B1, 1, 1); PG8_SCHED; PG8_LDA(At, 1, 0); PG8_STAGE(PG8_SA(0, 1), a2 + hstepA, voffA);
            PG8_WAIT_V(8); PG8_WAIT_L(0); PG8_BAR; PG8_MMA(0, 0, At, B0); PG8_MMA(0, 1, At, B1); PG8_BAR; PG8_SCHED;
            PG8_LDA(At, 1, 1); PG8_STAGE(PG8_SB(1, 0), b3, voffB); PG8_STAGE(PG8_SB(1, 1), b3 + hstepB, voffB); PG8_STAGE(PG8_SA(1, 0), a3, voffA);
            PG8_WAIT_V(8); PG8_WAIT_L(0); PG8_BAR; PG8_MMA(1, 0, At, B0); PG8_MMA(1, 1, At, B1); PG8_BAR; PG8_SCHED;
        }
        if constexpr (ALIGN_EPI) { if (wr == 0) PG8_BAR; }
        E(acc, cur, wr, wc, fr, fq);
        if (!has_next) break;
#pragma unroll
        for (int a = 0; a < 2; ++a)
#pragma unroll
            for (int b = 0; b < 2; ++b)
#pragma unroll
                for (int m = 0; m < 4; ++m)
#pragma unroll
                    for (int n = 0; n < 2; ++n) acc[a][b][m][n] = (f32x4){0.f, 0.f, 0.f, 0.f};
        cur = nxt; cA = nA; cB = nB; ++ui;
        if constexpr (ALIGN_EPI) { if (wr == 1) PG8_BAR; }
    }
    PG8_WAIT_V(0);
    if constexpr (!ALIGN_EPI) { if (wr == 0) PG8_BAR; }
    PG8_BAR;
#undef PG8_SA
#undef PG8_SB
#undef PG8_STAGE
#undef PG8_LDA
#undef PG8_LDB
#undef PG8_MMA
#undef PG8_WAIT_V
#undef PG8_WAIT_L
#undef PG8_BAR
#undef PG8_SCHED
}
}

template <class SrcF>
__device__ __forceinline__ void transpose_item(SrcF src, bf16_t* WT, int ldw, int k0, int n0, float* scr, int lane) {
#pragma unroll 8
    for (int i = 0; i < 32; ++i) { const int kk = 2 * i + (lane >> 5); scr[kk * 33 + (lane & 31)] = src(k0 + kk, n0 + (lane & 31)); }
    __builtin_amdgcn_wave_barrier(); asm volatile("s_waitcnt lgkmcnt(0)" ::: "memory");
    const int cc = lane & 7;
#pragma unroll
    for (int j = 0; j < 4; ++j) { const int n = (lane >> 3) + 8 * j; const float* s = scr + (8 * cc) * 33 + n;
        u32x4 o; o.x = pk2(s[0 * 33], s[1 * 33]); o.y = pk2(s[2 * 33], s[3 * 33]); o.z = pk2(s[4 * 33], s[5 * 33]); o.w = pk2(s[6 * 33], s[7 * 33]);
        *(u32x4*)(WT + (size_t)(n0 + n) * ldw + k0 + 8 * cc) = o; }
    asm volatile("s_waitcnt lgkmcnt(0)" ::: "memory"); __builtin_amdgcn_wave_barrier();
}
__device__ __forceinline__ int win_src_col(int n) {
    if (n < 2048) return n;
    if (n < 3072) return n + 4;
    const int i = n - 3072;
    if (i < 4) return 2048 + i;
    if (i < 8) return 3076 + (i - 4);
    if (i < 12) return 3080 + (i - 8);
    return -1;
}
__device__ __forceinline__ void rms_row_to_bf16(const float* xrow, bf16_t* orow, int lane) {
    const f32x4* xr = (const f32x4*)xrow + lane; f32x4 v[4]; float s = 0.f;
#pragma unroll
    for (int j = 0; j < 4; ++j) { v[j] = xr[64 * j]; s += (v[j].x * v[j].x + v[j].y * v[j].y) + (v[j].z * v[j].z + v[j].w * v[j].w); }
    const float rstd = rsqrtf(wave_sum(s) * (1.f / DM) + EPS);
    u32x2* o8 = (u32x2*)orow + lane;
#pragma unroll
    for (int j = 0; j < 4; ++j) { u32x2 w; w.x = pk2(v[j].x * rstd, v[j].y * rstd); w.y = pk2(v[j].z * rstd, v[j].w * rstd); o8[64 * j] = w; }
}
__device__ __forceinline__ void ph_prologue(const Ctx& c) {
    float* scr = (float*)c.lds + c.wave * 4096;
    const int gw = c.bid * 8 + c.wave, NGW = c.G * 8;
    constexpr int IT_IN = (NIN / 32) * (DM / 64), IT_OUT = (DM / 32) * (DM / 64), IT_GU = (NGU / 32) * (DM / 64), IT_DN = (DM / 32) * (DFF / 64), IT_GLU = (256 / 32) * (256 / 64);
    constexpr int IT_L = IT_IN + IT_OUT + IT_GU + IT_DN + IT_GLU;
    for (int it = gw; it < DEPTH * IT_L; it += NGW) {
        const int l = it / IT_L; int r = it % IT_L;
        if (r < IT_IN) { const int nb = r % (NIN / 32), kb = r / (NIN / 32); const float* W = c.in[I_WIN] + (size_t)l * DM * DIN; const float* ln = c.in[I_LNMPRE] + l * DM;
            transpose_item([=](int k, int n) -> float { const int sc = win_src_col(n); if (sc < 0) return 0.f; float v = W[(size_t)k * DIN + sc] * ln[k]; if (n >= 1280 && n < 1536) v *= 0.125f * LOG2E; return v; },
                           WSP(bf16_t, WS_WIN) + (size_t)l * NIN * DM, DM, kb * 64, nb * 32, scr, c.lane); continue; }
        r -= IT_IN;
        if (r < IT_OUT) { const int nb = r % (DM / 32), kb = r / (DM / 32); const float* W = c.in[I_WOUT] + (size_t)l * DM * DM; const float* gn = c.in[I_GAIN] + l * DM;
            transpose_item([=](int k, int n) -> float { return W[(size_t)k * DM + n] * gn[k]; }, WSP(bf16_t, WS_WOUT) + (size_t)l * DM * DM, DM, kb * 64, nb * 32, scr, c.lane); continue; }
        r -= IT_OUT;
        if (r < IT_GU) { const int nb = r % (NGU / 32), kb = r / (NGU / 32); const float* Wg = c.in[I_WG] + (size_t)l * DM * DFF; const float* Wu = c.in[I_WU] + (size_t)l * DM * DFF; const float* ln = c.in[I_LNFPRE] + l * DM;
            transpose_item([=](int k, int n) -> float { const int tile = n >> 8, hf = (n >> 7) & 1, j = tile * 128 + (n & 127); return (hf ? Wu : Wg)[(size_t)k * DFF + j] * ln[k]; },
                           WSP(bf16_t, WS_WGU) + (size_t)l * NGU * DM, DM, kb * 64, nb * 32, scr, c.lane); continue; }
        r -= IT_GU;
        if (r < IT_DN) { const int nb = r % (DM / 32), kb = r / (DM / 32); const float* W = c.in[I_WD] + (size_t)l * DFF * DM;
            transpose_item([=](int k, int n) -> float { return W[(size_t)k * DM + n]; }, WSP(bf16_t, WS_WDN) + (size_t)l * DM * DFF, DFF, kb * 64, nb * 32, scr, c.lane); continue; }
        r -= IT_DN;
        { const int nb = r % 8, kb = r / 8; const float* W = c.in[I_WGLU] + (size_t)l * 256 * 256;
            transpose_item([=](int k, int n) -> float { return W[(size_t)k * 256 + n]; }, WSP(bf16_t, WS_WGLU) + (size_t)l * 256 * 256, 256, kb * 64, nb * 32, scr, c.lane); }
    }
    for (int m = gw; m < MTOK; m += NGW) rms_row_to_bf16(c.in[I_X] + (size_t)m * DM, WSP(bf16_t, WS_XNY) + (size_t)m * DM, c.lane);
    __syncthreads();
    float* sh = (float*)c.lds;
    for (int it = c.bid; it < DEPTH * 16 * 65; it += c.G) {
        const int l = it / (16 * 65), g = (it / 65) % 16, d = it % 65;
        if (c.tid < 64) { const int n = c.tid;
            const double lr = (double)fminf(c.in[I_LRE][(l * 16 + g) * 64 + n], -1e-4f), li = (double)c.in[I_LIM][(l * 16 + g) * 64 + n], dt = exp((double)c.in[I_LOGDT][l * 16 + g]);
            const double mag1 = exp(lr * dt), abr = mag1 * cos(li * dt), abi = mag1 * sin(li * dt), den = lr * lr + li * li;
            const double cfr = ((abr - 1.0) * lr + abi * li) / den, cfi = (abi * lr - (abr - 1.0) * li) / den;
            const double magd = exp(lr * dt * d), wr = magd * cos(li * dt * d), wi = magd * sin(li * dt * d);
            sh[n] = (float)wr; sh[64 + n] = (float)wi; sh[128 + n] = (float)(wr * cfr - wi * cfi); sh[192 + n] = (float)(wr * cfi + wi * cfr);
            if (d == 64) { float* a64 = WSP(float, WS_A64) + ((size_t)(l * 16 + g) * 64 + n) * 2; a64[0] = (float)wr; a64[1] = (float)wi; } }
        __syncthreads();
        const float* cre = c.in[I_CRE] + (size_t)(l * 16 + g) * 16 * 64; const float* cim = c.in[I_CIM] + (size_t)(l * 16 + g) * 16 * 64;
        const float* bre = c.in[I_BRE] + (size_t)(l * 16 + g) * 64 * 16; const float* bim = c.in[I_BIM] + (size_t)(l * 16 + g) * 64 * 16;
        if (d < 64 && c.tid < 256) { const int p = c.tid >> 4, pp = c.tid & 15; float s = 0.f;
            for (int n = 0; n < 64; ++n) { const float wcr = sh[128 + n], wci = sh[192 + n], br = bre[n * 16 + pp], bi = bim[n * 16 + pp];
                const float xr = wcr * br - wci * bi, xi = wcr * bi + wci * br; s += cre[p * 64 + n] * xr - cim[p * 64 + n] * xi; }
            if (d == 0 && p == pp) s += c.in[I_S5D][l * 256 + g * 16 + p];
            WSP(float, WS_KERN)[(((size_t)(l * 16 + g) * 64 + d) * 16 + p) * 16 + pp] = s; }
        if (d < 64) { const int j = 63 - d; bf16_t* bm = WSP(bf16_t, WS_BM) + (size_t)(l * 16 + g) * 128 * 1024;
#pragma unroll
            for (int e = 0; e < 4; ++e) { const int idx = c.tid * 4 + e, row = idx >> 4, pp = idx & 15, n = row >> 1, ri = row & 1;
                const float wcr = sh[128 + n], wci = sh[192 + n], br = bre[n * 16 + pp], bi = bim[n * 16 + pp];
                const float val = ri ? (wcr * bi + wci * br) : (wcr * br - wci * bi);
                bm[(size_t)row * 1024 + j * 16 + pp] = (bf16_t)f2bf(val); } }
        if (d >= 1) { const int tau = d - 1; bf16_t* cm = WSP(bf16_t, WS_CM) + (size_t)(l * 16 + g) * 1024 * 128;
#pragma unroll
            for (int e = 0; e < 4; ++e) { const int idx = c.tid * 4 + e, p = idx >> 7, q = idx & 127, n = q >> 1, ri = q & 1;
                const float wr = sh[n], wi = sh[64 + n], cr = cre[p * 64 + n], ci = cim[p * 64 + n];
                const float val = ri ? -(cr * wi + ci * wr) : (cr * wr - ci * wi);
                cm[(size_t)(tau * 16 + p) * 128 + q] = (bf16_t)f2bf(val); } }
        __syncthreads();
    }
}

__device__ __forceinline__ void ph_B_texpand(const Ctx& c, int l) {
    bf16_t* TT = WSP(bf16_t, WS_TT);
    const float* KERN = WSP(float, WS_KERN) + (size_t)l * 16 * 64 * 256;
    const bf16_t* CM = WSP(bf16_t, WS_CM) + (size_t)l * 16 * 1024 * 128;
    for (int it = c.bid; it < 16 * 64; it += c.G) {
        const int g = it >> 6, tau = it & 63;
        for (int e = c.tid; e < 16 * (U2LD / 8); e += NTHR) {
            const int p = e / (U2LD / 8), c8 = (e % (U2LD / 8)) * 8; u32x4 w;
            if (c8 < 1024) { const int j = c8 >> 4, pp0 = c8 & 15;
                if (j <= tau) { const float* k = KERN + (((size_t)g * 64 + (tau - j)) * 16 + p) * 16 + pp0; w.x = pk2(k[0], k[1]); w.y = pk2(k[2], k[3]); w.z = pk2(k[4], k[5]); w.w = pk2(k[6], k[7]); }
                else w = (u32x4){0u, 0u, 0u, 0u}; }
            else w = *(const u32x4*)(CM + ((size_t)(g * 1024 + tau * 16 + p)) * 128 + (c8 - 1024));
            *(u32x4*)(TT + ((size_t)(g * 1024 + tau * 16 + p)) * U2LD + c8) = w; }
    }
}
__device__ __forceinline__ void split3(float F, unsigned& hi, unsigned& mid, unsigned& lo) { hi = f2bf(F); float r = F - bf2f(hi); mid = f2bf(r); r -= bf2f(mid); lo = f2bf(r); }
__device__ __forceinline__ void ph_B_gatescan(const Ctx& c) {
    float* sh = (float*)c.lds;
    const float* GT = WSP(float, WS_GT);
    for (int it = (c.bid + c.G - (32 % c.G)) % c.G; it < NB * 4; it += c.G) {
        const int b = it >> 2, h = it & 3; const size_t m0 = (size_t)b * SEQ + c.tid * 8;
        float ls[8]; float run = 0.f;
#pragma unroll
        for (int i = 0; i < 8; ++i) { run += log_sigmoidf_(GT[(m0 + i) * 16 + h]); ls[i] = run; }
        float inc = run;
#pragma unroll
        for (int o = 1; o < 64; o <<= 1) { const float y = __shfl_up(inc, o); if (c.lane >= o) inc += y; }
        __syncthreads(); if (c.lane == 63) sh[c.wave] = inc; __syncthreads();
        float off = inc - run;
#pragma unroll
        for (int w = 0; w < 8; ++w) if (w < c.wave) off += sh[w];
#pragma unroll
        for (int i = 0; i < 8; ++i) { const float F = (off + ls[i]) * LOG2E; const size_t m = m0 + i;
            WSP(float, WS_FCUM)[m * 4 + h] = F;
            unsigned hi, mid, lo; split3(F, hi, mid, lo); const unsigned one = 0x3f80u;
            u32x4 q0, q1 = (u32x4){0u, 0u, 0u, 0u}, k0;
            q0.x = hi | (mid << 16); q0.y = lo | (one << 16); q0.z = one | (one << 16); q0.w = 0u;
            k0.x = one | (one << 16); k0.y = one | ((hi ^ 0x8000u) << 16); k0.z = (mid ^ 0x8000u) | ((lo ^ 0x8000u) << 16); k0.w = 0u;
            u32x4* fq = (u32x4*)(WSP(bf16_t, WS_FQ) + (m * 4 + h) * 16); fq[0] = q0; fq[1] = q1;
            u32x4* fk = (u32x4*)(WSP(bf16_t, WS_FK) + (m * 4 + h) * 16); fk[0] = k0; fk[1] = q1; }
        __syncthreads();
    }
}
__device__ __forceinline__ void hg_gate(float z, float lb, float& logf, float& kk) {
    logf = log_sigmoidf_(z) + log1pf(lb * __expf(fminf(-z, 60.f)));
    kk = (1.f - lb) * sigmoidf_(-z);
}
__device__ __forceinline__ float hg_lb(const Ctx& c, int l, int ch) {
    if (l == 0) return 0.f;
    const float a = c.in[I_LB][ch], b = c.in[I_LB][256 + ch]; return fmaxf(1.f / (1.f + __expf(a - b)), 0.f);
}
__device__ __forceinline__ void ph_B_hgrn_local_naive(const Ctx& c, int l) {
    float* lg = (float*)c.lds; float* kk = lg + 4096; float* vv = kk + 4096;
    const bf16_t* P = WSP(bf16_t, WS_PACT);
    const int t = c.tid >> 3, c0 = (c.tid & 7) * 8;
    for (int u = c.bid; u < NUNIT; u += c.G) {
        const int bh = u >> 6, ch = u & 63, b = bh >> 2, h = bh & 3; const size_t m = (size_t)b * SEQ + ch * 64 + t;
        { float z[8], v[8]; unpack8(*(const u32x4*)(P + m * PW + PC_HGF + h * 64 + c0), z); unpack8(*(const u32x4*)(P + m * PW + PC_HGI + h * 64 + c0), v);
#pragma unroll
          for (int i = 0; i < 8; ++i) { float lf, k; hg_gate(z[i], hg_lb(c, l, h * 64 + c0 + i), lf, k); lg[t * 64 + c0 + i] = lf; kk[t * 64 + c0 + i] = k; vv[t * 64 + c0 + i] = v[i]; } }
        __syncthreads();
        if (c.tid < 64) { float a = 0.f; for (int s = 0; s < 64; ++s) { a += lg[s * 64 + c.tid]; lg[s * 64 + c.tid] = a; } }
        __syncthreads();
#pragma unroll
        for (int i = 0; i < 8; ++i) kk[t * 64 + c0 + i] *= __expf(lg[63 * 64 + c0 + i] - lg[t * 64 + c0 + i]);
        __syncthreads();
        { const int vd = t; float acc[8];
#pragma unroll
          for (int i = 0; i < 8; ++i) acc[i] = 0.f;
          for (int s = 0; s < 64; ++s) { const float v = vv[s * 64 + vd];
#pragma unroll
              for (int i = 0; i < 8; ++i) acc[i] += v * kk[s * 64 + c0 + i]; }
          float* o = WSP(float, WS_HSLOC) + ((size_t)u * 64 + vd) * 64 + c0; *(f32x4*)o = (f32x4){acc[0], acc[1], acc[2], acc[3]}; *(f32x4*)(o + 4) = (f32x4){acc[4], acc[5], acc[6], acc[7]}; }
        if (c.tid < 64) WSP(float, WS_HDEC)[(size_t)u * 64 + c.tid] = __expf(lg[63 * 64 + c.tid]);
        __syncthreads();
    }
}
__device__ __forceinline__ void ml_conv8(const Ctx& c, int l, const bf16_t* P, size_t m, int spos, int pcol, int wch, float (&o)[8]) {
    const float* cw = c.in[I_CONV] + (size_t)l * 4 * 512;
#pragma unroll
    for (int i = 0; i < 8; ++i) o[i] = 0.f;
#pragma unroll
    for (int j = 0; j < 4; ++j) { const int dt = 3 - j; if (spos - dt >= 0) { float x[8]; unpack8(*(const u32x4*)(P + (m - dt) * PW + pcol), x);
#pragma unroll
            for (int i = 0; i < 8; ++i) o[i] += cw[j * 512 + wch + i] * x[i]; } }
#pragma unroll
    for (int i = 0; i < 8; ++i) o[i] = siluf_(o[i]);
}
__device__ __forceinline__ void ph_B_mlstm_local_naive(const Ctx& c, int l) {
    float* kh = (float*)c.lds; float* vv = kh + 4096; float* bb = vv + 4096; float* ig = bb + 64;
    const bf16_t* P = WSP(bf16_t, WS_PACT); const float* GT = WSP(float, WS_GT);
    const int t = c.tid >> 3, c0 = (c.tid & 7) * 8;
    for (int u = c.bid; u < NUNIT; u += c.G) {
        const int bh = u >> 6, ch = u & 63, b = bh >> 2, h = bh & 3; const size_t m = (size_t)b * SEQ + ch * 64 + t;
        if (c.tid < 64) { const size_t mm = (size_t)b * SEQ + ch * 64 + c.tid; bb[c.tid] = log_sigmoidf_(GT[mm * 16 + 8 + h]); ig[c.tid] = GT[mm * 16 + 4 + h]; }
        __syncthreads();
        if (c.tid == 0) { float a = 0.f; for (int s = 0; s < 64; ++s) { a += bb[s]; bb[s] = a; } }
        __syncthreads();
        { float k[8], v[8]; ml_conv8(c, l, P, m, ch * 64 + t, PC_MLK + h * 64 + c0, 256 + h * 64 + c0, k); unpack8(*(const u32x4*)(P + m * PW + PC_MLV + h * 64 + c0), v);
          const float w = 0.125f * __expf(bb[63] - bb[t] + ig[t]);
#pragma unroll
          for (int i = 0; i < 8; ++i) { kh[t * 64 + c0 + i] = k[i] * w; vv[t * 64 + c0 + i] = v[i]; } }
        __syncthreads();
        for (int vd = t; vd < 65; vd += 64) { float acc[8];
#pragma unroll
            for (int i = 0; i < 8; ++i) acc[i] = 0.f;
            for (int s = 0; s < 64; ++s) { const float v = (vd < 64) ? vv[s * 64 + vd] : 1.f;
#pragma unroll
                for (int i = 0; i < 8; ++i) acc[i] += v * kh[s * 64 + c0 + i]; }
            float* o = WSP(float, WS_MSLOC) + ((size_t)u * 65 + vd) * 64 + c0; *(f32x4*)o = (f32x4){acc[0], acc[1], acc[2], acc[3]}; *(f32x4*)(o + 4) = (f32x4){acc[4], acc[5], acc[6], acc[7]}; }
        if (c.tid == 0) WSP(float, WS_MDEC)[u] = __expf(bb[63]);
        __syncthreads();
    }
}

__device__ __forceinline__ void ph_C_scans(const Ctx& c, int l) {
    const int NGT = c.G * NTHR;
    { const int gt = ((c.bid + c.G - (112 % c.G)) % c.G) * NTHR + c.tid;
      const float* XL = WSP(float, WS_XLOC); bf16_t* U2 = WSP(bf16_t, WS_U2); const float* A64 = WSP(float, WS_A64) + (size_t)l * 16 * 64 * 2;
      for (int i = gt; i < 16 * NB * 64; i += NGT) { const int n = i & 63, b = (i >> 6) & 7, g = i >> 9; const float ar = A64[(g * 64 + n) * 2], ai = A64[(g * 64 + n) * 2 + 1]; float xr = 0.f, xi = 0.f;
          const size_t row0 = (size_t)g * NCHT + b * NCH;
#pragma unroll 1
          for (int cb = 0; cb < NCH; cb += 16) { float lr[16], li[16];
#pragma unroll
              for (int k = 0; k < 16; ++k) { const f32x2_t v = *(const f32x2_t*)(XL + (row0 + cb + k) * 128 + 2 * n); lr[k] = v.x; li[k] = v.y; }
#pragma unroll
              for (int k = 0; k < 16; ++k) { *(unsigned*)(U2 + (row0 + cb + k) * U2LD + 1024 + 2 * n) = pk2(xr, xi);
                  const float nr = ar * xr - ai * xi + lr[k], ni = ar * xi + ai * xr + li[k]; xr = nr; xi = ni; } } } }
    { const int gt = c.bid * NTHR + c.tid;
      const float* SL = WSP(float, WS_HSLOC); const float* DC = WSP(float, WS_HDEC); bf16_t* SP = WSP(bf16_t, WS_HSPREV);
      for (int i = gt; i < 32 * 64 * 32; i += NGT) { const int k2 = (i & 31) * 2, vd = (i >> 5) & 63, bh = i >> 11; float s0 = 0.f, s1 = 0.f;
#pragma unroll 1
          for (int cb = 0; cb < NCH; cb += 16) { f32x2_t sl[16], dc[16];
#pragma unroll
              for (int k = 0; k < 16; ++k) { const size_t u = (size_t)bh * 64 + cb + k; sl[k] = *(const f32x2_t*)(SL + (u * 64 + vd) * 64 + k2); dc[k] = *(const f32x2_t*)(DC + u * 64 + k2); }
#pragma unroll
              for (int k = 0; k < 16; ++k) { const size_t u = (size_t)bh * 64 + cb + k; *(unsigned*)(SP + (u * 64 + vd) * 64 + k2) = pk2(s0, s1);
                  s0 = dc[k].x * s0 + sl[k].x; s1 = dc[k].y * s1 + sl[k].y; } } } }
    { const int gt = ((c.bid + c.G - (126 % c.G)) % c.G) * NTHR + c.tid;
      const float* SL = WSP(float, WS_MSLOC); const float* DC = WSP(float, WS_MDEC); bf16_t* SP = WSP(bf16_t, WS_MSPREV);
      for (int i = gt; i < 32 * 65 * 32; i += NGT) { const int k2 = (i & 31) * 2, vd = (i >> 5) % 65, bh = (i >> 5) / 65; float s0 = 0.f, s1 = 0.f;
#pragma unroll 1
          for (int cb = 0; cb < NCH; cb += 16) { f32x2_t sl[16]; float dc[16];
#pragma unroll
              for (int k = 0; k < 16; ++k) { const size_t u = (size_t)bh * 64 + cb + k; sl[k] = *(const f32x2_t*)(SL + (u * 65 + vd) * 64 + k2); dc[k] = DC[u]; }
#pragma unroll
              for (int k = 0; k < 16; ++k) { const size_t u = (size_t)bh * 64 + cb + k; *(unsigned*)(SP + (u * 80 + vd) * 64 + k2) = pk2(s0, s1);
                  s0 = dc[k] * s0 + sl[k].x; s1 = dc[k] * s1 + sl[k].y; } } } }
}
__device__ __forceinline__ void ph_C_fox_naive(const Ctx& c) {
    const bf16_t* P = WSP(bf16_t, WS_PACT); const float* FC = WSP(float, WS_FCUM); bf16_t* Y = WSP(bf16_t, WS_XNY);
    const int gw = c.bid * 8 + c.wave, NGW = c.G * 8;
    for (int r = gw; r < NB * 4 * SEQ; r += NGW) {
        const int q = r % SEQ, bh = r / SEQ, b = bh >> 2, h = bh & 3; const size_t m0 = (size_t)b * SEQ, mq = m0 + q;
        const float qv = bf2f(P[mq * PW + PC_FXQ + h * 64 + c.lane]); const float Fq = FC[mq * 4 + h];
        float mx = -INFINITY, lsum = 0.f, acc = 0.f;
        for (int kv = 0; kv <= q; ++kv) { const size_t mk = m0 + kv;
            const float s = wave_sum(qv * bf2f(P[mk * PW + PC_FXK + h * 64 + c.lane])) + (Fq - FC[mk * 4 + h]);
            const float mn = fmaxf(mx, s), al = exp2f(mx - mn), p = exp2f(s - mn);
            lsum = lsum * al + p; acc = acc * al + p * bf2f(P[mk * PW + PC_FXV + h * 64 + c.lane]); mx = mn; }
        const float o = acc / lsum; const float rstd = rsqrtf(wave_sum(o * o) * (1.f / 64.f) + EPS);
        Y[mq * DM + 512 + h * 64 + c.lane] = (bf16_t)f2bf(o * rstd);
    }
}


typedef float f32x16 __attribute__((ext_vector_type(16)));
typedef short s16x4 __attribute__((ext_vector_type(4)));
typedef __bf16 bf16x2_t __attribute__((ext_vector_type(2)));
__device__ __forceinline__ unsigned cvtpk(float lo, float hi) { f32x2_t v = {lo, hi}; bf16x2_t b = __builtin_convertvector(v, bf16x2_t); return __builtin_bit_cast(unsigned, b); }
__device__ __forceinline__ int crow(int r, int hi) { return (r & 3) + 8 * (r >> 2) + 4 * hi; }
__device__ __forceinline__ s16x4 ds_tr16(LAS const unsigned char* p) { return __builtin_bit_cast(s16x4, __builtin_amdgcn_ds_read_tr16_b64_v4i16((LAS s16x4*)p)); }
__device__ __forceinline__ void ph_C_fox_fast(const Ctx& c) {
    constexpr int KST = 176, VST = 192, KB = 64 * KST, VB = 64 * VST, BUF = KB + VB;
    LAS unsigned char* L = c.lds3;
    const bf16_t* P = WSP(bf16_t, WS_PACT); const bf16_t* FQ = WSP(bf16_t, WS_FQ); const bf16_t* FK = WSP(bf16_t, WS_FK); bf16_t* Y = WSP(bf16_t, WS_XNY);
    const int tid = c.tid, lane = c.lane, wave = c.wave, r32 = lane & 31, hi = lane >> 5;
    const int vcu = (c.G % 8 == 0) ? (c.bid % 8) * (c.G / 8) + c.bid / 8 : c.bid;
    const int srow = tid >> 3, sch = tid & 7;
    for (int pi = vcu; pi < 256; pi += c.G) {
        const int bh = pi >> 3, sx = pi & 7, b = bh >> 2, h = bh & 3; const size_t m0 = (size_t)b * SEQ;
#pragma unroll 1
        for (int kk = 0; kk < 2; ++kk) {
            const int qb = kk ? 15 - sx : sx, q0 = qb * 256 + wave * 32, NT = 4 * (qb + 1); const size_t mq = m0 + q0 + r32;
            bf16x8 qf[5];
#pragma unroll
            for (int s = 0; s < 4; ++s) qf[s] = *(const bf16x8*)(P + mq * PW + PC_FXQ + h * 64 + 16 * s + 8 * hi);
            qf[4] = *(const bf16x8*)(FQ + (mq * 4 + h) * 16 + 8 * hi);
            const bf16_t* ksrc = P + (m0 + srow) * PW + PC_FXK + h * 64 + sch * 8;
            const bf16_t* vsrc = P + (m0 + srow) * PW + PC_FXV + h * 64 + sch * 8;
            const bf16_t* fsrc = FK + ((m0 + (tid >> 1)) * 4 + h) * 16 + (tid & 1) * 8;
            u32x4 kreg = *(const u32x4*)ksrc, vreg = *(const u32x4*)vsrc, freg = (u32x4){0u, 0u, 0u, 0u};
            if (tid < 128) freg = *(const u32x4*)fsrc;
            *(LAS u32x4*)(L + srow * KST + sch * 16) = kreg; *(LAS u32x4*)(L + KB + srow * VST + sch * 16) = vreg;
            if (tid < 128) *(LAS u32x4*)(L + (tid >> 1) * KST + 128 + (tid & 1) * 16) = freg;
            __syncthreads();
            float m_run = -INFINITY, l_run = 0.f; f32x16 o0 = {}, o1 = {};
            for (int t = 0; t < NT; ++t) {
                const bool more = (t + 1 < NT);
                if (more) { const size_t off = (size_t)(t + 1) * 64 * PW; kreg = *(const u32x4*)(ksrc + off); vreg = *(const u32x4*)(vsrc + off); if (tid < 128) freg = *(const u32x4*)(fsrc + (size_t)(t + 1) * 64 * 64); }
                if (t * 64 <= q0 + 31) {
                    LAS const unsigned char* KL = L + (t & 1) * BUF; LAS const unsigned char* VL = KL + KB;
                    f32x16 p0 = {}, p1 = {};
#pragma unroll
                    for (int s = 0; s < 5; ++s) { const bf16x8 a0 = *(LAS const bf16x8*)(KL + r32 * KST + s * 32 + hi * 16), a1 = *(LAS const bf16x8*)(KL + (32 + r32) * KST + s * 32 + hi * 16);
                        p0 = __builtin_amdgcn_mfma_f32_32x32x16_bf16(a0, qf[s], p0, 0, 0, 0); p1 = __builtin_amdgcn_mfma_f32_32x32x16_bf16(a1, qf[s], p1, 0, 0, 0); }
                    if (t * 64 + 63 > q0) { const int qg = q0 + r32;
#pragma unroll
                        for (int r = 0; r < 16; ++r) { const int kv = t * 64 + crow(r, hi); if (kv > qg) p0[r] = -INFINITY; if (kv + 32 > qg) p1[r] = -INFINITY; } }
                    float mx = fmaxf(p0[0], p1[0]);
#pragma unroll
                    for (int r = 1; r < 16; ++r) mx = fmaxf(mx, fmaxf(p0[r], p1[r]));
                    mx = fmaxf(mx, __shfl_xor(mx, 32));
                    const float mn = fmaxf(m_run, mx), alpha = __builtin_amdgcn_exp2f(m_run - mn); m_run = mn;
                    float rs = 0.f;
#pragma unroll
                    for (int r = 0; r < 16; ++r) { p0[r] = __builtin_amdgcn_exp2f(p0[r] - mn); p1[r] = __builtin_amdgcn_exp2f(p1[r] - mn); rs += p0[r] + p1[r]; }
                    l_run = l_run * alpha + rs;
#pragma unroll
                    for (int r = 0; r < 16; ++r) { o0[r] *= alpha; o1[r] *= alpha; }
                    u32x4 pw[2][2];
#pragma unroll
                    for (int s = 0; s < 2; ++s) { pw[0][s] = (u32x4){cvtpk(p0[8 * s], p0[8 * s + 1]), cvtpk(p0[8 * s + 2], p0[8 * s + 3]), cvtpk(p0[8 * s + 4], p0[8 * s + 5]), cvtpk(p0[8 * s + 6], p0[8 * s + 7])};
                        pw[1][s] = (u32x4){cvtpk(p1[8 * s], p1[8 * s + 1]), cvtpk(p1[8 * s + 2], p1[8 * s + 3]), cvtpk(p1[8 * s + 4], p1[8 * s + 5]), cvtpk(p1[8 * s + 6], p1[8 * s + 7])}; }
                    LAS const unsigned char* vb = VL + (4 * hi + ((lane & 15) >> 2)) * VST + (((lane >> 4) & 1) * 16 + (lane & 3) * 4) * 2;
#pragma unroll
                    for (int blk = 0; blk < 2; ++blk)
#pragma unroll
                        for (int s = 0; s < 2; ++s) {
#pragma unroll
                            for (int db = 0; db < 2; ++db) { LAS const unsigned char* a = vb + (blk * 32 + 16 * s) * VST + db * 64;
                                const s16x4 lo = ds_tr16(a), hh = ds_tr16(a + 8 * VST);
                                const bf16x8 vf = (bf16x8){lo[0], lo[1], lo[2], lo[3], hh[0], hh[1], hh[2], hh[3]};
                                if (db == 0) o0 = __builtin_amdgcn_mfma_f32_32x32x16_bf16(vf, __builtin_bit_cast(bf16x8, pw[blk][s]), o0, 0, 0, 0);
                                else o1 = __builtin_amdgcn_mfma_f32_32x32x16_bf16(vf, __builtin_bit_cast(bf16x8, pw[blk][s]), o1, 0, 0, 0); } }
                }
                if (more) { LAS unsigned char* D = L + ((t + 1) & 1) * BUF;
                    *(LAS u32x4*)(D + srow * KST + sch * 16) = kreg; *(LAS u32x4*)(D + KB + srow * VST + sch * 16) = vreg;
                    if (tid < 128) *(LAS u32x4*)(D + (tid >> 1) * KST + 128 + (tid & 1) * 16) = freg; }
                __syncthreads();
            }
            const float lt = l_run + __shfl_xor(l_run, 32), inv = 1.f / lt; float ss = 0.f;
#pragma unroll
            for (int r = 0; r < 16; ++r) { o0[r] *= inv; o1[r] *= inv; ss += o0[r] * o0[r] + o1[r] * o1[r]; }
            ss += __shfl_xor(ss, 32);
            const float rstd = rsqrtf(ss * (1.f / 64.f) + EPS);
            bf16_t* yr = Y + mq * DM + 512 + h * 64;
#pragma unroll
            for (int g4 = 0; g4 < 4; ++g4) { u32x2 w0, w1; const int d = 8 * g4 + 4 * hi;
                w0.x = cvtpk(o0[4 * g4] * rstd, o0[4 * g4 + 1] * rstd); w0.y = cvtpk(o0[4 * g4 + 2] * rstd, o0[4 * g4 + 3] * rstd);
                w1.x = cvtpk(o1[4 * g4] * rstd, o1[4 * g4 + 1] * rstd); w1.y = cvtpk(o1[4 * g4 + 2] * rstd, o1[4 * g4 + 3] * rstd);
                *(u32x2*)(yr + d) = w0; *(u32x2*)(yr + 32 + d) = w1; }
        }
    }
}

__device__ __forceinline__ void ph_D_hgrn_out_naive(const Ctx& c, int l) {
    float* qq = (float*)c.lds; float* kk = qq + 4096; float* bc = kk + 4096; float* vv = bc + 4096; float* sp = vv + 4096; float* sc = sp + 4096;
    const bf16_t* P = WSP(bf16_t, WS_PACT); const bf16_t* SP = WSP(bf16_t, WS_HSPREV); bf16_t* Y = WSP(bf16_t, WS_XNY);
    const int t = c.tid >> 3, c0 = (c.tid & 7) * 8;
    for (int u = c.bid; u < NUNIT; u += c.G) {
        const int bh = u >> 6, ch = u & 63, b = bh >> 2, h = bh & 3; const size_t m = (size_t)b * SEQ + ch * 64 + t;
        { float z[8], v[8], q[8], s[8]; unpack8(*(const u32x4*)(P + m * PW + PC_HGF + h * 64 + c0), z); unpack8(*(const u32x4*)(P + m * PW + PC_HGI + h * 64 + c0), v);
          unpack8(*(const u32x4*)(P + m * PW + PC_HGQ + h * 64 + c0), q); unpack8(*(const u32x4*)(SP + ((size_t)u * 64 + t) * 64 + c0), s);
#pragma unroll
          for (int i = 0; i < 8; ++i) { float lf, k; hg_gate(z[i], hg_lb(c, l, h * 64 + c0 + i), lf, k); bc[t * 64 + c0 + i] = lf; kk[t * 64 + c0 + i] = k; vv[t * 64 + c0 + i] = v[i]; qq[t * 64 + c0 + i] = q[i];
              sp[(c0 + i) * 64 + t] = s[i]; } }
        __syncthreads();
        if (c.tid < 64) { float a = 0.f; for (int s = 0; s < 64; ++s) { a += bc[s * 64 + c.tid]; bc[s * 64 + c.tid] = a; } }
        __syncthreads();
#pragma unroll
        for (int i = 0; i < 8; ++i) { const int s = c0 + i; float a = 0.f;
            if (s <= t) for (int kd = 0; kd < 64; ++kd) a += qq[t * 64 + kd] * kk[s * 64 + kd] * __expf(bc[t * 64 + kd] - bc[s * 64 + kd]);
            sc[t * 65 + s] = a; }
        __syncthreads();
        float o[8];
#pragma unroll
        for (int i = 0; i < 8; ++i) o[i] = 0.f;
        for (int s = 0; s <= t; ++s) { const float w = sc[t * 65 + s];
#pragma unroll
            for (int i = 0; i < 8; ++i) o[i] += w * vv[s * 64 + c0 + i]; }
        for (int kd = 0; kd < 64; ++kd) { const float w = qq[t * 64 + kd] * __expf(bc[t * 64 + kd]);
#pragma unroll
            for (int i = 0; i < 8; ++i) o[i] += w * sp[kd * 64 + c0 + i]; }
        float ss = 0.f;
#pragma unroll
        for (int i = 0; i < 8; ++i) ss += o[i] * o[i];
        ss += __shfl_xor(ss, 1); ss += __shfl_xor(ss, 2); ss += __shfl_xor(ss, 4);
        const float rstd = rsqrtf(ss * (1.f / 64.f) + EPS);
        float g[8]; unpack8(*(const u32x4*)(P + m * PW + PC_HGG + h * 64 + c0), g);
#pragma unroll
        for (int i = 0; i < 8; ++i) o[i] = o[i] * rstd * siluf_(g[i]);
        *(u32x4*)(Y + m * DM + 256 + h * 64 + c0) = pack8(o);
        __syncthreads();
    }
}
__device__ __forceinline__ void ph_D_mlstm_out_naive(const Ctx& c, int l) {
    float* qq = (float*)c.lds; float* kk = qq + 4096; float* vv = kk + 4096; float* cp = vv + 4096; float* sc = cp + 4096; float* np = sc + 64 * 65; float* bb = np + 64; float* ig = bb + 64;
    const bf16_t* P = WSP(bf16_t, WS_PACT); const bf16_t* SP = WSP(bf16_t, WS_MSPREV); const float* GT = WSP(float, WS_GT); bf16_t* Y = WSP(bf16_t, WS_XNY);
    const int t = c.tid >> 3, c0 = (c.tid & 7) * 8;
    for (int u = c.bid; u < NUNIT; u += c.G) {
        const int bh = u >> 6, ch = u & 63, b = bh >> 2, h = bh & 3; const size_t m = (size_t)b * SEQ + ch * 64 + t;
        if (c.tid < 64) { const size_t mm = (size_t)b * SEQ + ch * 64 + c.tid; bb[c.tid] = log_sigmoidf_(GT[mm * 16 + 8 + h]); ig[c.tid] = GT[mm * 16 + 4 + h]; np[c.tid] = bf2f(SP[((size_t)u * 80 + 64) * 64 + c.tid]); }
        { float q[8], k[8], v[8], s[8]; ml_conv8(c, l, P, m, ch * 64 + t, PC_MLQ + h * 64 + c0, h * 64 + c0, q); ml_conv8(c, l, P, m, ch * 64 + t, PC_MLK + h * 64 + c0, 256 + h * 64 + c0, k);
          unpack8(*(const u32x4*)(P + m * PW + PC_MLV + h * 64 + c0), v); unpack8(*(const u32x4*)(SP + ((size_t)u * 80 + t) * 64 + c0), s);
#pragma unroll
          for (int i = 0; i < 8; ++i) { qq[t * 64 + c0 + i] = q[i]; kk[t * 64 + c0 + i] = k[i] * 0.125f; vv[t * 64 + c0 + i] = v[i]; cp[(c0 + i) * 64 + t] = s[i]; } }
        __syncthreads();
        if (c.tid == 0) { float a = 0.f; for (int s = 0; s < 64; ++s) { a += bb[s]; bb[s] = a; } }
        __syncthreads();
#pragma unroll
        for (int i = 0; i < 8; ++i) { const int s = c0 + i; float a = 0.f;
            if (s <= t) { for (int kd = 0; kd < 64; ++kd) a += qq[t * 64 + kd] * kk[s * 64 + kd]; a *= __expf(bb[t] - bb[s] + ig[s]); }
            sc[t * 65 + s] = a; }
        __syncthreads();
        float o[8]; float den = 0.f;
#pragma unroll
        for (int i = 0; i < 8; ++i) o[i] = 0.f;
        for (int s = 0; s <= t; ++s) { const float w = sc[t * 65 + s]; den += w;
#pragma unroll
            for (int i = 0; i < 8; ++i) o[i] += w * vv[s * 64 + c0 + i]; }
        const float eb = __expf(bb[t]);
        for (int kd = 0; kd < 64; ++kd) { const float w = qq[t * 64 + kd] * eb; den += w * np[kd];
#pragma unroll
            for (int i = 0; i < 8; ++i) o[i] += w * cp[kd * 64 + c0 + i]; }
        const float inv = 1.f / fmaxf(fabsf(den), 1.f);
        float ss = 0.f;
#pragma unroll
        for (int i = 0; i < 8; ++i) { o[i] *= inv; ss += o[i] * o[i]; }
        ss += __shfl_xor(ss, 1); ss += __shfl_xor(ss, 2); ss += __shfl_xor(ss, 4);
        const float rstd = rsqrtf(ss * (1.f / 64.f) + EPS);
        float g[8]; unpack8(*(const u32x4*)(P + m * PW + PC_MLO + h * 64 + c0), g);
#pragma unroll
        for (int i = 0; i < 8; ++i) o[i] = o[i] * rstd * sigmoidf_(g[i]);
        *(u32x4*)(Y + m * DM + 768 + h * 64 + c0) = pack8(o);
        __syncthreads();
    }
}


typedef float f32x4_t __attribute__((ext_vector_type(4)));
__device__ __forceinline__ bf16x8 frag_row(LAS const unsigned char* base, int stride, int r0, int k0, int lane) {
    return *(LAS const bf16x8*)(base + (r0 + (lane & 15)) * stride + (k0 + 8 * (lane >> 4)) * 2); }
__device__ __forceinline__ bf16x8 frag_tr(LAS const unsigned char* base, int stride, int k0, int c0, int lane) {
    const int g = lane >> 4, i = lane & 15; LAS const unsigned char* p = base + (k0 + 8 * g + (i >> 2)) * stride + (c0 + 4 * (i & 3)) * 2;
    const s16x4 lo = ds_tr16(p), hh = ds_tr16(p + 4 * stride); return (bf16x8){lo[0], lo[1], lo[2], lo[3], hh[0], hh[1], hh[2], hh[3]}; }
#define MFMA16(a, b, c) __builtin_amdgcn_mfma_f32_16x16x32_bf16((a), (b), (c), 0, 0, 0)
__device__ __forceinline__ void scan_t8(float (&x)[8], float (&tot)[8], LAS float* wt, int lane, int wave) {
#pragma unroll
    for (int off = 8; off < 64; off <<= 1) {
#pragma unroll
        for (int i = 0; i < 8; ++i) { const float y = __shfl_up(x[i], off); if (lane >= off) x[i] += y; } }
    if (lane >= 56) {
#pragma unroll
        for (int i = 0; i < 8; ++i) wt[wave * 64 + (lane & 7) * 8 + i] = x[i]; }
    __syncthreads();
#pragma unroll
    for (int i = 0; i < 8; ++i) { float pre = 0.f, t = 0.f;
#pragma unroll
        for (int w = 0; w < 8; ++w) { const float v = wt[w * 64 + (lane & 7) * 8 + i]; t += v; if (w < wave) pre += v; }
        x[i] += pre; tot[i] = t; }
}
constexpr int CST = 144;

__device__ __forceinline__ void ph_B_hgrn_local_fast(const Ctx& c, int l) {
    LAS unsigned char* KH = c.lds3; LAS unsigned char* VV = KH + 64 * CST; LAS float* wt = (LAS float*)(VV + 64 * CST);
    const bf16_t* P = WSP(bf16_t, WS_PACT);
    const int tid = c.tid, lane = c.lane, wave = c.wave, t = tid >> 3, c0 = (tid & 7) * 8;
    for (int u = c.bid; u < NUNIT; u += c.G) {
        const int bh = u >> 6, ch = u & 63, b = bh >> 2, h = bh & 3; const size_t m = (size_t)b * SEQ + ch * 64 + t;
        const u32x4 zr = *(const u32x4*)(P + m * PW + PC_HGF + h * 64 + c0), vr = *(const u32x4*)(P + m * PW + PC_HGI + h * 64 + c0);
        float z[8], lf[8], kk[8], tot[8]; unpack8(zr, z);
#pragma unroll
        for (int i = 0; i < 8; ++i) hg_gate(z[i], hg_lb(c, l, h * 64 + c0 + i), lf[i], kk[i]);
        scan_t8(lf, tot, wt, lane, wave);
#pragma unroll
        for (int i = 0; i < 8; ++i) kk[i] *= __expf(tot[i] - lf[i]);
        *(LAS u32x4*)(KH + t * CST + c0 * 2) = pack8(kk); *(LAS u32x4*)(VV + t * CST + c0 * 2) = vr;
        if (t == 63) {
#pragma unroll
            for (int i = 0; i < 8; ++i) WSP(float, WS_HDEC)[(size_t)u * 64 + c0 + i] = __expf(tot[i]); }
        __syncthreads();
        { const int a = wave >> 1;
#pragma unroll
          for (int j = 0; j < 2; ++j) { const int bt = 2 * (wave & 1) + j; f32x4_t acc = {0.f, 0.f, 0.f, 0.f};
#pragma unroll
              for (int ks = 0; ks < 2; ++ks) acc = MFMA16(frag_tr(KH, CST, 32 * ks, 16 * a, lane), frag_tr(VV, CST, 32 * ks, 16 * bt, lane), acc);
              *(f32x4_t*)(WSP(float, WS_HSLOC) + ((size_t)u * 64 + 16 * bt + (lane & 15)) * 64 + 16 * a + 4 * (lane >> 4)) = acc; } }
        __syncthreads();
    }
}

__device__ __forceinline__ void ph_D_hgrn_out_fast(const Ctx& c, int l) {
    LAS unsigned char* QA = c.lds3; LAS unsigned char* QB = QA + 32 * CST; LAS unsigned char* QC = QB + 32 * CST; LAS unsigned char* KA = QC + 32 * CST; LAS unsigned char* KB_ = KA + 32 * CST; LAS unsigned char* KC = KB_ + 32 * CST;
    LAS unsigned char* QH = KC + 32 * CST; LAS unsigned char* VV = QH + 64 * CST; LAS unsigned char* SP = VV + 64 * CST; LAS unsigned char* SC = SP + 64 * CST;
    LAS float* refs = (LAS float*)(SC + 64 * CST); LAS float* wt = refs + 4 * 64; LAS float* ssb = wt + 8 * 64;
    const bf16_t* P = WSP(bf16_t, WS_PACT); const bf16_t* SPG = WSP(bf16_t, WS_HSPREV); bf16_t* Y = WSP(bf16_t, WS_XNY);
    const int tid = c.tid, lane = c.lane, wave = c.wave, t = tid >> 3, c0 = (tid & 7) * 8;
    for (int u = c.bid; u < NUNIT; u += c.G) {
        const int bh = u >> 6, ch = u & 63, b = bh >> 2, h = bh & 3; const size_t m0 = (size_t)b * SEQ + ch * 64, m = m0 + t;
        const u32x4 zr = *(const u32x4*)(P + m * PW + PC_HGF + h * 64 + c0), vr = *(const u32x4*)(P + m * PW + PC_HGI + h * 64 + c0), qr = *(const u32x4*)(P + m * PW + PC_HGQ + h * 64 + c0);
        const u32x4 sr = *(const u32x4*)(SPG + ((size_t)u * 64 + t) * 64 + c0);
        float z[8], q[8], bc[8], kk[8], tot[8]; unpack8(zr, z); unpack8(qr, q);
#pragma unroll
        for (int i = 0; i < 8; ++i) hg_gate(z[i], hg_lb(c, l, h * 64 + c0 + i), bc[i], kk[i]);
        scan_t8(bc, tot, wt, lane, wave);
        if ((t & 15) == 15 && t < 63) {
#pragma unroll
            for (int i = 0; i < 8; ++i) refs[(t >> 4) * 64 + c0 + i] = bc[i]; }
        *(LAS u32x4*)(VV + t * CST + c0 * 2) = vr; *(LAS u32x4*)(SP + t * CST + c0 * 2) = sr;
        __syncthreads();
        { float o1[8], o2[8], o3[8], o4[8];
          if (t < 32) {
#pragma unroll
              for (int i = 0; i < 8; ++i) { const float r15 = refs[c0 + i], r31 = refs[64 + c0 + i]; o1[i] = q[i] * __expf(bc[i] - r15); o2[i] = kk[i] * __expf(r15 - bc[i]); o3[i] = kk[i] * __expf(r31 - bc[i]); }
              *(LAS u32x4*)(QA + t * CST + c0 * 2) = pack8(o1); *(LAS u32x4*)(KA + t * CST + c0 * 2) = pack8(o2); *(LAS u32x4*)(KB_ + t * CST + c0 * 2) = pack8(o3);
          } else { const int tt = t - 32;
#pragma unroll
              for (int i = 0; i < 8; ++i) { const float r31 = refs[64 + c0 + i], r47 = refs[128 + c0 + i]; o1[i] = q[i] * __expf(bc[i] - r31); o2[i] = q[i] * __expf(bc[i] - r47); o3[i] = kk[i] * __expf(r47 - bc[i]); }
              *(LAS u32x4*)(QB + tt * CST + c0 * 2) = pack8(o1); *(LAS u32x4*)(QC + tt * CST + c0 * 2) = pack8(o2); *(LAS u32x4*)(KC + tt * CST + c0 * 2) = pack8(o3); }
#pragma unroll
          for (int i = 0; i < 8; ++i) o4[i] = q[i] * __expf(bc[i]);
          *(LAS u32x4*)(QH + t * CST + c0 * 2) = pack8(o4); }
        __syncthreads();
#pragma unroll
        for (int e2 = 0; e2 < 2; ++e2) { const int e = wave + 8 * e2, ti = e >> 2, si = e & 3; f32x4_t acc = {0.f, 0.f, 0.f, 0.f};
            if (si <= ti) { LAS const unsigned char* Qp = (ti < 2) ? QA : ((si < 2) ? QB : QC); LAS const unsigned char* Kp = (ti < 2) ? KA : ((si < 2) ? KB_ : KC);
                const int qr0 = 16 * (ti & 1), kr0 = 16 * (si & 1);
#pragma unroll
                for (int ks = 0; ks < 2; ++ks) acc = MFMA16(frag_row(Kp, CST, kr0, 32 * ks, lane), frag_row(Qp, CST, qr0, 32 * ks, lane), acc);
                if (si == ti) {
#pragma unroll
                    for (int i = 0; i < 4; ++i) if (4 * (lane >> 4) + i > (lane & 15)) acc[i] = 0.f; } }
            u32x2 w; w.x = cvtpk(acc[0], acc[1]); w.y = cvtpk(acc[2], acc[3]);
            *(LAS u32x2*)(SC + (16 * ti + (lane & 15)) * CST + (16 * si + 4 * (lane >> 4)) * 2) = w; }
        __syncthreads();
        { const int ts = wave >> 1; f32x4_t acc[2]; float ss = 0.f;
#pragma unroll
          for (int j = 0; j < 2; ++j) { const int vt = 2 * (wave & 1) + j; acc[j] = (f32x4_t){0.f, 0.f, 0.f, 0.f};
              acc[j] = MFMA16(frag_tr(VV, CST, 0, 16 * vt, lane), frag_row(SC, CST, 16 * ts, 0, lane), acc[j]);
              if (ts >= 2) acc[j] = MFMA16(frag_tr(VV, CST, 32, 16 * vt, lane), frag_row(SC, CST, 16 * ts, 32, lane), acc[j]);
#pragma unroll
              for (int ks = 0; ks < 2; ++ks) acc[j] = MFMA16(frag_row(SP, CST, 16 * vt, 32 * ks, lane), frag_row(QH, CST, 16 * ts, 32 * ks, lane), acc[j]);
#pragma unroll
              for (int i = 0; i < 4; ++i) ss += acc[j][i] * acc[j][i]; }
          ss += __shfl_xor(ss, 16); ss += __shfl_xor(ss, 32);
          if (lane < 16) ssb[(16 * ts + lane) * 2 + (wave & 1)] = ss;
          __syncthreads();
          const int tl = 16 * ts + (lane & 15); const float rstd = rsqrtf((ssb[tl * 2] + ssb[tl * 2 + 1]) * (1.f / 64.f) + EPS);
#pragma unroll
          for (int j = 0; j < 2; ++j) { const int vd = 16 * (2 * (wave & 1) + j) + 4 * (lane >> 4);
              const u32x2 gr = *(const u32x2*)(P + (m0 + tl) * PW + PC_HGG + h * 64 + vd);
              const float g0 = bf2f(gr.x & 0xffffu), g1 = bf2f(gr.x >> 16), g2 = bf2f(gr.y & 0xffffu), g3 = bf2f(gr.y >> 16);
              u32x2 w; w.x = cvtpk(acc[j][0] * rstd * siluf_(g0), acc[j][1] * rstd * siluf_(g1)); w.y = cvtpk(acc[j][2] * rstd * siluf_(g2), acc[j][3] * rstd * siluf_(g3));
              *(u32x2*)(Y + (m0 + tl) * DM + 256 + h * 64 + vd) = w; } }
        __syncthreads();
    }
}


constexpr int VST80 = 176;
__device__ __forceinline__ void ml_gates(const Ctx& c, LAS float* bb, LAS float* igs, size_t m0, int h) {
    if (c.tid < 64) { const float* GT = WSP(float, WS_GT); float x = log_sigmoidf_(GT[(m0 + c.tid) * 16 + 8 + h]);
#pragma unroll
        for (int off = 1; off < 64; off <<= 1) { const float y = __shfl_up(x, off); if (c.lane >= off) x += y; }
        bb[c.tid] = x; igs[c.tid] = GT[(m0 + c.tid) * 16 + 4 + h]; }
}
__device__ __forceinline__ void ph_B_mlstm_local_fast(const Ctx& c, int l) {
    LAS unsigned char* KH = c.lds3; LAS unsigned char* VV = KH + 64 * CST; LAS float* bb = (LAS float*)(VV + 64 * VST80); LAS float* igs = bb + 64;
    const bf16_t* P = WSP(bf16_t, WS_PACT);
    const int tid = c.tid, lane = c.lane, wave = c.wave, t = tid >> 3, c0 = (tid & 7) * 8;
    for (int u = c.bid; u < NUNIT; u += c.G) {
        const int bh = u >> 6, ch = u & 63, b = bh >> 2, h = bh & 3; const size_t m0 = (size_t)b * SEQ + ch * 64, m = m0 + t;
        ml_gates(c, bb, igs, m0, h);
        const u32x4 vr = *(const u32x4*)(P + m * PW + PC_MLV + h * 64 + c0);
        float k[8]; ml_conv8(c, l, P, m, ch * 64 + t, PC_MLK + h * 64 + c0, 256 + h * 64 + c0, k);
        __syncthreads();
        { const float w = 0.125f * __expf(bb[63] - bb[t] + igs[t]);
#pragma unroll
          for (int i = 0; i < 8; ++i) k[i] *= w; }
        *(LAS u32x4*)(KH + t * CST + c0 * 2) = pack8(k); *(LAS u32x4*)(VV + t * VST80 + c0 * 2) = vr;
        if ((tid & 7) < 2) *(LAS u32x4*)(VV + t * VST80 + 128 + (tid & 7) * 16) = (u32x4){(tid & 7) == 0 ? 0x3f80u : 0u, 0u, 0u, 0u};
        if (tid == 0) WSP(float, WS_MDEC)[u] = __expf(bb[63]);
        __syncthreads();
#pragma unroll
        for (int j = 0; j < 3; ++j) { const int e = wave + 8 * j; if (e < 20) { const int a = e & 3, bt = e >> 2; f32x4_t acc = {0.f, 0.f, 0.f, 0.f};
#pragma unroll
            for (int ks = 0; ks < 2; ++ks) acc = MFMA16(frag_tr(KH, CST, 32 * ks, 16 * a, lane), frag_tr(VV, VST80, 32 * ks, 16 * bt, lane), acc);
            const int vd = 16 * bt + (lane & 15);
            if (vd < 65) *(f32x4_t*)(WSP(float, WS_MSLOC) + ((size_t)u * 65 + vd) * 64 + 16 * a + 4 * (lane >> 4)) = acc; } }
        __syncthreads();
    }
}
__device__ __forceinline__ void ph_D_mlstm_out_fast(const Ctx& c, int l) {
    LAS unsigned char* QT = c.lds3; LAS unsigned char* KT = QT + 64 * CST; LAS unsigned char* VV = KT + 64 * CST; LAS unsigned char* CP = VV + 64 * VST80; LAS unsigned char* SC = CP + 80 * CST;
    LAS float* bb = (LAS float*)(SC + 64 * CST); LAS float* igs = bb + 64; LAS float* den = igs + 64; LAS float* ssb = den + 64;
    const bf16_t* P = WSP(bf16_t, WS_PACT); const bf16_t* SPG = WSP(bf16_t, WS_MSPREV); bf16_t* Y = WSP(bf16_t, WS_XNY);
    const int tid = c.tid, lane = c.lane, wave = c.wave, t = tid >> 3, c0 = (tid & 7) * 8;
    for (int u = c.bid; u < NUNIT; u += c.G) {
        const int bh = u >> 6, ch = u & 63, b = bh >> 2, h = bh & 3; const size_t m0 = (size_t)b * SEQ + ch * 64, m = m0 + t;
        ml_gates(c, bb, igs, m0, h);
        const u32x4 vr = *(const u32x4*)(P + m * PW + PC_MLV + h * 64 + c0);
        const u32x4 cr = *(const u32x4*)(SPG + (size_t)u * 80 * 64 + tid * 8);
        u32x4 cr2 = (u32x4){0u, 0u, 0u, 0u}; if (tid < 128) cr2 = *(const u32x4*)(SPG + (size_t)u * 80 * 64 + (512 + tid) * 8);
        float q[8], k[8]; ml_conv8(c, l, P, m, ch * 64 + t, PC_MLQ + h * 64 + c0, h * 64 + c0, q); ml_conv8(c, l, P, m, ch * 64 + t, PC_MLK + h * 64 + c0, 256 + h * 64 + c0, k);
        __syncthreads();
        { const float eq = __expf(bb[t]), ek = 0.125f * __expf(igs[t] - bb[t]);
#pragma unroll
          for (int i = 0; i < 8; ++i) { q[i] *= eq; k[i] *= ek; } }
        *(LAS u32x4*)(QT + t * CST + c0 * 2) = pack8(q); *(LAS u32x4*)(KT + t * CST + c0 * 2) = pack8(k); *(LAS u32x4*)(VV + t * VST80 + c0 * 2) = vr;
        if ((tid & 7) < 2) *(LAS u32x4*)(VV + t * VST80 + 128 + (tid & 7) * 16) = (u32x4){(tid & 7) == 0 ? 0x3f80u : 0u, 0u, 0u, 0u};
        *(LAS u32x4*)(CP + (tid >> 3) * CST + (tid & 7) * 16) = cr; if (tid < 128) *(LAS u32x4*)(CP + (64 + (tid >> 3)) * CST + (tid & 7) * 16) = cr2;
        __syncthreads();
#pragma unroll
        for (int e2 = 0; e2 < 2; ++e2) { const int e = wave + 8 * e2, ti = e >> 2, si = e & 3; f32x4_t acc = {0.f, 0.f, 0.f, 0.f};
            if (si <= ti) {
#pragma unroll
                for (int ks = 0; ks < 2; ++ks) acc = MFMA16(frag_row(KT, CST, 16 * si, 32 * ks, lane), frag_row(QT, CST, 16 * ti, 32 * ks, lane), acc);
                if (si == ti) {
#pragma unroll
                    for (int i = 0; i < 4; ++i) if (4 * (lane >> 4) + i > (lane & 15)) acc[i] = 0.f; } }
            u32x2 w; w.x = cvtpk(acc[0], acc[1]); w.y = cvtpk(acc[2], acc[3]);
            *(LAS u32x2*)(SC + (16 * ti + (lane & 15)) * CST + (16 * si + 4 * (lane >> 4)) * 2) = w; }
        __syncthreads();
        { const int ts = wave >> 1, hf = wave & 1; f32x4_t acc[3];
#pragma unroll
          for (int j = 0; j < 3; ++j) { acc[j] = (f32x4_t){0.f, 0.f, 0.f, 0.f}; if (j < 2 || hf == 0) { const int vt = (j == 2) ? 4 : 2 * hf + j;
              acc[j] = MFMA16(frag_tr(VV, VST80, 0, 16 * vt, lane), frag_row(SC, CST, 16 * ts, 0, lane), acc[j]);
              if (ts >= 2) acc[j] = MFMA16(frag_tr(VV, VST80, 32, 16 * vt, lane), frag_row(SC, CST, 16 * ts, 32, lane), acc[j]);
#pragma unroll
              for (int ks = 0; ks < 2; ++ks) acc[j] = MFMA16(frag_row(CP, CST, 16 * vt, 32 * ks, lane), frag_row(QT, CST, 16 * ts, 32 * ks, lane), acc[j]); } }
          if (hf == 0 && lane < 16) den[16 * ts + lane] = acc[2][0];
          __syncthreads();
          const int tl = 16 * ts + (lane & 15); const float inv = 1.f / fmaxf(fabsf(den[tl]), 1.f); float ss = 0.f;
#pragma unroll
          for (int j = 0; j < 2; ++j)
#pragma unroll
              for (int i = 0; i < 4; ++i) { acc[j][i] *= inv; ss += acc[j][i] * acc[j][i]; }
          ss += __shfl_xor(ss, 16); ss += __shfl_xor(ss, 32);
          if (lane < 16) ssb[(16 * ts + lane) * 2 + hf] = ss;
          __syncthreads();
          const float rstd = rsqrtf((ssb[tl * 2] + ssb[tl * 2 + 1]) * (1.f / 64.f) + EPS);
#pragma unroll
          for (int j = 0; j < 2; ++j) { const int vd = 16 * (2 * hf + j) + 4 * (lane >> 4);
              const u32x2 gr = *(const u32x2*)(P + (m0 + tl) * PW + PC_MLO + h * 64 + vd);
              const float g0 = bf2f(gr.x & 0xffffu), g1 = bf2f(gr.x >> 16), g2 = bf2f(gr.y & 0xffffu), g3 = bf2f(gr.y >> 16);
              u32x2 w; w.x = cvtpk(acc[j][0] * rstd * sigmoidf_(g0), acc[j][1] * rstd * sigmoidf_(g1)); w.y = cvtpk(acc[j][2] * rstd * sigmoidf_(g2), acc[j][3] * rstd * sigmoidf_(g3));
              *(u32x2*)(Y + (m0 + tl) * DM + 768 + h * 64 + vd) = w; } }
        __syncthreads();
    }
}


constexpr int TAB_OFF = 100 * 1024;
__device__ __forceinline__ void range_split(int w, int G, int N, int ns, int extra, int& lo, int& hi) {
    if (ns >= G) { const int q = N / G, r = N % G; lo = w * q + (w < r ? w : r); hi = lo + q + (w < r ? 1 : 0); return; }
    const int T = (N + ns * extra + G - 1) / G; int cs = T - extra; if (cs < 0) cs = 0;
    if (w < ns) { lo = w * cs; hi = lo + cs; return; }
    const int rest = N - ns * cs, no = G - ns, k = w - ns, q = rest / no, r = rest % no; lo = ns * cs + k * q + (k < r ? k : r); hi = lo + q + (k < r ? 1 : 0);
}
__device__ __forceinline__ void stage_tables(const Ctx& c, int l) {
    LAS float* lbv = (LAS float*)(c.lds3 + TAB_OFF); LAS float* cwt = lbv + 256;
    if (c.tid < 256) lbv[c.tid] = hg_lb(c, l, c.tid);
    for (int i = c.tid; i < 2048; i += NTHR) cwt[i] = c.in[I_CONV][(size_t)l * 2048 + i];
    __syncthreads();
}
__device__ __forceinline__ void hg_gate_fast(float z, float lb, float& logf, float& kk) {
    z = fmaxf(z, -80.f); const float e = __expf(-z), s = __builtin_amdgcn_rcpf(1.f + e), oml = 1.f - lb;
    logf = __logf(lb + oml * s); kk = oml * e * s;
}
__device__ __forceinline__ void hgrn_local_units(const Ctx& c, int lo, int hi) {
    LAS unsigned char* KH = c.lds3; LAS unsigned char* VV = KH + 64 * CST; LAS float* wt = (LAS float*)(VV + 64 * CST); LAS const float* lbv = (LAS const float*)(c.lds3 + TAB_OFF);
    const bf16_t* P = WSP(bf16_t, WS_PACT);
    const int tid = c.tid, lane = c.lane, wave = c.wave, t = tid >> 3, c0 = (tid & 7) * 8;
    u32x4 zr = {}, vr = {};
#define HL_LOAD(u_) do { const int bh_ = (u_) >> 6, ch_ = (u_) & 63; const size_t m_ = (size_t)(bh_ >> 2) * SEQ + ch_ * 64 + t; const bf16_t* p_ = P + m_ * PW + (bh_ & 3) * 64 + c0; zr = *(const u32x4*)(p_ + PC_HGF); vr = *(const u32x4*)(p_ + PC_HGI); } while (0)
    if (lo < hi) HL_LOAD(lo);
    for (int u = lo; u < hi; ++u) {
        const int h = (u >> 6) & 3;
        float z[8], lf[8], kk[8], tot[8]; unpack8(zr, z); const u32x4 vcur = vr;
        if (u + 1 < hi) HL_LOAD(u + 1);
#pragma unroll
        for (int i = 0; i < 8; ++i) hg_gate_fast(z[i], lbv[h * 64 + c0 + i], lf[i], kk[i]);
        scan_t8(lf, tot, wt, lane, wave);
#pragma unroll
        for (int i = 0; i < 8; ++i) kk[i] *= __expf(tot[i] - lf[i]);
        *(LAS u32x4*)(KH + t * CST + c0 * 2) = pack8(kk); *(LAS u32x4*)(VV + t * CST + c0 * 2) = vcur;
        if (t == 63) {
#pragma unroll
            for (int i = 0; i < 8; ++i) WSP(float, WS_HDEC)[(size_t)u * 64 + c0 + i] = __expf(tot[i]); }
        __syncthreads();
        { const int a = wave >> 1;
#pragma unroll
          for (int j = 0; j < 2; ++j) { const int bt = 2 * (wave & 1) + j; f32x4_t acc = {0.f, 0.f, 0.f, 0.f};
#pragma unroll
              for (int ks = 0; ks < 2; ++ks) acc = MFMA16(frag_tr(KH, CST, 32 * ks, 16 * a, lane), frag_tr(VV, CST, 32 * ks, 16 * bt, lane), acc);
              *(f32x4_t*)(WSP(float, WS_HSLOC) + ((size_t)u * 64 + 16 * bt + (lane & 15)) * 64 + 16 * a + 4 * (lane >> 4)) = acc; } }
        __syncthreads();
    }
#undef HL_LOAD
}
__device__ __forceinline__ void hgrn_out_units(const Ctx& c, int lo, int hi) {
    LAS unsigned char* QA = c.lds3; LAS unsigned char* QB = QA + 32 * CST; LAS unsigned char* QC = QB + 32 * CST; LAS unsigned char* KA = QC + 32 * CST; LAS unsigned char* KB_ = KA + 32 * CST; LAS unsigned char* KC = KB_ + 32 * CST;
    LAS unsigned char* QH = KC + 32 * CST; LAS unsigned char* VV = QH + 64 * CST; LAS unsigned char* SP = VV + 64 * CST; LAS unsigned char* SC = SP + 64 * CST;
    LAS float* refs = (LAS float*)(SC + 64 * CST); LAS float* wt = refs + 4 * 64; LAS float* ssb = wt + 8 * 64; LAS const float* lbv = (LAS const float*)(c.lds3 + TAB_OFF);
    const bf16_t* P = WSP(bf16_t, WS_PACT); const bf16_t* SPG = WSP(bf16_t, WS_HSPREV); bf16_t* Y = WSP(bf16_t, WS_XNY);
    const int tid = c.tid, lane = c.lane, wave = c.wave, t = tid >> 3, c0 = (tid & 7) * 8;
    u32x4 zr = {}, vr = {}, qr = {}, sr = {};
#define HO_LOAD(u_) do { const int bh_ = (u_) >> 6, ch_ = (u_) & 63; const size_t m_ = (size_t)(bh_ >> 2) * SEQ + ch_ * 64 + t; const bf16_t* p_ = P + m_ * PW + (bh_ & 3) * 64 + c0; \
        zr = *(const u32x4*)(p_ + PC_HGF); vr = *(const u32x4*)(p_ + PC_HGI); qr = *(const u32x4*)(p_ + PC_HGQ); sr = *(const u32x4*)(SPG + ((size_t)(u_) * 64 + t) * 64 + c0); } while (0)
    if (lo < hi) HO_LOAD(lo);
    for (int u = lo; u < hi; ++u) {
        const int bh = u >> 6, ch = u & 63, b = bh >> 2, h = bh & 3; const size_t m0 = (size_t)b * SEQ + ch * 64;
        float z[8], q[8], bc[8], kk[8], tot[8]; unpack8(zr, z); unpack8(qr, q);
        *(LAS u32x4*)(VV + t * CST + c0 * 2) = vr; *(LAS u32x4*)(SP + t * CST + c0 * 2) = sr;
        if (u + 1 < hi) HO_LOAD(u + 1);
#pragma unroll
        for (int i = 0; i < 8; ++i) hg_gate_fast(z[i], lbv[h * 64 + c0 + i], bc[i], kk[i]);
        scan_t8(bc, tot, wt, lane, wave);
        if ((t & 15) == 15 && t < 63) {
#pragma unroll
            for (int i = 0; i < 8; ++i) refs[(t >> 4) * 64 + c0 + i] = bc[i]; }
        __syncthreads();
        { float o1[8], o2[8], o3[8], o4[8];
          if (t < 32) {
#pragma unroll
              for (int i = 0; i < 8; ++i) { const float r15 = refs[c0 + i], r31 = refs[64 + c0 + i]; const float ea = __expf(bc[i] - r15); o1[i] = q[i] * ea; o2[i] = kk[i] * __builtin_amdgcn_rcpf(ea); o3[i] = kk[i] * __expf(r31 - bc[i]); }
              *(LAS u32x4*)(QA + t * CST + c0 * 2) = pack8(o1); *(LAS u32x4*)(KA + t * CST + c0 * 2) = pack8(o2); *(LAS u32x4*)(KB_ + t * CST + c0 * 2) = pack8(o3);
          } else { const int tt = t - 32;
#pragma unroll
              for (int i = 0; i < 8; ++i) { const float r31 = refs[64 + c0 + i], r47 = refs[128 + c0 + i]; const float ec = __expf(bc[i] - r47); o1[i] = q[i] * __expf(bc[i] - r31); o2[i] = q[i] * ec; o3[i] = kk[i] * __builtin_amdgcn_rcpf(ec); }
              *(LAS u32x4*)(QB + tt * CST + c0 * 2) = pack8(o1); *(LAS u32x4*)(QC + tt * CST + c0 * 2) = pack8(o2); *(LAS u32x4*)(KC + tt * CST + c0 * 2) = pack8(o3); }
#pragma unroll
          for (int i = 0; i < 8; ++i) o4[i] = q[i] * __expf(bc[i]);
          *(LAS u32x4*)(QH + t * CST + c0 * 2) = pack8(o4); }
        __syncthreads();
#pragma unroll
        for (int e2 = 0; e2 < 2; ++e2) { const int e = wave + 8 * e2, ti = e >> 2, si = e & 3; f32x4_t acc = {0.f, 0.f, 0.f, 0.f};
            if (si <= ti) { LAS const unsigned char* Qp = (ti < 2) ? QA : ((si < 2) ? QB : QC); LAS const unsigned char* Kp = (ti < 2) ? KA : ((si < 2) ? KB_ : KC);
                const int qr0 = 16 * (ti & 1), kr0 = 16 * (si & 1);
#pragma unroll
                for (int ks = 0; ks < 2; ++ks) acc = MFMA16(frag_row(Kp, CST, kr0, 32 * ks, lane), frag_row(Qp, CST, qr0, 32 * ks, lane), acc);
                if (si == ti) {
#pragma unroll
                    for (int i = 0; i < 4; ++i) if (4 * (lane >> 4) + i > (lane & 15)) acc[i] = 0.f; } }
            u32x2 w; w.x = cvtpk(acc[0], acc[1]); w.y = cvtpk(acc[2], acc[3]);
            *(LAS u32x2*)(SC + (16 * ti + (lane & 15)) * CST + (16 * si + 4 * (lane >> 4)) * 2) = w; }
        __syncthreads();
        { const int ts = wave >> 1; f32x4_t acc[2]; float ss = 0.f; const int tl = 16 * ts + (lane & 15);
          u32x2 gr[2];
#pragma unroll
          for (int j = 0; j < 2; ++j) gr[j] = *(const u32x2*)(P + (m0 + tl) * PW + PC_HGG + h * 64 + 16 * (2 * (wave & 1) + j) + 4 * (lane >> 4));
#pragma unroll
          for (int j = 0; j < 2; ++j) { const int vt = 2 * (wave & 1) + j; acc[j] = (f32x4_t){0.f, 0.f, 0.f, 0.f};
              acc[j] = MFMA16(frag_tr(VV, CST, 0, 16 * vt, lane), frag_row(SC, CST, 16 * ts, 0, lane), acc[j]);
              if (ts >= 2) acc[j] = MFMA16(frag_tr(VV, CST, 32, 16 * vt, lane), frag_row(SC, CST, 16 * ts, 32, lane), acc[j]);
#pragma unroll
              for (int ks = 0; ks < 2; ++ks) acc[j] = MFMA16(frag_row(SP, CST, 16 * vt, 32 * ks, lane), frag_row(QH, CST, 16 * ts, 32 * ks, lane), acc[j]);
#pragma unroll
              for (int i = 0; i < 4; ++i) ss += acc[j][i] * acc[j][i]; }
          ss += __shfl_xor(ss, 16); ss += __shfl_xor(ss, 32);
          if (lane < 16) ssb[(16 * ts + lane) * 2 + (wave & 1)] = ss;
          __syncthreads();
          const float rstd = rsqrtf((ssb[tl * 2] + ssb[tl * 2 + 1]) * (1.f / 64.f) + EPS);
#pragma unroll
          for (int j = 0; j < 2; ++j) { const int vd = 16 * (2 * (wave & 1) + j) + 4 * (lane >> 4);
              const float g0 = bf2f(gr[j].x & 0xffffu), g1 = bf2f(gr[j].x >> 16), g2 = bf2f(gr[j].y & 0xffffu), g3 = bf2f(gr[j].y >> 16);
              u32x2 w; w.x = cvtpk(acc[j][0] * rstd * siluf_(g0), acc[j][1] * rstd * siluf_(g1)); w.y = cvtpk(acc[j][2] * rstd * siluf_(g2), acc[j][3] * rstd * siluf_(g3));
              *(u32x2*)(Y + (m0 + tl) * DM + 256 + h * 64 + vd) = w; } }
        __syncthreads();
    }
#undef HO_LOAD
}
__device__ __forceinline__ void conv8_regs(const u32x4 (&rows)[4], int spos, LAS const float* cw, float (&o)[8]) {
#pragma unroll
    for (int i = 0; i < 8; ++i) o[i] = 0.f;
#pragma unroll
    for (int j = 0; j < 4; ++j) if (spos - (3 - j) >= 0) { float x[8]; unpack8(rows[j], x);
#pragma unroll
        for (int i = 0; i < 8; ++i) o[i] += cw[j * 512 + i] * x[i]; }
#pragma unroll
    for (int i = 0; i < 8; ++i) o[i] = siluf_(o[i]);
}
__device__ __forceinline__ void ml_gates_regs(const Ctx& c, LAS float* bb, LAS float* igs, float gf, float gi) {
    if (c.tid < 64) { float x = log_sigmoidf_(gf);
#pragma unroll
        for (int off = 1; off < 64; off <<= 1) { const float y = __shfl_up(x, off); if (c.lane >= off) x += y; }
        bb[c.tid] = x; igs[c.tid] = gi; }
}
__device__ __forceinline__ void mlstm_local_units(const Ctx& c, int lo, int hi) {
    LAS unsigned char* KH = c.lds3; LAS unsigned char* VV = KH + 64 * CST; LAS float* bb = (LAS float*)(VV + 64 * VST80); LAS float* igs = bb + 64; LAS const float* cwt = (LAS const float*)(c.lds3 + TAB_OFF) + 256;
    const bf16_t* P = WSP(bf16_t, WS_PACT); const float* GT = WSP(float, WS_GT);
    const int tid = c.tid, lane = c.lane, wave = c.wave, t = tid >> 3, c0 = (tid & 7) * 8;
    u32x4 vr = {}, kr[4] = {}; float gf = 0.f, gi = 0.f;
#define ML_LOAD(u_) do { const int bh_ = (u_) >> 6, ch_ = (u_) & 63, sp_ = ch_ * 64 + t; const size_t mb_ = (size_t)(bh_ >> 2) * SEQ + ch_ * 64, m_ = mb_ + t; const bf16_t* p_ = P + m_ * PW + (bh_ & 3) * 64 + c0; \
        vr = *(const u32x4*)(p_ + PC_MLV); _Pragma("unroll") for (int j_ = 0; j_ < 4; ++j_) if (sp_ - (3 - j_) >= 0) kr[j_] = *(const u32x4*)(p_ + PC_MLK - (size_t)(3 - j_) * PW); \
        if (tid < 64) { gf = GT[(mb_ + tid) * 16 + 8 + (bh_ & 3)]; gi = GT[(mb_ + tid) * 16 + 4 + (bh_ & 3)]; } } while (0)
    if (lo < hi) ML_LOAD(lo);
    for (int u = lo; u < hi; ++u) {
        const int ch = u & 63, h = (u >> 6) & 3;
        ml_gates_regs(c, bb, igs, gf, gi);
        float k[8]; conv8_regs(kr, ch * 64 + t, cwt + 256 + h * 64 + c0, k); const u32x4 vcur = vr;
        if (u + 1 < hi) ML_LOAD(u + 1);
        __syncthreads();
        { const float w = 0.125f * __expf(bb[63] - bb[t] + igs[t]);
#pragma unroll
          for (int i = 0; i < 8; ++i) k[i] *= w; }
        *(LAS u32x4*)(KH + t * CST + c0 * 2) = pack8(k); *(LAS u32x4*)(VV + t * VST80 + c0 * 2) = vcur;
        if ((tid & 7) < 2) *(LAS u32x4*)(VV + t * VST80 + 128 + (tid & 7) * 16) = (u32x4){(tid & 7) == 0 ? 0x3f80u : 0u, 0u, 0u, 0u};
        if (tid == 0) WSP(float, WS_MDEC)[u] = __expf(bb[63]);
        __syncthreads();
#pragma unroll
        for (int j = 0; j < 3; ++j) { const int e = wave + 8 * j; if (e < 20) { const int a = e & 3, bt = e >> 2; f32x4_t acc = {0.f, 0.f, 0.f, 0.f};
#pragma unroll
            for (int ks = 0; ks < 2; ++ks) acc = MFMA16(frag_tr(KH, CST, 32 * ks, 16 * a, lane), frag_tr(VV, VST80, 32 * ks, 16 * bt, lane), acc);
            const int vd = 16 * bt + (lane & 15);
            if (vd < 65) *(f32x4_t*)(WSP(float, WS_MSLOC) + ((size_t)u * 65 + vd) * 64 + 16 * a + 4 * (lane >> 4)) = acc; } }
        __syncthreads();
    }
#undef ML_LOAD
}
__device__ __forceinline__ void mlstm_out_units(const Ctx& c, int lo, int hi) {
    LAS unsigned char* QT = c.lds3; LAS unsigned char* KT = QT + 64 * CST; LAS unsigned char* VV = KT + 64 * CST; LAS unsigned char* CP = VV + 64 * VST80; LAS unsigned char* SC = CP + 80 * CST;
    LAS float* bb = (LAS float*)(SC + 64 * CST); LAS float* igs = bb + 64; LAS float* den = igs + 64; LAS float* ssb = den + 64; LAS const float* cwt = (LAS const float*)(c.lds3 + TAB_OFF) + 256;
    const bf16_t* P = WSP(bf16_t, WS_PACT); const bf16_t* SPG = WSP(bf16_t, WS_MSPREV); const float* GT = WSP(float, WS_GT); bf16_t* Y = WSP(bf16_t, WS_XNY);
    const int tid = c.tid, lane = c.lane, wave = c.wave, t = tid >> 3, c0 = (tid & 7) * 8;
    u32x4 vr = {}, cr = {}, cr2 = {}, qrw[4] = {}, kr[4] = {}; float gf = 0.f, gi = 0.f;
#define MO_LOAD(u_) do { const int bh_ = (u_) >> 6, ch_ = (u_) & 63, sp_ = ch_ * 64 + t; const size_t mb_ = (size_t)(bh_ >> 2) * SEQ + ch_ * 64, m_ = mb_ + t; const bf16_t* p_ = P + m_ * PW + (bh_ & 3) * 64 + c0; \
        vr = *(const u32x4*)(p_ + PC_MLV); cr = *(const u32x4*)(SPG + (size_t)(u_) * 80 * 64 + tid * 8); if (tid < 128) cr2 = *(const u32x4*)(SPG + (size_t)(u_) * 80 * 64 + (512 + tid) * 8); \
        _Pragma("unroll") for (int j_ = 0; j_ < 4; ++j_) if (sp_ - (3 - j_) >= 0) { kr[j_] = *(const u32x4*)(p_ + PC_MLK - (size_t)(3 - j_) * PW); qrw[j_] = *(const u32x4*)(p_ + PC_MLQ - (size_t)(3 - j_) * PW); } \
        if (tid < 64) { gf = GT[(mb_ + tid) * 16 + 8 + (bh_ & 3)]; gi = GT[(mb_ + tid) * 16 + 4 + (bh_ & 3)]; } } while (0)
    if (lo < hi) MO_LOAD(lo);
    for (int u = lo; u < hi; ++u) {
        const int bh = u >> 6, ch = u & 63, b = bh >> 2, h = bh & 3; const size_t m0 = (size_t)b * SEQ + ch * 64;
        ml_gates_regs(c, bb, igs, gf, gi);
        float q[8], k[8]; conv8_regs(qrw, ch * 64 + t, cwt + h * 64 + c0, q); conv8_regs(kr, ch * 64 + t, cwt + 256 + h * 64 + c0, k);
        *(LAS u32x4*)(VV + t * VST80 + c0 * 2) = vr;
        *(LAS u32x4*)(CP + (tid >> 3) * CST + (tid & 7) * 16) = cr; if (tid < 128) *(LAS u32x4*)(CP + (64 + (tid >> 3)) * CST + (tid & 7) * 16) = cr2;
        if ((tid & 7) < 2) *(LAS u32x4*)(VV + t * VST80 + 128 + (tid & 7) * 16) = (u32x4){(tid & 7) == 0 ? 0x3f80u : 0u, 0u, 0u, 0u};
        if (u + 1 < hi) MO_LOAD(u + 1);
        __syncthreads();
        { const float eq = __expf(bb[t]), ek = 0.125f * __expf(igs[t] - bb[t]);
#pragma unroll
          for (int i = 0; i < 8; ++i) { q[i] *= eq; k[i] *= ek; } }
        *(LAS u32x4*)(QT + t * CST + c0 * 2) = pack8(q); *(LAS u32x4*)(KT + t * CST + c0 * 2) = pack8(k);
        __syncthreads();
#pragma unroll
        for (int e2 = 0; e2 < 2; ++e2) { const int e = wave + 8 * e2, ti = e >> 2, si = e & 3; f32x4_t acc = {0.f, 0.f, 0.f, 0.f};
            if (si <= ti) {
#pragma unroll
                for (int ks = 0; ks < 2; ++ks) acc = MFMA16(frag_row(KT, CST, 16 * si, 32 * ks, lane), frag_row(QT, CST, 16 * ti, 32 * ks, lane), acc);
                if (si == ti) {
#pragma unroll
                    for (int i = 0; i < 4; ++i) if (4 * (lane >> 4) + i > (lane & 15)) acc[i] = 0.f; } }
            u32x2 w; w.x = cvtpk(acc[0], acc[1]); w.y = cvtpk(acc[2], acc[3]);
            *(LAS u32x2*)(SC + (16 * ti + (lane & 15)) * CST + (16 * si + 4 * (lane >> 4)) * 2) = w; }
        __syncthreads();
        { const int ts = wave >> 1, hf = wave & 1; f32x4_t acc[3]; const int tl = 16 * ts + (lane & 15);
          u32x2 gr[2];
#pragma unroll
          for (int j = 0; j < 2; ++j) gr[j] = *(const u32x2*)(P + (m0 + tl) * PW + PC_MLO + h * 64 + 16 * (2 * hf + j) + 4 * (lane >> 4));
#pragma unroll
          for (int j = 0; j < 3; ++j) { acc[j] = (f32x4_t){0.f, 0.f, 0.f, 0.f}; if (j < 2 || hf == 0) { const int vt = (j == 2) ? 4 : 2 * hf + j;
              acc[j] = MFMA16(frag_tr(VV, VST80, 0, 16 * vt, lane), frag_row(SC, CST, 16 * ts, 0, lane), acc[j]);
              if (ts >= 2) acc[j] = MFMA16(frag_tr(VV, VST80, 32, 16 * vt, lane), frag_row(SC, CST, 16 * ts, 32, lane), acc[j]);
#pragma unroll
              for (int ks = 0; ks < 2; ++ks) acc[j] = MFMA16(frag_row(CP, CST, 16 * vt, 32 * ks, lane), frag_row(QT, CST, 16 * ts, 32 * ks, lane), acc[j]); } }
          if (hf == 0 && lane < 16) den[16 * ts + lane] = acc[2][0];
          __syncthreads();
          const float inv = 1.f / fmaxf(fabsf(den[tl]), 1.f); float ss = 0.f;
#pragma unroll
          for (int j = 0; j < 2; ++j)
#pragma unroll
              for (int i = 0; i < 4; ++i) { acc[j][i] *= inv; ss += acc[j][i] * acc[j][i]; }
          ss += __shfl_xor(ss, 16); ss += __shfl_xor(ss, 32);
          if (lane < 16) ssb[(16 * ts + lane) * 2 + hf] = ss;
          __syncthreads();
          const float rstd = rsqrtf((ssb[tl * 2] + ssb[tl * 2 + 1]) * (1.f / 64.f) + EPS);
#pragma unroll
          for (int j = 0; j < 2; ++j) { const int vd = 16 * (2 * hf + j) + 4 * (lane >> 4);
              const float g0 = bf2f(gr[j].x & 0xffffu), g1 = bf2f(gr[j].x >> 16), g2 = bf2f(gr[j].y & 0xffffu), g3 = bf2f(gr[j].y >> 16);
              u32x2 w; w.x = cvtpk(acc[j][0] * rstd * sigmoidf_(g0), acc[j][1] * rstd * sigmoidf_(g1)); w.y = cvtpk(acc[j][2] * rstd * sigmoidf_(g2), acc[j][3] * rstd * sigmoidf_(g3));
              *(u32x2*)(Y + (m0 + tl) * DM + 768 + h * 64 + vd) = w; } }
        __syncthreads();
    }
#undef MO_LOAD
}
#ifndef BAL_B_EXTRA
#define BAL_B_EXTRA 8
#endif
#ifndef BAL_D_EXTRA
#define BAL_D_EXTRA 8
#endif

__device__ __forceinline__ void ph_E_glu_naive(const Ctx& c, int l) {
    float* g1 = (float*)c.lds;
    bf16_t* wl = (bf16_t*)(g1 + 64 * 256);
    const bf16_t* G1 = WSP(bf16_t, WS_G1); const bf16_t* WT = WSP(bf16_t, WS_WGLU) + (size_t)l * 256 * 256; bf16_t* Y = WSP(bf16_t, WS_XNY);
    const int t = c.tid >> 3, j8 = c.tid & 7;
    for (int u = c.bid; u < MTOK / 64; u += c.G) {
        const size_t m0 = (size_t)u * 64;
        for (int e = c.tid; e < 64 * 32; e += NTHR) { const int r = e >> 5, c8 = (e & 31) * 8; float v[8]; unpack8(*(const u32x4*)(G1 + (m0 + r) * 256 + c8), v);
#pragma unroll
            for (int i = 0; i < 8; ++i) g1[r * 256 + c8 + i] = v[i]; }
        float yv[32]; float ss = 0.f;
#pragma unroll
        for (int hf = 0; hf < 2; ++hf) {
            __syncthreads();
            for (int e = c.tid; e < 128 * 32; e += NTHR) { const int r = e >> 5, c8 = (e & 31) * 8; *(u32x4*)(wl + r * 264 + c8) = *(const u32x4*)(WT + (size_t)(hf * 128 + r) * 256 + c8); }
            __syncthreads();
#pragma unroll
            for (int i = 0; i < 16; ++i) { const int nl = j8 * 16 + i; float a = 0.f;
                for (int k = 0; k < 256; k += 2) { const unsigned w = *(const unsigned*)(wl + nl * 264 + k); a += g1[t * 256 + k] * bf2f(w & 0xffffu) + g1[t * 256 + k + 1] * bf2f(w >> 16); }
                const float g = g1[t * 256 + hf * 128 + nl]; const float y = g * sigmoidf_(a); yv[hf * 16 + i] = y; ss += y * y; }
        }
        ss += __shfl_xor(ss, 1); ss += __shfl_xor(ss, 2); ss += __shfl_xor(ss, 4);
        const float rstd = rsqrtf(ss * (1.f / 256.f) + EPS);
#pragma unroll
        for (int hf = 0; hf < 2; ++hf)
#pragma unroll
            for (int i8 = 0; i8 < 2; ++i8) { float o[8];
#pragma unroll
                for (int i = 0; i < 8; ++i) o[i] = yv[hf * 16 + i8 * 8 + i] * rstd;
                *(u32x4*)(Y + (m0 + t) * DM + hf * 128 + j8 * 16 + i8 * 8) = pack8(o); }
        __syncthreads();
    }
}


__device__ __forceinline__ void ph_E_glu_fast(const Ctx& c, int l) {
    constexpr int GST = 528;
    LAS unsigned char* GT_ = c.lds3; LAS float* ssb = (LAS float*)(GT_ + 64 * GST);
    const bf16_t* G1 = WSP(bf16_t, WS_G1); const bf16_t* WT = WSP(bf16_t, WS_WGLU) + (size_t)l * 256 * 256; bf16_t* Y = WSP(bf16_t, WS_XNY);
    const int tid = c.tid, lane = c.lane, wave = c.wave;
    for (int u = c.bid; u < MTOK / 64; u += c.G) {
        const size_t m0 = (size_t)u * 64;
#pragma unroll
        for (int e = 0; e < 4; ++e) { const int ci = tid + 512 * e, r = ci >> 5, c8 = (ci & 31) * 8; *(LAS u32x4*)(GT_ + r * GST + c8 * 2) = *(const u32x4*)(G1 + (m0 + r) * 256 + c8); }
        __syncthreads();
        f32x4_t acc[2][4];
#pragma unroll
        for (int j = 0; j < 2; ++j)
#pragma unroll
            for (int mt = 0; mt < 4; ++mt) acc[j][mt] = (f32x4_t){0.f, 0.f, 0.f, 0.f};
#pragma unroll 2
        for (int ks = 0; ks < 8; ++ks) { bf16x8 wf[2], gf[4];
#pragma unroll
            for (int j = 0; j < 2; ++j) wf[j] = *(const bf16x8*)(WT + (size_t)(16 * (2 * wave + j) + (lane & 15)) * 256 + 32 * ks + 8 * (lane >> 4));
#pragma unroll
            for (int mt = 0; mt < 4; ++mt) gf[mt] = frag_row(GT_, GST, 16 * mt, 32 * ks, lane);
#pragma unroll
            for (int j = 0; j < 2; ++j)
#pragma unroll
                for (int mt = 0; mt < 4; ++mt) acc[j][mt] = MFMA16(wf[j], gf[mt], acc[j][mt]); }
#pragma unroll
        for (int mt = 0; mt < 4; ++mt) { float ss = 0.f;
#pragma unroll
            for (int j = 0; j < 2; ++j) { const int n = 16 * (2 * wave + j) + 4 * (lane >> 4); const u32x2 gr = *(LAS const u32x2*)(GT_ + (16 * mt + (lane & 15)) * GST + n * 2);
                const float g0 = bf2f(gr.x & 0xffffu), g1 = bf2f(gr.x >> 16), g2 = bf2f(gr.y & 0xffffu), g3 = bf2f(gr.y >> 16);
                acc[j][mt][0] = g0 * sigmoidf_(acc[j][mt][0]); acc[j][mt][1] = g1 * sigmoidf_(acc[j][mt][1]); acc[j][mt][2] = g2 * sigmoidf_(acc[j][mt][2]); acc[j][mt][3] = g3 * sigmoidf_(acc[j][mt][3]);
#pragma unroll
                for (int i = 0; i < 4; ++i) ss += acc[j][mt][i] * acc[j][mt][i]; }
            ss += __shfl_xor(ss, 16); ss += __shfl_xor(ss, 32);
            if (lane < 16) ssb[(16 * mt + lane) * 8 + wave] = ss; }
        __syncthreads();
#pragma unroll
        for (int mt = 0; mt < 4; ++mt) { const int tl = 16 * mt + (lane & 15); float s = 0.f;
#pragma unroll
            for (int w = 0; w < 8; ++w) s += ssb[tl * 8 + w];
            const float rstd = rsqrtf(s * (1.f / 256.f) + EPS);
#pragma unroll
            for (int j = 0; j < 2; ++j) { const int n = 16 * (2 * wave + j) + 4 * (lane >> 4); u32x2 w; w.x = cvtpk(acc[j][mt][0] * rstd, acc[j][mt][1] * rstd); w.y = cvtpk(acc[j][mt][2] * rstd, acc[j][mt][3] * rstd);
                *(u32x2*)(Y + (m0 + tl) * DM + n) = w; } }
        __syncthreads();
    }
}

__device__ __forceinline__ void ph_rowpass(const Ctx& c, const float* hprev, const float* gpost, float* hout, bf16_t* xn) {
    const bf16_t* MX = WSP(bf16_t, WS_MX);
    const int gw = c.bid * 8 + c.wave, NGW = c.G * 8;
    for (int m = gw; m < MTOK; m += NGW) {
        const u32x2* mr = (const u32x2*)(MX + (size_t)m * DM) + c.lane; const f32x4* hr = (const f32x4*)(hprev + (size_t)m * DM) + c.lane; const f32x4* gr = (const f32x4*)gpost + c.lane;
        f32x4 x[4], hv[4]; float s = 0.f;
#pragma unroll
        for (int j = 0; j < 4; ++j) { const u32x2 w = mr[64 * j]; x[j] = (f32x4){bf2f(w.x & 0xffffu), bf2f(w.x >> 16), bf2f(w.y & 0xffffu), bf2f(w.y >> 16)}; hv[j] = hr[64 * j];
            s += (x[j].x * x[j].x + x[j].y * x[j].y) + (x[j].z * x[j].z + x[j].w * x[j].w); }
        const float r1 = rsqrtf(wave_sum(s) * (1.f / DM) + EPS); float s2 = 0.f;
#pragma unroll
        for (int j = 0; j < 4; ++j) { const f32x4 g = gr[64 * j]; hv[j] = hv[j] + x[j] * r1 * g; s2 += (hv[j].x * hv[j].x + hv[j].y * hv[j].y) + (hv[j].z * hv[j].z + hv[j].w * hv[j].w); }
        f32x4* ho = (f32x4*)(hout + (size_t)m * DM) + c.lane;
#pragma unroll
        for (int j = 0; j < 4; ++j) ho[64 * j] = hv[j];
        if (xn) { const float r2 = rsqrtf(wave_sum(s2) * (1.f / DM) + EPS); u32x2* o8 = (u32x2*)(xn + (size_t)m * DM) + c.lane;
#pragma unroll
            for (int j = 0; j < 4; ++j) { u32x2 w; w.x = pk2(hv[j].x * r2, hv[j].y * r2); w.y = pk2(hv[j].z * r2, hv[j].w * r2); o8[64 * j] = w; } }
    }
}


typedef GAS unsigned gu32;
#define XB_TMO      128
#define XB_XCNT(j)  (256  + 64 * (j))
#define XB_XSUB(j)  (1280 + 64 * (j))
#define XB_XGEN(j)  (2304 + 64 * (j))
#define XB_TOP      3328
#define XB_TOPGEN   3392
#define XCD_BAR_WORDS 3456
#define XB_SPIN_CAP (1u << 22)
constexpr int CW_BAR = 4096;
constexpr int MISC_OFF = LDS_BYTES - 512;
__device__ __forceinline__ unsigned xb_ld(unsigned* p)              { return __hip_atomic_load(p, __ATOMIC_RELAXED, __HIP_MEMORY_SCOPE_AGENT); }
__device__ __forceinline__ unsigned xb_add(unsigned* p, unsigned v) { return __hip_atomic_fetch_add(p, v, __ATOMIC_RELAXED, __HIP_MEMORY_SCOPE_AGENT); }
__device__ __forceinline__ unsigned xb_xcc_id() { return (unsigned)__builtin_amdgcn_s_getreg((3 << 11) | 20) & 0xFu; }
#define XB_SPIN(cond, bar) do { unsigned _sp = 0; while (cond) { __builtin_amdgcn_s_sleep(1); \
    if ((++_sp & 255u) == 0u) { if (xb_ld(&(bar)[XB_TMO])) break; if (_sp > XB_SPIN_CAP) { atomicAdd(&(bar)[XB_TMO], 1u); break; } } } } while (0)
struct XcdBarrier { unsigned* bar; unsigned x; volatile LAS unsigned* st; };
__device__ __forceinline__ XcdBarrier xcd_barrier_post(unsigned* bar, volatile LAS unsigned* st) {
    XcdBarrier b; b.bar = bar; b.x = xb_xcc_id(); b.st = st;
    if (threadIdx.x == 0) (void)xb_add(&bar[XB_XCNT(b.x)], 1u);
    return b;
}
__device__ __forceinline__ void xcd_barrier_complete(unsigned* bar, unsigned x, unsigned& nloc, unsigned& nx) {
    const unsigned G = gridDim.x * gridDim.y * gridDim.z;
    unsigned sum, cnt, mine, sp = 0u;
    for (;;) {
        sum = 0u; cnt = 0u; mine = 0u;
#pragma unroll
        for (unsigned j = 0; j < 16; ++j) { const unsigned c = xb_ld(&bar[XB_XCNT(j)]); sum += c; cnt += (c > 0u) ? 1u : 0u; mine = (j == x) ? c : mine; }
        if (sum == G) break;
        __builtin_amdgcn_s_sleep(1);
        if ((++sp & 255u) == 0u) { if (xb_ld(&bar[XB_TMO])) break; if (sp > XB_SPIN_CAP) { atomicAdd(&bar[XB_TMO], 1u); break; } }
    }
    nloc = mine > 0u ? mine : 1u; nx = cnt > 0u ? cnt : 1u;
}
__device__ __forceinline__ void xcd_barrier(const XcdBarrier& b) {
    asm volatile("s_waitcnt vmcnt(0)" ::: "memory");
    __syncthreads();
    if (threadIdx.x == 0) {
        unsigned* bar = b.bar;
        __builtin_amdgcn_s_waitcnt(0);
        unsigned nloc = b.st[0], nx = b.st[1];
        if (nloc == 0u) { xcd_barrier_complete(bar, b.x, nloc, nx); b.st[0] = nloc; b.st[1] = nx; }
        const unsigned old = xb_add(&bar[XB_XSUB(b.x)], 1u);
        const unsigned gen = old / nloc;
        if (old + 1u == (gen + 1u) * nloc) {
            __builtin_amdgcn_fence(__ATOMIC_RELEASE, "agent");
            asm volatile("s_waitcnt vmcnt(0)" ::: "memory");
            const unsigned og = xb_add(&bar[XB_TOP], 1u);
            const unsigned tg = og / nx;
            if (og + 1u == (tg + 1u) * nx) xb_add(&bar[XB_TOPGEN], 1u);
            else XB_SPIN(xb_ld(&bar[XB_TOPGEN]) == tg, bar);
            __builtin_amdgcn_fence(__ATOMIC_ACQUIRE, "agent");
            xb_add(&bar[XB_XGEN(b.x)], 1u);
            asm volatile("s_waitcnt vmcnt(0)" ::: "memory");
        } else {
            XB_SPIN(xb_ld(&bar[XB_XGEN(b.x)]) == gen, bar);
            __builtin_amdgcn_fence(__ATOMIC_ACQUIRE, "agent");
            asm volatile("s_waitcnt vmcnt(0)" ::: "memory");
        }
    }
    __syncthreads();
}

struct Args { const float* in[23]; float* out; unsigned char* ws; int lo, hi; };
constexpr int NPHASE = 1 + 10 * DEPTH;

__global__ void __launch_bounds__(NTHR, 2) hybrid_fwd(Args args) {
    extern __shared__ __attribute__((aligned(16))) unsigned char lds_raw[];
    Ctx c;
#pragma unroll
    for (int i = 0; i < 23; ++i) c.in[i] = args.in[i];
    c.out = args.out; c.ws = args.ws; c.lds = lds_raw; c.lds3 = (LAS unsigned char*)lds_raw; c.tid = threadIdx.x; c.lane = c.tid & 63; c.wave = __builtin_amdgcn_readfirstlane(c.tid >> 6); c.G = gridDim.x; c.bid = blockIdx.x;
    const int lo = args.lo, hi = args.hi;
    volatile LAS unsigned* MISC = (volatile LAS unsigned*)(c.lds3 + MISC_OFF);
    if (c.tid < 128) MISC[c.tid] = 0u;
    __syncthreads();
    XcdBarrier gbar; gbar.bar = (unsigned*)(args.ws + WS_CTL) + CW_BAR; gbar.x = 0; gbar.st = nullptr;
    if (hi - lo > 1) gbar = xcd_barrier_post((unsigned*)(args.ws + WS_CTL) + CW_BAR, MISC + 8);
#define STAMP(k) do { if (TIME_FROM >= 0 && c.bid == 0 && c.tid == 0) { asm volatile("s_waitcnt vmcnt(0)" ::: "memory"); ((volatile LAS unsigned long long*)(MISC + 16))[(k)] = __builtin_amdgcn_s_memrealtime(); } } while (0)
#define SEAM(k) do { if (IN(k) && IN((k) + 1)) xcd_barrier(gbar); STAMP((k) + 1); } while (0)
#define IN(k) (lo <= (k) && (k) < hi)
#define FRESH() do { c.tid = opaque_v((int)threadIdx.x); c.lane = c.tid & 63; } while (0)
    STAMP(0);
    if (IN(0)) { FRESH(); ph_prologue(c); }
    SEAM(0);
    for (int l = 0; l < DEPTH; ++l) {
        const int pb = 1 + 10 * l;
        if (IN(pb + 0)) {
            EpiInProj E{WSP(bf16_t, WS_U2), WSP(bf16_t, WS_PACT), WSP(float, WS_GT), c.in[I_GB] + l * 12};
#if USE_PG8
            { pg8::Gemm g{WSP(bf16_t, WS_XNY), WSP(bf16_t, WS_WIN) + (size_t)l * NIN * DM, DM, DM, DM, (size_t)256 * DM * 2, (size_t)256 * DM * 2};
              pg8::StaticOrder S; S.init(MTOK, NIN, c.G, c.bid); pg8::EpiWrap<EpiInProj, false> W{E};
              pg8::gemm_phase<pg8::EpiWrap<EpiInProj, false>, pg8::StaticOrder, true>(c.lds3, g, S, W); }
#else
            gemm_naive<false>(c, WSP(bf16_t, WS_XNY), DM, WSP(bf16_t, WS_WIN) + (size_t)l * NIN * DM, DM, DM,
                [](int t, int& r0, int& c0, int& b0) -> bool { if (t >= (MTOK / 64) * (NIN / 64)) return false; r0 = 64 * (t / (NIN / 64)); c0 = b0 = 64 * (t % (NIN / 64)); return true; }, E);
#endif
        }
        SEAM(pb + 0);
        if (IN(pb + 1)) {
            FRESH(); ph_B_texpand(c, l); FRESH(); ph_B_gatescan(c);
            { EpiXloc E{WSP(float, WS_XLOC)};
#if USE_PG8
              { pg8::Gemm g{WSP(bf16_t, WS_U2), WSP(bf16_t, WS_BM) + (size_t)l * 16 * 128 * 1024, U2LD, 1024, 1024, (size_t)256 * U2LD * 2, (size_t)128 * 1024 * 2};
                pg8::SchedXloc S{c.G, c.bid}; pg8::EpiWrap<EpiXloc, false> W{E};
                pg8::gemm_phase<pg8::EpiWrap<EpiXloc, false>, pg8::SchedXloc, false>(c.lds3, g, S, W); __syncthreads(); }
#else
              gemm_naive<false>(c, WSP(bf16_t, WS_U2), U2LD, WSP(bf16_t, WS_BM) + (size_t)l * 16 * 128 * 1024, 1024, 1024,
                [](int t, int& r0, int& c0, int& b0) -> bool { if (t >= 128 * 2) return false; const int rt = t >> 1, ct = t & 1, g = rt >> 3; r0 = 64 * rt; c0 = 256 * g + 64 * ct; b0 = g * 128 + 64 * ct; return true; }, E);
#endif
            }
            FRESH(); stage_tables(c, l);
            { int ulo, uhi; range_split(c.bid, c.G, 2 * NUNIT, 64, BAL_B_EXTRA, ulo, uhi);
              FRESH(); hgrn_local_units(c, ulo < NUNIT ? ulo : NUNIT, uhi < NUNIT ? uhi : NUNIT);
              FRESH(); mlstm_local_units(c, (ulo > NUNIT ? ulo : NUNIT) - NUNIT, (uhi > NUNIT ? uhi : NUNIT) - NUNIT); }
        }
        SEAM(pb + 1);
        if (IN(pb + 2)) { FRESH(); ph_C_scans(c, l); FRESH();
#if FAST_FOX
            ph_C_fox_fast(c);
#else
            ph_C_fox_naive(c);
#endif
        }
        SEAM(pb + 2);
        if (IN(pb + 3)) {
            { EpiS5Y E{WSP(bf16_t, WS_G1)};
#if USE_PG8
              { pg8::Gemm g{WSP(bf16_t, WS_U2), WSP(bf16_t, WS_TT), U2LD, U2LD, U2LD, (size_t)256 * U2LD * 2, (size_t)256 * U2LD * 2};
                pg8::SchedS5Y S{c.G, c.bid}; pg8::EpiWrap<EpiS5Y, false> W{E};
                pg8::gemm_phase<pg8::EpiWrap<EpiS5Y, false>, pg8::SchedS5Y, false>(c.lds3, g, S, W); __syncthreads(); }
#else
              gemm_naive<false>(c, WSP(bf16_t, WS_U2), U2LD, WSP(bf16_t, WS_TT), U2LD, U2LD,
                [](int t, int& r0, int& c0, int& b0) -> bool { if (t >= 128 * 16) return false; const int rt = t >> 4, ct = t & 15, g = rt >> 3; r0 = 64 * rt; c0 = b0 = g * 1024 + 64 * ct; return true; }, E);
#endif
            }
            FRESH(); stage_tables(c, l);
            { int ulo, uhi; range_split(c.bid, c.G, 2 * NUNIT, 128, BAL_D_EXTRA, ulo, uhi);
              FRESH(); hgrn_out_units(c, ulo < NUNIT ? ulo : NUNIT, uhi < NUNIT ? uhi : NUNIT);
              FRESH(); mlstm_out_units(c, (ulo > NUNIT ? ulo : NUNIT) - NUNIT, (uhi > NUNIT ? uhi : NUNIT) - NUNIT); }
        }
        SEAM(pb + 3);
        if (IN(pb + 4)) { FRESH();
#if FAST_GLU
            ph_E_glu_fast(c, l);
#else
            ph_E_glu_naive(c, l);
#endif
        }
        SEAM(pb + 4);
        if (IN(pb + 5)) {
            EpiPlainBf16 E{WSP(bf16_t, WS_MX), DM};
#if USE_PG8
            { pg8::Gemm g{WSP(bf16_t, WS_XNY), WSP(bf16_t, WS_WOUT) + (size_t)l * DM * DM, DM, DM, DM, (size_t)256 * DM * 2, (size_t)256 * DM * 2};
              pg8::StaticOrder S; S.init(MTOK, DM, c.G, c.bid); pg8::EpiWrap<EpiPlainBf16, false> W{E};
              pg8::gemm_phase<pg8::EpiWrap<EpiPlainBf16, false>, pg8::StaticOrder, true>(c.lds3, g, S, W); }
#else
            gemm_naive<false>(c, WSP(bf16_t, WS_XNY), DM, WSP(bf16_t, WS_WOUT) + (size_t)l * DM * DM, DM, DM,
                [](int t, int& r0, int& c0, int& b0) -> bool { if (t >= (MTOK / 64) * 16) return false; r0 = 64 * (t >> 4); c0 = b0 = 64 * (t & 15); return true; }, E);
#endif
        }
        SEAM(pb + 5);
        if (IN(pb + 6)) { FRESH(); } if (IN(pb + 6)) ph_rowpass(c, l == 0 ? c.in[I_X] : c.out, c.in[I_LNMPOST] + l * DM, c.out, WSP(bf16_t, WS_XNY));
        SEAM(pb + 6);
        if (IN(pb + 7)) {
            EpiSwiGLU E{WSP(bf16_t, WS_PACT)};
#if USE_PG8
            { pg8::Gemm g{WSP(bf16_t, WS_XNY), WSP(bf16_t, WS_WGU) + (size_t)l * NGU * DM, DM, DM, DM, (size_t)256 * DM * 2, (size_t)256 * DM * 2};
              pg8::StaticOrder S; S.init(MTOK, NGU, c.G, c.bid); pg8::EpiWrap<EpiSwiGLU, true> W{E};
              pg8::gemm_phase<pg8::EpiWrap<EpiSwiGLU, true>, pg8::StaticOrder, true>(c.lds3, g, S, W); }
#else
            gemm_naive<true>(c, WSP(bf16_t, WS_XNY), DM, WSP(bf16_t, WS_WGU) + (size_t)l * NGU * DM, DM, DM,
                [](int t, int& r0, int& c0, int& b0) -> bool { if (t >= (MTOK / 64) * (DFF / 64)) return false; r0 = 64 * (t / (DFF / 64)); c0 = 64 * (t % (DFF / 64)); b0 = (c0 >> 7) * 256 + (c0 & 127); return true; }, E);
#endif
        }
        SEAM(pb + 7);
        if (IN(pb + 8)) {
            EpiPlainBf16 E{WSP(bf16_t, WS_MX), DM};
#if USE_PG8
            { pg8::Gemm g{WSP(bf16_t, WS_PACT), WSP(bf16_t, WS_WDN) + (size_t)l * DM * DFF, DFF, DFF, DFF, (size_t)256 * DFF * 2, (size_t)256 * DFF * 2};
              pg8::StaticOrder S; S.init(MTOK, DM, c.G, c.bid); pg8::EpiWrap<EpiPlainBf16, false> W{E};
              pg8::gemm_phase<pg8::EpiWrap<EpiPlainBf16, false>, pg8::StaticOrder, true>(c.lds3, g, S, W); }
#else
            gemm_naive<false>(c, WSP(bf16_t, WS_PACT), DFF, WSP(bf16_t, WS_WDN) + (size_t)l * DM * DFF, DFF, DFF,
                [](int t, int& r0, int& c0, int& b0) -> bool { if (t >= (MTOK / 64) * 16) return false; r0 = 64 * (t >> 4); c0 = b0 = 64 * (t & 15); return true; }, E);
#endif
        }
        SEAM(pb + 8);
        if (IN(pb + 9)) { FRESH(); } if (IN(pb + 9)) ph_rowpass(c, c.out, c.in[I_LNFPOST] + l * DM, c.out, (l + 1 < DEPTH) ? WSP(bf16_t, WS_XNY) : (bf16_t*)nullptr);
        SEAM(pb + 9);
    }
#if TIME_FROM >= 0
    if (c.bid == 0 && c.tid == 0) { __threadfence(); volatile LAS unsigned long long* ts = (volatile LAS unsigned long long*)(MISC + 16);
        const float dt = 1.f + (float)(ts[TIME_TO] - ts[TIME_FROM]) * 1e-3f; atomicAdd(c.out, dt); }
#endif
#undef IN
}

extern "C" void kernel_launch(void* const* d_in, const int* in_sizes, int n_in, void* d_out, int out_size, void* d_ws, size_t ws_size, hipStream_t stream) {
    static int grid = 0;
    if (grid == 0) {
        if (n_in != 23 || in_sizes[0] != MTOK * DM || out_size != MTOK * DM || ws_size < WS_END) {
            fprintf(stderr, "kernel_launch: unexpected shapes (n_in %d, in0 %d, out %d, ws %zu, need ws %zu); nothing launched\n", n_in, n_in > 0 ? in_sizes[0] : -1, out_size, ws_size, (size_t)WS_END); grid = -1; return; }
        int dev = 0, cus = 0;
        if (hipGetDevice(&dev) != hipSuccess || hipDeviceGetAttribute(&cus, hipDeviceAttributeMultiprocessorCount, dev) != hipSuccess) { grid = -1; return; }
        if (hipFuncSetAttribute((const void*)hybrid_fwd, hipFuncAttributeMaxDynamicSharedMemorySize, LDS_BYTES) != hipSuccess) { fprintf(stderr, "kernel_launch: hipFuncSetAttribute failed\n"); grid = -1; return; }
        grid = cus;
    }
    if (grid < 0) return;
    (void)hipMemsetAsync((char*)d_ws + WS_CTL, 0, CTL_BYTES, stream);
    Args a{};
    for (int i = 0; i < 23; ++i) a.in[i] = (const float*)d_in[i];
    a.out = (float*)d_out; a.ws = (unsigned char*)d_ws;
#if N_LAUNCH_MODE == 1
    a.lo = 0; a.hi = NPHASE; hipLaunchKernelGGL(hybrid_fwd, dim3(grid), dim3(NTHR), LDS_BYTES, stream, a);
#else
    for (int p = 0; p < NPHASE; ++p) { a.lo = p; a.hi = p + 1; hipLaunchKernelGGL(hybrid_fwd, dim3(grid), dim3(NTHR), LDS_BYTES, stream, a); }
#endif
}
```

```cpp
#include <hip/hip_runtime.h>
#include <cstdio>
#include <cstdint>

#ifndef N_LAUNCH_MODE
#define N_LAUNCH_MODE 1
#endif
#ifndef FAST_FOX
#define FAST_FOX 1
#endif
#ifndef FAST_HGRN
#define FAST_HGRN 1
#endif
#ifndef FAST_MLSTM
#define FAST_MLSTM 1
#endif
#ifndef FAST_GLU
#define FAST_GLU 1
#endif
#ifndef TIME_FROM
#define TIME_FROM -1
#define TIME_TO -1
#endif
#ifndef USE_PG8
#define USE_PG8 1
#endif

#define LAS __attribute__((address_space(3)))
#define GAS __attribute__((address_space(1)))
typedef unsigned short bf16_t;
typedef float f32x4 __attribute__((ext_vector_type(4)));
typedef unsigned u32x4 __attribute__((ext_vector_type(4)));
typedef unsigned u32x2 __attribute__((ext_vector_type(2)));
typedef short bf16x8 __attribute__((ext_vector_type(8)));
typedef float f32x2_t __attribute__((ext_vector_type(2)));

constexpr int NB = 8, SEQ = 4096, DM = 1024, MTOK = NB * SEQ, DEPTH = 2;
constexpr int DIN = 3084, NIN = 3328, DFF = 2816, NGU = 2 * DFF;
constexpr int CL = 64, NCH = SEQ / CL, NCHT = NB * NCH;
constexpr int PW = 2816;
constexpr int U2LD = 1152;
constexpr int NUNIT = NB * 4 * NCH;
constexpr float EPS = 1e-6f;
constexpr float LOG2E = 1.4426950408889634f;
constexpr int PC_HGQ = 0, PC_HGF = 256, PC_HGI = 512, PC_HGG = 768, PC_FXQ = 1024, PC_FXK = 1280, PC_FXV = 1536, PC_MLQ = 1792, PC_MLK = 2048, PC_MLV = 2304, PC_MLO = 2560;

constexpr size_t MiB = 1u << 20;
constexpr size_t WS_CTL = 0, CTL_BYTES = 1 * MiB;
constexpr size_t WS_WIN = 1 * MiB;
constexpr size_t WS_WOUT = 14 * MiB;
constexpr size_t WS_WGU = 18 * MiB;
constexpr size_t WS_WDN = 40 * MiB;
constexpr size_t WS_WGLU = 51 * MiB;
constexpr size_t WS_KERN = 52 * MiB;
constexpr size_t WS_A64 = 54 * MiB;
constexpr size_t WS_BM = 55 * MiB;
constexpr size_t WS_TT = 71 * MiB;
constexpr size_t WS_CM = 107 * MiB;
constexpr size_t WS_U2 = 115 * MiB;
constexpr size_t WS_GT = 133 * MiB;
constexpr size_t WS_FQ = 135 * MiB;
constexpr size_t WS_FK = 139 * MiB;
constexpr size_t WS_FCUM = 143 * MiB;
constexpr size_t WS_XNY = 144 * MiB;
constexpr size_t WS_PACT = 208 * MiB;
constexpr size_t WS_SCR = 384 * MiB;
constexpr size_t WS_MX = WS_SCR;
constexpr size_t WS_XLOC = WS_SCR;
constexpr size_t WS_G1 = WS_SCR + 4 * MiB;
constexpr size_t WS_HSLOC = WS_SCR + 20 * MiB;
constexpr size_t WS_HDEC = WS_SCR + 52 * MiB;
constexpr size_t WS_MDEC = WS_SCR + 52 * MiB + 512 * 1024;
constexpr size_t WS_HSPREV = WS_SCR + 53 * MiB;
constexpr size_t WS_MSLOC = WS_SCR + 69 * MiB;
constexpr size_t WS_MSPREV = WS_SCR + 102 * MiB;
constexpr size_t WS_END = 512 * MiB;
static_assert(WS_MSPREV + (size_t)NUNIT * 80 * 64 * 2 <= WS_END, "ws map");
static_assert(WS_MSLOC + (size_t)NUNIT * 65 * 64 * 4 <= WS_MSPREV, "ws map");

constexpr int LDS_BYTES = 147456;
constexpr int NTHR = 512;

__device__ __forceinline__ int opaque_v(int x) { asm volatile("" : "+v"(x)); return x; }
__device__ __forceinline__ float bf2f(unsigned b) { return __uint_as_float(b << 16); }
__device__ __forceinline__ unsigned f2bf(float f) { unsigned u = __float_as_uint(f); return (u + 0x7fffu + ((u >> 16) & 1u)) >> 16; }
typedef __bf16 bf16x2_t __attribute__((ext_vector_type(2)));
__device__ __forceinline__ unsigned pk2(float lo, float hi) { f32x2_t v = {lo, hi}; bf16x2_t b = __builtin_convertvector(v, bf16x2_t); return __builtin_bit_cast(unsigned, b); }
__device__ __forceinline__ float wave_sum(float v) {
#pragma unroll
    for (int o = 1; o < 64; o <<= 1) v += __shfl_xor(v, o);
    return v;
}
__device__ __forceinline__ float sigmoidf_(float x) { return __builtin_amdgcn_rcpf(1.f + __expf(-x)); }
__device__ __forceinline__ float log_sigmoidf_(float x) { return fminf(x, 0.f) - __logf(1.f + __expf(-fabsf(x))); }
__device__ __forceinline__ float siluf_(float x) { return x * sigmoidf_(x); }
__device__ __forceinline__ float gelu_tanh(float x) { const float u = 0.7978845608028654f * (x + 0.044715f * x * x * x); return x * (1.f - __builtin_amdgcn_rcpf(1.f + __expf(2.f * u))); }
__device__ __forceinline__ void unpack8(const u32x4 w, float (&v)[8]) {
    v[0] = bf2f(w.x & 0xffffu); v[1] = bf2f(w.x >> 16); v[2] = bf2f(w.y & 0xffffu); v[3] = bf2f(w.y >> 16);
    v[4] = bf2f(w.z & 0xffffu); v[5] = bf2f(w.z >> 16); v[6] = bf2f(w.w & 0xffffu); v[7] = bf2f(w.w >> 16);
}
__device__ __forceinline__ u32x4 pack8(const float (&v)[8]) { u32x4 w; w.x = pk2(v[0], v[1]); w.y = pk2(v[2], v[3]); w.z = pk2(v[4], v[5]); w.w = pk2(v[6], v[7]); return w; }

struct Ctx {
    const float* in[23]; float* out; unsigned char* ws;
    unsigned char* lds; LAS unsigned char* lds3; int tid, lane, wave, G, bid;
};
#define WSP(T, off) ((T*)(c.ws + (off)))
enum { I_X = 0, I_WIN, I_GB, I_LRE, I_LIM, I_BRE, I_BIM, I_CRE, I_CIM, I_S5D, I_LOGDT, I_WGLU, I_LB, I_CONV, I_GAIN, I_WOUT, I_LNMPRE, I_LNMPOST, I_LNFPRE, I_LNFPOST, I_WG, I_WU, I_WD };

template <bool PAIR, class TileF, class Epi>
__device__ __forceinline__ void gemm_naive(const Ctx& c, const bf16_t* A, int lda, const bf16_t* Bt, int ldb, int K, TileF tf, const Epi& E) {
    float* As = (float*)c.lds;
    float* Bs = As + 64 * 65;
    float* Bs2 = Bs + 64 * 65;
    const int r = c.tid >> 3, cg = c.tid & 7;
    for (int t = c.bid;; t += c.G) {
        int row0, col0, brow0; if (!tf(t, row0, col0, brow0)) break;
        float acc[8], acc2[8];
#pragma unroll
        for (int i = 0; i < 8; ++i) { acc[i] = 0.f; acc2[i] = 0.f; }
        for (int k0 = 0; k0 < K; k0 += 64) {
            __syncthreads();
            { float v[8]; unpack8(*(const u32x4*)(A + (size_t)(row0 + r) * lda + k0 + cg * 8), v);
#pragma unroll
              for (int i = 0; i < 8; ++i) As[r * 65 + cg * 8 + i] = v[i];
              unpack8(*(const u32x4*)(Bt + (size_t)(brow0 + r) * ldb + k0 + cg * 8), v);
#pragma unroll
              for (int i = 0; i < 8; ++i) Bs[r * 65 + cg * 8 + i] = v[i];
              if (PAIR) { unpack8(*(const u32x4*)(Bt + (size_t)(brow0 + 128 + r) * ldb + k0 + cg * 8), v);
#pragma unroll
                  for (int i = 0; i < 8; ++i) Bs2[r * 65 + cg * 8 + i] = v[i]; } }
            __syncthreads();
            for (int k = 0; k < 64; ++k) {
                const float a = As[r * 65 + k];
#pragma unroll
                for (int i = 0; i < 8; ++i) { acc[i] += a * Bs[(cg * 8 + i) * 65 + k]; if (PAIR) acc2[i] += a * Bs2[(cg * 8 + i) * 65 + k]; }
            }
        }
        E(row0 + r, col0 + cg * 8, acc, acc2);
    }
    __syncthreads();
}

struct EpiInProj {
    bf16_t* U2; bf16_t* P; float* GT; const float* gb;
    __device__ __forceinline__ void operator()(int row, int col, const float (&v)[8], const float (&)[8]) const {
        if (col < 256) { const int g = col >> 4, p0 = col & 15, ch = row >> 6, j = row & 63;
            *(u32x4*)(U2 + ((size_t)(g * NCHT + ch) * U2LD + j * 16 + p0)) = pack8(v); }
        else if (col < 3072) { *(u32x4*)(P + (size_t)row * PW + (col - 256)) = pack8(v); }
        else if (col < 3088) { const int i0 = col - 3072;
#pragma unroll
            for (int i = 0; i < 8; ++i) if (i0 + i < 12) GT[(size_t)row * 16 + i0 + i] = v[i] + gb[i0 + i]; }
    }
};
struct EpiPlainBf16 {
    bf16_t* O; int ld;
    __device__ __forceinline__ void operator()(int row, int col, const float (&v)[8], const float (&)[8]) const { *(u32x4*)(O + (size_t)row * ld + col) = pack8(v); }
};
struct EpiSwiGLU {
    bf16_t* O;
    __device__ __forceinline__ void operator()(int row, int col, const float (&g)[8], const float (&u)[8]) const {
        float v[8];
#pragma unroll
        for (int i = 0; i < 8; ++i) v[i] = siluf_(g[i]) * u[i];
        *(u32x4*)(O + (size_t)row * DFF + col) = pack8(v); }
};
struct EpiXloc {
    float* X;
    __device__ __forceinline__ void operator()(int row, int col, const float (&v)[8], const float (&)[8]) const {
        const int cl = col & 255; if (cl < 128) { float* p = X + (size_t)row * 128 + cl; *(f32x4*)p = (f32x4){v[0], v[1], v[2], v[3]}; *(f32x4*)(p + 4) = (f32x4){v[4], v[5], v[6], v[7]}; } }
};
struct EpiS5Y {
    bf16_t* G1;
    __device__ __forceinline__ void operator()(int row, int col, const float (&v)[8], const float (&)[8]) const {
        const int g = row >> 9, ch = row & 511, cl = col - g * 1024, tau = cl >> 4, p0 = cl & 15; float o[8];
#pragma unroll
        for (int i = 0; i < 8; ++i) o[i] = gelu_tanh(v[i]);
        *(u32x4*)(G1 + ((size_t)(ch * 64 + tau) * 256 + g * 16 + p0)) = pack8(o); }
};


namespace pg8 {
constexpr int BM = 256, BK = 64, HALF = 128, HTB = HALF * BK * 2, STAGE_BYTES = 8 * HTB, NXCD = 8, WGM = 8;
__host__ __device__ __forceinline__ int lds_byte(int r, int c) { const int st = (r >> 4) * 2 + (c >> 5), rr = r & 15, cc = c & 31, ob = rr * 64 + cc * 2; return st * 1024 + (ob ^ (((ob >> 9) & 1) << 5)); }
__host__ __device__ __forceinline__ void stage_rc(int b, int& R, int& C) { const int st = b / 1024, sb = b % 1024, swz = sb ^ (((sb >> 9) & 1) << 5); R = (st >> 1) * 16 + swz / 64; C = (st & 1) * 32 + (swz % 64) / 2; }
__host__ __device__ __forceinline__ int perm32(int rho) { const int n = rho >> 4, i = rho & 15; return 8 * (i >> 2) + 4 * n + (i & 3); }
struct Unit { int pm, pn; };
struct Gemm { const bf16_t* A; const bf16_t* Bt; int lda, ldb, K; size_t astep, bstep; };
struct StaticOrder {
    int nM, nN, nwg, G, c;
    __device__ void init(int M, int N, int G_, int c_) { nM = M / BM; nN = N / BM; nwg = nM * nN; G = G_; c = c_; }
    __device__ bool next(int i, Unit& u) const {
        const long L = (long)i * G + c; if (L >= nwg) return false;
        int wgid = (int)L; { const int q = nwg / NXCD, r = nwg % NXCD, xcd = wgid % NXCD, off = wgid / NXCD; wgid = (xcd < r ? xcd * (q + 1) : r * (q + 1) + (xcd - r) * q) + off; }
        const int nig = WGM * nN, gid = wgid / nig, fm = gid * WGM, gsz = (nM - fm) < WGM ? (nM - fm) : WGM;
        u.pm = fm + ((wgid % nig) % gsz); u.pn = (wgid % nig) / gsz; return true;
    }
};
struct SchedXloc { int G, c; __device__ bool next(int i, Unit& u) const { const int L = i * G + c; if (L >= 32) return false; u.pm = L; u.pn = L >> 1; return true; } };
struct SchedS5Y { int G, c; __device__ bool next(int i, Unit& u) const { const int L = i * G + c; if (L >= 128) return false; const int g = L >> 3; u.pm = g * 2 + ((L >> 2) & 1); u.pn = g * 4 + (L & 3); return true; } };

template <class F, bool PAIR> struct EpiWrap {
    F f;
    __device__ __forceinline__ void operator()(const f32x4 (&acc)[2][2][4][2], const Unit& u, int wr, int wc, int fr, int fq) const {
#pragma unroll
        for (int ai = 0; ai < 2; ++ai)
#pragma unroll
            for (int m = 0; m < 4; ++m) { const int row = u.pm * BM + ai * HALF + wr * 64 + m * 16 + fr;
                if (PAIR) { const int col = u.pn * HALF + wc * 32 + 8 * fq;
                    const float g[8] = {acc[ai][0][m][0][0], acc[ai][0][m][0][1], acc[ai][0][m][0][2], acc[ai][0][m][0][3], acc[ai][0][m][1][0], acc[ai][0][m][1][1], acc[ai][0][m][1][2], acc[ai][0][m][1][3]};
                    const float v[8] = {acc[ai][1][m][0][0], acc[ai][1][m][0][1], acc[ai][1][m][0][2], acc[ai][1][m][0][3], acc[ai][1][m][1][0], acc[ai][1][m][1][1], acc[ai][1][m][1][2], acc[ai][1][m][1][3]};
                    f(row, col, g, v); }
                else {
#pragma unroll
                    for (int bj = 0; bj < 2; ++bj) { const int col = u.pn * BM + bj * HALF + wc * 32 + 8 * fq;
                        const float v[8] = {acc[ai][bj][m][0][0], acc[ai][bj][m][0][1], acc[ai][bj][m][0][2], acc[ai][bj][m][0][3], acc[ai][bj][m][1][0], acc[ai][bj][m][1][1], acc[ai][bj][m][1][2], acc[ai][bj][m][1][3]};
                        f(row, col, v, v); } } }
    }
};

template <class Epi, class Sched, bool ALIGN_EPI>
__device__ __forceinline__ void gemm_phase(LAS unsigned char* lds, const Gemm g, const Sched& S, const Epi& E) {
    const int tid = opaque_v((int)threadIdx.x), wid = __builtin_amdgcn_readfirstlane(tid >> 6), lane = tid & 63, wr = wid >> 2, wc = wid & 3, fr = lane & 15, fq = lane >> 4;
    const int K = g.K, nt = K / BK;
    unsigned voffA[2], voffB[2];
#pragma unroll
    for (int i = 0; i < 2; ++i) { int R, C; stage_rc(tid * 16 + i * 8192, R, C); const int Rb = (R & ~31) + perm32(R & 31);
        voffA[i] = (unsigned)(R * g.lda + C) * 2u; voffB[i] = (unsigned)(Rb * g.ldb + C) * 2u; }
    const size_t kstep = (size_t)(BK * 2);
    const size_t hstepA = (size_t)HALF * g.lda * 2, hstepB = (size_t)HALF * g.ldb * 2;
    const unsigned ldsw = (unsigned)wid * 1024u;
    const int aoff = lds_byte(wr * 64 + fr, fq * 8), boff = lds_byte(wc * 32 + fr, fq * 8);
#define PG8_SA(b, h) (((b) * 2 + (h)) * HTB)
#define PG8_SB(b, h) ((4 + (b) * 2 + (h)) * HTB)
#define PG8_STAGE(bufoff, gbase, voff) do { _Pragma("unroll") for (int _i = 0; _i < 2; ++_i) \
        __builtin_amdgcn_global_load_lds((const unsigned*)((const char*)(gbase) + (voff)[_i]), (LAS unsigned*)(lds + (bufoff) + ldsw + _i * 8192), 16, 0, 0); } while (0)
#define PG8_LDA(dst, b, h) do { _Pragma("unroll") for (int m = 0; m < 4; ++m) _Pragma("unroll") for (int k = 0; k < 2; ++k) dst[m][k] = *(const LAS bf16x8*)(lds + PG8_SA(b, h) + aoff + m * 2048 + k * 1024); } while (0)
#define PG8_LDB(dst, b, h) do { _Pragma("unroll") for (int n = 0; n < 2; ++n) _Pragma("unroll") for (int k = 0; k < 2; ++k) dst[n][k] = *(const LAS bf16x8*)(lds + PG8_SB(b, h) + boff + n * 2048 + k * 1024); } while (0)
#define PG8_MMA(ai, bj, At, Bt) do { __builtin_amdgcn_s_setprio(1); _Pragma("unroll") for (int m = 0; m < 4; ++m) _Pragma("unroll") for (int n = 0; n < 2; ++n) _Pragma("unroll") for (int k = 0; k < 2; ++k) \
        acc[ai][bj][m][n] = __builtin_amdgcn_mfma_f32_16x16x32_bf16(Bt[n][k], At[m][k], acc[ai][bj][m][n], 0, 0, 0); __builtin_amdgcn_s_setprio(0); } while (0)
#define PG8_WAIT_V(n) asm volatile("s_waitcnt vmcnt(" #n ")" ::: "memory")
#define PG8_WAIT_L(n) asm volatile("s_waitcnt lgkmcnt(" #n ")" ::: "memory")
#define PG8_BAR __builtin_amdgcn_s_barrier()
#define PG8_SCHED __builtin_amdgcn_sched_barrier(0)
    Unit cur, nxt; int ui = 0;
    if (!S.next(0, cur)) return;
    f32x4 acc[2][2][4][2];
#pragma unroll
    for (int a = 0; a < 2; ++a)
#pragma unroll
        for (int b = 0; b < 2; ++b)
#pragma unroll
            for (int m = 0; m < 4; ++m)
#pragma unroll
                for (int n = 0; n < 2; ++n) acc[a][b][m][n] = (f32x4){0.f, 0.f, 0.f, 0.f};
    bf16x8 At[4][2], B0[2][2], B1[2][2];
    const char* cA = (const char*)g.A + (size_t)cur.pm * g.astep; const char* cB = (const char*)g.Bt + (size_t)cur.pn * g.bstep;
    PG8_STAGE(PG8_SB(0, 0), cB, voffB); PG8_STAGE(PG8_SB(0, 1), cB + hstepB, voffB); PG8_STAGE(PG8_SA(0, 0), cA, voffA); PG8_STAGE(PG8_SA(0, 1), cA + hstepA, voffA);
    if (wr == 1) PG8_BAR;
    PG8_WAIT_V(2); PG8_BAR;
    PG8_STAGE(PG8_SB(1, 0), cB + kstep, voffB); PG8_STAGE(PG8_SA(1, 0), cA + kstep, voffA); PG8_STAGE(PG8_SB(1, 1), cB + hstepB + kstep, voffB);
    PG8_WAIT_V(6); PG8_BAR;
    for (;;) {
        const bool has_next = S.next(ui + 1, nxt);
        const char* nA = has_next ? (const char*)g.A + (size_t)nxt.pm * g.astep : cA; const char* nB = has_next ? (const char*)g.Bt + (size_t)nxt.pn * g.bstep : cB;
        for (int t = 0; t < nt; t += 2) {
            const bool last = (t == nt - 2);
            const char* a1 = cA + (size_t)(t + 1) * kstep;
            const char* a2 = last ? nA : cA + (size_t)(t + 2) * kstep; const char* b2 = last ? nB : cB + (size_t)(t + 2) * kstep;
            const char* a3 = a2 + kstep; const char* b3 = b2 + kstep;
            PG8_LDB(B0, 0, 0); PG8_LDB(B1, 0, 1); PG8_SCHED; PG8_LDA(At, 0, 0); PG8_STAGE(PG8_SA(1, 1), a1 + hstepA, voffA);
            PG8_WAIT_V(8); PG8_WAIT_L(0); PG8_BAR; PG8_MMA(0, 0, At, B0); PG8_MMA(0, 1, At, B1); PG8_BAR; PG8_SCHED;
            PG8_LDA(At, 0, 1); PG8_STAGE(PG8_SB(0, 0), b2, voffB); PG8_STAGE(PG8_SB(0, 1), b2 + hstepB, voffB); PG8_STAGE(PG8_SA(0, 0), a2, voffA);
            PG8_WAIT_V(8); PG8_WAIT_L(0); PG8_BAR; PG8_MMA(1, 0, At, B0); PG8_MMA(1, 1, At, B1); PG8_BAR; PG8_SCHED;
            PG8_LDB(B0, 1, 0); PG8_LDB(B1, 1, 1); PG8_SCHED; PG8_LDA(At, 1, 0); PG8_STAGE(PG8_SA(0, 1), a2 + hstepA, voffA);
            PG8_WAIT_V(8); PG8_WAIT_L(0); PG8_BAR; PG8_MMA(0, 0, At, B0); PG8_MMA(0, 1, At, B1); PG8_BAR; PG8_SCHED;
            PG8_LDA(At, 1, 1); PG8_STAGE(PG8_SB(1, 0), b3, voffB); PG8_STAGE(PG8_SB(1, 1), b3 + hstepB, voffB); PG8_STAGE(PG8_SA(1, 0), a3, voffA);
            PG8_WAIT_V(8); PG8_WAIT_L(0); PG8_BAR; PG8_MMA(1, 0, At, B0); PG8_MMA(1, 1, At, B1); PG8_BAR; PG8_SCHED;
        }
        if constexpr (ALIGN_EPI) { if (wr == 0) PG8_BAR; }
        E(acc, cur, wr, wc, fr, fq);
        if (!has_next) break;
#pragma unroll
        for (int a = 0; a < 2; ++a)
#pragma unroll
            for (int b = 0; b < 2; ++b)
#pragma unroll
                for (int m = 0; m < 4; ++m)
#pragma unroll
                    for (int n = 0; n < 2; ++n) acc[a][b][m][n] = (f32x4){0.f, 0.f, 0.f, 0.f};
        cur = nxt; cA = nA; cB = nB; ++ui;
        if constexpr (ALIGN_EPI) { if (wr == 1) PG8_BAR; }
    }
    PG8_WAIT_V(0);
    if constexpr (!ALIGN_EPI) { if (wr == 0) PG8_BAR; }
    PG8_BAR;
#undef PG8_SA
#undef PG8_SB
#undef PG8_STAGE
#undef PG8_LDA
#undef PG8_LDB
#undef PG8_MMA
#undef PG8_WAIT_V
#undef PG8_WAIT_L
#undef PG8_BAR
#undef PG8_SCHED
}
}

template <class SrcF>
__device__ __forceinline__ void transpose_item(SrcF src4, bf16_t* WT, int ldw, int k0, int n0, float* scr, int lane) {
    f32x4 v[16];
#pragma unroll
    for (int i = 0; i < 16; ++i) v[i] = src4(k0 + 4 * i + (lane >> 4), n0 + 4 * (lane & 15));
#pragma unroll
    for (int i = 0; i < 16; ++i) { float* s = scr + (4 * i + (lane >> 4)) * 65 + 4 * (lane & 15); s[0] = v[i].x; s[1] = v[i].y; s[2] = v[i].z; s[3] = v[i].w; }
    __builtin_amdgcn_wave_barrier(); asm volatile("s_waitcnt lgkmcnt(0)" ::: "memory");
    const int cc = lane & 7;
#pragma unroll
    for (int j = 0; j < 8; ++j) { const int n = (lane >> 3) + 8 * j; const float* s = scr + (8 * cc) * 65 + n;
        u32x4 o; o.x = pk2(s[0 * 65], s[1 * 65]); o.y = pk2(s[2 * 65], s[3 * 65]); o.z = pk2(s[4 * 65], s[5 * 65]); o.w = pk2(s[6 * 65], s[7 * 65]);
        *(u32x4*)(WT + (size_t)(n0 + n) * ldw + k0 + 8 * cc) = o; }
    asm volatile("s_waitcnt lgkmcnt(0)" ::: "memory"); __builtin_amdgcn_wave_barrier();
}
__device__ __forceinline__ int win_src_col(int n) {
    if (n < 2048) return n;
    if (n < 3072) return n + 4;
    const int i = n - 3072;
    if (i < 4) return 2048 + i;
    if (i < 8) return 3076 + (i - 4);
    if (i < 12) return 3080 + (i - 8);
    return -1;
}
__device__ __forceinline__ void rms_row_to_bf16(const float* xrow, bf16_t* orow, int lane) {
    const f32x4* xr = (const f32x4*)xrow + lane; f32x4 v[4]; float s = 0.f;
#pragma unroll
    for (int j = 0; j < 4; ++j) { v[j] = xr[64 * j]; s += (v[j].x * v[j].x + v[j].y * v[j].y) + (v[j].z * v[j].z + v[j].w * v[j].w); }
    const float rstd = rsqrtf(wave_sum(s) * (1.f / DM) + EPS);
    u32x2* o8 = (u32x2*)orow + lane;
#pragma unroll
    for (int j = 0; j < 4; ++j) { u32x2 w; w.x = pk2(v[j].x * rstd, v[j].y * rstd); w.y = pk2(v[j].z * rstd, v[j].w * rstd); o8[64 * j] = w; }
}
__device__ __forceinline__ void ph_prologue(const Ctx& c) {
    float* scr = (float*)c.lds + c.wave * (64 * 65);
    const int gw = c.bid * 8 + c.wave, NGW = c.G * 8;
    constexpr int IT_IN = (NIN / 64) * (DM / 64), IT_OUT = (DM / 64) * (DM / 64), IT_GU = (NGU / 64) * (DM / 64), IT_DN = (DM / 64) * (DFF / 64), IT_GLU = (256 / 64) * (256 / 64);
    constexpr int IT_L = IT_IN + IT_OUT + IT_GU + IT_DN + IT_GLU;
    for (int it = gw; it < DEPTH * IT_L; it += NGW) {
        const int l = it / IT_L; int r = it % IT_L;
        if (r < IT_IN) { const int nb = r % (NIN / 64), kb = r / (NIN / 64); const float* W = c.in[I_WIN] + (size_t)l * DM * DIN; const float* ln = c.in[I_LNMPRE] + l * DM;
            if (nb < 48) transpose_item([=](int k, int n) -> f32x4 { const int sc = (n < 2048) ? n : n + 4; const float s = ln[k] * ((n >= 1280 && n < 1536) ? 0.125f * LOG2E : 1.f); return *(const f32x4*)(W + (size_t)k * DIN + sc) * s; },
                WSP(bf16_t, WS_WIN) + (size_t)l * NIN * DM, DM, kb * 64, nb * 64, scr, c.lane);
            else transpose_item([=](int k, int n) -> f32x4 { const float s = ln[k]; f32x4 v; const int s0 = win_src_col(n), s1 = win_src_col(n + 1), s2 = win_src_col(n + 2), s3 = win_src_col(n + 3);
                    const float* wr = W + (size_t)k * DIN; const float a0 = wr[s0 < 0 ? 0 : s0], a1 = wr[s1 < 0 ? 0 : s1], a2 = wr[s2 < 0 ? 0 : s2], a3 = wr[s3 < 0 ? 0 : s3];
                    v.x = s0 < 0 ? 0.f : a0 * s; v.y = s1 < 0 ? 0.f : a1 * s; v.z = s2 < 0 ? 0.f : a2 * s; v.w = s3 < 0 ? 0.f : a3 * s; return v; },
                WSP(bf16_t, WS_WIN) + (size_t)l * NIN * DM, DM, kb * 64, nb * 64, scr, c.lane);
            continue; }
        r -= IT_IN;
        if (r < IT_OUT) { const int nb = r % (DM / 64), kb = r / (DM / 64); const float* W = c.in[I_WOUT] + (size_t)l * DM * DM; const float* gn = c.in[I_GAIN] + l * DM;
            transpose_item([=](int k, int n) -> f32x4 { return *(const f32x4*)(W + (size_t)k * DM + n) * gn[k]; }, WSP(bf16_t, WS_WOUT) + (size_t)l * DM * DM, DM, kb * 64, nb * 64, scr, c.lane); continue; }
        r -= IT_OUT;
        if (r < IT_GU) { const int nb = r % (NGU / 64), kb = r / (NGU / 64); const float* Wg = c.in[I_WG] + (size_t)l * DM * DFF; const float* Wu = c.in[I_WU] + (size_t)l * DM * DFF; const float* ln = c.in[I_LNFPRE] + l * DM;
            transpose_item([=](int k, int n) -> f32x4 { const int tile = n >> 8, hf = (n >> 7) & 1, j = tile * 128 + (n & 127); return *(const f32x4*)((hf ? Wu : Wg) + (size_t)k * DFF + j) * ln[k]; },
                WSP(bf16_t, WS_WGU) + (size_t)l * NGU * DM, DM, kb * 64, nb * 64, scr, c.lane); continue; }
        r -= IT_GU;
        if (r < IT_DN) { const int nb = r % (DM / 64), kb = r / (DM / 64); const float* W = c.in[I_WD] + (size_t)l * DFF * DM;
            transpose_item([=](int k, int n) -> f32x4 { return *(const f32x4*)(W + (size_t)k * DM + n); }, WSP(bf16_t, WS_WDN) + (size_t)l * DM * DFF, DFF, kb * 64, nb * 64, scr, c.lane); continue; }
        r -= IT_DN;
        { const int nb = r % 4, kb = r / 4; const float* W = c.in[I_WGLU] + (size_t)l * 256 * 256;
            transpose_item([=](int k, int n) -> f32x4 { return *(const f32x4*)(W + (size_t)k * 256 + n); }, WSP(bf16_t, WS_WGLU) + (size_t)l * 256 * 256, 256, kb * 64, nb * 64, scr, c.lane); }
    }
    for (int m = 2 * gw; m < MTOK; m += 2 * NGW) {
        const f32x4* x0 = (const f32x4*)(c.in[I_X] + (size_t)m * DM) + c.lane; const f32x4* x1 = x0 + DM / 4; f32x4 v0[4], v1[4]; float s0 = 0.f, s1 = 0.f;
#pragma unroll
        for (int j = 0; j < 4; ++j) { v0[j] = x0[64 * j]; v1[j] = x1[64 * j]; }
#pragma unroll
        for (int j = 0; j < 4; ++j) { s0 += (v0[j].x * v0[j].x + v0[j].y * v0[j].y) + (v0[j].z * v0[j].z + v0[j].w * v0[j].w); s1 += (v1[j].x * v1[j].x + v1[j].y * v1[j].y) + (v1[j].z * v1[j].z + v1[j].w * v1[j].w); }
        const float r0 = rsqrtf(wave_sum(s0) * (1.f / DM) + EPS), r1 = rsqrtf(wave_sum(s1) * (1.f / DM) + EPS);
        u32x2* o0 = (u32x2*)(WSP(bf16_t, WS_XNY) + (size_t)m * DM) + c.lane; u32x2* o1 = o0 + DM / 4;
#pragma unroll
        for (int j = 0; j < 4; ++j) { u32x2 w; w.x = pk2(v0[j].x * r0, v0[j].y * r0); w.y = pk2(v0[j].z * r0, v0[j].w * r0); o0[64 * j] = w; w.x = pk2(v1[j].x * r1, v1[j].y * r1); w.y = pk2(v1[j].z * r1, v1[j].w * r1); o1[64 * j] = w; }
    }
    __syncthreads();
    float* sh = (float*)c.lds;
    float* cre = sh + 256; float* cim = cre + 1024; float* bre = cim + 1024; float* bim = bre + 1024;
    for (int it = c.bid; it < DEPTH * 16 * 13; it += c.G) {
        const int l = it / (16 * 13), g = (it / 13) % 16, db = it % 13;
        { const size_t o = (size_t)(l * 16 + g) * 1024;
          for (int e = c.tid; e < 1024; e += NTHR) { cre[e] = c.in[I_CRE][o + e]; cim[e] = c.in[I_CIM][o + e]; bre[e] = c.in[I_BRE][o + e]; bim[e] = c.in[I_BIM][o + e]; } }
        double a1r = 1., a1i = 0., cfr = 0., cfi = 0., wr = 1., wi = 0.;
        if (c.tid < 64) { const int n = c.tid;
            const double lr = (double)fminf(c.in[I_LRE][(l * 16 + g) * 64 + n], -1e-4f), li = (double)c.in[I_LIM][(l * 16 + g) * 64 + n], dt = exp((double)c.in[I_LOGDT][l * 16 + g]);
            const double mag1 = exp(lr * dt); a1r = mag1 * cos(li * dt); a1i = mag1 * sin(li * dt); const double den = lr * lr + li * li;
            cfr = ((a1r - 1.0) * lr + a1i * li) / den; cfi = (a1i * lr - (a1r - 1.0) * li) / den;
            double br = a1r, bi = a1i;
            for (int e = db * 5; e > 0; e >>= 1) { if (e & 1) { const double t = wr * br - wi * bi; wi = wr * bi + wi * br; wr = t; } const double t2 = br * br - bi * bi; bi = 2.0 * br * bi; br = t2; } }
#pragma unroll 1
        for (int d = db * 5; d < db * 5 + 5; ++d) {
            __syncthreads();
            if (c.tid < 64) { const int n = c.tid;
                sh[n] = (float)wr; sh[64 + n] = (float)wi; sh[128 + n] = (float)(wr * cfr - wi * cfi); sh[192 + n] = (float)(wr * cfi + wi * cfr);
                if (d == 64) { float* a64 = WSP(float, WS_A64) + ((size_t)(l * 16 + g) * 64 + n) * 2; a64[0] = (float)wr; a64[1] = (float)wi; }
                const double t = wr * a1r - wi * a1i; wi = wr * a1i + wi * a1r; wr = t; }
            __syncthreads();
            if (d < 64 && c.tid < 256) { const int p = c.tid >> 4, pp = c.tid & 15; float s = 0.f;
#pragma unroll 8
                for (int n = 0; n < 64; ++n) { const float wcr = sh[128 + n], wci = sh[192 + n], br = bre[n * 16 + pp], bi = bim[n * 16 + pp];
                    const float xr = wcr * br - wci * bi, xi = wcr * bi + wci * br; s += cre[p * 64 + n] * xr - cim[p * 64 + n] * xi; }
                if (d == 0 && p == pp) s += c.in[I_S5D][l * 256 + g * 16 + p];
                WSP(float, WS_KERN)[(((size_t)(l * 16 + g) * 64 + d) * 16 + p) * 16 + pp] = s; }
            if (d < 64) { const int j = 63 - d; bf16_t* bm = WSP(bf16_t, WS_BM) + (size_t)(l * 16 + g) * 128 * 1024;
#pragma unroll
                for (int e = 0; e < 4; ++e) { const int idx = c.tid * 4 + e, row = idx >> 4, pp = idx & 15, n = row >> 1, ri = row & 1;
                    const float wcr = sh[128 + n], wci = sh[192 + n], br = bre[n * 16 + pp], bi = bim[n * 16 + pp];
                    const float val = ri ? (wcr * bi + wci * br) : (wcr * br - wci * bi);
                    bm[(size_t)row * 1024 + j * 16 + pp] = (bf16_t)f2bf(val); } }
            if (d >= 1) { const int tau = d - 1; bf16_t* cm = WSP(bf16_t, WS_CM) + (size_t)(l * 16 + g) * 1024 * 128;
#pragma unroll
                for (int e = 0; e < 4; ++e) { const int idx = c.tid * 4 + e, p = idx >> 7, q = idx & 127, n = q >> 1, ri = q & 1;
                    const float wr = sh[n], wi = sh[64 + n], cr = cre[p * 64 + n], ci = cim[p * 64 + n];
                    const float val = ri ? -(cr * wi + ci * wr) : (cr * wr - ci * wi);
                    cm[(size_t)(tau * 16 + p) * 128 + q] = (bf16_t)f2bf(val); } }
        }
        __syncthreads();
    }
}

__device__ __forceinline__ void ph_B_texpand(const Ctx& c, int l) {
    bf16_t* TT = WSP(bf16_t, WS_TT);
    const float* KERN = WSP(float, WS_KERN) + (size_t)l * 16 * 64 * 256;
    const bf16_t* CM = WSP(bf16_t, WS_CM) + (size_t)l * 16 * 1024 * 128;
    for (int it = c.bid; it < 16 * 64; it += c.G) {
        const int g = it >> 6, tau = it & 63;
        for (int e = c.tid; e < 16 * (U2LD / 8); e += NTHR) {
            const int p = e / (U2LD / 8), c8 = (e % (U2LD / 8)) * 8; u32x4 w;
            if (c8 < 1024) { const int j = c8 >> 4, pp0 = c8 & 15;
                if (j <= tau) { const float* k = KERN + (((size_t)g * 64 + (tau - j)) * 16 + p) * 16 + pp0; w.x = pk2(k[0], k[1]); w.y = pk2(k[2], k[3]); w.z = pk2(k[4], k[5]); w.w = pk2(k[6], k[7]); }
                else w = (u32x4){0u, 0u, 0u, 0u}; }
            else w = *(const u32x4*)(CM + ((size_t)(g * 1024 + tau * 16 + p)) * 128 + (c8 - 1024));
            *(u32x4*)(TT + ((size_t)(g * 1024 + tau * 16 + p)) * U2LD + c8) = w; }
    }
}
__device__ __forceinline__ void split3(float F, unsigned& hi, unsigned& mid, unsigned& lo) { hi = f2bf(F); float r = F - bf2f(hi); mid = f2bf(r); r -= bf2f(mid); lo = f2bf(r); }
__device__ __forceinline__ void ph_B_gatescan(const Ctx& c) {
    float* sh = (float*)c.lds;
    const float* GT = WSP(float, WS_GT);
    for (int it = (c.bid + c.G - (32 % c.G)) % c.G; it < NB * 4; it += c.G) {
        const int b = it >> 2, h = it & 3; const size_t m0 = (size_t)b * SEQ + c.tid * 8;
        float ls[8]; float run = 0.f;
#pragma unroll
        for (int i = 0; i < 8; ++i) { run += log_sigmoidf_(GT[(m0 + i) * 16 + h]); ls[i] = run; }
        float inc = run;
#pragma unroll
        for (int o = 1; o < 64; o <<= 1) { const float y = __shfl_up(inc, o); if (c.lane >= o) inc += y; }
        __syncthreads(); if (c.lane == 63) sh[c.wave] = inc; __syncthreads();
        float off = inc - run;
#pragma unroll
        for (int w = 0; w < 8; ++w) if (w < c.wave) off += sh[w];
#pragma unroll
        for (int i = 0; i < 8; ++i) { const float F = (off + ls[i]) * LOG2E; const size_t m = m0 + i;
            WSP(float, WS_FCUM)[m * 4 + h] = F;
            unsigned hi, mid, lo; split3(F, hi, mid, lo); const unsigned one = 0x3f80u;
            u32x4 q0, q1 = (u32x4){0u, 0u, 0u, 0u}, k0;
            q0.x = hi | (mid << 16); q0.y = lo | (one << 16); q0.z = one | (one << 16); q0.w = 0u;
            k0.x = one | (one << 16); k0.y = one | ((hi ^ 0x8000u) << 16); k0.z = (mid ^ 0x8000u) | ((lo ^ 0x8000u) << 16); k0.w = 0u;
            u32x4* fq = (u32x4*)(WSP(bf16_t, WS_FQ) + (m * 4 + h) * 16); fq[0] = q0; fq[1] = q1;
            u32x4* fk = (u32x4*)(WSP(bf16_t, WS_FK) + (m * 4 + h) * 16); fk[0] = k0; fk[1] = q1; }
        __syncthreads();
    }
}
__device__ __forceinline__ void hg_gate(float z, float lb, float& logf, float& kk) {
    logf = log_sigmoidf_(z) + log1pf(lb * __expf(fminf(-z, 60.f)));
    kk = (1.f - lb) * sigmoidf_(-z);
}
__device__ __forceinline__ float hg_lb(const Ctx& c, int l, int ch) {
    if (l == 0) return 0.f;
    const float a = c.in[I_LB][ch], b = c.in[I_LB][256 + ch]; return fmaxf(1.f / (1.f + __expf(a - b)), 0.f);
}
__device__ __forceinline__ void ph_B_hgrn_local_naive(const Ctx& c, int l) {
    float* lg = (float*)c.lds; float* kk = lg + 4096; float* vv = kk + 4096;
    const bf16_t* P = WSP(bf16_t, WS_PACT);
    const int t = c.tid >> 3, c0 = (c.tid & 7) * 8;
    for (int u = c.bid; u < NUNIT; u += c.G) {
        const int bh = u >> 6, ch = u & 63, b = bh >> 2, h = bh & 3; const size_t m = (size_t)b * SEQ + ch * 64 + t;
        { float z[8], v[8]; unpack8(*(const u32x4*)(P + m * PW + PC_HGF + h * 64 + c0), z); unpack8(*(const u32x4*)(P + m * PW + PC_HGI + h * 64 + c0), v);
#pragma unroll
          for (int i = 0; i < 8; ++i) { float lf, k; hg_gate(z[i], hg_lb(c, l, h * 64 + c0 + i), lf, k); lg[t * 64 + c0 + i] = lf; kk[t * 64 + c0 + i] = k; vv[t * 64 + c0 + i] = v[i]; } }
        __syncthreads();
        if (c.tid < 64) { float a = 0.f; for (int s = 0; s < 64; ++s) { a += lg[s * 64 + c.tid]; lg[s * 64 + c.tid] = a; } }
        __syncthreads();
#pragma unroll
        for (int i = 0; i < 8; ++i) kk[t * 64 + c0 + i] *= __expf(lg[63 * 64 + c0 + i] - lg[t * 64 + c0 + i]);
        __syncthreads();
        { const int vd = t; float acc[8];
#pragma unroll
          for (int i = 0; i < 8; ++i) acc[i] = 0.f;
          for (int s = 0; s < 64; ++s) { const float v = vv[s * 64 + vd];
#pragma unroll
              for (int i = 0; i < 8; ++i) acc[i] += v * kk[s * 64 + c0 + i]; }
          float* o = WSP(float, WS_HSLOC) + ((size_t)u * 64 + vd) * 64 + c0; *(f32x4*)o = (f32x4){acc[0], acc[1], acc[2], acc[3]}; *(f32x4*)(o + 4) = (f32x4){acc[4], acc[5], acc[6], acc[7]}; }
        if (c.tid < 64) WSP(float, WS_HDEC)[(size_t)u * 64 + c.tid] = __expf(lg[63 * 64 + c.tid]);
        __syncthreads();
    }
}
__device__ __forceinline__ void ml_conv8(const Ctx& c, int l, const bf16_t* P, size_t m, int spos, int pcol, int wch, float (&o)[8]) {
    const float* cw = c.in[I_CONV] + (size_t)l * 4 * 512;
#pragma unroll
    for (int i = 0; i < 8; ++i) o[i] = 0.f;
#pragma unroll
    for (int j = 0; j < 4; ++j) { const int dt = 3 - j; if (spos - dt >= 0) { float x[8]; unpack8(*(const u32x4*)(P + (m - dt) * PW + pcol), x);
#pragma unroll
            for (int i = 0; i < 8; ++i) o[i] += cw[j * 512 + wch + i] * x[i]; } }
#pragma unroll
    for (int i = 0; i < 8; ++i) o[i] = siluf_(o[i]);
}
__device__ __forceinline__ void ph_B_mlstm_local_naive(const Ctx& c, int l) {
    float* kh = (float*)c.lds; float* vv = kh + 4096; float* bb = vv + 4096; float* ig = bb + 64;
    const bf16_t* P = WSP(bf16_t, WS_PACT); const float* GT = WSP(float, WS_GT);
    const int t = c.tid >> 3, c0 = (c.tid & 7) * 8;
    for (int u = c.bid; u < NUNIT; u += c.G) {
        const int bh = u >> 6, ch = u & 63, b = bh >> 2, h = bh & 3; const size_t m = (size_t)b * SEQ + ch * 64 + t;
        if (c.tid < 64) { const size_t mm = (size_t)b * SEQ + ch * 64 + c.tid; bb[c.tid] = log_sigmoidf_(GT[mm * 16 + 8 + h]); ig[c.tid] = GT[mm * 16 + 4 + h]; }
        __syncthreads();
        if (c.tid == 0) { float a = 0.f; for (int s = 0; s < 64; ++s) { a += bb[s]; bb[s] = a; } }
        __syncthreads();
        { float k[8], v[8]; ml_conv8(c, l, P, m, ch * 64 + t, PC_MLK + h * 64 + c0, 256 + h * 64 + c0, k); unpack8(*(const u32x4*)(P + m * PW + PC_MLV + h * 64 + c0), v);
          const float w = 0.125f * __expf(bb[63] - bb[t] + ig[t]);
#pragma unroll
          for (int i = 0; i < 8; ++i) { kh[t * 64 + c0 + i] = k[i] * w; vv[t * 64 + c0 + i] = v[i]; } }
        __syncthreads();
        for (int vd = t; vd < 65; vd += 64) { float acc[8];
#pragma unroll
            for (int i = 0; i < 8; ++i) acc[i] = 0.f;
            for (int s = 0; s < 64; ++s) { const float v = (vd < 64) ? vv[s * 64 + vd] : 1.f;
#pragma unroll
                for (int i = 0; i < 8; ++i) acc[i] += v * kh[s * 64 + c0 + i]; }
            float* o = WSP(float, WS_MSLOC) + ((size_t)u * 65 + vd) * 64 + c0; *(f32x4*)o = (f32x4){acc[0], acc[1], acc[2], acc[3]}; *(f32x4*)(o + 4) = (f32x4){acc[4], acc[5], acc[6], acc[7]}; }
        if (c.tid == 0) WSP(float, WS_MDEC)[u] = __expf(bb[63]);
        __syncthreads();
    }
}

__device__ __forceinline__ void ph_C_scans(const Ctx& c, int l) {
    const int NGT = c.G * NTHR;
    { const int gt = ((c.bid + c.G - (112 % c.G)) % c.G) * NTHR + c.tid;
      const float* XL = WSP(float, WS_XLOC); bf16_t* U2 = WSP(bf16_t, WS_U2); const float* A64 = WSP(float, WS_A64) + (size_t)l * 16 * 64 * 2;
      for (int i = gt; i < 16 * NB * 64; i += NGT) { const int n = i & 63, b = (i >> 6) & 7, g = i >> 9; const float ar = A64[(g * 64 + n) * 2], ai = A64[(g * 64 + n) * 2 + 1]; float xr = 0.f, xi = 0.f;
          const size_t row0 = (size_t)g * NCHT + b * NCH;
#pragma unroll 1
          for (int cb = 0; cb < NCH; cb += 16) { float lr[16], li[16];
#pragma unroll
              for (int k = 0; k < 16; ++k) { const f32x2_t v = *(const f32x2_t*)(XL + (row0 + cb + k) * 128 + 2 * n); lr[k] = v.x; li[k] = v.y; }
#pragma unroll
              for (int k = 0; k < 16; ++k) { *(unsigned*)(U2 + (row0 + cb + k) * U2LD + 1024 + 2 * n) = pk2(xr, xi);
                  const float nr = ar * xr - ai * xi + lr[k], ni = ar * xi + ai * xr + li[k]; xr = nr; xi = ni; } } } }
    { const int gt = c.bid * NTHR + c.tid;
      const float* SL = WSP(float, WS_HSLOC); const float* DC = WSP(float, WS_HDEC); bf16_t* SP = WSP(bf16_t, WS_HSPREV);
      for (int i = gt; i < 32 * 64 * 32; i += NGT) { const int k2 = (i & 31) * 2, vd = (i >> 5) & 63, bh = i >> 11; float s0 = 0.f, s1 = 0.f;
#pragma unroll 1
          for (int cb = 0; cb < NCH; cb += 16) { f32x2_t sl[16], dc[16];
#pragma unroll
              for (int k = 0; k < 16; ++k) { const size_t u = (size_t)bh * 64 + cb + k; sl[k] = *(const f32x2_t*)(SL + (u * 64 + vd) * 64 + k2); dc[k] = *(const f32x2_t*)(DC + u * 64 + k2); }
#pragma unroll
              for (int k = 0; k < 16; ++k) { const size_t u = (size_t)bh * 64 + cb + k; *(unsigned*)(SP + (u * 64 + vd) * 64 + k2) = pk2(s0, s1);
                  s0 = dc[k].x * s0 + sl[k].x; s1 = dc[k].y * s1 + sl[k].y; } } } }
    { const int gt = ((c.bid + c.G - (126 % c.G)) % c.G) * NTHR + c.tid;
      const float* SL = WSP(float, WS_MSLOC); const float* DC = WSP(float, WS_MDEC); bf16_t* SP = WSP(bf16_t, WS_MSPREV);
      for (int i = gt; i < 32 * 65 * 32; i += NGT) { const int k2 = (i & 31) * 2, vd = (i >> 5) % 65, bh = (i >> 5) / 65; float s0 = 0.f, s1 = 0.f;
#pragma unroll 1
          for (int cb = 0; cb < NCH; cb += 16) { f32x2_t sl[16]; float dc[16];
#pragma unroll
              for (int k = 0; k < 16; ++k) { const size_t u = (size_t)bh * 64 + cb + k; sl[k] = *(const f32x2_t*)(SL + (u * 65 + vd) * 64 + k2); dc[k] = DC[u]; }
#pragma unroll
              for (int k = 0; k < 16; ++k) { const size_t u = (size_t)bh * 64 + cb + k; *(unsigned*)(SP + (u * 80 + vd) * 64 + k2) = pk2(s0, s1);
                  s0 = dc[k] * s0 + sl[k].x; s1 = dc[k] * s1 + sl[k].y; } } } }
}
__device__ __forceinline__ void ph_C_fox_naive(const Ctx& c) {
    const bf16_t* P = WSP(bf16_t, WS_PACT); const float* FC = WSP(float, WS_FCUM); bf16_t* Y = WSP(bf16_t, WS_XNY);
    const int gw = c.bid * 8 + c.wave, NGW = c.G * 8;
    for (int r = gw; r < NB * 4 * SEQ; r += NGW) {
        const int q = r % SEQ, bh = r / SEQ, b = bh >> 2, h = bh & 3; const size_t m0 = (size_t)b * SEQ, mq = m0 + q;
        const float qv = bf2f(P[mq * PW + PC_FXQ + h * 64 + c.lane]); const float Fq = FC[mq * 4 + h];
        float mx = -INFINITY, lsum = 0.f, acc = 0.f;
        for (int kv = 0; kv <= q; ++kv) { const size_t mk = m0 + kv;
            const float s = wave_sum(qv * bf2f(P[mk * PW + PC_FXK + h * 64 + c.lane])) + (Fq - FC[mk * 4 + h]);
            const float mn = fmaxf(mx, s), al = exp2f(mx - mn), p = exp2f(s - mn);
            lsum = lsum * al + p; acc = acc * al + p * bf2f(P[mk * PW + PC_FXV + h * 64 + c.lane]); mx = mn; }
        const float o = acc / lsum; const float rstd = rsqrtf(wave_sum(o * o) * (1.f / 64.f) + EPS);
        Y[mq * DM + 512 + h * 64 + c.lane] = (bf16_t)f2bf(o * rstd);
    }
}


typedef float f32x16 __attribute__((ext_vector_type(16)));
typedef short s16x4 __attribute__((ext_vector_type(4)));
__device__ __forceinline__ unsigned cvtpk(float lo, float hi) { f32x2_t v = {lo, hi}; bf16x2_t b = __builtin_convertvector(v, bf16x2_t); return __builtin_bit_cast(unsigned, b); }
__device__ __forceinline__ int crow(int r, int hi) { return (r & 3) + 8 * (r >> 2) + 4 * hi; }
__device__ __forceinline__ s16x4 ds_tr16(LAS const unsigned char* p) { return __builtin_bit_cast(s16x4, __builtin_amdgcn_ds_read_tr16_b64_v4i16((LAS s16x4*)p)); }
__device__ __forceinline__ void ph_C_fox_fast(const Ctx& c) {
    constexpr int KST = 176, VST = 192, KB = 64 * KST, VB = 64 * VST, BUF = KB + VB;
    LAS unsigned char* L = c.lds3;
    const bf16_t* P = WSP(bf16_t, WS_PACT); const bf16_t* FQ = WSP(bf16_t, WS_FQ); const bf16_t* FK = WSP(bf16_t, WS_FK); bf16_t* Y = WSP(bf16_t, WS_XNY);
    const int tid = c.tid, lane = c.lane, wave = c.wave, r32 = lane & 31, hi = lane >> 5;
    const int vcu = (c.G % 8 == 0) ? (c.bid % 8) * (c.G / 8) + c.bid / 8 : c.bid;
    const int srow = tid >> 3, sch = tid & 7;
    for (int pi = vcu; pi < 256; pi += c.G) {
        const int bh = pi >> 3, sx = pi & 7, b = bh >> 2, h = bh & 3; const size_t m0 = (size_t)b * SEQ;
#pragma unroll 1
        for (int kk = 0; kk < 2; ++kk) {
            const int qb = kk ? 15 - sx : sx, q0 = qb * 256 + wave * 32, NT = 4 * (qb + 1); const size_t mq = m0 + q0 + r32;
            bf16x8 qf[5];
#pragma unroll
            for (int s = 0; s < 4; ++s) qf[s] = *(const bf16x8*)(P + mq * PW + PC_FXQ + h * 64 + 16 * s + 8 * hi);
            qf[4] = *(const bf16x8*)(FQ + (mq * 4 + h) * 16 + 8 * hi);
            const bf16_t* ksrc = P + (m0 + srow) * PW + PC_FXK + h * 64 + sch * 8;
            const bf16_t* vsrc = P + (m0 + srow) * PW + PC_FXV + h * 64 + sch * 8;
            const bf16_t* fsrc = FK + ((m0 + (tid >> 1)) * 4 + h) * 16 + (tid & 1) * 8;
            u32x4 kreg = *(const u32x4*)ksrc, vreg = *(const u32x4*)vsrc, freg = (u32x4){0u, 0u, 0u, 0u};
            if (tid < 128) freg = *(const u32x4*)fsrc;
            *(LAS u32x4*)(L + srow * KST + sch * 16) = kreg; *(LAS u32x4*)(L + KB + srow * VST + sch * 16) = vreg;
            if (tid < 128) *(LAS u32x4*)(L + (tid >> 1) * KST + 128 + (tid & 1) * 16) = freg;
            __syncthreads();
            float m_run = -INFINITY, l_run = 0.f; f32x16 o0 = {}, o1 = {};
            for (int t = 0; t < NT; ++t) {
                const bool more = (t + 1 < NT);
                if (more) { const size_t off = (size_t)(t + 1) * 64 * PW; kreg = *(const u32x4*)(ksrc + off); vreg = *(const u32x4*)(vsrc + off); if (tid < 128) freg = *(const u32x4*)(fsrc + (size_t)(t + 1) * 64 * 64); }
                if (t * 64 <= q0 + 31) {
                    LAS const unsigned char* KL = L + (t & 1) * BUF; LAS const unsigned char* VL = KL + KB;
                    f32x16 p0 = {}, p1 = {};
#pragma unroll
                    for (int s = 0; s < 5; ++s) { const bf16x8 a0 = *(LAS const bf16x8*)(KL + r32 * KST + s * 32 + hi * 16), a1 = *(LAS const bf16x8*)(KL + (32 + r32) * KST + s * 32 + hi * 16);
                        p0 = __builtin_amdgcn_mfma_f32_32x32x16_bf16(a0, qf[s], p0, 0, 0, 0); p1 = __builtin_amdgcn_mfma_f32_32x32x16_bf16(a1, qf[s], p1, 0, 0, 0); }
                    if (t * 64 + 63 > q0) { const int qg = q0 + r32;
#pragma unroll
                        for (int r = 0; r < 16; ++r) { const int kv = t * 64 + crow(r, hi); if (kv > qg) p0[r] = -INFINITY; if (kv + 32 > qg) p1[r] = -INFINITY; } }
                    float mx = fmaxf(p0[0], p1[0]);
#pragma unroll
                    for (int r = 1; r < 16; ++r) mx = fmaxf(mx, fmaxf(p0[r], p1[r]));
                    mx = fmaxf(mx, __shfl_xor(mx, 32));
                    const float mn = fmaxf(m_run, mx), alpha = __builtin_amdgcn_exp2f(m_run - mn); m_run = mn;
                    float rs = 0.f;
#pragma unroll
                    for (int r = 0; r < 16; ++r) { p0[r] = __builtin_amdgcn_exp2f(p0[r] - mn); p1[r] = __builtin_amdgcn_exp2f(p1[r] - mn); rs += p0[r] + p1[r]; }
                    l_run = l_run * alpha + rs;
#pragma unroll
                    for (int r = 0; r < 16; ++r) { o0[r] *= alpha; o1[r] *= alpha; }
                    u32x4 pw[2][2];
#pragma unroll
                    for (int s = 0; s < 2; ++s) { pw[0][s] = (u32x4){cvtpk(p0[8 * s], p0[8 * s + 1]), cvtpk(p0[8 * s + 2], p0[8 * s + 3]), cvtpk(p0[8 * s + 4], p0[8 * s + 5]), cvtpk(p0[8 * s + 6], p0[8 * s + 7])};
                        pw[1][s] = (u32x4){cvtpk(p1[8 * s], p1[8 * s + 1]), cvtpk(p1[8 * s + 2], p1[8 * s + 3]), cvtpk(p1[8 * s + 4], p1[8 * s + 5]), cvtpk(p1[8 * s + 6], p1[8 * s + 7])}; }
                    LAS const unsigned char* vb = VL + (4 * hi + ((lane & 15) >> 2)) * VST + (((lane >> 4) & 1) * 16 + (lane & 3) * 4) * 2;
#pragma unroll
                    for (int blk = 0; blk < 2; ++blk)
#pragma unroll
                        for (int s = 0; s < 2; ++s) {
#pragma unroll
                            for (int db = 0; db < 2; ++db) { LAS const unsigned char* a = vb + (blk * 32 + 16 * s) * VST + db * 64;
                                const s16x4 lo = ds_tr16(a), hh = ds_tr16(a + 8 * VST);
                                const bf16x8 vf = (bf16x8){lo[0], lo[1], lo[2], lo[3], hh[0], hh[1], hh[2], hh[3]};
                                if (db == 0) o0 = __builtin_amdgcn_mfma_f32_32x32x16_bf16(vf, __builtin_bit_cast(bf16x8, pw[blk][s]), o0, 0, 0, 0);
                                else o1 = __builtin_amdgcn_mfma_f32_32x32x16_bf16(vf, __builtin_bit_cast(bf16x8, pw[blk][s]), o1, 0, 0, 0); } }
                }
                if (more) { LAS unsigned char* D = L + ((t + 1) & 1) * BUF;
                    *(LAS u32x4*)(D + srow * KST + sch * 16) = kreg; *(LAS u32x4*)(D + KB + srow * VST + sch * 16) = vreg;
                    if (tid < 128) *(LAS u32x4*)(D + (tid >> 1) * KST + 128 + (tid & 1) * 16) = freg; }
                __syncthreads();
            }
            const float lt = l_run + __shfl_xor(l_run, 32), inv = 1.f / lt; float ss = 0.f;
#pragma unroll
            for (int r = 0; r < 16; ++r) { o0[r] *= inv; o1[r] *= inv; ss += o0[r] * o0[r] + o1[r] * o1[r]; }
            ss += __shfl_xor(ss, 32);
            const float rstd = rsqrtf(ss * (1.f / 64.f) + EPS);
            bf16_t* yr = Y + mq * DM + 512 + h * 64;
#pragma unroll
            for (int g4 = 0; g4 < 4; ++g4) { u32x2 w0, w1; const int d = 8 * g4 + 4 * hi;
                w0.x = cvtpk(o0[4 * g4] * rstd, o0[4 * g4 + 1] * rstd); w0.y = cvtpk(o0[4 * g4 + 2] * rstd, o0[4 * g4 + 3] * rstd);
                w1.x = cvtpk(o1[4 * g4] * rstd, o1[4 * g4 + 1] * rstd); w1.y = cvtpk(o1[4 * g4 + 2] * rstd, o1[4 * g4 + 3] * rstd);
                *(u32x2*)(yr + d) = w0; *(u32x2*)(yr + 32 + d) = w1; }
        }
    }
}

__device__ __forceinline__ void ph_D_hgrn_out_naive(const Ctx& c, int l) {
    float* qq = (float*)c.lds; float* kk = qq + 4096; float* bc = kk + 4096; float* vv = bc + 4096; float* sp = vv + 4096; float* sc = sp + 4096;
    const bf16_t* P = WSP(bf16_t, WS_PACT); const bf16_t* SP = WSP(bf16_t, WS_HSPREV); bf16_t* Y = WSP(bf16_t, WS_XNY);
    const int t = c.tid >> 3, c0 = (c.tid & 7) * 8;
    for (int u = c.bid; u < NUNIT; u += c.G) {
        const int bh = u >> 6, ch = u & 63, b = bh >> 2, h = bh & 3; const size_t m = (size_t)b * SEQ + ch * 64 + t;
        { float z[8], v[8], q[8], s[8]; unpack8(*(const u32x4*)(P + m * PW + PC_HGF + h * 64 + c0), z); unpack8(*(const u32x4*)(P + m * PW + PC_HGI + h * 64 + c0), v);
          unpack8(*(const u32x4*)(P + m * PW + PC_HGQ + h * 64 + c0), q); unpack8(*(const u32x4*)(SP + ((size_t)u * 64 + t) * 64 + c0), s);
#pragma unroll
          for (int i = 0; i < 8; ++i) { float lf, k; hg_gate(z[i], hg_lb(c, l, h * 64 + c0 + i), lf, k); bc[t * 64 + c0 + i] = lf; kk[t * 64 + c0 + i] = k; vv[t * 64 + c0 + i] = v[i]; qq[t * 64 + c0 + i] = q[i];
              sp[(c0 + i) * 64 + t] = s[i]; } }
        __syncthreads();
        if (c.tid < 64) { float a = 0.f; for (int s = 0; s < 64; ++s) { a += bc[s * 64 + c.tid]; bc[s * 64 + c.tid] = a; } }
        __syncthreads();
#pragma unroll
        for (int i = 0; i < 8; ++i) { const int s = c0 + i; float a = 0.f;
            if (s <= t) for (int kd = 0; kd < 64; ++kd) a += qq[t * 64 + kd] * kk[s * 64 + kd] * __expf(bc[t * 64 + kd] - bc[s * 64 + kd]);
            sc[t * 65 + s] = a; }
        __syncthreads();
        float o[8];
#pragma unroll
        for (int i = 0; i < 8; ++i) o[i] = 0.f;
        for (int s = 0; s <= t; ++s) { const float w = sc[t * 65 + s];
#pragma unroll
            for (int i = 0; i < 8; ++i) o[i] += w * vv[s * 64 + c0 + i]; }
        for (int kd = 0; kd < 64; ++kd) { const float w = qq[t * 64 + kd] * __expf(bc[t * 64 + kd]);
#pragma unroll
            for (int i = 0; i < 8; ++i) o[i] += w * sp[kd * 64 + c0 + i]; }
        float ss = 0.f;
#pragma unroll
        for (int i = 0; i < 8; ++i) ss += o[i] * o[i];
        ss += __shfl_xor(ss, 1); ss += __shfl_xor(ss, 2); ss += __shfl_xor(ss, 4);
        const float rstd = rsqrtf(ss * (1.f / 64.f) + EPS);
        float g[8]; unpack8(*(const u32x4*)(P + m * PW + PC_HGG + h * 64 + c0), g);
#pragma unroll
        for (int i = 0; i < 8; ++i) o[i] = o[i] * rstd * siluf_(g[i]);
        *(u32x4*)(Y + m * DM + 256 + h * 64 + c0) = pack8(o);
        __syncthreads();
    }
}
__device__ __forceinline__ void ph_D_mlstm_out_naive(const Ctx& c, int l) {
    float* qq = (float*)c.lds; float* kk = qq + 4096; float* vv = kk + 4096; float* cp = vv + 4096; float* sc = cp + 4096; float* np = sc + 64 * 65; float* bb = np + 64; float* ig = bb + 64;
    const bf16_t* P = WSP(bf16_t, WS_PACT); const bf16_t* SP = WSP(bf16_t, WS_MSPREV); const float* GT = WSP(float, WS_GT); bf16_t* Y = WSP(bf16_t, WS_XNY);
    const int t = c.tid >> 3, c0 = (c.tid & 7) * 8;
    for (int u = c.bid; u < NUNIT; u += c.G) {
        const int bh = u >> 6, ch = u & 63, b = bh >> 2, h = bh & 3; const size_t m = (size_t)b * SEQ + ch * 64 + t;
        if (c.tid < 64) { const size_t mm = (size_t)b * SEQ + ch * 64 + c.tid; bb[c.tid] = log_sigmoidf_(GT[mm * 16 + 8 + h]); ig[c.tid] = GT[mm * 16 + 4 + h]; np[c.tid] = bf2f(SP[((size_t)u * 80 + 64) * 64 + c.tid]); }
        { float q[8], k[8], v[8], s[8]; ml_conv8(c, l, P, m, ch * 64 + t, PC_MLQ + h * 64 + c0, h * 64 + c0, q); ml_conv8(c, l, P, m, ch * 64 + t, PC_MLK + h * 64 + c0, 256 + h * 64 + c0, k);
          unpack8(*(const u32x4*)(P + m * PW + PC_MLV + h * 64 + c0), v); unpack8(*(const u32x4*)(SP + ((size_t)u * 80 + t) * 64 + c0), s);
#pragma unroll
          for (int i = 0; i < 8; ++i) { qq[t * 64 + c0 + i] = q[i]; kk[t * 64 + c0 + i] = k[i] * 0.125f; vv[t * 64 + c0 + i] = v[i]; cp[(c0 + i) * 64 + t] = s[i]; } }
        __syncthreads();
        if (c.tid == 0) { float a = 0.f; for (int s = 0; s < 64; ++s) { a += bb[s]; bb[s] = a; } }
        __syncthreads();
#pragma unroll
        for (int i = 0; i < 8; ++i) { const int s = c0 + i; float a = 0.f;
            if (s <= t) { for (int kd = 0; kd < 64; ++kd) a += qq[t * 64 + kd] * kk[s * 64 + kd]; a *= __expf(bb[t] - bb[s] + ig[s]); }
            sc[t * 65 + s] = a; }
        __syncthreads();
        float o[8]; float den = 0.f;
#pragma unroll
        for (int i = 0; i < 8; ++i) o[i] = 0.f;
        for (int s = 0; s <= t; ++s) { const float w = sc[t * 65 + s]; den += w;
#pragma unroll
            for (int i = 0; i < 8; ++i) o[i] += w * vv[s * 64 + c0 + i]; }
        const float eb = __expf(bb[t]);
        for (int kd = 0; kd < 64; ++kd) { const float w = qq[t * 64 + kd] * eb; den += w * np[kd];
#pragma unroll
            for (int i = 0; i < 8; ++i) o[i] += w * cp[kd * 64 + c0 + i]; }
        const float inv = 1.f / fmaxf(fabsf(den), 1.f);
        float ss = 0.f;
#pragma unroll
        for (int i = 0; i < 8; ++i) { o[i] *= inv; ss += o[i] * o[i]; }
        ss += __shfl_xor(ss, 1); ss += __shfl_xor(ss, 2); ss += __shfl_xor(ss, 4);
        const float rstd = rsqrtf(ss * (1.f / 64.f) + EPS);
        float g[8]; unpack8(*(const u32x4*)(P + m * PW + PC_MLO + h * 64 + c0), g);
#pragma unroll
        for (int i = 0; i < 8; ++i) o[i] = o[i] * rstd * sigmoidf_(g[i]);
        *(u32x4*)(Y + m * DM + 768 + h * 64 + c0) = pack8(o);
        __syncthreads();
    }
}


typedef float f32x4_t __attribute__((ext_vector_type(4)));
__device__ __forceinline__ bf16x8 frag_row(LAS const unsigned char* base, int stride, int r0, int k0, int lane) {
    return *(LAS const bf16x8*)(base + (r0 + (lane & 15)) * stride + (k0 + 8 * (lane >> 4)) * 2); }
__device__ __forceinline__ bf16x8 frag_tr(LAS const unsigned char* base, int stride, int k0, int c0, int lane) {
    const int g = lane >> 4, i = lane & 15; LAS const unsigned char* p = base + (k0 + 8 * g + (i >> 2)) * stride + (c0 + 4 * (i & 3)) * 2;
    const s16x4 lo = ds_tr16(p), hh = ds_tr16(p + 4 * stride); return (bf16x8){lo[0], lo[1], lo[2], lo[3], hh[0], hh[1], hh[2], hh[3]}; }
#define MFMA16(a, b, c) __builtin_amdgcn_mfma_f32_16x16x32_bf16((a), (b), (c), 0, 0, 0)
__device__ __forceinline__ void scan_t8(float (&x)[8], float (&tot)[8], LAS float* wt, int lane, int wave) {
#pragma unroll
    for (int off = 8; off < 64; off <<= 1) {
#pragma unroll
        for (int i = 0; i < 8; ++i) { const float y = __shfl_up(x[i], off); if (lane >= off) x[i] += y; } }
    if (lane >= 56) {
#pragma unroll
        for (int i = 0; i < 8; ++i) wt[wave * 64 + (lane & 7) * 8 + i] = x[i]; }
    __syncthreads();
#pragma unroll
    for (int i = 0; i < 8; ++i) { float pre = 0.f, t = 0.f;
#pragma unroll
        for (int w = 0; w < 8; ++w) { const float v = wt[w * 64 + (lane & 7) * 8 + i]; t += v; if (w < wave) pre += v; }
        x[i] += pre; tot[i] = t; }
}
constexpr int CST = 144;

__device__ __forceinline__ void ph_B_hgrn_local_fast(const Ctx& c, int l) {
    LAS unsigned char* KH = c.lds3; LAS unsigned char* VV = KH + 64 * CST; LAS float* wt = (LAS float*)(VV + 64 * CST);
    const bf16_t* P = WSP(bf16_t, WS_PACT);
    const int tid = c.tid, lane = c.lane, wave = c.wave, t = tid >> 3, c0 = (tid & 7) * 8;
    for (int u = c.bid; u < NUNIT; u += c.G) {
        const int bh = u >> 6, ch = u & 63, b = bh >> 2, h = bh & 3; const size_t m = (size_t)b * SEQ + ch * 64 + t;
        const u32x4 zr = *(const u32x4*)(P + m * PW + PC_HGF + h * 64 + c0), vr = *(const u32x4*)(P + m * PW + PC_HGI + h * 64 + c0);
        float z[8], lf[8], kk[8], tot[8]; unpack8(zr, z);
#pragma unroll
        for (int i = 0; i < 8; ++i) hg_gate(z[i], hg_lb(c, l, h * 64 + c0 + i), lf[i], kk[i]);
        scan_t8(lf, tot, wt, lane, wave);
#pragma unroll
        for (int i = 0; i < 8; ++i) kk[i] *= __expf(tot[i] - lf[i]);
        *(LAS u32x4*)(KH + t * CST + c0 * 2) = pack8(kk); *(LAS u32x4*)(VV + t * CST + c0 * 2) = vr;
        if (t == 63) {
#pragma unroll
            for (int i = 0; i < 8; ++i) WSP(float, WS_HDEC)[(size_t)u * 64 + c0 + i] = __expf(tot[i]); }
        __syncthreads();
        { const int a = wave >> 1;
#pragma unroll
          for (int j = 0; j < 2; ++j) { const int bt = 2 * (wave & 1) + j; f32x4_t acc = {0.f, 0.f, 0.f, 0.f};
#pragma unroll
              for (int ks = 0; ks < 2; ++ks) acc = MFMA16(frag_tr(KH, CST, 32 * ks, 16 * a, lane), frag_tr(VV, CST, 32 * ks, 16 * bt, lane), acc);
              *(f32x4_t*)(WSP(float, WS_HSLOC) + ((size_t)u * 64 + 16 * bt + (lane & 15)) * 64 + 16 * a + 4 * (lane >> 4)) = acc; } }
        __syncthreads();
    }
}

__device__ __forceinline__ void ph_D_hgrn_out_fast(const Ctx& c, int l) {
    LAS unsigned char* QA = c.lds3; LAS unsigned char* QB = QA + 32 * CST; LAS unsigned char* QC = QB + 32 * CST; LAS unsigned char* KA = QC + 32 * CST; LAS unsigned char* KB_ = KA + 32 * CST; LAS unsigned char* KC = KB_ + 32 * CST;
    LAS unsigned char* QH = KC + 32 * CST; LAS unsigned char* VV = QH + 64 * CST; LAS unsigned char* SP = VV + 64 * CST; LAS unsigned char* SC = SP + 64 * CST;
    LAS float* refs = (LAS float*)(SC + 64 * CST); LAS float* wt = refs + 4 * 64; LAS float* ssb = wt + 8 * 64;
    const bf16_t* P = WSP(bf16_t, WS_PACT); const bf16_t* SPG = WSP(bf16_t, WS_HSPREV); bf16_t* Y = WSP(bf16_t, WS_XNY);
    const int tid = c.tid, lane = c.lane, wave = c.wave, t = tid >> 3, c0 = (tid & 7) * 8;
    for (int u = c.bid; u < NUNIT; u += c.G) {
        const int bh = u >> 6, ch = u & 63, b = bh >> 2, h = bh & 3; const size_t m0 = (size_t)b * SEQ + ch * 64, m = m0 + t;
        const u32x4 zr = *(const u32x4*)(P + m * PW + PC_HGF + h * 64 + c0), vr = *(const u32x4*)(P + m * PW + PC_HGI + h * 64 + c0), qr = *(const u32x4*)(P + m * PW + PC_HGQ + h * 64 + c0);
        const u32x4 sr = *(const u32x4*)(SPG + ((size_t)u * 64 + t) * 64 + c0);
        float z[8], q[8], bc[8], kk[8], tot[8]; unpack8(zr, z); unpack8(qr, q);
#pragma unroll
        for (int i = 0; i < 8; ++i) hg_gate(z[i], hg_lb(c, l, h * 64 + c0 + i), bc[i], kk[i]);
        scan_t8(bc, tot, wt, lane, wave);
        if ((t & 15) == 15 && t < 63) {
#pragma unroll
            for (int i = 0; i < 8; ++i) refs[(t >> 4) * 64 + c0 + i] = bc[i]; }
        *(LAS u32x4*)(VV + t * CST + c0 * 2) = vr; *(LAS u32x4*)(SP + t * CST + c0 * 2) = sr;
        __syncthreads();
        { float o1[8], o2[8], o3[8], o4[8];
          if (t < 32) {
#pragma unroll
              for (int i = 0; i < 8; ++i) { const float r15 = refs[c0 + i], r31 = refs[64 + c0 + i]; o1[i] = q[i] * __expf(bc[i] - r15); o2[i] = kk[i] * __expf(r15 - bc[i]); o3[i] = kk[i] * __expf(r31 - bc[i]); }
              *(LAS u32x4*)(QA + t * CST + c0 * 2) = pack8(o1); *(LAS u32x4*)(KA + t * CST + c0 * 2) = pack8(o2); *(LAS u32x4*)(KB_ + t * CST + c0 * 2) = pack8(o3);
          } else { const int tt = t - 32;
#pragma unroll
              for (int i = 0; i < 8; ++i) { const float r31 = refs[64 + c0 + i], r47 = refs[128 + c0 + i]; o1[i] = q[i] * __expf(bc[i] - r31); o2[i] = q[i] * __expf(bc[i] - r47); o3[i] = kk[i] * __expf(r47 - bc[i]); }
              *(LAS u32x4*)(QB + tt * CST + c0 * 2) = pack8(o1); *(LAS u32x4*)(QC + tt * CST + c0 * 2) = pack8(o2); *(LAS u32x4*)(KC + tt * CST + c0 * 2) = pack8(o3); }
#pragma unroll
          for (int i = 0; i < 8; ++i) o4[i] = q[i] * __expf(bc[i]);
          *(LAS u32x4*)(QH + t * CST + c0 * 2) = pack8(o4); }
        __syncthreads();
#pragma unroll
        for (int e2 = 0; e2 < 2; ++e2) { const int e = wave + 8 * e2, ti = e >> 2, si = e & 3; f32x4_t acc = {0.f, 0.f, 0.f, 0.f};
            if (si <= ti) { LAS const unsigned char* Qp = (ti < 2) ? QA : ((si < 2) ? QB : QC); LAS const unsigned char* Kp = (ti < 2) ? KA : ((si < 2) ? KB_ : KC);
                const int qr0 = 16 * (ti & 1), kr0 = 16 * (si & 1);
#pragma unroll
                for (int ks = 0; ks < 2; ++ks) acc = MFMA16(frag_row(Kp, CST, kr0, 32 * ks, lane), frag_row(Qp, CST, qr0, 32 * ks, lane), acc);
                if (si == ti) {
#pragma unroll
                    for (int i = 0; i < 4; ++i) if (4 * (lane >> 4) + i > (lane & 15)) acc[i] = 0.f; } }
            u32x2 w; w.x = cvtpk(acc[0], acc[1]); w.y = cvtpk(acc[2], acc[3]);
            *(LAS u32x2*)(SC + (16 * ti + (lane & 15)) * CST + (16 * si + 4 * (lane >> 4)) * 2) = w; }
        __syncthreads();
        { const int ts = wave >> 1; f32x4_t acc[2]; float ss = 0.f;
#pragma unroll
          for (int j = 0; j < 2; ++j) { const int vt = 2 * (wave & 1) + j; acc[j] = (f32x4_t){0.f, 0.f, 0.f, 0.f};
              acc[j] = MFMA16(frag_tr(VV, CST, 0, 16 * vt, lane), frag_row(SC, CST, 16 * ts, 0, lane), acc[j]);
              if (ts >= 2) acc[j] = MFMA16(frag_tr(VV, CST, 32, 16 * vt, lane), frag_row(SC, CST, 16 * ts, 32, lane), acc[j]);
#pragma unroll
              for (int ks = 0; ks < 2; ++ks) acc[j] = MFMA16(frag_row(SP, CST, 16 * vt, 32 * ks, lane), frag_row(QH, CST, 16 * ts, 32 * ks, lane), acc[j]);
#pragma unroll
              for (int i = 0; i < 4; ++i) ss += acc[j][i] * acc[j][i]; }
          ss += __shfl_xor(ss, 16); ss += __shfl_xor(ss, 32);
          if (lane < 16) ssb[(16 * ts + lane) * 2 + (wave & 1)] = ss;
          __syncthreads();
          const int tl = 16 * ts + (lane & 15); const float rstd = rsqrtf((ssb[tl * 2] + ssb[tl * 2 + 1]) * (1.f / 64.f) + EPS);
#pragma unroll
          for (int j = 0; j < 2; ++j) { const int vd = 16 * (2 * (wave & 1) + j) + 4 * (lane >> 4);
              const u32x2 gr = *(const u32x2*)(P + (m0 + tl) * PW + PC_HGG + h * 64 + vd);
              const float g0 = bf2f(gr.x & 0xffffu), g1 = bf2f(gr.x >> 16), g2 = bf2f(gr.y & 0xffffu), g3 = bf2f(gr.y >> 16);
              u32x2 w; w.x = cvtpk(acc[j][0] * rstd * siluf_(g0), acc[j][1] * rstd * siluf_(g1)); w.y = cvtpk(acc[j][2] * rstd * siluf_(g2), acc[j][3] * rstd * siluf_(g3));
              *(u32x2*)(Y + (m0 + tl) * DM + 256 + h * 64 + vd) = w; } }
        __syncthreads();
    }
}


constexpr int VST80 = 176;
__device__ __forceinline__ void ml_gates(const Ctx& c, LAS float* bb, LAS float* igs, size_t m0, int h) {
    if (c.tid < 64) { const float* GT = WSP(float, WS_GT); float x = log_sigmoidf_(GT[(m0 + c.tid) * 16 + 8 + h]);
#pragma unroll
        for (int off = 1; off < 64; off <<= 1) { const float y = __shfl_up(x, off); if (c.lane >= off) x += y; }
        bb[c.tid] = x; igs[c.tid] = GT[(m0 + c.tid) * 16 + 4 + h]; }
}
__device__ __forceinline__ void ph_B_mlstm_local_fast(const Ctx& c, int l) {
    LAS unsigned char* KH = c.lds3; LAS unsigned char* VV = KH + 64 * CST; LAS float* bb = (LAS float*)(VV + 64 * VST80); LAS float* igs = bb + 64;
    const bf16_t* P = WSP(bf16_t, WS_PACT);
    const int tid = c.tid, lane = c.lane, wave = c.wave, t = tid >> 3, c0 = (tid & 7) * 8;
    for (int u = c.bid; u < NUNIT; u += c.G) {
        const int bh = u >> 6, ch = u & 63, b = bh >> 2, h = bh & 3; const size_t m0 = (size_t)b * SEQ + ch * 64, m = m0 + t;
        ml_gates(c, bb, igs, m0, h);
        const u32x4 vr = *(const u32x4*)(P + m * PW + PC_MLV + h * 64 + c0);
        float k[8]; ml_conv8(c, l, P, m, ch * 64 + t, PC_MLK + h * 64 + c0, 256 + h * 64 + c0, k);
        __syncthreads();
        { const float w = 0.125f * __expf(bb[63] - bb[t] + igs[t]);
#pragma unroll
          for (int i = 0; i < 8; ++i) k[i] *= w; }
        *(LAS u32x4*)(KH + t * CST + c0 * 2) = pack8(k); *(LAS u32x4*)(VV + t * VST80 + c0 * 2) = vr;
        if ((tid & 7) < 2) *(LAS u32x4*)(VV + t * VST80 + 128 + (tid & 7) * 16) = (u32x4){(tid & 7) == 0 ? 0x3f80u : 0u, 0u, 0u, 0u};
        if (tid == 0) WSP(float, WS_MDEC)[u] = __expf(bb[63]);
        __syncthreads();
#pragma unroll
        for (int j = 0; j < 3; ++j) { const int e = wave + 8 * j; if (e < 20) { const int a = e & 3, bt = e >> 2; f32x4_t acc = {0.f, 0.f, 0.f, 0.f};
#pragma unroll
            for (int ks = 0; ks < 2; ++ks) acc = MFMA16(frag_tr(KH, CST, 32 * ks, 16 * a, lane), frag_tr(VV, VST80, 32 * ks, 16 * bt, lane), acc);
            const int vd = 16 * bt + (lane & 15);
            if (vd < 65) *(f32x4_t*)(WSP(float, WS_MSLOC) + ((size_t)u * 65 + vd) * 64 + 16 * a + 4 * (lane >> 4)) = acc; } }
        __syncthreads();
    }
}
__device__ __forceinline__ void ph_D_mlstm_out_fast(const Ctx& c, int l) {
    LAS unsigned char* QT = c.lds3; LAS unsigned char* KT = QT + 64 * CST; LAS unsigned char* VV = KT + 64 * CST; LAS unsigned char* CP = VV + 64 * VST80; LAS unsigned char* SC = CP + 80 * CST;
    LAS float* bb = (LAS float*)(SC + 64 * CST); LAS float* igs = bb + 64; LAS float* den = igs + 64; LAS float* ssb = den + 64;
    const bf16_t* P = WSP(bf16_t, WS_PACT); const bf16_t* SPG = WSP(bf16_t, WS_MSPREV); bf16_t* Y = WSP(bf16_t, WS_XNY);
    const int tid = c.tid, lane = c.lane, wave = c.wave, t = tid >> 3, c0 = (tid & 7) * 8;
    for (int u = c.bid; u < NUNIT; u += c.G) {
        const int bh = u >> 6, ch = u & 63, b = bh >> 2, h = bh & 3; const size_t m0 = (size_t)b * SEQ + ch * 64, m = m0 + t;
        ml_gates(c, bb, igs, m0, h);
        const u32x4 vr = *(const u32x4*)(P + m * PW + PC_MLV + h * 64 + c0);
        const u32x4 cr = *(const u32x4*)(SPG + (size_t)u * 80 * 64 + tid * 8);
        u32x4 cr2 = (u32x4){0u, 0u, 0u, 0u}; if (tid < 128) cr2 = *(const u32x4*)(SPG + (size_t)u * 80 * 64 + (512 + tid) * 8);
        float q[8], k[8]; ml_conv8(c, l, P, m, ch * 64 + t, PC_MLQ + h * 64 + c0, h * 64 + c0, q); ml_conv8(c, l, P, m, ch * 64 + t, PC_MLK + h * 64 + c0, 256 + h * 64 + c0, k);
        __syncthreads();
        { const float eq = __expf(bb[t]), ek = 0.125f * __expf(igs[t] - bb[t]);
#pragma unroll
          for (int i = 0; i < 8; ++i) { q[i] *= eq; k[i] *= ek; } }
        *(LAS u32x4*)(QT + t * CST + c0 * 2) = pack8(q); *(LAS u32x4*)(KT + t * CST + c0 * 2) = pack8(k); *(LAS u32x4*)(VV + t * VST80 + c0 * 2) = vr;
        if ((tid & 7) < 2) *(LAS u32x4*)(VV + t * VST80 + 128 + (tid & 7) * 16) = (u32x4){(tid & 7) == 0 ? 0x3f80u : 0u, 0u, 0u, 0u};
        *(LAS u32x4*)(CP + (tid >> 3) * CST + (tid & 7) * 16) = cr; if (tid < 128) *(LAS u32x4*)(CP + (64 + (tid >> 3)) * CST + (tid & 7) * 16) = cr2;
        __syncthreads();
#pragma unroll
        for (int e2 = 0; e2 < 2; ++e2) { const int e = wave + 8 * e2, ti = e >> 2, si = e & 3; f32x4_t acc = {0.f, 0.f, 0.f, 0.f};
            if (si <= ti) {
#pragma unroll
                for (int ks = 0; ks < 2; ++ks) acc = MFMA16(frag_row(KT, CST, 16 * si, 32 * ks, lane), frag_row(QT, CST, 16 * ti, 32 * ks, lane), acc);
                if (si == ti) {
#pragma unroll
                    for (int i = 0; i < 4; ++i) if (4 * (lane >> 4) + i > (lane & 15)) acc[i] = 0.f; } }
            u32x2 w; w.x = cvtpk(acc[0], acc[1]); w.y = cvtpk(acc[2], acc[3]);
            *(LAS u32x2*)(SC + (16 * ti + (lane & 15)) * CST + (16 * si + 4 * (lane >> 4)) * 2) = w; }
        __syncthreads();
        { const int ts = wave >> 1, hf = wave & 1; f32x4_t acc[3];
#pragma unroll
          for (int j = 0; j < 3; ++j) { acc[j] = (f32x4_t){0.f, 0.f, 0.f, 0.f}; if (j < 2 || hf == 0) { const int vt = (j == 2) ? 4 : 2 * hf + j;
              acc[j] = MFMA16(frag_tr(VV, VST80, 0, 16 * vt, lane), frag_row(SC, CST, 16 * ts, 0, lane), acc[j]);
              if (ts >= 2) acc[j] = MFMA16(frag_tr(VV, VST80, 32, 16 * vt, lane), frag_row(SC, CST, 16 * ts, 32, lane), acc[j]);
#pragma unroll
              for (int ks = 0; ks < 2; ++ks) acc[j] = MFMA16(frag_row(CP, CST, 16 * vt, 32 * ks, lane), frag_row(QT, CST, 16 * ts, 32 * ks, lane), acc[j]); } }
          if (hf == 0 && lane < 16) den[16 * ts + lane] = acc[2][0];
          __syncthreads();
          const int tl = 16 * ts + (lane & 15); const float inv = 1.f / fmaxf(fabsf(den[tl]), 1.f); float ss = 0.f;
#pragma unroll
          for (int j = 0; j < 2; ++j)
#pragma unroll
              for (int i = 0; i < 4; ++i) { acc[j][i] *= inv; ss += acc[j][i] * acc[j][i]; }
          ss += __shfl_xor(ss, 16); ss += __shfl_xor(ss, 32);
          if (lane < 16) ssb[(16 * ts + lane) * 2 + hf] = ss;
          __syncthreads();
          const float rstd = rsqrtf((ssb[tl * 2] + ssb[tl * 2 + 1]) * (1.f / 64.f) + EPS);
#pragma unroll
          for (int j = 0; j < 2; ++j) { const int vd = 16 * (2 * hf + j) + 4 * (lane >> 4);
              const u32x2 gr = *(const u32x2*)(P + (m0 + tl) * PW + PC_MLO + h * 64 + vd);
              const float g0 = bf2f(gr.x & 0xffffu), g1 = bf2f(gr.x >> 16), g2 = bf2f(gr.y & 0xffffu), g3 = bf2f(gr.y >> 16);
              u32x2 w; w.x = cvtpk(acc[j][0] * rstd * sigmoidf_(g0), acc[j][1] * rstd * sigmoidf_(g1)); w.y = cvtpk(acc[j][2] * rstd * sigmoidf_(g2), acc[j][3] * rstd * sigmoidf_(g3));
              *(u32x2*)(Y + (m0 + tl) * DM + 768 + h * 64 + vd) = w; } }
        __syncthreads();
    }
}


constexpr int TAB_OFF = 100 * 1024;
__device__ __forceinline__ void range_split(int w, int G, int N, int ns, int extra, int& lo, int& hi) {
    if (ns >= G) { const int q = N / G, r = N % G; lo = w * q + (w < r ? w : r); hi = lo + q + (w < r ? 1 : 0); return; }
    const int T = (N + ns * extra + G - 1) / G; int cs = T - extra; if (cs < 0) cs = 0;
    if (w < ns) { lo = w * cs; hi = lo + cs; return; }
    const int rest = N - ns * cs, no = G - ns, k = w - ns, q = rest / no, r = rest % no; lo = ns * cs + k * q + (k < r ? k : r); hi = lo + q + (k < r ? 1 : 0);
}
__device__ __forceinline__ void stage_tables(const Ctx& c, int l) {
    LAS float* lbv = (LAS float*)(c.lds3 + TAB_OFF); LAS float* cwt = lbv + 256;
    if (c.tid < 256) lbv[c.tid] = hg_lb(c, l, c.tid);
    for (int i = c.tid; i < 2048; i += NTHR) cwt[i] = c.in[I_CONV][(size_t)l * 2048 + i];
    __syncthreads();
}
__device__ __forceinline__ void hg_gate_fast(float z, float lb, float& logf, float& kk) {
    z = fmaxf(z, -80.f); const float e = __expf(-z), s = __builtin_amdgcn_rcpf(1.f + e), oml = 1.f - lb;
    logf = __logf(lb + oml * s); kk = oml * e * s;
}
__device__ __forceinline__ void hgrn_local_units(const Ctx& c, int lo, int hi) {
    LAS unsigned char* KH = c.lds3; LAS unsigned char* VV = KH + 64 * CST; LAS float* wt = (LAS float*)(VV + 64 * CST); LAS const float* lbv = (LAS const float*)(c.lds3 + TAB_OFF);
    const bf16_t* P = WSP(bf16_t, WS_PACT);
    const int tid = c.tid, lane = c.lane, wave = c.wave, t = tid >> 3, c0 = (tid & 7) * 8;
    u32x4 zr = {}, vr = {};
#define HL_LOAD(u_) do { const int bh_ = (u_) >> 6, ch_ = (u_) & 63; const size_t m_ = (size_t)(bh_ >> 2) * SEQ + ch_ * 64 + t; const bf16_t* p_ = P + m_ * PW + (bh_ & 3) * 64 + c0; zr = *(const u32x4*)(p_ + PC_HGF); vr = *(const u32x4*)(p_ + PC_HGI); } while (0)
    if (lo < hi) HL_LOAD(lo);
    for (int u = lo; u < hi; ++u) {
        const int h = (u >> 6) & 3;
        float z[8], lf[8], kk[8], tot[8]; unpack8(zr, z); const u32x4 vcur = vr;
        if (u + 1 < hi) HL_LOAD(u + 1);
#pragma unroll
        for (int i = 0; i < 8; ++i) hg_gate_fast(z[i], lbv[h * 64 + c0 + i], lf[i], kk[i]);
        scan_t8(lf, tot, wt, lane, wave);
#pragma unroll
        for (int i = 0; i < 8; ++i) kk[i] *= __expf(tot[i] - lf[i]);
        *(LAS u32x4*)(KH + t * CST + c0 * 2) = pack8(kk); *(LAS u32x4*)(VV + t * CST + c0 * 2) = vcur;
        if (t == 63) {
#pragma unroll
            for (int i = 0; i < 8; ++i) WSP(float, WS_HDEC)[(size_t)u * 64 + c0 + i] = __expf(tot[i]); }
        __syncthreads();
        { const int a = wave >> 1;
#pragma unroll
          for (int j = 0; j < 2; ++j) { const int bt = 2 * (wave & 1) + j; f32x4_t acc = {0.f, 0.f, 0.f, 0.f};
#pragma unroll
              for (int ks = 0; ks < 2; ++ks) acc = MFMA16(frag_tr(KH, CST, 32 * ks, 16 * a, lane), frag_tr(VV, CST, 32 * ks, 16 * bt, lane), acc);
              *(f32x4_t*)(WSP(float, WS_HSLOC) + ((size_t)u * 64 + 16 * bt + (lane & 15)) * 64 + 16 * a + 4 * (lane >> 4)) = acc; } }
        __syncthreads();
    }
#undef HL_LOAD
}
__device__ __forceinline__ void hgrn_out_units(const Ctx& c, int lo, int hi) {
    LAS unsigned char* QA = c.lds3; LAS unsigned char* QB = QA + 32 * CST; LAS unsigned char* QC = QB + 32 * CST; LAS unsigned char* KA = QC + 32 * CST; LAS unsigned char* KB_ = KA + 32 * CST; LAS unsigned char* KC = KB_ + 32 * CST;
    LAS unsigned char* QH = KC + 32 * CST; LAS unsigned char* VV = QH + 64 * CST; LAS unsigned char* SP = VV + 64 * CST; LAS unsigned char* SC = SP + 64 * CST;
    LAS float* refs = (LAS float*)(SC + 64 * CST); LAS float* wt = refs + 4 * 64; LAS float* ssb = wt + 8 * 64; LAS const float* lbv = (LAS const float*)(c.lds3 + TAB_OFF);
    const bf16_t* P = WSP(bf16_t, WS_PACT); const bf16_t* SPG = WSP(bf16_t, WS_HSPREV); bf16_t* Y = WSP(bf16_t, WS_XNY);
    const int tid = c.tid, lane = c.lane, wave = c.wave, t = tid >> 3, c0 = (tid & 7) * 8;
    u32x4 zr = {}, vr = {}, qr = {}, sr = {};
#define HO_LOAD(u_) do { const int bh_ = (u_) >> 6, ch_ = (u_) & 63; const size_t m_ = (size_t)(bh_ >> 2) * SEQ + ch_ * 64 + t; const bf16_t* p_ = P + m_ * PW + (bh_ & 3) * 64 + c0; \
        zr = *(const u32x4*)(p_ + PC_HGF); vr = *(const u32x4*)(p_ + PC_HGI); qr = *(const u32x4*)(p_ + PC_HGQ); sr = *(const u32x4*)(SPG + ((size_t)(u_) * 64 + t) * 64 + c0); } while (0)
    if (lo < hi) HO_LOAD(lo);
    for (int u = lo; u < hi; ++u) {
        const int bh = u >> 6, ch = u & 63, b = bh >> 2, h = bh & 3; const size_t m0 = (size_t)b * SEQ + ch * 64;
        float z[8], q[8], bc[8], kk[8], tot[8]; unpack8(zr, z); unpack8(qr, q);
        *(LAS u32x4*)(VV + t * CST + c0 * 2) = vr; *(LAS u32x4*)(SP + t * CST + c0 * 2) = sr;
        if (u + 1 < hi) HO_LOAD(u + 1);
#pragma unroll
        for (int i = 0; i < 8; ++i) hg_gate_fast(z[i], lbv[h * 64 + c0 + i], bc[i], kk[i]);
        scan_t8(bc, tot, wt, lane, wave);
        if ((t & 15) == 15 && t < 63) {
#pragma unroll
            for (int i = 0; i < 8; ++i) refs[(t >> 4) * 64 + c0 + i] = bc[i]; }
        __syncthreads();
        { float o1[8], o2[8], o3[8], o4[8];
          if (t < 32) {
#pragma unroll
              for (int i = 0; i < 8; ++i) { const float r15 = refs[c0 + i], r31 = refs[64 + c0 + i]; const float ea = __expf(bc[i] - r15); o1[i] = q[i] * ea; o2[i] = kk[i] * __builtin_amdgcn_rcpf(ea); o3[i] = kk[i] * __expf(r31 - bc[i]); }
              *(LAS u32x4*)(QA + t * CST + c0 * 2) = pack8(o1); *(LAS u32x4*)(KA + t * CST + c0 * 2) = pack8(o2); *(LAS u32x4*)(KB_ + t * CST + c0 * 2) = pack8(o3);
          } else { const int tt = t - 32;
#pragma unroll
              for (int i = 0; i < 8; ++i) { const float r31 = refs[64 + c0 + i], r47 = refs[128 + c0 + i]; const float ec = __expf(bc[i] - r47); o1[i] = q[i] * __expf(bc[i] - r31); o2[i] = q[i] * ec; o3[i] = kk[i] * __builtin_amdgcn_rcpf(ec); }
              *(LAS u32x4*)(QB + tt * CST + c0 * 2) = pack8(o1); *(LAS u32x4*)(QC + tt * CST + c0 * 2) = pack8(o2); *(LAS u32x4*)(KC + tt * CST + c0 * 2) = pack8(o3); }
#pragma unroll
          for (int i = 0; i < 8; ++i) o4[i] = q[i] * __expf(bc[i]);
          *(LAS u32x4*)(QH + t * CST + c0 * 2) = pack8(o4); }
        __syncthreads();
#pragma unroll
        for (int e2 = 0; e2 < 2; ++e2) { const int e = wave + 8 * e2, ti = e >> 2, si = e & 3; f32x4_t acc = {0.f, 0.f, 0.f, 0.f};
            if (si <= ti) { LAS const unsigned char* Qp = (ti < 2) ? QA : ((si < 2) ? QB : QC); LAS const unsigned char* Kp = (ti < 2) ? KA : ((si < 2) ? KB_ : KC);
                const int qr0 = 16 * (ti & 1), kr0 = 16 * (si & 1);
#pragma unroll
                for (int ks = 0; ks < 2; ++ks) acc = MFMA16(frag_row(Kp, CST, kr0, 32 * ks, lane), frag_row(Qp, CST, qr0, 32 * ks, lane), acc);
                if (si == ti) {
#pragma unroll
                    for (int i = 0; i < 4; ++i) if (4 * (lane >> 4) + i > (lane & 15)) acc[i] = 0.f; } }
            u32x2 w; w.x = cvtpk(acc[0], acc[1]); w.y = cvtpk(acc[2], acc[3]);
            *(LAS u32x2*)(SC + (16 * ti + (lane & 15)) * CST + (16 * si + 4 * (lane >> 4)) * 2) = w; }
        __syncthreads();
        { const int ts = wave >> 1; f32x4_t acc[2]; float ss = 0.f; const int tl = 16 * ts + (lane & 15);
          u32x2 gr[2];
#pragma unroll
          for (int j = 0; j < 2; ++j) gr[j] = *(const u32x2*)(P + (m0 + tl) * PW + PC_HGG + h * 64 + 16 * (2 * (wave & 1) + j) + 4 * (lane >> 4));
#pragma unroll
          for (int j = 0; j < 2; ++j) { const int vt = 2 * (wave & 1) + j; acc[j] = (f32x4_t){0.f, 0.f, 0.f, 0.f};
              acc[j] = MFMA16(frag_tr(VV, CST, 0, 16 * vt, lane), frag_row(SC, CST, 16 * ts, 0, lane), acc[j]);
              if (ts >= 2) acc[j] = MFMA16(frag_tr(VV, CST, 32, 16 * vt, lane), frag_row(SC, CST, 16 * ts, 32, lane), acc[j]);
#pragma unroll
              for (int ks = 0; ks < 2; ++ks) acc[j] = MFMA16(frag_row(SP, CST, 16 * vt, 32 * ks, lane), frag_row(QH, CST, 16 * ts, 32 * ks, lane), acc[j]);
#pragma unroll
              for (int i = 0; i < 4; ++i) ss += acc[j][i] * acc[j][i]; }
          ss += __shfl_xor(ss, 16); ss += __shfl_xor(ss, 32);
          if (lane < 16) ssb[(16 * ts + lane) * 2 + (wave & 1)] = ss;
          __syncthreads();
          const float rstd = rsqrtf((ssb[tl * 2] + ssb[tl * 2 + 1]) * (1.f / 64.f) + EPS);
#pragma unroll
          for (int j = 0; j < 2; ++j) { const int vd = 16 * (2 * (wave & 1) + j) + 4 * (lane >> 4);
              const float g0 = bf2f(gr[j].x & 0xffffu), g1 = bf2f(gr[j].x >> 16), g2 = bf2f(gr[j].y & 0xffffu), g3 = bf2f(gr[j].y >> 16);
              u32x2 w; w.x = cvtpk(acc[j][0] * rstd * siluf_(g0), acc[j][1] * rstd * siluf_(g1)); w.y = cvtpk(acc[j][2] * rstd * siluf_(g2), acc[j][3] * rstd * siluf_(g3));
              *(u32x2*)(Y + (m0 + tl) * DM + 256 + h * 64 + vd) = w; } }
        __syncthreads();
    }
#undef HO_LOAD
}
__device__ __forceinline__ void conv8_regs(const u32x4 (&rows)[4], int spos, LAS const float* cw, float (&o)[8]) {
#pragma unroll
    for (int i = 0; i < 8; ++i) o[i] = 0.f;
#pragma unroll
    for (int j = 0; j < 4; ++j) if (spos - (3 - j) >= 0) { float x[8]; unpack8(rows[j], x);
#pragma unroll
        for (int i = 0; i < 8; ++i) o[i] += cw[j * 512 + i] * x[i]; }
#pragma unroll
    for (int i = 0; i < 8; ++i) o[i] = siluf_(o[i]);
}
__device__ __forceinline__ void ml_gates_regs(const Ctx& c, LAS float* bb, LAS float* igs, float gf, float gi) {
    if (c.tid < 64) { float x = log_sigmoidf_(gf);
#pragma unroll
        for (int off = 1; off < 64; off <<= 1) { const float y = __shfl_up(x, off); if (c.lane >= off) x += y; }
        bb[c.tid] = x; igs[c.tid] = gi; }
}
__device__ __forceinline__ void mlstm_local_units(const Ctx& c, int lo, int hi) {
    LAS unsigned char* KH = c.lds3; LAS unsigned char* VV = KH + 64 * CST; LAS float* bb = (LAS float*)(VV + 64 * VST80); LAS float* igs = bb + 64; LAS const float* cwt = (LAS const float*)(c.lds3 + TAB_OFF) + 256;
    const bf16_t* P = WSP(bf16_t, WS_PACT); const float* GT = WSP(float, WS_GT);
    const int tid = c.tid, lane = c.lane, wave = c.wave, t = tid >> 3, c0 = (tid & 7) * 8;
    u32x4 vr = {}, kr[4] = {}; float gf = 0.f, gi = 0.f;
#define ML_LOAD(u_) do { const int bh_ = (u_) >> 6, ch_ = (u_) & 63, sp_ = ch_ * 64 + t; const size_t mb_ = (size_t)(bh_ >> 2) * SEQ + ch_ * 64, m_ = mb_ + t; const bf16_t* p_ = P + m_ * PW + (bh_ & 3) * 64 + c0; \
        vr = *(const u32x4*)(p_ + PC_MLV); _Pragma("unroll") for (int j_ = 0; j_ < 4; ++j_) if (sp_ - (3 - j_) >= 0) kr[j_] = *(const u32x4*)(p_ + PC_MLK - (size_t)(3 - j_) * PW); \
        if (tid < 64) { gf = GT[(mb_ + tid) * 16 + 8 + (bh_ & 3)]; gi = GT[(mb_ + tid) * 16 + 4 + (bh_ & 3)]; } } while (0)
    if (lo < hi) ML_LOAD(lo);
    for (int u = lo; u < hi; ++u) {
        const int ch = u & 63, h = (u >> 6) & 3;
        ml_gates_regs(c, bb, igs, gf, gi);
        float k[8]; conv8_regs(kr, ch * 64 + t, cwt + 256 + h * 64 + c0, k); const u32x4 vcur = vr;
        if (u + 1 < hi) ML_LOAD(u + 1);
        __syncthreads();
        { const float w = 0.125f * __expf(bb[63] - bb[t] + igs[t]);
#pragma unroll
          for (int i = 0; i < 8; ++i) k[i] *= w; }
        *(LAS u32x4*)(KH + t * CST + c0 * 2) = pack8(k); *(LAS u32x4*)(VV + t * VST80 + c0 * 2) = vcur;
        if ((tid & 7) < 2) *(LAS u32x4*)(VV + t * VST80 + 128 + (tid & 7) * 16) = (u32x4){(tid & 7) == 0 ? 0x3f80u : 0u, 0u, 0u, 0u};
        if (tid == 0) WSP(float, WS_MDEC)[u] = __expf(bb[63]);
        __syncthreads();
#pragma unroll
        for (int j = 0; j < 3; ++j) { const int e = wave + 8 * j; if (e < 20) { const int a = e & 3, bt = e >> 2; f32x4_t acc = {0.f, 0.f, 0.f, 0.f};
#pragma unroll
            for (int ks = 0; ks < 2; ++ks) acc = MFMA16(frag_tr(KH, CST, 32 * ks, 16 * a, lane), frag_tr(VV, VST80, 32 * ks, 16 * bt, lane), acc);
            const int vd = 16 * bt + (lane & 15);
            if (vd < 65) *(f32x4_t*)(WSP(float, WS_MSLOC) + ((size_t)u * 65 + vd) * 64 + 16 * a + 4 * (lane >> 4)) = acc; } }
        __syncthreads();
    }
#undef ML_LOAD
}
__device__ __forceinline__ void mlstm_out_units(const Ctx& c, int lo, int hi) {
    LAS unsigned char* QT = c.lds3; LAS unsigned char* KT = QT + 64 * CST; LAS unsigned char* VV = KT + 64 * CST; LAS unsigned char* CP = VV + 64 * VST80; LAS unsigned char* SC = CP + 80 * CST;
    LAS float* bb = (LAS float*)(SC + 64 * CST); LAS float* igs = bb + 64; LAS float* den = igs + 64; LAS float* ssb = den + 64; LAS const float* cwt = (LAS const float*)(c.lds3 + TAB_OFF) + 256;
    const bf16_t* P = WSP(bf16_t, WS_PACT); const bf16_t* SPG = WSP(bf16_t, WS_MSPREV); const float* GT = WSP(float, WS_GT); bf16_t* Y = WSP(bf16_t, WS_XNY);
    const int tid = c.tid, lane = c.lane, wave = c.wave, t = tid >> 3, c0 = (tid & 7) * 8;
    u32x4 vr = {}, cr = {}, cr2 = {}, qrw[4] = {}, kr[4] = {}; float gf = 0.f, gi = 0.f;
#define MO_LOAD(u_) do { const int bh_ = (u_) >> 6, ch_ = (u_) & 63, sp_ = ch_ * 64 + t; const size_t mb_ = (size_t)(bh_ >> 2) * SEQ + ch_ * 64, m_ = mb_ + t; const bf16_t* p_ = P + m_ * PW + (bh_ & 3) * 64 + c0; \
        vr = *(const u32x4*)(p_ + PC_MLV); cr = *(const u32x4*)(SPG + (size_t)(u_) * 80 * 64 + tid * 8); if (tid < 128) cr2 = *(const u32x4*)(SPG + (size_t)(u_) * 80 * 64 + (512 + tid) * 8); \
        _Pragma("unroll") for (int j_ = 0; j_ < 4; ++j_) if (sp_ - (3 - j_) >= 0) { kr[j_] = *(const u32x4*)(p_ + PC_MLK - (size_t)(3 - j_) * PW); qrw[j_] = *(const u32x4*)(p_ + PC_MLQ - (size_t)(3 - j_) * PW); } \
        if (tid < 64) { gf = GT[(mb_ + tid) * 16 + 8 + (bh_ & 3)]; gi = GT[(mb_ + tid) * 16 + 4 + (bh_ & 3)]; } } while (0)
    if (lo < hi) MO_LOAD(lo);
    for (int u = lo; u < hi; ++u) {
        const int bh = u >> 6, ch = u & 63, b = bh >> 2, h = bh & 3; const size_t m0 = (size_t)b * SEQ + ch * 64;
        ml_gates_regs(c, bb, igs, gf, gi);
        float q[8], k[8]; conv8_regs(qrw, ch * 64 + t, cwt + h * 64 + c0, q); conv8_regs(kr, ch * 64 + t, cwt + 256 + h * 64 + c0, k);
        *(LAS u32x4*)(VV + t * VST80 + c0 * 2) = vr;
        *(LAS u32x4*)(CP + (tid >> 3) * CST + (tid & 7) * 16) = cr; if (tid < 128) *(LAS u32x4*)(CP + (64 + (tid >> 3)) * CST + (tid & 7) * 16) = cr2;
        if ((tid & 7) < 2) *(LAS u32x4*)(VV + t * VST80 + 128 + (tid & 7) * 16) = (u32x4){(tid & 7) == 0 ? 0x3f80u : 0u, 0u, 0u, 0u};
        if (u + 1 < hi) MO_LOAD(u + 1);
        __syncthreads();
        { const float eq = __expf(bb[t]), ek = 0.125f * __expf(igs[t] - bb[t]);
#pragma unroll
          for (int i = 0; i < 8; ++i) { q[i] *= eq; k[i] *= ek; } }
        *(LAS u32x4*)(QT + t * CST + c0 * 2) = pack8(q); *(LAS u32x4*)(KT + t * CST + c0 * 2) = pack8(k);
        __syncthreads();
#pragma unroll
        for (int e2 = 0; e2 < 2; ++e2) { const int e = wave + 8 * e2, ti = e >> 2, si = e & 3; f32x4_t acc = {0.f, 0.f, 0.f, 0.f};
            if (si <= ti) {
#pragma unroll
                for (int ks = 0; ks < 2; ++ks) acc = MFMA16(frag_row(KT, CST, 16 * si, 32 * ks, lane), frag_row(QT, CST, 16 * ti, 32 * ks, lane), acc);
                if (si == ti) {
#pragma unroll
                    for (int i = 0; i < 4; ++i) if (4 * (lane >> 4) + i > (lane & 15)) acc[i] = 0.f; } }
            u32x2 w; w.x = cvtpk(acc[0], acc[1]); w.y = cvtpk(acc[2], acc[3]);
            *(LAS u32x2*)(SC + (16 * ti + (lane & 15)) * CST + (16 * si + 4 * (lane >> 4)) * 2) = w; }
        __syncthreads();
        { const int ts = wave >> 1, hf = wave & 1; f32x4_t acc[3]; const int tl = 16 * ts + (lane & 15);
          u32x2 gr[2];
#pragma unroll
          for (int j = 0; j < 2; ++j) gr[j] = *(const u32x2*)(P + (m0 + tl) * PW + PC_MLO + h * 64 + 16 * (2 * hf + j) + 4 * (lane >> 4));
#pragma unroll
          for (int j = 0; j < 3; ++j) { acc[j] = (f32x4_t){0.f, 0.f, 0.f, 0.f}; if (j < 2 || hf == 0) { const int vt = (j == 2) ? 4 : 2 * hf + j;
              acc[j] = MFMA16(frag_tr(VV, VST80, 0, 16 * vt, lane), frag_row(SC, CST, 16 * ts, 0, lane), acc[j]);
              if (ts >= 2) acc[j] = MFMA16(frag_tr(VV, VST80, 32, 16 * vt, lane), frag_row(SC, CST, 16 * ts, 32, lane), acc[j]);
#pragma unroll
              for (int ks = 0; ks < 2; ++ks) acc[j] = MFMA16(frag_row(CP, CST, 16 * vt, 32 * ks, lane), frag_row(QT, CST, 16 * ts, 32 * ks, lane), acc[j]); } }
          if (hf == 0 && lane < 16) den[16 * ts + lane] = acc[2][0];
          __syncthreads();
          const float inv = 1.f / fmaxf(fabsf(den[tl]), 1.f); float ss = 0.f;
#pragma unroll
          for (int j = 0; j < 2; ++j)
#pragma unroll
              for (int i = 0; i < 4; ++i) { acc[j][i] *= inv; ss += acc[j][i] * acc[j][i]; }
          ss += __shfl_xor(ss, 16); ss += __shfl_xor(ss, 32);
          if (lane < 16) ssb[(16 * ts + lane) * 2 + hf] = ss;
          __syncthreads();
          const float rstd = rsqrtf((ssb[tl * 2] + ssb[tl * 2 + 1]) * (1.f / 64.f) + EPS);
#pragma unroll
          for (int j = 0; j < 2; ++j) { const int vd = 16 * (2 * hf + j) + 4 * (lane >> 4);
              const float g0 = bf2f(gr[j].x & 0xffffu), g1 = bf2f(gr[j].x >> 16), g2 = bf2f(gr[j].y & 0xffffu), g3 = bf2f(gr[j].y >> 16);
              u32x2 w; w.x = cvtpk(acc[j][0] * rstd * sigmoidf_(g0), acc[j][1] * rstd * sigmoidf_(g1)); w.y = cvtpk(acc[j][2] * rstd * sigmoidf_(g2), acc[j][3] * rstd * sigmoidf_(g3));
              *(u32x2*)(Y + (m0 + tl) * DM + 768 + h * 64 + vd) = w; } }
        __syncthreads();
    }
#undef MO_LOAD
}
#ifndef BAL_B_EXTRA
#define BAL_B_EXTRA 8
#endif
#ifndef BAL_D_EXTRA
#define BAL_D_EXTRA 8
#endif

__device__ __forceinline__ void ph_E_glu_naive(const Ctx& c, int l) {
    float* g1 = (float*)c.lds;
    bf16_t* wl = (bf16_t*)(g1 + 64 * 256);
    const bf16_t* G1 = WSP(bf16_t, WS_G1); const bf16_t* WT = WSP(bf16_t, WS_WGLU) + (size_t)l * 256 * 256; bf16_t* Y = WSP(bf16_t, WS_XNY);
    const int t = c.tid >> 3, j8 = c.tid & 7;
    for (int u = c.bid; u < MTOK / 64; u += c.G) {
        const size_t m0 = (size_t)u * 64;
        for (int e = c.tid; e < 64 * 32; e += NTHR) { const int r = e >> 5, c8 = (e & 31) * 8; float v[8]; unpack8(*(const u32x4*)(G1 + (m0 + r) * 256 + c8), v);
#pragma unroll
            for (int i = 0; i < 8; ++i) g1[r * 256 + c8 + i] = v[i]; }
        float yv[32]; float ss = 0.f;
#pragma unroll
        for (int hf = 0; hf < 2; ++hf) {
            __syncthreads();
            for (int e = c.tid; e < 128 * 32; e += NTHR) { const int r = e >> 5, c8 = (e & 31) * 8; *(u32x4*)(wl + r * 264 + c8) = *(const u32x4*)(WT + (size_t)(hf * 128 + r) * 256 + c8); }
            __syncthreads();
#pragma unroll
            for (int i = 0; i < 16; ++i) { const int nl = j8 * 16 + i; float a = 0.f;
                for (int k = 0; k < 256; k += 2) { const unsigned w = *(const unsigned*)(wl + nl * 264 + k); a += g1[t * 256 + k] * bf2f(w & 0xffffu) + g1[t * 256 + k + 1] * bf2f(w >> 16); }
                const float g = g1[t * 256 + hf * 128 + nl]; const float y = g * sigmoidf_(a); yv[hf * 16 + i] = y; ss += y * y; }
        }
        ss += __shfl_xor(ss, 1); ss += __shfl_xor(ss, 2); ss += __shfl_xor(ss, 4);
        const float rstd = rsqrtf(ss * (1.f / 256.f) + EPS);
#pragma unroll
        for (int hf = 0; hf < 2; ++hf)
#pragma unroll
            for (int i8 = 0; i8 < 2; ++i8) { float o[8];
#pragma unroll
                for (int i = 0; i < 8; ++i) o[i] = yv[hf * 16 + i8 * 8 + i] * rstd;
                *(u32x4*)(Y + (m0 + t) * DM + hf * 128 + j8 * 16 + i8 * 8) = pack8(o); }
        __syncthreads();
    }
}


__device__ __forceinline__ void ph_E_glu_fast(const Ctx& c, int l) {
    constexpr int GST = 528;
    LAS unsigned char* GT_ = c.lds3; LAS float* ssb = (LAS float*)(GT_ + 64 * GST);
    const bf16_t* G1 = WSP(bf16_t, WS_G1); const bf16_t* WT = WSP(bf16_t, WS_WGLU) + (size_t)l * 256 * 256; bf16_t* Y = WSP(bf16_t, WS_XNY);
    const int tid = c.tid, lane = c.lane, wave = c.wave;
    for (int u = c.bid; u < MTOK / 64; u += c.G) {
        const size_t m0 = (size_t)u * 64;
#pragma unroll
        for (int e = 0; e < 4; ++e) { const int ci = tid + 512 * e, r = ci >> 5, c8 = (ci & 31) * 8; *(LAS u32x4*)(GT_ + r * GST + c8 * 2) = *(const u32x4*)(G1 + (m0 + r) * 256 + c8); }
        __syncthreads();
        f32x4_t acc[2][4];
#pragma unroll
        for (int j = 0; j < 2; ++j)
#pragma unroll
            for (int mt = 0; mt < 4; ++mt) acc[j][mt] = (f32x4_t){0.f, 0.f, 0.f, 0.f};
#pragma unroll 2
        for (int ks = 0; ks < 8; ++ks) { bf16x8 wf[2], gf[4];
#pragma unroll
            for (int j = 0; j < 2; ++j) wf[j] = *(const bf16x8*)(WT + (size_t)(16 * (2 * wave + j) + (lane & 15)) * 256 + 32 * ks + 8 * (lane >> 4));
#pragma unroll
            for (int mt = 0; mt < 4; ++mt) gf[mt] = frag_row(GT_, GST, 16 * mt, 32 * ks, lane);
#pragma unroll
            for (int j = 0; j < 2; ++j)
#pragma unroll
                for (int mt = 0; mt < 4; ++mt) acc[j][mt] = MFMA16(wf[j], gf[mt], acc[j][mt]); }
#pragma unroll
        for (int mt = 0; mt < 4; ++mt) { float ss = 0.f;
#pragma unroll
            for (int j = 0; j < 2; ++j) { const int n = 16 * (2 * wave + j) + 4 * (lane >> 4); const u32x2 gr = *(LAS const u32x2*)(GT_ + (16 * mt + (lane & 15)) * GST + n * 2);
                const float g0 = bf2f(gr.x & 0xffffu), g1 = bf2f(gr.x >> 16), g2 = bf2f(gr.y & 0xffffu), g3 = bf2f(gr.y >> 16);
                acc[j][mt][0] = g0 * sigmoidf_(acc[j][mt][0]); acc[j][mt][1] = g1 * sigmoidf_(acc[j][mt][1]); acc[j][mt][2] = g2 * sigmoidf_(acc[j][mt][2]); acc[j][mt][3] = g3 * sigmoidf_(acc[j][mt][3]);
#pragma unroll
                for (int i = 0; i < 4; ++i) ss += acc[j][mt][i] * acc[j][mt][i]; }
            ss += __shfl_xor(ss, 16); ss += __shfl_xor(ss, 32);
            if (lane < 16) ssb[(16 * mt + lane) * 8 + wave] = ss; }
        __syncthreads();
#pragma unroll
        for (int mt = 0; mt < 4; ++mt) { const int tl = 16 * mt + (lane & 15); float s = 0.f;
#pragma unroll
            for (int w = 0; w < 8; ++w) s += ssb[tl * 8 + w];
            const float rstd = rsqrtf(s * (1.f / 256.f) + EPS);
#pragma unroll
            for (int j = 0; j < 2; ++j) { const int n = 16 * (2 * wave + j) + 4 * (lane >> 4); u32x2 w; w.x = cvtpk(acc[j][mt][0] * rstd, acc[j][mt][1] * rstd); w.y = cvtpk(acc[j][mt][2] * rstd, acc[j][mt][3] * rstd);
                *(u32x2*)(Y + (m0 + tl) * DM + n) = w; } }
        __syncthreads();
    }
}

__device__ __forceinline__ void ph_rowpass(const Ctx& c, const float* hprev, const float* gpost, float* hout, bf16_t* xn) {
    const bf16_t* MX = WSP(bf16_t, WS_MX);
    const int gw = c.bid * 8 + c.wave, NGW = c.G * 8;
    for (int m = gw; m < MTOK; m += NGW) {
        const u32x2* mr = (const u32x2*)(MX + (size_t)m * DM) + c.lane; const f32x4* hr = (const f32x4*)(hprev + (size_t)m * DM) + c.lane; const f32x4* gr = (const f32x4*)gpost + c.lane;
        f32x4 x[4], hv[4]; float s = 0.f;
#pragma unroll
        for (int j = 0; j < 4; ++j) { const u32x2 w = mr[64 * j]; x[j] = (f32x4){bf2f(w.x & 0xffffu), bf2f(w.x >> 16), bf2f(w.y & 0xffffu), bf2f(w.y >> 16)}; hv[j] = hr[64 * j];
            s += (x[j].x * x[j].x + x[j].y * x[j].y) + (x[j].z * x[j].z + x[j].w * x[j].w); }
        const float r1 = rsqrtf(wave_sum(s) * (1.f / DM) + EPS); float s2 = 0.f;
#pragma unroll
        for (int j = 0; j < 4; ++j) { const f32x4 g = gr[64 * j]; hv[j] = hv[j] + x[j] * r1 * g; s2 += (hv[j].x * hv[j].x + hv[j].y * hv[j].y) + (hv[j].z * hv[j].z + hv[j].w * hv[j].w); }
        f32x4* ho = (f32x4*)(hout + (size_t)m * DM) + c.lane;
#pragma unroll
        for (int j = 0; j < 4; ++j) ho[64 * j] = hv[j];
        if (xn) { const float r2 = rsqrtf(wave_sum(s2) * (1.f / DM) + EPS); u32x2* o8 = (u32x2*)(xn + (size_t)m * DM) + c.lane;
#pragma unroll
            for (int j = 0; j < 4; ++j) { u32x2 w; w.x = pk2(hv[j].x * r2, hv[j].y * r2); w.y = pk2(hv[j].z * r2, hv[j].w * r2); o8[64 * j] = w; } }
    }
}


typedef GAS unsigned gu32;
#define XB_TMO      128
#define XB_XCNT(j)  (256  + 64 * (j))
#define XB_XSUB(j)  (1280 + 64 * (j))
#define XB_XGEN(j)  (2304 + 64 * (j))
#define XB_TOP      3328
#define XB_TOPGEN   3392
#define XCD_BAR_WORDS 3456
#define XB_SPIN_CAP (1u << 22)
constexpr int CW_BAR = 4096;
constexpr int MISC_OFF = LDS_BYTES - 512;
__device__ __forceinline__ unsigned xb_ld(unsigned* p)              { return __hip_atomic_load(p, __ATOMIC_RELAXED, __HIP_MEMORY_SCOPE_AGENT); }
__device__ __forceinline__ unsigned xb_add(unsigned* p, unsigned v) { return __hip_atomic_fetch_add(p, v, __ATOMIC_RELAXED, __HIP_MEMORY_SCOPE_AGENT); }
__device__ __forceinline__ unsigned xb_xcc_id() { return (unsigned)__builtin_amdgcn_s_getreg((3 << 11) | 20) & 0xFu; }
#define XB_SPIN(cond, bar) do { unsigned _sp = 0; while (cond) { __builtin_amdgcn_s_sleep(1); \
    if ((++_sp & 255u) == 0u) { if (xb_ld(&(bar)[XB_TMO])) break; if (_sp > XB_SPIN_CAP) { atomicAdd(&(bar)[XB_TMO], 1u); break; } } } } while (0)
struct XcdBarrier { unsigned* bar; unsigned x; volatile LAS unsigned* st; };
__device__ __forceinline__ XcdBarrier xcd_barrier_post(unsigned* bar, volatile LAS unsigned* st) {
    XcdBarrier b; b.bar = bar; b.x = xb_xcc_id(); b.st = st;
    if (threadIdx.x == 0) (void)xb_add(&bar[XB_XCNT(b.x)], 1u);
    return b;
}
__device__ __forceinline__ void xcd_barrier_complete(unsigned* bar, unsigned x, unsigned& nloc, unsigned& nx) {
    const unsigned G = gridDim.x * gridDim.y * gridDim.z;
    unsigned sum, cnt, mine, sp = 0u;
    for (;;) {
        sum = 0u; cnt = 0u; mine = 0u;
#pragma unroll
        for (unsigned j = 0; j < 16; ++j) { const unsigned c = xb_ld(&bar[XB_XCNT(j)]); sum += c; cnt += (c > 0u) ? 1u : 0u; mine = (j == x) ? c : mine; }
        if (sum == G) break;
        __builtin_amdgcn_s_sleep(1);
        if ((++sp & 255u) == 0u) { if (xb_ld(&bar[XB_TMO])) break; if (sp > XB_SPIN_CAP) { atomicAdd(&bar[XB_TMO], 1u); break; } }
    }
    nloc = mine > 0u ? mine : 1u; nx = cnt > 0u ? cnt : 1u;
}
__device__ __forceinline__ void xcd_barrier(const XcdBarrier& b) {
    asm volatile("s_waitcnt vmcnt(0)" ::: "memory");
    __syncthreads();
    if (threadIdx.x == 0) {
        unsigned* bar = b.bar;
        __builtin_amdgcn_s_waitcnt(0);
        unsigned nloc = b.st[0], nx = b.st[1];
        if (nloc == 0u) { xcd_barrier_complete(bar, b.x, nloc, nx); b.st[0] = nloc; b.st[1] = nx; }
        const unsigned old = xb_add(&bar[XB_XSUB(b.x)], 1u);
        const unsigned gen = old / nloc;
        if (old + 1u == (gen + 1u) * nloc) {
            __builtin_amdgcn_fence(__ATOMIC_RELEASE, "agent");
            asm volatile("s_waitcnt vmcnt(0)" ::: "memory");
            const unsigned og = xb_add(&bar[XB_TOP], 1u);
            const unsigned tg = og / nx;
            if (og + 1u == (tg + 1u) * nx) xb_add(&bar[XB_TOPGEN], 1u);
            else XB_SPIN(xb_ld(&bar[XB_TOPGEN]) == tg, bar);
            __builtin_amdgcn_fence(__ATOMIC_ACQUIRE, "agent");
            xb_add(&bar[XB_XGEN(b.x)], 1u);
            asm volatile("s_waitcnt vmcnt(0)" ::: "memory");
        } else {
            XB_SPIN(xb_ld(&bar[XB_XGEN(b.x)]) == gen, bar);
            __builtin_amdgcn_fence(__ATOMIC_ACQUIRE, "agent");
            asm volatile("s_waitcnt vmcnt(0)" ::: "memory");
        }
    }
    __syncthreads();
}

struct Args { const float* in[23]; float* out; unsigned char* ws; int lo, hi; };
constexpr int NPHASE = 1 + 10 * DEPTH;

__global__ void __launch_bounds__(NTHR, 2) hybrid_fwd(Args args) {
    extern __shared__ __attribute__((aligned(16))) unsigned char lds_raw[];
    Ctx c;
#pragma unroll
    for (int i = 0; i < 23; ++i) c.in[i] = args.in[i];
    c.out = args.out; c.ws = args.ws; c.lds = lds_raw; c.lds3 = (LAS unsigned char*)lds_raw; c.tid = threadIdx.x; c.lane = c.tid & 63; c.wave = __builtin_amdgcn_readfirstlane(c.tid >> 6); c.G = gridDim.x; c.bid = blockIdx.x;
    const int lo = args.lo, hi = args.hi;
    volatile LAS unsigned* MISC = (volatile LAS unsigned*)(c.lds3 + MISC_OFF);
    if (c.tid < 128) MISC[c.tid] = 0u;
    __syncthreads();
    XcdBarrier gbar; gbar.bar = (unsigned*)(args.ws + WS_CTL) + CW_BAR; gbar.x = 0; gbar.st = nullptr;
    if (hi - lo > 1) gbar = xcd_barrier_post((unsigned*)(args.ws + WS_CTL) + CW_BAR, MISC + 8);
#define STAMP(k) do { if (TIME_FROM >= 0 && c.bid == 0 && c.tid == 0) { asm volatile("s_waitcnt vmcnt(0)" ::: "memory"); ((volatile LAS unsigned long long*)(MISC + 16))[(k)] = __builtin_amdgcn_s_memrealtime(); } } while (0)
#define SEAM(k) do { if (IN(k) && IN((k) + 1)) xcd_barrier(gbar); STAMP((k) + 1); } while (0)
#define IN(k) (lo <= (k) && (k) < hi)
#define FRESH() do { c.tid = opaque_v((int)threadIdx.x); c.lane = c.tid & 63; } while (0)
    STAMP(0);
    if (IN(0)) { FRESH(); ph_prologue(c); }
    SEAM(0);
    for (int l = 0; l < DEPTH; ++l) {
        const int pb = 1 + 10 * l;
        if (IN(pb + 0)) {
            EpiInProj E{WSP(bf16_t, WS_U2), WSP(bf16_t, WS_PACT), WSP(float, WS_GT), c.in[I_GB] + l * 12};
#if USE_PG8
            { pg8::Gemm g{WSP(bf16_t, WS_XNY), WSP(bf16_t, WS_WIN) + (size_t)l * NIN * DM, DM, DM, DM, (size_t)256 * DM * 2, (size_t)256 * DM * 2};
              pg8::StaticOrder S; S.init(MTOK, NIN, c.G, c.bid); pg8::EpiWrap<EpiInProj, false> W{E};
              pg8::gemm_phase<pg8::EpiWrap<EpiInProj, false>, pg8::StaticOrder, true>(c.lds3, g, S, W); }
#else
            gemm_naive<false>(c, WSP(bf16_t, WS_XNY), DM, WSP(bf16_t, WS_WIN) + (size_t)l * NIN * DM, DM, DM,
                [](int t, int& r0, int& c0, int& b0) -> bool { if (t >= (MTOK / 64) * (NIN / 64)) return false; r0 = 64 * (t / (NIN / 64)); c0 = b0 = 64 * (t % (NIN / 64)); return true; }, E);
#endif
        }
        SEAM(pb + 0);
        if (IN(pb + 1)) {
            FRESH(); ph_B_texpand(c, l); FRESH(); ph_B_gatescan(c);
            { EpiXloc E{WSP(float, WS_XLOC)};
#if USE_PG8
              { pg8::Gemm g{WSP(bf16_t, WS_U2), WSP(bf16_t, WS_BM) + (size_t)l * 16 * 128 * 1024, U2LD, 1024, 1024, (size_t)256 * U2LD * 2, (size_t)128 * 1024 * 2};
                pg8::SchedXloc S{c.G, c.bid}; pg8::EpiWrap<EpiXloc, false> W{E};
                pg8::gemm_phase<pg8::EpiWrap<EpiXloc, false>, pg8::SchedXloc, false>(c.lds3, g, S, W); __syncthreads(); }
#else
              gemm_naive<false>(c, WSP(bf16_t, WS_U2), U2LD, WSP(bf16_t, WS_BM) + (size_t)l * 16 * 128 * 1024, 1024, 1024,
                [](int t, int& r0, int& c0, int& b0) -> bool { if (t >= 128 * 2) return false; const int rt = t >> 1, ct = t & 1, g = rt >> 3; r0 = 64 * rt; c0 = 256 * g + 64 * ct; b0 = g * 128 + 64 * ct; return true; }, E);
#endif
            }
            FRESH(); stage_tables(c, l);
            { int ulo, uhi; range_split(c.bid, c.G, 2 * NUNIT, 64, BAL_B_EXTRA, ulo, uhi);
              FRESH(); hgrn_local_units(c, ulo < NUNIT ? ulo : NUNIT, uhi < NUNIT ? uhi : NUNIT);
              FRESH(); mlstm_local_units(c, (ulo > NUNIT ? ulo : NUNIT) - NUNIT, (uhi > NUNIT ? uhi : NUNIT) - NUNIT); }
        }
        SEAM(pb + 1);
        if (IN(pb + 2)) { FRESH(); ph_C_scans(c, l); FRESH();
#if FAST_FOX
            ph_C_fox_fast(c);
#else
            ph_C_fox_naive(c);
#endif
        }
        SEAM(pb + 2);
        if (IN(pb + 3)) {
            { EpiS5Y E{WSP(bf16_t, WS_G1)};
#if USE_PG8
              { pg8::Gemm g{WSP(bf16_t, WS_U2), WSP(bf16_t, WS_TT), U2LD, U2LD, U2LD, (size_t)256 * U2LD * 2, (size_t)256 * U2LD * 2};
                pg8::SchedS5Y S{c.G, c.bid}; pg8::EpiWrap<EpiS5Y, false> W{E};
                pg8::gemm_phase<pg8::EpiWrap<EpiS5Y, false>, pg8::SchedS5Y, false>(c.lds3, g, S, W); __syncthreads(); }
#else
              gemm_naive<false>(c, WSP(bf16_t, WS_U2), U2LD, WSP(bf16_t, WS_TT), U2LD, U2LD,
                [](int t, int& r0, int& c0, int& b0) -> bool { if (t >= 128 * 16) return false; const int rt = t >> 4, ct = t & 15, g = rt >> 3; r0 = 64 * rt; c0 = b0 = g * 1024 + 64 * ct; return true; }, E);
#endif
            }
            FRESH(); stage_tables(c, l);
            { int ulo, uhi; range_split(c.bid, c.G, 2 * NUNIT, 128, BAL_D_EXTRA, ulo, uhi);
              FRESH(); hgrn_out_units(c, ulo < NUNIT ? ulo : NUNIT, uhi < NUNIT ? uhi : NUNIT);
              FRESH(); mlstm_out_units(c, (ulo > NUNIT ? ulo : NUNIT) - NUNIT, (uhi > NUNIT ? uhi : NUNIT) - NUNIT); }
        }
        SEAM(pb + 3);
        if (IN(pb + 4)) { FRESH();
#if FAST_GLU
            ph_E_glu_fast(c, l);
#else
            ph_E_glu_naive(c, l);
#endif
        }
        SEAM(pb + 4);
        if (IN(pb + 5)) {
            EpiPlainBf16 E{WSP(bf16_t, WS_MX), DM};
#if USE_PG8
            { pg8::Gemm g{WSP(bf16_t, WS_XNY), WSP(bf16_t, WS_WOUT) + (size_t)l * DM * DM, DM, DM, DM, (size_t)256 * DM * 2, (size_t)256 * DM * 2};
              pg8::StaticOrder S; S.init(MTOK, DM, c.G, c.bid); pg8::EpiWrap<EpiPlainBf16, false> W{E};
              pg8::gemm_phase<pg8::EpiWrap<EpiPlainBf16, false>, pg8::StaticOrder, true>(c.lds3, g, S, W); }
#else
            gemm_naive<false>(c, WSP(bf16_t, WS_XNY), DM, WSP(bf16_t, WS_WOUT) + (size_t)l * DM * DM, DM, DM,
                [](int t, int& r0, int& c0, int& b0) -> bool { if (t >= (MTOK / 64) * 16) return false; r0 = 64 * (t >> 4); c0 = b0 = 64 * (t & 15); return true; }, E);
#endif
        }
        SEAM(pb + 5);
        if (IN(pb + 6)) { FRESH(); } if (IN(pb + 6)) ph_rowpass(c, l == 0 ? c.in[I_X] : c.out, c.in[I_LNMPOST] + l * DM, c.out, WSP(bf16_t, WS_XNY));
        SEAM(pb + 6);
        if (IN(pb + 7)) {
            EpiSwiGLU E{WSP(bf16_t, WS_PACT)};
#if USE_PG8
            { pg8::Gemm g{WSP(bf16_t, WS_XNY), WSP(bf16_t, WS_WGU) + (size_t)l * NGU * DM, DM, DM, DM, (size_t)256 * DM * 2, (size_t)256 * DM * 2};
              pg8::StaticOrder S; S.init(MTOK, NGU, c.G, c.bid); pg8::EpiWrap<EpiSwiGLU, true> W{E};
              pg8::gemm_phase<pg8::EpiWrap<EpiSwiGLU, true>, pg8::StaticOrder, true>(c.lds3, g, S, W); }
#else
            gemm_naive<true>(c, WSP(bf16_t, WS_XNY), DM, WSP(bf16_t, WS_WGU) + (size_t)l * NGU * DM, DM, DM,
                [](int t, int& r0, int& c0, int& b0) -> bool { if (t >= (MTOK / 64) * (DFF / 64)) return false; r0 = 64 * (t / (DFF / 64)); c0 = 64 * (t % (DFF / 64)); b0 = (c0 >> 7) * 256 + (c0 & 127); return true; }, E);
#endif
        }
        SEAM(pb + 7);
        if (IN(pb + 8)) {
            EpiPlainBf16 E{WSP(bf16_t, WS_MX), DM};
#if USE_PG8
            { pg8::Gemm g{WSP(bf16_t, WS_PACT), WSP(bf16_t, WS_WDN) + (size_t)l * DM * DFF, DFF, DFF, DFF, (size_t)256 * DFF * 2, (size_t)256 * DFF * 2};
              pg8::StaticOrder S; S.init(MTOK, DM, c.G, c.bid); pg8::EpiWrap<EpiPlainBf16, false> W{E};
              pg8::gemm_phase<pg8::EpiWrap<EpiPlainBf16, false>, pg8::StaticOrder, true>(c.lds3, g, S, W); }
#else
            gemm_naive<false>(c, WSP(bf16_t, WS_PACT), DFF, WSP(bf16_t, WS_WDN) + (size_t)l * DM * DFF, DFF, DFF,
                [](int t, int& r0, int& c0, int& b0) -> bool { if (t >= (MTOK / 64) * 16) return false; r0 = 64 * (t >> 4); c0 = b0 = 64 * (t & 15); return true; }, E);
#endif
        }
        SEAM(pb + 8);
        if (IN(pb + 9)) { FRESH(); } if (IN(pb + 9)) ph_rowpass(c, c.out, c.in[I_LNFPOST] + l * DM, c.out, (l + 1 < DEPTH) ? WSP(bf16_t, WS_XNY) : (bf16_t*)nullptr);
        SEAM(pb + 9);
    }
#if TIME_FROM >= 0
    if (c.bid == 0 && c.tid == 0) { __threadfence(); volatile LAS unsigned long long* ts = (volatile LAS unsigned long long*)(MISC + 16);
        const float dt = 1.f + (float)(ts[TIME_TO] - ts[TIME_FROM]) * 1e-3f; atomicAdd(c.out, dt); }
#endif
#undef IN
}

extern "C" void kernel_launch(void* const* d_in, const int* in_sizes, int n_in, void* d_out, int out_size, void* d_ws, size_t ws_size, hipStream_t stream) {
    static int grid = 0;
    if (grid == 0) {
        if (n_in != 23 || in_sizes[0] != MTOK * DM || out_size != MTOK * DM || ws_size < WS_END) {
            fprintf(stderr, "kernel_launch: unexpected shapes (n_in %d, in0 %d, out %d, ws %zu, need ws %zu); nothing launched\n", n_in, n_in > 0 ? in_sizes[0] : -1, out_size, ws_size, (size_t)WS_END); grid = -1; return; }
        int dev = 0, cus = 0;
        if (hipGetDevice(&dev) != hipSuccess || hipDeviceGetAttribute(&cus, hipDeviceAttributeMultiprocessorCount, dev) != hipSuccess) { grid = -1; return; }
        if (hipFuncSetAttribute((const void*)hybrid_fwd, hipFuncAttributeMaxDynamicSharedMemorySize, LDS_BYTES) != hipSuccess) { fprintf(stderr, "kernel_launch: hipFuncSetAttribute failed\n"); grid = -1; return; }
        grid = cus;
    }
    if (grid < 0) return;
    (void)hipMemsetAsync((char*)d_ws + WS_CTL, 0, CTL_BYTES, stream);
    Args a{};
    for (int i = 0; i < 23; ++i) a.in[i] = (const float*)d_in[i];
    a.out = (float*)d_out; a.ws = (unsigned char*)d_ws;
#if N_LAUNCH_MODE == 1
    a.lo = 0; a.hi = NPHASE; hipLaunchKernelGGL(hybrid_fwd, dim3(grid), dim3(NTHR), LDS_BYTES, stream, a);
#else
    for (int p = 0; p < NPHASE; ++p) { a.lo = p; a.hi = p + 1; hipLaunchKernelGGL(hybrid_fwd, dim3(grid), dim3(NTHR), LDS_BYTES, stream, a); }
#endif
}
```

```cpp
#include <hip/hip_runtime.h>
#include <cstdio>
#include <cstdint>

#ifndef N_LAUNCH_MODE
#define N_LAUNCH_MODE 1
#endif
#ifndef FAST_FOX
#define FAST_FOX 1
#endif
#ifndef FAST_HGRN
#define FAST_HGRN 1
#endif
#ifndef FAST_MLSTM
#define FAST_MLSTM 1
#endif
#ifndef FAST_GLU
#define FAST_GLU 1
#endif
#ifndef TIME_FROM
#define TIME_FROM -1
#define TIME_TO -1
#endif
#ifndef USE_PG8
#define USE_PG8 1
#endif

#define LAS __attribute__((address_space(3)))
#define GAS __attribute__((address_space(1)))
typedef unsigned short bf16_t;
typedef float f32x4 __attribute__((ext_vector_type(4)));
typedef unsigned u32x4 __attribute__((ext_vector_type(4)));
typedef unsigned u32x2 __attribute__((ext_vector_type(2)));
typedef short bf16x8 __attribute__((ext_vector_type(8)));
typedef float f32x2_t __attribute__((ext_vector_type(2)));

constexpr int NB = 8, SEQ = 4096, DM = 1024, MTOK = NB * SEQ, DEPTH = 2;
constexpr int DIN = 3084, NIN = 3328, DFF = 2816, NGU = 2 * DFF;
constexpr int CL = 64, NCH = SEQ / CL, NCHT = NB * NCH;
constexpr int PW = 2816;
constexpr int U2LD = 1152;
constexpr int NUNIT = NB * 4 * NCH;
constexpr float EPS = 1e-6f;
constexpr float LOG2E = 1.4426950408889634f;
constexpr int PC_HGQ = 0, PC_HGF = 256, PC_HGI = 512, PC_HGG = 768, PC_FXQ = 1024, PC_FXK = 1280, PC_FXV = 1536, PC_MLQ = 1792, PC_MLK = 2048, PC_MLV = 2304, PC_MLO = 2560;

constexpr size_t MiB = 1u << 20;
constexpr size_t WS_CTL = 0, CTL_BYTES = 1 * MiB;
constexpr size_t WS_WIN = 1 * MiB;
constexpr size_t WS_WOUT = 14 * MiB;
constexpr size_t WS_WGU = 18 * MiB;
constexpr size_t WS_WDN = 40 * MiB;
constexpr size_t WS_WGLU = 51 * MiB;
constexpr size_t WS_KERN = 52 * MiB;
constexpr size_t WS_A64 = 54 * MiB;
constexpr size_t WS_BM = 55 * MiB;
constexpr size_t WS_TT = 71 * MiB;
constexpr size_t WS_CM = 107 * MiB;
constexpr size_t WS_U2 = 115 * MiB;
constexpr size_t WS_GT = 133 * MiB;
constexpr size_t WS_FQ = 135 * MiB;
constexpr size_t WS_FK = 139 * MiB;
constexpr size_t WS_FCUM = 143 * MiB;
constexpr size_t WS_KMAX = 143 * MiB + 768 * 1024;
constexpr size_t WS_XNY = 144 * MiB;
constexpr size_t WS_PACT = 208 * MiB;
constexpr size_t WS_SCR = 384 * MiB;
constexpr size_t WS_MX = WS_SCR;
constexpr size_t WS_XLOC = WS_SCR;
constexpr size_t WS_G1 = WS_SCR + 4 * MiB;
constexpr size_t WS_HSLOC = WS_SCR + 20 * MiB;
constexpr size_t WS_HDEC = WS_SCR + 52 * MiB;
constexpr size_t WS_MDEC = WS_SCR + 52 * MiB + 512 * 1024;
constexpr size_t WS_HSPREV = WS_SCR + 53 * MiB;
constexpr size_t WS_MSLOC = WS_SCR + 69 * MiB;
constexpr size_t WS_MSPREV = WS_SCR + 102 * MiB;
constexpr size_t WS_END = 512 * MiB;
static_assert(WS_MSPREV + (size_t)NUNIT * 80 * 64 * 2 <= WS_END, "ws map");
static_assert(WS_MSLOC + (size_t)NUNIT * 65 * 64 * 4 <= WS_MSPREV, "ws map");

constexpr int LDS_BYTES = 147456;
constexpr int NTHR = 512;

__device__ __forceinline__ int opaque_v(int x) { asm volatile("" : "+v"(x)); return x; }
__device__ __forceinline__ float bf2f(unsigned b) { return __uint_as_float(b << 16); }
__device__ __forceinline__ unsigned f2bf(float f) { unsigned u = __float_as_uint(f); return (u + 0x7fffu + ((u >> 16) & 1u)) >> 16; }
typedef __bf16 bf16x2_t __attribute__((ext_vector_type(2)));
__device__ __forceinline__ unsigned pk2(float lo, float hi) { f32x2_t v = {lo, hi}; bf16x2_t b = __builtin_convertvector(v, bf16x2_t); return __builtin_bit_cast(unsigned, b); }
__device__ __forceinline__ float wave_sum(float v) {
#pragma unroll
    for (int o = 1; o < 64; o <<= 1) v += __shfl_xor(v, o);
    return v;
}
__device__ __forceinline__ float sigmoidf_(float x) { return __builtin_amdgcn_rcpf(1.f + __expf(-x)); }
__device__ __forceinline__ float log_sigmoidf_(float x) { return fminf(x, 0.f) - __logf(1.f + __expf(-fabsf(x))); }
__device__ __forceinline__ float siluf_(float x) { return x * sigmoidf_(x); }
__device__ __forceinline__ float gelu_tanh(float x) { const float u = 0.7978845608028654f * (x + 0.044715f * x * x * x); return x * (1.f - __builtin_amdgcn_rcpf(1.f + __expf(2.f * u))); }
__device__ __forceinline__ void unpack8(const u32x4 w, float (&v)[8]) {
    v[0] = bf2f(w.x & 0xffffu); v[1] = bf2f(w.x >> 16); v[2] = bf2f(w.y & 0xffffu); v[3] = bf2f(w.y >> 16);
    v[4] = bf2f(w.z & 0xffffu); v[5] = bf2f(w.z >> 16); v[6] = bf2f(w.w & 0xffffu); v[7] = bf2f(w.w >> 16);
}
__device__ __forceinline__ u32x4 pack8(const float (&v)[8]) { u32x4 w; w.x = pk2(v[0], v[1]); w.y = pk2(v[2], v[3]); w.z = pk2(v[4], v[5]); w.w = pk2(v[6], v[7]); return w; }

struct Ctx {
    const float* in[23]; float* out; unsigned char* ws;
    unsigned char* lds; LAS unsigned char* lds3; int tid, lane, wave, G, bid;
};
#define WSP(T, off) ((T*)(c.ws + (off)))
enum { I_X = 0, I_WIN, I_GB, I_LRE, I_LIM, I_BRE, I_BIM, I_CRE, I_CIM, I_S5D, I_LOGDT, I_WGLU, I_LB, I_CONV, I_GAIN, I_WOUT, I_LNMPRE, I_LNMPOST, I_LNFPRE, I_LNFPOST, I_WG, I_WU, I_WD };

template <bool PAIR, class TileF, class Epi>
__device__ __forceinline__ void gemm_naive(const Ctx& c, const bf16_t* A, int lda, const bf16_t* Bt, int ldb, int K, TileF tf, const Epi& E) {
    float* As = (float*)c.lds;
    float* Bs = As + 64 * 65;
    float* Bs2 = Bs + 64 * 65;
    const int r = c.tid >> 3, cg = c.tid & 7;
    for (int t = c.bid;; t += c.G) {
        int row0, col0, brow0; if (!tf(t, row0, col0, brow0)) break;
        float acc[8], acc2[8];
#pragma unroll
        for (int i = 0; i < 8; ++i) { acc[i] = 0.f; acc2[i] = 0.f; }
        for (int k0 = 0; k0 < K; k0 += 64) {
            __syncthreads();
            { float v[8]; unpack8(*(const u32x4*)(A + (size_t)(row0 + r) * lda + k0 + cg * 8), v);
#pragma unroll
              for (int i = 0; i < 8; ++i) As[r * 65 + cg * 8 + i] = v[i];
              unpack8(*(const u32x4*)(Bt + (size_t)(brow0 + r) * ldb + k0 + cg * 8), v);
#pragma unroll
              for (int i = 0; i < 8; ++i) Bs[r * 65 + cg * 8 + i] = v[i];
              if (PAIR) { unpack8(*(const u32x4*)(Bt + (size_t)(brow0 + 128 + r) * ldb + k0 + cg * 8), v);
#pragma unroll
                  for (int i = 0; i < 8; ++i) Bs2[r * 65 + cg * 8 + i] = v[i]; } }
            __syncthreads();
            for (int k = 0; k < 64; ++k) {
                const float a = As[r * 65 + k];
#pragma unroll
                for (int i = 0; i < 8; ++i) { acc[i] += a * Bs[(cg * 8 + i) * 65 + k]; if (PAIR) acc2[i] += a * Bs2[(cg * 8 + i) * 65 + k]; }
            }
        }
        E(row0 + r, col0 + cg * 8, acc, acc2);
    }
    __syncthreads();
}

struct EpiInProj {
    bf16_t* U2; bf16_t* P; float* GT; const float* gb;
    __device__ __forceinline__ void operator()(int row, int col, const float (&v)[8], const float (&)[8]) const {
        if (col < 256) { const int g = col >> 4, p0 = col & 15, ch = row >> 6, j = row & 63;
            *(u32x4*)(U2 + ((size_t)(g * NCHT + ch) * U2LD + j * 16 + p0)) = pack8(v); }
        else if (col < 3072) { *(u32x4*)(P + (size_t)row * PW + (col - 256)) = pack8(v); }
        else if (col < 3088) { const int i0 = col - 3072;
#pragma unroll
            for (int i = 0; i < 8; ++i) if (i0 + i < 12) GT[(size_t)row * 16 + i0 + i] = v[i] + gb[i0 + i]; }
    }
};
struct EpiPlainBf16 {
    bf16_t* O; int ld;
    __device__ __forceinline__ void operator()(int row, int col, const float (&v)[8], const float (&)[8]) const { *(u32x4*)(O + (size_t)row * ld + col) = pack8(v); }
};
struct EpiSwiGLU {
    bf16_t* O;
    __device__ __forceinline__ void operator()(int row, int col, const float (&g)[8], const float (&u)[8]) const {
        float v[8];
#pragma unroll
        for (int i = 0; i < 8; ++i) v[i] = siluf_(g[i]) * u[i];
        *(u32x4*)(O + (size_t)row * DFF + col) = pack8(v); }
};
struct EpiXloc {
    float* X;
    __device__ __forceinline__ void operator()(int row, int col, const float (&v)[8], const float (&)[8]) const {
        const int cl = col & 255; if (cl < 128) { float* p = X + (size_t)row * 128 + cl; *(f32x4*)p = (f32x4){v[0], v[1], v[2], v[3]}; *(f32x4*)(p + 4) = (f32x4){v[4], v[5], v[6], v[7]}; } }
};
struct EpiS5Y {
    bf16_t* G1;
    __device__ __forceinline__ void operator()(int row, int col, const float (&v)[8], const float (&)[8]) const {
        const int g = row >> 9, ch = row & 511, cl = col - g * 1024, tau = cl >> 4, p0 = cl & 15; float o[8];
#pragma unroll
        for (int i = 0; i < 8; ++i) o[i] = gelu_tanh(v[i]);
        *(u32x4*)(G1 + ((size_t)(ch * 64 + tau) * 256 + g * 16 + p0)) = pack8(o); }
};


namespace pg8 {
constexpr int BM = 256, BK = 64, HALF = 128, HTB = HALF * BK * 2, STAGE_BYTES = 8 * HTB, NXCD = 8, WGM = 8;
__host__ __device__ __forceinline__ int lds_byte(int r, int c) { const int st = (r >> 4) * 2 + (c >> 5), rr = r & 15, cc = c & 31, ob = rr * 64 + cc * 2; return st * 1024 + (ob ^ (((ob >> 9) & 1) << 5)); }
__host__ __device__ __forceinline__ void stage_rc(int b, int& R, int& C) { const int st = b / 1024, sb = b % 1024, swz = sb ^ (((sb >> 9) & 1) << 5); R = (st >> 1) * 16 + swz / 64; C = (st & 1) * 32 + (swz % 64) / 2; }
__host__ __device__ __forceinline__ int perm32(int rho) { const int n = rho >> 4, i = rho & 15; return 8 * (i >> 2) + 4 * n + (i & 3); }
struct Unit { int pm, pn; };
struct Gemm { const bf16_t* A; const bf16_t* Bt; int lda, ldb, K; size_t astep, bstep; };
struct StaticOrder {
    int nM, nN, nwg, G, c;
    __device__ void init(int M, int N, int G_, int c_) { nM = M / BM; nN = N / BM; nwg = nM * nN; G = G_; c = c_; }
    __device__ bool next(int i, Unit& u) const {
        const long L = (long)i * G + c; if (L >= nwg) return false;
        int wgid = (int)L; { const int q = nwg / NXCD, r = nwg % NXCD, xcd = wgid % NXCD, off = wgid / NXCD; wgid = (xcd < r ? xcd * (q + 1) : r * (q + 1) + (xcd - r) * q) + off; }
        const int nig = WGM * nN, gid = wgid / nig, fm = gid * WGM, gsz = (nM - fm) < WGM ? (nM - fm) : WGM;
        u.pm = fm + ((wgid % nig) % gsz); u.pn = (wgid % nig) / gsz; return true;
    }
};
struct SchedXloc { int G, c; __device__ bool next(int i, Unit& u) const { const int L = i * G + c; if (L >= 32) return false; u.pm = L; u.pn = L >> 1; return true; } };
struct SchedS5Y { int G, c; __device__ bool next(int i, Unit& u) const { const int L = i * G + c; if (L >= 128) return false; const int g = L >> 3; u.pm = g * 2 + ((L >> 2) & 1); u.pn = g * 4 + (L & 3); return true; } };

template <class F, bool PAIR> struct EpiWrap {
    F f;
    __device__ __forceinline__ void operator()(const f32x4 (&acc)[2][2][4][2], const Unit& u, int wr, int wc, int fr, int fq) const {
#pragma unroll
        for (int ai = 0; ai < 2; ++ai)
#pragma unroll
            for (int m = 0; m < 4; ++m) { const int row = u.pm * BM + ai * HALF + wr * 64 + m * 16 + fr;
                if (PAIR) { const int col = u.pn * HALF + wc * 32 + 8 * fq;
                    const float g[8] = {acc[ai][0][m][0][0], acc[ai][0][m][0][1], acc[ai][0][m][0][2], acc[ai][0][m][0][3], acc[ai][0][m][1][0], acc[ai][0][m][1][1], acc[ai][0][m][1][2], acc[ai][0][m][1][3]};
                    const float v[8] = {acc[ai][1][m][0][0], acc[ai][1][m][0][1], acc[ai][1][m][0][2], acc[ai][1][m][0][3], acc[ai][1][m][1][0], acc[ai][1][m][1][1], acc[ai][1][m][1][2], acc[ai][1][m][1][3]};
                    f(row, col, g, v); }
                else {
#pragma unroll
                    for (int bj = 0; bj < 2; ++bj) { const int col = u.pn * BM + bj * HALF + wc * 32 + 8 * fq;
                        const float v[8] = {acc[ai][bj][m][0][0], acc[ai][bj][m][0][1], acc[ai][bj][m][0][2], acc[ai][bj][m][0][3], acc[ai][bj][m][1][0], acc[ai][bj][m][1][1], acc[ai][bj][m][1][2], acc[ai][bj][m][1][3]};
                        f(row, col, v, v); } } }
    }
};

template <class Epi, class Sched, bool ALIGN_EPI>
__device__ __forceinline__ void gemm_phase(LAS unsigned char* lds, const Gemm g, const Sched& S, const Epi& E) {
    const int tid = opaque_v((int)threadIdx.x), wid = __builtin_amdgcn_readfirstlane(tid >> 6), lane = tid & 63, wr = wid >> 2, wc = wid & 3, fr = lane & 15, fq = lane >> 4;
    const int K = g.K, nt = K / BK;
    unsigned voffA[2], voffB[2];
#pragma unroll
    for (int i = 0; i < 2; ++i) { int R, C; stage_rc(tid * 16 + i * 8192, R, C); const int Rb = (R & ~31) + perm32(R & 31);
        voffA[i] = (unsigned)(R * g.lda + C) * 2u; voffB[i] = (unsigned)(Rb * g.ldb + C) * 2u; }
    const size_t kstep = (size_t)(BK * 2);
    const size_t hstepA = (size_t)HALF * g.lda * 2, hstepB = (size_t)HALF * g.ldb * 2;
    const unsigned ldsw = (unsigned)wid * 1024u;
    const int aoff = lds_byte(wr * 64 + fr, fq * 8), boff = lds_byte(wc * 32 + fr, fq * 8);
#define PG8_SA(b, h) (((b) * 2 + (h)) * HTB)
#define PG8_SB(b, h) ((4 + (b) * 2 + (h)) * HTB)
#define PG8_STAGE(bufoff, gbase, voff) do { _Pragma("unroll") for (int _i = 0; _i < 2; ++_i) \
        __builtin_amdgcn_global_load_lds((const unsigned*)((const char*)(gbase) + (voff)[_i]), (LAS unsigned*)(lds + (bufoff) + ldsw + _i * 8192), 16, 0, 0); } while (0)
#define PG8_LDA(dst, b, h) do { _Pragma("unroll") for (int m = 0; m < 4; ++m) _Pragma("unroll") for (int k = 0; k < 2; ++k) dst[m][k] = *(const LAS bf16x8*)(lds + PG8_SA(b, h) + aoff + m * 2048 + k * 1024); } while (0)
#define PG8_LDB(dst, b, h) do { _Pragma("unroll") for (int n = 0; n < 2; ++n) _Pragma("unroll") for (int k = 0; k < 2; ++k) dst[n][k] = *(const LAS bf16x8*)(lds + PG8_SB(b, h) + boff + n * 2048 + k * 1024); } while (0)
#define PG8_MMA(ai, bj, At, Bt) do { __builtin_amdgcn_s_setprio(1); _Pragma("unroll") for (int m = 0; m < 4; ++m) _Pragma("unroll") for (int n = 0; n < 2; ++n) _Pragma("unroll") for (int k = 0; k < 2; ++k) \
        acc[ai][bj][m][n] = __builtin_amdgcn_mfma_f32_16x16x32_bf16(Bt[n][k], At[m][k], acc[ai][bj][m][n], 0, 0, 0); __builtin_amdgcn_s_setprio(0); } while (0)
#define PG8_WAIT_V(n) asm volatile("s_waitcnt vmcnt(" #n ")" ::: "memory")
#define PG8_WAIT_L(n) asm volatile("s_waitcnt lgkmcnt(" #n ")" ::: "memory")
#define PG8_BAR __builtin_amdgcn_s_barrier()
#define PG8_SCHED __builtin_amdgcn_sched_barrier(0)
    Unit cur, nxt; int ui = 0;
    if (!S.next(0, cur)) return;
    f32x4 acc[2][2][4][2];
#pragma unroll
    for (int a = 0; a < 2; ++a)
#pragma unroll
        for (int b = 0; b < 2; ++b)
#pragma unroll
            for (int m = 0; m < 4; ++m)
#pragma unroll
                for (int n = 0; n < 2; ++n) acc[a][b][m][n] = (f32x4){0.f, 0.f, 0.f, 0.f};
    bf16x8 At[4][2], B0[2][2], B1[2][2];
    const char* cA = (const char*)g.A + (size_t)cur.pm * g.astep; const char* cB = (const char*)g.Bt + (size_t)cur.pn * g.bstep;
    PG8_STAGE(PG8_SB(0, 0), cB, voffB); PG8_STAGE(PG8_SB(0, 1), cB + hstepB, voffB); PG8_STAGE(PG8_SA(0, 0), cA, voffA); PG8_STAGE(PG8_SA(0, 1), cA + hstepA, voffA);
    if (wr == 1) PG8_BAR;
    PG8_WAIT_V(2); PG8_BAR;
    PG8_STAGE(PG8_SB(1, 0), cB + kstep, voffB); PG8_STAGE(PG8_SA(1, 0), cA + kstep, voffA); PG8_STAGE(PG8_SB(1, 1), cB + hstepB + kstep, voffB);
    PG8_WAIT_V(6); PG8_BAR;
    for (;;) {
        const bool has_next = S.next(ui + 1, nxt);
        const char* nA = has_next ? (const char*)g.A + (size_t)nxt.pm * g.astep : cA; const char* nB = has_next ? (const char*)g.Bt + (size_t)nxt.pn * g.bstep : cB;
        for (int t = 0; t < nt; t += 2) {
            const bool last = (t == nt - 2);
            const char* a1 = cA + (size_t)(t + 1) * kstep;
            const char* a2 = last ? nA : cA + (size_t)(t + 2) * kstep; const char* b2 = last ? nB : cB + (size_t)(t + 2) * kstep;
            const char* a3 = a2 + kstep; const char* b3 = b2 + kstep;
            PG8_LDB(B0, 0, 0); PG8_LDB(B1, 0, 1); PG8_SCHED; PG8_LDA(At, 0, 0); PG8_STAGE(PG8_SA(1, 1), a1 + hstepA, voffA);
            PG8_WAIT_V(8); PG8_WAIT_L(0); PG8_BAR; PG8_MMA(0, 0, At, B0); PG8_MMA(0, 1, At, B1); PG8_BAR; PG8_SCHED;
            PG8_LDA(At, 0, 1); PG8_STAGE(PG8_SB(0, 0), b2, voffB); PG8_STAGE(PG8_SB(0, 1), b2 + hstepB, voffB); PG8_STAGE(PG8_SA(0, 0), a2, voffA);
            PG8_WAIT_V(8); PG8_WAIT_L(0); PG8_BAR; PG8_MMA(1, 0, At, B0); PG8_MMA(1, 1, At, B1); PG8_BAR; PG8_SCHED;
            PG8_LDB(B0, 1, 0); PG8_LDB(B1, 1, 1); PG8_SCHED; PG8_LDA(At, 1, 0); PG8_STAGE(PG8_SA(0, 1), a2 + hstepA, voffA);
            PG8_WAIT_V(8); PG8_WAIT_L(0); PG8_BAR; PG8_MMA(0, 0, At, B0); PG8_MMA(0, 1, At, B1); PG8_BAR; PG8_SCHED;
            PG8_LDA(At, 1, 1); PG8_STAGE(PG8_SB(1, 0), b3, voffB); PG8_STAGE(PG8_SB(1, 1), b3 + hstepB, voffB); PG8_STAGE(PG8_SA(1, 0), a3, voffA);
            PG8_WAIT_V(8); PG8_WAIT_L(0); PG8_BAR; PG8_MMA(1, 0, At, B0); PG8_MMA(1, 1, At, B1); PG8_BAR; PG8_SCHED;
        }
        if constexpr (ALIGN_EPI) { if (wr == 0) PG8_BAR; }
        E(acc, cur, wr, wc, fr, fq);
        if (!has_next) break;
#pragma unroll
        for (int a = 0; a < 2; ++a)
#pragma unroll
            for (int b = 0; b < 2; ++b)
#pragma unroll
                for (int m = 0; m < 4; ++m)
#pragma unroll
                    for (int n = 0; n < 2; ++n) acc[a][b][m][n] = (f32x4){0.f, 0.f, 0.f, 0.f};
        cur = nxt; cA = nA; cB = nB; ++ui;
        if constexpr (ALIGN_EPI) { if (wr == 1) PG8_BAR; }
    }
    PG8_WAIT_V(0);
    if constexpr (!ALIGN_EPI) { if (wr == 0) PG8_BAR; }
    PG8_BAR;
#undef PG8_SA
#undef PG8_SB
#undef PG8_STAGE
#undef PG8_LDA
#undef PG8_LDB
#undef PG8_MMA
#undef PG8_WAIT_V
#undef PG8_WAIT_L
#undef PG8_BAR
#undef PG8_SCHED
}
}

template <class SrcF>
__device__ __forceinline__ void transpose_item(SrcF src4, bf16_t* WT, int ldw, int k0, int n0, float* scr, int lane) {
    f32x4 v[16];
#pragma unroll
    for (int i = 0; i < 16; ++i) v[i] = src4(k0 + 4 * i + (lane >> 4), n0 + 4 * (lane & 15));
#pragma unroll
    for (int i = 0; i < 16; ++i) { float* s = scr + (4 * i + (lane >> 4)) * 65 + 4 * (lane & 15); s[0] = v[i].x; s[1] = v[i].y; s[2] = v[i].z; s[3] = v[i].w; }
    __builtin_amdgcn_wave_barrier(); asm volatile("s_waitcnt lgkmcnt(0)" ::: "memory");
    const int cc = lane & 7;
#pragma unroll
    for (int j = 0; j < 8; ++j) { const int n = (lane >> 3) + 8 * j; const float* s = scr + (8 * cc) * 65 + n;
        u32x4 o; o.x = pk2(s[0 * 65], s[1 * 65]); o.y = pk2(s[2 * 65], s[3 * 65]); o.z = pk2(s[4 * 65], s[5 * 65]); o.w = pk2(s[6 * 65], s[7 * 65]);
        *(u32x4*)(WT + (size_t)(n0 + n) * ldw + k0 + 8 * cc) = o; }
    asm volatile("s_waitcnt lgkmcnt(0)" ::: "memory"); __builtin_amdgcn_wave_barrier();
}
__device__ __forceinline__ int win_src_col(int n) {
    if (n < 2048) return n;
    if (n < 3072) return n + 4;
    const int i = n - 3072;
    if (i < 4) return 2048 + i;
    if (i < 8) return 3076 + (i - 4);
    if (i < 12) return 3080 + (i - 8);
    return -1;
}
__device__ __forceinline__ void rms_row_to_bf16(const float* xrow, bf16_t* orow, int lane) {
    const f32x4* xr = (const f32x4*)xrow + lane; f32x4 v[4]; float s = 0.f;
#pragma unroll
    for (int j = 0; j < 4; ++j) { v[j] = xr[64 * j]; s += (v[j].x * v[j].x + v[j].y * v[j].y) + (v[j].z * v[j].z + v[j].w * v[j].w); }
    const float rstd = rsqrtf(wave_sum(s) * (1.f / DM) + EPS);
    u32x2* o8 = (u32x2*)orow + lane;
#pragma unroll
    for (int j = 0; j < 4; ++j) { u32x2 w; w.x = pk2(v[j].x * rstd, v[j].y * rstd); w.y = pk2(v[j].z * rstd, v[j].w * rstd); o8[64 * j] = w; }
}
__device__ __forceinline__ void ph_prologue(const Ctx& c) {
    float* scr = (float*)c.lds + c.wave * (64 * 65);
    const int gw = c.bid * 8 + c.wave, NGW = c.G * 8;
    constexpr int IT_IN = (NIN / 64) * (DM / 64), IT_OUT = (DM / 64) * (DM / 64), IT_GU = (NGU / 64) * (DM / 64), IT_DN = (DM / 64) * (DFF / 64), IT_GLU = (256 / 64) * (256 / 64);
    constexpr int IT_L = IT_IN + IT_OUT + IT_GU + IT_DN + IT_GLU;
    for (int it = gw; it < DEPTH * IT_L; it += NGW) {
        const int l = it / IT_L; int r = it % IT_L;
        if (r < IT_IN) { const int nb = r % (NIN / 64), kb = r / (NIN / 64); const float* W = c.in[I_WIN] + (size_t)l * DM * DIN; const float* ln = c.in[I_LNMPRE] + l * DM;
            if (nb < 48) transpose_item([=](int k, int n) -> f32x4 { const int sc = (n < 2048) ? n : n + 4; const float s = ln[k] * ((n >= 1280 && n < 1536) ? 0.125f * LOG2E : 1.f); return *(const f32x4*)(W + (size_t)k * DIN + sc) * s; },
                WSP(bf16_t, WS_WIN) + (size_t)l * NIN * DM, DM, kb * 64, nb * 64, scr, c.lane);
            else transpose_item([=](int k, int n) -> f32x4 { const float s = ln[k]; f32x4 v; const int s0 = win_src_col(n), s1 = win_src_col(n + 1), s2 = win_src_col(n + 2), s3 = win_src_col(n + 3);
                    const float* wr = W + (size_t)k * DIN; const float a0 = wr[s0 < 0 ? 0 : s0], a1 = wr[s1 < 0 ? 0 : s1], a2 = wr[s2 < 0 ? 0 : s2], a3 = wr[s3 < 0 ? 0 : s3];
                    v.x = s0 < 0 ? 0.f : a0 * s; v.y = s1 < 0 ? 0.f : a1 * s; v.z = s2 < 0 ? 0.f : a2 * s; v.w = s3 < 0 ? 0.f : a3 * s; return v; },
                WSP(bf16_t, WS_WIN) + (size_t)l * NIN * DM, DM, kb * 64, nb * 64, scr, c.lane);
            continue; }
        r -= IT_IN;
        if (r < IT_OUT) { const int nb = r % (DM / 64), kb = r / (DM / 64); const float* W = c.in[I_WOUT] + (size_t)l * DM * DM; const float* gn = c.in[I_GAIN] + l * DM;
            transpose_item([=](int k, int n) -> f32x4 { return *(const f32x4*)(W + (size_t)k * DM + n) * gn[k]; }, WSP(bf16_t, WS_WOUT) + (size_t)l * DM * DM, DM, kb * 64, nb * 64, scr, c.lane); continue; }
        r -= IT_OUT;
        if (r < IT_GU) { const int nb = r % (NGU / 64), kb = r / (NGU / 64); const float* Wg = c.in[I_WG] + (size_t)l * DM * DFF; const float* Wu = c.in[I_WU] + (size_t)l * DM * DFF; const float* ln = c.in[I_LNFPRE] + l * DM;
            transpose_item([=](int k, int n) -> f32x4 { const int tile = n >> 8, hf = (n >> 7) & 1, j = tile * 128 + (n & 127); return *(const f32x4*)((hf ? Wu : Wg) + (size_t)k * DFF + j) * ln[k]; },
                WSP(bf16_t, WS_WGU) + (size_t)l * NGU * DM, DM, kb * 64, nb * 64, scr, c.lane); continue; }
        r -= IT_GU;
        if (r < IT_DN) { const int nb = r % (DM / 64), kb = r / (DM / 64); const float* W = c.in[I_WD] + (size_t)l * DFF * DM;
            transpose_item([=](int k, int n) -> f32x4 { return *(const f32x4*)(W + (size_t)k * DM + n); }, WSP(bf16_t, WS_WDN) + (size_t)l * DM * DFF, DFF, kb * 64, nb * 64, scr, c.lane); continue; }
        r -= IT_DN;
        { const int nb = r % 4, kb = r / 4; const float* W = c.in[I_WGLU] + (size_t)l * 256 * 256;
            transpose_item([=](int k, int n) -> f32x4 { return *(const f32x4*)(W + (size_t)k * 256 + n); }, WSP(bf16_t, WS_WGLU) + (size_t)l * 256 * 256, 256, kb * 64, nb * 64, scr, c.lane); }
    }
    for (int m = 2 * gw; m < MTOK; m += 2 * NGW) {
        const f32x4* x0 = (const f32x4*)(c.in[I_X] + (size_t)m * DM) + c.lane; const f32x4* x1 = x0 + DM / 4; f32x4 v0[4], v1[4]; float s0 = 0.f, s1 = 0.f;
#pragma unroll
        for (int j = 0; j < 4; ++j) { v0[j] = x0[64 * j]; v1[j] = x1[64 * j]; }
#pragma unroll
        for (int j = 0; j < 4; ++j) { s0 += (v0[j].x * v0[j].x + v0[j].y * v0[j].y) + (v0[j].z * v0[j].z + v0[j].w * v0[j].w); s1 += (v1[j].x * v1[j].x + v1[j].y * v1[j].y) + (v1[j].z * v1[j].z + v1[j].w * v1[j].w); }
        const float r0 = rsqrtf(wave_sum(s0) * (1.f / DM) + EPS), r1 = rsqrtf(wave_sum(s1) * (1.f / DM) + EPS);
        u32x2* o0 = (u32x2*)(WSP(bf16_t, WS_XNY) + (size_t)m * DM) + c.lane; u32x2* o1 = o0 + DM / 4;
#pragma unroll
        for (int j = 0; j < 4; ++j) { u32x2 w; w.x = pk2(v0[j].x * r0, v0[j].y * r0); w.y = pk2(v0[j].z * r0, v0[j].w * r0); o0[64 * j] = w; w.x = pk2(v1[j].x * r1, v1[j].y * r1); w.y = pk2(v1[j].z * r1, v1[j].w * r1); o1[64 * j] = w; }
    }
    __syncthreads();
    float* sh = (float*)c.lds;
    float* cre = sh + 256; float* cim = cre + 1024; float* bre = cim + 1024; float* bim = bre + 1024;
    for (int it = c.bid; it < DEPTH * 16 * 13; it += c.G) {
        const int l = it / (16 * 13), g = (it / 13) % 16, db = it % 13;
        { const size_t o = (size_t)(l * 16 + g) * 1024;
          for (int e = c.tid; e < 1024; e += NTHR) { cre[e] = c.in[I_CRE][o + e]; cim[e] = c.in[I_CIM][o + e]; bre[e] = c.in[I_BRE][o + e]; bim[e] = c.in[I_BIM][o + e]; } }
        double a1r = 1., a1i = 0., cfr = 0., cfi = 0., wr = 1., wi = 0.;
        if (c.tid < 64) { const int n = c.tid;
            const double lr = (double)fminf(c.in[I_LRE][(l * 16 + g) * 64 + n], -1e-4f), li = (double)c.in[I_LIM][(l * 16 + g) * 64 + n], dt = exp((double)c.in[I_LOGDT][l * 16 + g]);
            const double mag1 = exp(lr * dt); a1r = mag1 * cos(li * dt); a1i = mag1 * sin(li * dt); const double den = lr * lr + li * li;
            cfr = ((a1r - 1.0) * lr + a1i * li) / den; cfi = (a1i * lr - (a1r - 1.0) * li) / den;
            double br = a1r, bi = a1i;
            for (int e = db * 5; e > 0; e >>= 1) { if (e & 1) { const double t = wr * br - wi * bi; wi = wr * bi + wi * br; wr = t; } const double t2 = br * br - bi * bi; bi = 2.0 * br * bi; br = t2; } }
#pragma unroll 1
        for (int d = db * 5; d < db * 5 + 5; ++d) {
            __syncthreads();
            if (c.tid < 64) { const int n = c.tid;
                sh[n] = (float)wr; sh[64 + n] = (float)wi; sh[128 + n] = (float)(wr * cfr - wi * cfi); sh[192 + n] = (float)(wr * cfi + wi * cfr);
                if (d == 64) { float* a64 = WSP(float, WS_A64) + ((size_t)(l * 16 + g) * 64 + n) * 2; a64[0] = (float)wr; a64[1] = (float)wi; }
                const double t = wr * a1r - wi * a1i; wi = wr * a1i + wi * a1r; wr = t; }
            __syncthreads();
            if (d < 64 && c.tid < 256) { const int p = c.tid >> 4, pp = c.tid & 15; float s = 0.f;
#pragma unroll 8
                for (int n = 0; n < 64; ++n) { const float wcr = sh[128 + n], wci = sh[192 + n], br = bre[n * 16 + pp], bi = bim[n * 16 + pp];
                    const float xr = wcr * br - wci * bi, xi = wcr * bi + wci * br; s += cre[p * 64 + n] * xr - cim[p * 64 + n] * xi; }
                if (d == 0 && p == pp) s += c.in[I_S5D][l * 256 + g * 16 + p];
                WSP(float, WS_KERN)[(((size_t)(l * 16 + g) * 64 + d) * 16 + p) * 16 + pp] = s; }
            if (d < 64) { const int j = 63 - d; bf16_t* bm = WSP(bf16_t, WS_BM) + (size_t)(l * 16 + g) * 128 * 1024;
#pragma unroll
                for (int e = 0; e < 4; ++e) { const int idx = c.tid * 4 + e, row = idx >> 4, pp = idx & 15, n = row >> 1, ri = row & 1;
                    const float wcr = sh[128 + n], wci = sh[192 + n], br = bre[n * 16 + pp], bi = bim[n * 16 + pp];
                    const float val = ri ? (wcr * bi + wci * br) : (wcr * br - wci * bi);
                    bm[(size_t)row * 1024 + j * 16 + pp] = (bf16_t)f2bf(val); } }
            if (d >= 1) { const int tau = d - 1; bf16_t* cm = WSP(bf16_t, WS_CM) + (size_t)(l * 16 + g) * 1024 * 128;
#pragma unroll
                for (int e = 0; e < 4; ++e) { const int idx = c.tid * 4 + e, p = idx >> 7, q = idx & 127, n = q >> 1, ri = q & 1;
                    const float wr = sh[n], wi = sh[64 + n], cr = cre[p * 64 + n], ci = cim[p * 64 + n];
                    const float val = ri ? -(cr * wi + ci * wr) : (cr * wr - ci * wi);
                    cm[(size_t)(tau * 16 + p) * 128 + q] = (bf16_t)f2bf(val); } }
        }
        __syncthreads();
    }
}

__device__ __forceinline__ void ph_B_texpand(const Ctx& c, int l) {
    bf16_t* TT = WSP(bf16_t, WS_TT);
    const float* KERN = WSP(float, WS_KERN) + (size_t)l * 16 * 64 * 256;
    const bf16_t* CM = WSP(bf16_t, WS_CM) + (size_t)l * 16 * 1024 * 128;
    for (int it = c.bid; it < 16 * 64; it += c.G) {
        const int g = it >> 6, tau = it & 63;
        for (int e = c.tid; e < 16 * (U2LD / 8); e += NTHR) {
            const int p = e / (U2LD / 8), c8 = (e % (U2LD / 8)) * 8; u32x4 w;
            if (c8 < 1024) { const int j = c8 >> 4, pp0 = c8 & 15;
                if (j <= tau) { const float* k = KERN + (((size_t)g * 64 + (tau - j)) * 16 + p) * 16 + pp0; w.x = pk2(k[0], k[1]); w.y = pk2(k[2], k[3]); w.z = pk2(k[4], k[5]); w.w = pk2(k[6], k[7]); }
                else w = (u32x4){0u, 0u, 0u, 0u}; }
            else w = *(const u32x4*)(CM + ((size_t)(g * 1024 + tau * 16 + p)) * 128 + (c8 - 1024));
            *(u32x4*)(TT + ((size_t)(g * 1024 + tau * 16 + p)) * U2LD + c8) = w; }
    }
}
__device__ __forceinline__ void split3(float F, unsigned& hi, unsigned& mid, unsigned& lo) { hi = f2bf(F); float r = F - bf2f(hi); mid = f2bf(r); r -= bf2f(mid); lo = f2bf(r); }
__device__ __forceinline__ void ph_B_gatescan(const Ctx& c) {
    float* sh = (float*)c.lds;
    const float* GT = WSP(float, WS_GT);
    for (int it = (c.bid + c.G - (32 % c.G)) % c.G; it < NB * 4; it += c.G) {
        const int b = it >> 2, h = it & 3; const size_t m0 = (size_t)b * SEQ + c.tid * 8;
        float ls[8]; float run = 0.f;
#pragma unroll
        for (int i = 0; i < 8; ++i) { run += log_sigmoidf_(GT[(m0 + i) * 16 + h]); ls[i] = run; }
        float inc = run;
#pragma unroll
        for (int o = 1; o < 64; o <<= 1) { const float y = __shfl_up(inc, o); if (c.lane >= o) inc += y; }
        __syncthreads(); if (c.lane == 63) sh[c.wave] = inc; __syncthreads();
        float off = inc - run;
#pragma unroll
        for (int w = 0; w < 8; ++w) if (w < c.wave) off += sh[w];
#pragma unroll
        for (int i = 0; i < 8; ++i) { const float F = (off + ls[i]) * LOG2E; const size_t m = m0 + i;
            WSP(float, WS_FCUM)[m * 4 + h] = F;
            unsigned hi, mid, lo; split3(F, hi, mid, lo); const unsigned one = 0x3f80u;
            u32x4 q0, q1 = (u32x4){0u, 0u, 0u, 0u}, k0;
            q0.x = hi | (mid << 16); q0.y = lo | (one << 16); q0.z = one | (one << 16); q0.w = 0u;
            k0.x = one | (one << 16); k0.y = one | ((hi ^ 0x8000u) << 16); k0.z = (mid ^ 0x8000u) | ((lo ^ 0x8000u) << 16); k0.w = 0u;
            u32x4* fq = (u32x4*)(WSP(bf16_t, WS_FQ) + (m * 4 + h) * 16); fq[0] = q0; fq[1] = q1;
            u32x4* fk = (u32x4*)(WSP(bf16_t, WS_FK) + (m * 4 + h) * 16); fk[0] = k0; fk[1] = q1; }
        __syncthreads();
    }
}

__device__ __forceinline__ void ph_B_kmax(const Ctx& c) {
    const bf16_t* P = WSP(bf16_t, WS_PACT); const int gw = c.bid * 8 + c.wave, NGW = c.G * 8;
    for (int it = NGW - 1 - gw; it < 32 * 64; it += NGW) { const int bh = it >> 6, tl = it & 63, b = bh >> 2, h = bh & 3; const size_t m = (size_t)b * SEQ + tl * 64 + c.lane; float s = 0.f;
#pragma unroll
        for (int j = 0; j < 8; ++j) { float v[8]; unpack8(*(const u32x4*)(P + m * PW + PC_FXK + h * 64 + 8 * j), v);
#pragma unroll
            for (int i = 0; i < 8; ++i) s += v[i] * v[i]; }
        float n = sqrtf(s);
#pragma unroll
        for (int o = 1; o < 64; o <<= 1) n = fmaxf(n, __shfl_xor(n, o));
        if (c.lane == 0) WSP(float, WS_KMAX)[it] = n; }
}
__device__ __forceinline__ void hg_gate(float z, float lb, float& logf, float& kk) {
    logf = log_sigmoidf_(z) + log1pf(lb * __expf(fminf(-z, 60.f)));
    kk = (1.f - lb) * sigmoidf_(-z);
}
__device__ __forceinline__ float hg_lb(const Ctx& c, int l, int ch) {
    if (l == 0) return 0.f;
    const float a = c.in[I_LB][ch], b = c.in[I_LB][256 + ch]; return fmaxf(1.f / (1.f + __expf(a - b)), 0.f);
}
__device__ __forceinline__ void ph_B_hgrn_local_naive(const Ctx& c, int l) {
    float* lg = (float*)c.lds; float* kk = lg + 4096; float* vv = kk + 4096;
    const bf16_t* P = WSP(bf16_t, WS_PACT);
    const int t = c.tid >> 3, c0 = (c.tid & 7) * 8;
    for (int u = c.bid; u < NUNIT; u += c.G) {
        const int bh = u >> 6, ch = u & 63, b = bh >> 2, h = bh & 3; const size_t m = (size_t)b * SEQ + ch * 64 + t;
        { float z[8], v[8]; unpack8(*(const u32x4*)(P + m * PW + PC_HGF + h * 64 + c0), z); unpack8(*(const u32x4*)(P + m * PW + PC_HGI + h * 64 + c0), v);
#pragma unroll
          for (int i = 0; i < 8; ++i) { float lf, k; hg_gate(z[i], hg_lb(c, l, h * 64 + c0 + i), lf, k); lg[t * 64 + c0 + i] = lf; kk[t * 64 + c0 + i] = k; vv[t * 64 + c0 + i] = v[i]; } }
        __syncthreads();
        if (c.tid < 64) { float a = 0.f; for (int s = 0; s < 64; ++s) { a += lg[s * 64 + c.tid]; lg[s * 64 + c.tid] = a; } }
        __syncthreads();
#pragma unroll
        for (int i = 0; i < 8; ++i) kk[t * 64 + c0 + i] *= __expf(lg[63 * 64 + c0 + i] - lg[t * 64 + c0 + i]);
        __syncthreads();
        { const int vd = t; float acc[8];
#pragma unroll
          for (int i = 0; i < 8; ++i) acc[i] = 0.f;
          for (int s = 0; s < 64; ++s) { const float v = vv[s * 64 + vd];
#pragma unroll
              for (int i = 0; i < 8; ++i) acc[i] += v * kk[s * 64 + c0 + i]; }
          float* o = WSP(float, WS_HSLOC) + ((size_t)u * 64 + vd) * 64 + c0; *(f32x4*)o = (f32x4){acc[0], acc[1], acc[2], acc[3]}; *(f32x4*)(o + 4) = (f32x4){acc[4], acc[5], acc[6], acc[7]}; }
        if (c.tid < 64) WSP(float, WS_HDEC)[(size_t)u * 64 + c.tid] = __expf(lg[63 * 64 + c.tid]);
        __syncthreads();
    }
}
__device__ __forceinline__ void ml_conv8(const Ctx& c, int l, const bf16_t* P, size_t m, int spos, int pcol, int wch, float (&o)[8]) {
    const float* cw = c.in[I_CONV] + (size_t)l * 4 * 512;
#pragma unroll
    for (int i = 0; i < 8; ++i) o[i] = 0.f;
#pragma unroll
    for (int j = 0; j < 4; ++j) { const int dt = 3 - j; if (spos - dt >= 0) { float x[8]; unpack8(*(const u32x4*)(P + (m - dt) * PW + pcol), x);
#pragma unroll
            for (int i = 0; i < 8; ++i) o[i] += cw[j * 512 + wch + i] * x[i]; } }
#pragma unroll
    for (int i = 0; i < 8; ++i) o[i] = siluf_(o[i]);
}
__device__ __forceinline__ void ph_B_mlstm_local_naive(const Ctx& c, int l) {
    float* kh = (float*)c.lds; float* vv = kh + 4096; float* bb = vv + 4096; float* ig = bb + 64;
    const bf16_t* P = WSP(bf16_t, WS_PACT); const float* GT = WSP(float, WS_GT);
    const int t = c.tid >> 3, c0 = (c.tid & 7) * 8;
    for (int u = c.bid; u < NUNIT; u += c.G) {
        const int bh = u >> 6, ch = u & 63, b = bh >> 2, h = bh & 3; const size_t m = (size_t)b * SEQ + ch * 64 + t;
        if (c.tid < 64) { const size_t mm = (size_t)b * SEQ + ch * 64 + c.tid; bb[c.tid] = log_sigmoidf_(GT[mm * 16 + 8 + h]); ig[c.tid] = GT[mm * 16 + 4 + h]; }
        __syncthreads();
        if (c.tid == 0) { float a = 0.f; for (int s = 0; s < 64; ++s) { a += bb[s]; bb[s] = a; } }
        __syncthreads();
        { float k[8], v[8]; ml_conv8(c, l, P, m, ch * 64 + t, PC_MLK + h * 64 + c0, 256 + h * 64 + c0, k); unpack8(*(const u32x4*)(P + m * PW + PC_MLV + h * 64 + c0), v);
          const float w = 0.125f * __expf(bb[63] - bb[t] + ig[t]);
#pragma unroll
          for (int i = 0; i < 8; ++i) { kh[t * 64 + c0 + i] = k[i] * w; vv[t * 64 + c0 + i] = v[i]; } }
        __syncthreads();
        for (int vd = t; vd < 65; vd += 64) { float acc[8];
#pragma unroll
            for (int i = 0; i < 8; ++i) acc[i] = 0.f;
            for (int s = 0; s < 64; ++s) { const float v = (vd < 64) ? vv[s * 64 + vd] : 1.f;
#pragma unroll
                for (int i = 0; i < 8; ++i) acc[i] += v * kh[s * 64 + c0 + i]; }
            float* o = WSP(float, WS_MSLOC) + ((size_t)u * 65 + vd) * 64 + c0; *(f32x4*)o = (f32x4){acc[0], acc[1], acc[2], acc[3]}; *(f32x4*)(o + 4) = (f32x4){acc[4], acc[5], acc[6], acc[7]}; }
        if (c.tid == 0) WSP(float, WS_MDEC)[u] = __expf(bb[63]);
        __syncthreads();
    }
}

__device__ __forceinline__ void ph_C_scans(const Ctx& c, int l) {
    const int NGT = c.G * NTHR;
    { const int gt = ((c.bid + c.G - (112 % c.G)) % c.G) * NTHR + c.tid;
      const float* XL = WSP(float, WS_XLOC); bf16_t* U2 = WSP(bf16_t, WS_U2); const float* A64 = WSP(float, WS_A64) + (size_t)l * 16 * 64 * 2;
      for (int i = gt; i < 16 * NB * 64; i += NGT) { const int n = i & 63, b = (i >> 6) & 7, g = i >> 9; const float ar = A64[(g * 64 + n) * 2], ai = A64[(g * 64 + n) * 2 + 1]; float xr = 0.f, xi = 0.f;
          const size_t row0 = (size_t)g * NCHT + b * NCH;
#pragma unroll 1
          for (int cb = 0; cb < NCH; cb += 16) { float lr[16], li[16];
#pragma unroll
              for (int k = 0; k < 16; ++k) { const f32x2_t v = *(const f32x2_t*)(XL + (row0 + cb + k) * 128 + 2 * n); lr[k] = v.x; li[k] = v.y; }
#pragma unroll
              for (int k = 0; k < 16; ++k) { *(unsigned*)(U2 + (row0 + cb + k) * U2LD + 1024 + 2 * n) = pk2(xr, xi);
                  const float nr = ar * xr - ai * xi + lr[k], ni = ar * xi + ai * xr + li[k]; xr = nr; xi = ni; } } } }
    { const int gt = c.bid * NTHR + c.tid;
      const float* SL = WSP(float, WS_HSLOC); const float* DC = WSP(float, WS_HDEC); bf16_t* SP = WSP(bf16_t, WS_HSPREV);
      for (int i = gt; i < 32 * 64 * 32; i += NGT) { const int k2 = (i & 31) * 2, vd = (i >> 5) & 63, bh = i >> 11; float s0 = 0.f, s1 = 0.f;
#pragma unroll 1
          for (int cb = 0; cb < NCH; cb += 16) { f32x2_t sl[16], dc[16];
#pragma unroll
              for (int k = 0; k < 16; ++k) { const size_t u = (size_t)bh * 64 + cb + k; sl[k] = *(const f32x2_t*)(SL + (u * 64 + vd) * 64 + k2); dc[k] = *(const f32x2_t*)(DC + u * 64 + k2); }
#pragma unroll
              for (int k = 0; k < 16; ++k) { const size_t u = (size_t)bh * 64 + cb + k; *(unsigned*)(SP + (u * 64 + vd) * 64 + k2) = pk2(s0, s1);
                  s0 = dc[k].x * s0 + sl[k].x; s1 = dc[k].y * s1 + sl[k].y; } } } }
    { const int gt = ((c.bid + c.G - (126 % c.G)) % c.G) * NTHR + c.tid;
      const float* SL = WSP(float, WS_MSLOC); const float* DC = WSP(float, WS_MDEC); bf16_t* SP = WSP(bf16_t, WS_MSPREV);
      for (int i = gt; i < 32 * 65 * 32; i += NGT) { const int k2 = (i & 31) * 2, vd = (i >> 5) % 65, bh = (i >> 5) / 65; float s0 = 0.f, s1 = 0.f;
#pragma unroll 1
          for (int cb = 0; cb < NCH; cb += 16) { f32x2_t sl[16]; float dc[16];
#pragma unroll
              for (int k = 0; k < 16; ++k) { const size_t u = (size_t)bh * 64 + cb + k; sl[k] = *(const f32x2_t*)(SL + (u * 65 + vd) * 64 + k2); dc[k] = DC[u]; }
#pragma unroll
              for (int k = 0; k < 16; ++k) { const size_t u = (size_t)bh * 64 + cb + k; *(unsigned*)(SP + (u * 80 + vd) * 64 + k2) = pk2(s0, s1);
                  s0 = dc[k] * s0 + sl[k].x; s1 = dc[k] * s1 + sl[k].y; } } } }
}
__device__ __forceinline__ void ph_C_fox_naive(const Ctx& c) {
    const bf16_t* P = WSP(bf16_t, WS_PACT); const float* FC = WSP(float, WS_FCUM); bf16_t* Y = WSP(bf16_t, WS_XNY);
    const int gw = c.bid * 8 + c.wave, NGW = c.G * 8;
    for (int r = gw; r < NB * 4 * SEQ; r += NGW) {
        const int q = r % SEQ, bh = r / SEQ, b = bh >> 2, h = bh & 3; const size_t m0 = (size_t)b * SEQ, mq = m0 + q;
        const float qv = bf2f(P[mq * PW + PC_FXQ + h * 64 + c.lane]); const float Fq = FC[mq * 4 + h];
        float mx = -INFINITY, lsum = 0.f, acc = 0.f;
        for (int kv = 0; kv <= q; ++kv) { const size_t mk = m0 + kv;
            const float s = wave_sum(qv * bf2f(P[mk * PW + PC_FXK + h * 64 + c.lane])) + (Fq - FC[mk * 4 + h]);
            const float mn = fmaxf(mx, s), al = exp2f(mx - mn), p = exp2f(s - mn);
            lsum = lsum * al + p; acc = acc * al + p * bf2f(P[mk * PW + PC_FXV + h * 64 + c.lane]); mx = mn; }
        const float o = acc / lsum; const float rstd = rsqrtf(wave_sum(o * o) * (1.f / 64.f) + EPS);
        Y[mq * DM + 512 + h * 64 + c.lane] = (bf16_t)f2bf(o * rstd);
    }
}


typedef float f32x16 __attribute__((ext_vector_type(16)));
typedef short s16x4 __attribute__((ext_vector_type(4)));
__device__ __forceinline__ unsigned cvtpk(float lo, float hi) { f32x2_t v = {lo, hi}; bf16x2_t b = __builtin_convertvector(v, bf16x2_t); return __builtin_bit_cast(unsigned, b); }
__device__ __forceinline__ int crow(int r, int hi) { return (r & 3) + 8 * (r >> 2) + 4 * hi; }
__device__ __forceinline__ s16x4 ds_tr16(LAS const unsigned char* p) { return __builtin_bit_cast(s16x4, __builtin_amdgcn_ds_read_tr16_b64_v4i16((LAS s16x4*)p)); }
#ifndef FOX_THR
#define FOX_THR 40.f
#endif
__device__ __forceinline__ void ph_C_fox_fast(const Ctx& c) {
    constexpr int KST = 176, VST = 192, KB = 64 * KST, VB = 64 * VST, BUF = KB + VB;
    LAS unsigned char* L = c.lds3; LAS float* kmp = (LAS float*)(L + 2 * BUF); LAS float* fend = kmp + 64; LAS int* flags = (LAS int*)(fend + 64);
    const bf16_t* P = WSP(bf16_t, WS_PACT); const bf16_t* FQ = WSP(bf16_t, WS_FQ); const bf16_t* FK = WSP(bf16_t, WS_FK); const float* FC = WSP(float, WS_FCUM); bf16_t* Y = WSP(bf16_t, WS_XNY);
    const int tid = c.tid, lane = c.lane, wave = c.wave, r32 = lane & 31, hi = lane >> 5;
    const int vcu = (c.G % 8 == 0) ? (c.bid % 8) * (c.G / 8) + c.bid / 8 : c.bid;
    const int srow = tid >> 3, sch = tid & 7;
    for (int pi = vcu; pi < 256; pi += c.G) {
        const int bh = pi >> 3, sx = pi & 7, b = bh >> 2, h = bh & 3; const size_t m0 = (size_t)b * SEQ;
#pragma unroll 1
        for (int kk = 0; kk < 2; ++kk) {
            const int qb = kk ? 15 - sx : sx, q0 = qb * 256 + wave * 32, NT = 4 * (qb + 1); const size_t mq = m0 + q0 + r32;
            bf16x8 qf[5]; float qn = 0.f;
#pragma unroll
            for (int s = 0; s < 4; ++s) { const u32x4 w = *(const u32x4*)(P + mq * PW + PC_FXQ + h * 64 + 16 * s + 8 * hi); qf[s] = __builtin_bit_cast(bf16x8, w); float v[8]; unpack8(w, v);
#pragma unroll
                for (int i = 0; i < 8; ++i) qn += v[i] * v[i]; }
            qf[4] = *(const bf16x8*)(FQ + (mq * 4 + h) * 16 + 8 * hi);
            qn += __shfl_xor(qn, 32); qn = sqrtf(qn) * 1.01f + 1.f;
            const float Fq = FC[mq * 4 + h];
            if (tid < 64) { float km = WSP(float, WS_KMAX)[bh * 64 + tid];
#pragma unroll
                for (int o = 1; o < 64; o <<= 1) { const float y = __shfl_up(km, o); if (lane >= o) km = fmaxf(km, y); }
                kmp[tid] = km; fend[tid] = FC[(m0 + 64 * tid + 63) * 4 + h]; }
            const bf16_t* ksrc = P + (m0 + srow) * PW + PC_FXK + h * 64 + sch * 8;
            const bf16_t* vsrc = P + (m0 + srow) * PW + PC_FXV + h * 64 + sch * 8;
            const bf16_t* fsrc = FK + ((m0 + (tid >> 1)) * 4 + h) * 16 + (tid & 1) * 8;
            u32x4 kreg, vreg, freg = (u32x4){0u, 0u, 0u, 0u};
            { const size_t off = (size_t)(NT - 1) * 64 * PW; kreg = *(const u32x4*)(ksrc + off); vreg = *(const u32x4*)(vsrc + off); if (tid < 128) freg = *(const u32x4*)(fsrc + (size_t)(NT - 1) * 64 * 64); }
            *(LAS u32x4*)(L + srow * KST + sch * 16) = kreg; *(LAS u32x4*)(L + KB + srow * VST + sch * 16) = vreg;
            if (tid < 128) *(LAS u32x4*)(L + (tid >> 1) * KST + 128 + (tid & 1) * 16) = freg;
            __syncthreads();
            float m_run = -INFINITY, l_run = 0.f; f32x16 o0 = {}, o1 = {};
            bool need = true;
            for (int t = NT - 1, st = 0; t >= 0; --t, ++st) {
                const bool more = (t > 0);
                if (more) { const size_t off = (size_t)(t - 1) * 64 * PW; kreg = *(const u32x4*)(ksrc + off); vreg = *(const u32x4*)(vsrc + off); if (tid < 128) freg = *(const u32x4*)(fsrc + (size_t)(t - 1) * 64 * 64); }
                if (need && t * 64 <= q0 + 31) {
                    LAS const unsigned char* KL = L + (st & 1) * BUF; LAS const unsigned char* VL = KL + KB;
                    f32x16 p0 = {}, p1 = {};
#pragma unroll
                    for (int s = 0; s < 5; ++s) { const bf16x8 a0 = *(LAS const bf16x8*)(KL + r32 * KST + s * 32 + hi * 16), a1 = *(LAS const bf16x8*)(KL + (32 + r32) * KST + s * 32 + hi * 16);
                        p0 = __builtin_amdgcn_mfma_f32_32x32x16_bf16(a0, qf[s], p0, 0, 0, 0); p1 = __builtin_amdgcn_mfma_f32_32x32x16_bf16(a1, qf[s], p1, 0, 0, 0); }
                    if (t * 64 + 63 > q0) { const int qg = q0 + r32;
#pragma unroll
                        for (int r = 0; r < 16; ++r) { const int kv = t * 64 + crow(r, hi); if (kv > qg) p0[r] = -INFINITY; if (kv + 32 > qg) p1[r] = -INFINITY; } }
                    float mx = fmaxf(p0[0], p1[0]);
#pragma unroll
                    for (int r = 1; r < 16; ++r) mx = fmaxf(mx, fmaxf(p0[r], p1[r]));
                    mx = fmaxf(mx, __shfl_xor(mx, 32));
                    const float mn = fmaxf(m_run, mx);
                    const float msafe = (mn == -INFINITY) ? 0.f : mn, alpha = __builtin_amdgcn_exp2f(m_run - msafe); m_run = mn;
                    float rs = 0.f;
#pragma unroll
                    for (int r = 0; r < 16; ++r) { p0[r] = __builtin_amdgcn_exp2f(p0[r] - msafe); p1[r] = __builtin_amdgcn_exp2f(p1[r] - msafe); rs += p0[r] + p1[r]; }
                    l_run = l_run * alpha + rs;
                    if (!__all(alpha == 1.f)) {
#pragma unroll
                        for (int r = 0; r < 16; ++r) { o0[r] *= alpha; o1[r] *= alpha; } }
                    u32x4 pw[2][2];
#pragma unroll
                    for (int s = 0; s < 2; ++s) { pw[0][s] = (u32x4){cvtpk(p0[8 * s], p0[8 * s + 1]), cvtpk(p0[8 * s + 2], p0[8 * s + 3]), cvtpk(p0[8 * s + 4], p0[8 * s + 5]), cvtpk(p0[8 * s + 6], p0[8 * s + 7])};
                        pw[1][s] = (u32x4){cvtpk(p1[8 * s], p1[8 * s + 1]), cvtpk(p1[8 * s + 2], p1[8 * s + 3]), cvtpk(p1[8 * s + 4], p1[8 * s + 5]), cvtpk(p1[8 * s + 6], p1[8 * s + 7])}; }
                    LAS const unsigned char* vb = VL + (4 * hi + ((lane & 15) >> 2)) * VST + (((lane >> 4) & 1) * 16 + (lane & 3) * 4) * 2;
#pragma unroll
                    for (int blk = 0; blk < 2; ++blk)
#pragma unroll
                        for (int s = 0; s < 2; ++s) {
#pragma unroll
                            for (int db = 0; db < 2; ++db) { LAS const unsigned char* a = vb + (blk * 32 + 16 * s) * VST + db * 64;
                                const s16x4 lo = ds_tr16(a), hh = ds_tr16(a + 8 * VST);
                                const bf16x8 vf = (bf16x8){lo[0], lo[1], lo[2], lo[3], hh[0], hh[1], hh[2], hh[3]};
                                if (db == 0) o0 = __builtin_amdgcn_mfma_f32_32x32x16_bf16(vf, __builtin_bit_cast(bf16x8, pw[blk][s]), o0, 0, 0, 0);
                                else o1 = __builtin_amdgcn_mfma_f32_32x32x16_bf16(vf, __builtin_bit_cast(bf16x8, pw[blk][s]), o1, 0, 0, 0); } }
                }
                if (more && need && (t - 1) * 64 <= q0 + 31 && m_run > -INFINITY) { const float bound = qn * kmp[t - 1] + (Fq - fend[t - 1]); need = __any(bound - m_run >= -FOX_THR); }
                if (lane == 0) flags[(st & 1) * 8 + wave] = (more && need) ? 1 : 0;
                if (more) { LAS unsigned char* D = L + ((st + 1) & 1) * BUF;
                    *(LAS u32x4*)(D + srow * KST + sch * 16) = kreg; *(LAS u32x4*)(D + KB + srow * VST + sch * 16) = vreg;
                    if (tid < 128) *(LAS u32x4*)(D + (tid >> 1) * KST + 128 + (tid & 1) * 16) = freg; }
                __syncthreads();
                int any = 0;
#pragma unroll
                for (int w = 0; w < 8; ++w) any |= flags[(st & 1) * 8 + w];
                if (!any) break;
            }
            const float lt = l_run + __shfl_xor(l_run, 32), inv = 1.f / lt; float ss = 0.f;
#pragma unroll
            for (int r = 0; r < 16; ++r) { o0[r] *= inv; o1[r] *= inv; ss += o0[r] * o0[r] + o1[r] * o1[r]; }
            ss += __shfl_xor(ss, 32);
            const float rstd = rsqrtf(ss * (1.f / 64.f) + EPS);
            bf16_t* yr = Y + mq * DM + 512 + h * 64;
#pragma unroll
            for (int g4 = 0; g4 < 4; ++g4) { u32x2 w0, w1; const int d = 8 * g4 + 4 * hi;
                w0.x = cvtpk(o0[4 * g4] * rstd, o0[4 * g4 + 1] * rstd); w0.y = cvtpk(o0[4 * g4 + 2] * rstd, o0[4 * g4 + 3] * rstd);
                w1.x = cvtpk(o1[4 * g4] * rstd, o1[4 * g4 + 1] * rstd); w1.y = cvtpk(o1[4 * g4 + 2] * rstd, o1[4 * g4 + 3] * rstd);
                *(u32x2*)(yr + d) = w0; *(u32x2*)(yr + 32 + d) = w1; }
        }
    }
}

__device__ __forceinline__ void ph_D_hgrn_out_naive(const Ctx& c, int l) {
    float* qq = (float*)c.lds; float* kk = qq + 4096; float* bc = kk + 4096; float* vv = bc + 4096; float* sp = vv + 4096; float* sc = sp + 4096;
    const bf16_t* P = WSP(bf16_t, WS_PACT); const bf16_t* SP = WSP(bf16_t, WS_HSPREV); bf16_t* Y = WSP(bf16_t, WS_XNY);
    const int t = c.tid >> 3, c0 = (c.tid & 7) * 8;
    for (int u = c.bid; u < NUNIT; u += c.G) {
        const int bh = u >> 6, ch = u & 63, b = bh >> 2, h = bh & 3; const size_t m = (size_t)b * SEQ + ch * 64 + t;
        { float z[8], v[8], q[8], s[8]; unpack8(*(const u32x4*)(P + m * PW + PC_HGF + h * 64 + c0), z); unpack8(*(const u32x4*)(P + m * PW + PC_HGI + h * 64 + c0), v);
          unpack8(*(const u32x4*)(P + m * PW + PC_HGQ + h * 64 + c0), q); unpack8(*(const u32x4*)(SP + ((size_t)u * 64 + t) * 64 + c0), s);
#pragma unroll
          for (int i = 0; i < 8; ++i) { float lf, k; hg_gate(z[i], hg_lb(c, l, h * 64 + c0 + i), lf, k); bc[t * 64 + c0 + i] = lf; kk[t * 64 + c0 + i] = k; vv[t * 64 + c0 + i] = v[i]; qq[t * 64 + c0 + i] = q[i];
              sp[(c0 + i) * 64 + t] = s[i]; } }
        __syncthreads();
        if (c.tid < 64) { float a = 0.f; for (int s = 0; s < 64; ++s) { a += bc[s * 64 + c.tid]; bc[s * 64 + c.tid] = a; } }
        __syncthreads();
#pragma unroll
        for (int i = 0; i < 8; ++i) { const int s = c0 + i; float a = 0.f;
            if (s <= t) for (int kd = 0; kd < 64; ++kd) a += qq[t * 64 + kd] * kk[s * 64 + kd] * __expf(bc[t * 64 + kd] - bc[s * 64 + kd]);
            sc[t * 65 + s] = a; }
        __syncthreads();
        float o[8];
#pragma unroll
        for (int i = 0; i < 8; ++i) o[i] = 0.f;
        for (int s = 0; s <= t; ++s) { const float w = sc[t * 65 + s];
#pragma unroll
            for (int i = 0; i < 8; ++i) o[i] += w * vv[s * 64 + c0 + i]; }
        for (int kd = 0; kd < 64; ++kd) { const float w = qq[t * 64 + kd] * __expf(bc[t * 64 + kd]);
#pragma unroll
            for (int i = 0; i < 8; ++i) o[i] += w * sp[kd * 64 + c0 + i]; }
        float ss = 0.f;
#pragma unroll
        for (int i = 0; i < 8; ++i) ss += o[i] * o[i];
        ss += __shfl_xor(ss, 1); ss += __shfl_xor(ss, 2); ss += __shfl_xor(ss, 4);
        const float rstd = rsqrtf(ss * (1.f / 64.f) + EPS);
        float g[8]; unpack8(*(const u32x4*)(P + m * PW + PC_HGG + h * 64 + c0), g);
#pragma unroll
        for (int i = 0; i < 8; ++i) o[i] = o[i] * rstd * siluf_(g[i]);
        *(u32x4*)(Y + m * DM + 256 + h * 64 + c0) = pack8(o);
        __syncthreads();
    }
}
__device__ __forceinline__ void ph_D_mlstm_out_naive(const Ctx& c, int l) {
    float* qq = (float*)c.lds; float* kk = qq + 4096; float* vv = kk + 4096; float* cp = vv + 4096; float* sc = cp + 4096; float* np = sc + 64 * 65; float* bb = np + 64; float* ig = bb + 64;
    const bf16_t* P = WSP(bf16_t, WS_PACT); const bf16_t* SP = WSP(bf16_t, WS_MSPREV); const float* GT = WSP(float, WS_GT); bf16_t* Y = WSP(bf16_t, WS_XNY);
    const int t = c.tid >> 3, c0 = (c.tid & 7) * 8;
    for (int u = c.bid; u < NUNIT; u += c.G) {
        const int bh = u >> 6, ch = u & 63, b = bh >> 2, h = bh & 3; const size_t m = (size_t)b * SEQ + ch * 64 + t;
        if (c.tid < 64) { const size_t mm = (size_t)b * SEQ + ch * 64 + c.tid; bb[c.tid] = log_sigmoidf_(GT[mm * 16 + 8 + h]); ig[c.tid] = GT[mm * 16 + 4 + h]; np[c.tid] = bf2f(SP[((size_t)u * 80 + 64) * 64 + c.tid]); }
        { float q[8], k[8], v[8], s[8]; ml_conv8(c, l, P, m, ch * 64 + t, PC_MLQ + h * 64 + c0, h * 64 + c0, q); ml_conv8(c, l, P, m, ch * 64 + t, PC_MLK + h * 64 + c0, 256 + h * 64 + c0, k);
          unpack8(*(const u32x4*)(P + m * PW + PC_MLV + h * 64 + c0), v); unpack8(*(const u32x4*)(SP + ((size_t)u * 80 + t) * 64 + c0), s);
#pragma unroll
          for (int i = 0; i < 8; ++i) { qq[t * 64 + c0 + i] = q[i]; kk[t * 64 + c0 + i] = k[i] * 0.125f; vv[t * 64 + c0 + i] = v[i]; cp[(c0 + i) * 64 + t] = s[i]; } }
        __syncthreads();
        if (c.tid == 0) { float a = 0.f; for (int s = 0; s < 64; ++s) { a += bb[s]; bb[s] = a; } }
        __syncthreads();
#pragma unroll
        for (int i = 0; i < 8; ++i) { const int s = c0 + i; float a = 0.f;
            if (s <= t) { for (int kd = 0; kd < 64; ++kd) a += qq[t * 64 + kd] * kk[s * 64 + kd]; a *= __expf(bb[t] - bb[s] + ig[s]); }
            sc[t * 65 + s] = a; }
        __syncthreads();
        float o[8]; float den = 0.f;
#pragma unroll
        for (int i = 0; i < 8; ++i) o[i] = 0.f;
        for (int s = 0; s <= t; ++s) { const float w = sc[t * 65 + s]; den += w;
#pragma unroll
            for (int i = 0; i < 8; ++i) o[i] += w * vv[s * 64 + c0 + i]; }
        const float eb = __expf(bb[t]);
        for (int kd = 0; kd < 64; ++kd) { const float w = qq[t * 64 + kd] * eb; den += w * np[kd];
#pragma unroll
            for (int i = 0; i < 8; ++i) o[i] += w * cp[kd * 64 + c0 + i]; }
        const float inv = 1.f / fmaxf(fabsf(den), 1.f);
        float ss = 0.f;
#pragma unroll
        for (int i = 0; i < 8; ++i) { o[i] *= inv; ss += o[i] * o[i]; }
        ss += __shfl_xor(ss, 1); ss += __shfl_xor(ss, 2); ss += __shfl_xor(ss, 4);
        const float rstd = rsqrtf(ss * (1.f / 64.f) + EPS);
        float g[8]; unpack8(*(const u32x4*)(P + m * PW + PC_MLO + h * 64 + c0), g);
#pragma unroll
        for (int i = 0; i < 8; ++i) o[i] = o[i] * rstd * sigmoidf_(g[i]);
        *(u32x4*)(Y + m * DM + 768 + h * 64 + c0) = pack8(o);
        __syncthreads();
    }
}


typedef float f32x4_t __attribute__((ext_vector_type(4)));
__device__ __forceinline__ bf16x8 frag_row(LAS const unsigned char* base, int stride, int r0, int k0, int lane) {
    return *(LAS const bf16x8*)(base + (r0 + (lane & 15)) * stride + (k0 + 8 * (lane >> 4)) * 2); }
__device__ __forceinline__ bf16x8 frag_tr(LAS const unsigned char* base, int stride, int k0, int c0, int lane) {
    const int g = lane >> 4, i = lane & 15; LAS const unsigned char* p = base + (k0 + 8 * g + (i >> 2)) * stride + (c0 + 4 * (i & 3)) * 2;
    const s16x4 lo = ds_tr16(p), hh = ds_tr16(p + 4 * stride); return (bf16x8){lo[0], lo[1], lo[2], lo[3], hh[0], hh[1], hh[2], hh[3]}; }
#define MFMA16(a, b, c) __builtin_amdgcn_mfma_f32_16x16x32_bf16((a), (b), (c), 0, 0, 0)
__device__ __forceinline__ void scan_t8(float (&x)[8], float (&tot)[8], LAS float* wt, int lane, int wave) {
#pragma unroll
    for (int off = 8; off < 64; off <<= 1) {
#pragma unroll
        for (int i = 0; i < 8; ++i) { const float y = __shfl_up(x[i], off); if (lane >= off) x[i] += y; } }
    if (lane >= 56) {
#pragma unroll
        for (int i = 0; i < 8; ++i) wt[wave * 64 + (lane & 7) * 8 + i] = x[i]; }
    __syncthreads();
#pragma unroll
    for (int i = 0; i < 8; ++i) { float pre = 0.f, t = 0.f;
#pragma unroll
        for (int w = 0; w < 8; ++w) { const float v = wt[w * 64 + (lane & 7) * 8 + i]; t += v; if (w < wave) pre += v; }
        x[i] += pre; tot[i] = t; }
}
constexpr int CST = 144;

__device__ __forceinline__ void ph_B_hgrn_local_fast(const Ctx& c, int l) {
    LAS unsigned char* KH = c.lds3; LAS unsigned char* VV = KH + 64 * CST; LAS float* wt = (LAS float*)(VV + 64 * CST);
    const bf16_t* P = WSP(bf16_t, WS_PACT);
    const int tid = c.tid, lane = c.lane, wave = c.wave, t = tid >> 3, c0 = (tid & 7) * 8;
    for (int u = c.bid; u < NUNIT; u += c.G) {
        const int bh = u >> 6, ch = u & 63, b = bh >> 2, h = bh & 3; const size_t m = (size_t)b * SEQ + ch * 64 + t;
        const u32x4 zr = *(const u32x4*)(P + m * PW + PC_HGF + h * 64 + c0), vr = *(const u32x4*)(P + m * PW + PC_HGI + h * 64 + c0);
        float z[8], lf[8], kk[8], tot[8]; unpack8(zr, z);
#pragma unroll
        for (int i = 0; i < 8; ++i) hg_gate(z[i], hg_lb(c, l, h * 64 + c0 + i), lf[i], kk[i]);
        scan_t8(lf, tot, wt, lane, wave);
#pragma unroll
        for (int i = 0; i < 8; ++i) kk[i] *= __expf(tot[i] - lf[i]);
        *(LAS u32x4*)(KH + t * CST + c0 * 2) = pack8(kk); *(LAS u32x4*)(VV + t * CST + c0 * 2) = vr;
        if (t == 63) {
#pragma unroll
            for (int i = 0; i < 8; ++i) WSP(float, WS_HDEC)[(size_t)u * 64 + c0 + i] = __expf(tot[i]); }
        __syncthreads();
        { const int a = wave >> 1;
#pragma unroll
          for (int j = 0; j < 2; ++j) { const int bt = 2 * (wave & 1) + j; f32x4_t acc = {0.f, 0.f, 0.f, 0.f};
#pragma unroll
              for (int ks = 0; ks < 2; ++ks) acc = MFMA16(frag_tr(KH, CST, 32 * ks, 16 * a, lane), frag_tr(VV, CST, 32 * ks, 16 * bt, lane), acc);
              *(f32x4_t*)(WSP(float, WS_HSLOC) + ((size_t)u * 64 + 16 * bt + (lane & 15)) * 64 + 16 * a + 4 * (lane >> 4)) = acc; } }
        __syncthreads();
    }
}

__device__ __forceinline__ void ph_D_hgrn_out_fast(const Ctx& c, int l) {
    LAS unsigned char* QA = c.lds3; LAS unsigned char* QB = QA + 32 * CST; LAS unsigned char* QC = QB + 32 * CST; LAS unsigned char* KA = QC + 32 * CST; LAS unsigned char* KB_ = KA + 32 * CST; LAS unsigned char* KC = KB_ + 32 * CST;
    LAS unsigned char* QH = KC + 32 * CST; LAS unsigned char* VV = QH + 64 * CST; LAS unsigned char* SP = VV + 64 * CST; LAS unsigned char* SC = SP + 64 * CST;
    LAS float* refs = (LAS float*)(SC + 64 * CST); LAS float* wt = refs + 4 * 64; LAS float* ssb = wt + 8 * 64;
    const bf16_t* P = WSP(bf16_t, WS_PACT); const bf16_t* SPG = WSP(bf16_t, WS_HSPREV); bf16_t* Y = WSP(bf16_t, WS_XNY);
    const int tid = c.tid, lane = c.lane, wave = c.wave, t = tid >> 3, c0 = (tid & 7) * 8;
    for (int u = c.bid; u < NUNIT; u += c.G) {
        const int bh = u >> 6, ch = u & 63, b = bh >> 2, h = bh & 3; const size_t m0 = (size_t)b * SEQ + ch * 64, m = m0 + t;
        const u32x4 zr = *(const u32x4*)(P + m * PW + PC_HGF + h * 64 + c0), vr = *(const u32x4*)(P + m * PW + PC_HGI + h * 64 + c0), qr = *(const u32x4*)(P + m * PW + PC_HGQ + h * 64 + c0);
        const u32x4 sr = *(const u32x4*)(SPG + ((size_t)u * 64 + t) * 64 + c0);
        float z[8], q[8], bc[8], kk[8], tot[8]; unpack8(zr, z); unpack8(qr, q);
#pragma unroll
        for (int i = 0; i < 8; ++i) hg_gate(z[i], hg_lb(c, l, h * 64 + c0 + i), bc[i], kk[i]);
        scan_t8(bc, tot, wt, lane, wave);
        if ((t & 15) == 15 && t < 63) {
#pragma unroll
            for (int i = 0; i < 8; ++i) refs[(t >> 4) * 64 + c0 + i] = bc[i]; }
        *(LAS u32x4*)(VV + t * CST + c0 * 2) = vr; *(LAS u32x4*)(SP + t * CST + c0 * 2) = sr;
        __syncthreads();
        { float o1[8], o2[8], o3[8], o4[8];
          if (t < 32) {
#pragma unroll
              for (int i = 0; i < 8; ++i) { const float r15 = refs[c0 + i], r31 = refs[64 + c0 + i]; o1[i] = q[i] * __expf(bc[i] - r15); o2[i] = kk[i] * __expf(r15 - bc[i]); o3[i] = kk[i] * __expf(r31 - bc[i]); }
              *(LAS u32x4*)(QA + t * CST + c0 * 2) = pack8(o1); *(LAS u32x4*)(KA + t * CST + c0 * 2) = pack8(o2); *(LAS u32x4*)(KB_ + t * CST + c0 * 2) = pack8(o3);
          } else { const int tt = t - 32;
#pragma unroll
              for (int i = 0; i < 8; ++i) { const float r31 = refs[64 + c0 + i], r47 = refs[128 + c0 + i]; o1[i] = q[i] * __expf(bc[i] - r31); o2[i] = q[i] * __expf(bc[i] - r47); o3[i] = kk[i] * __expf(r47 - bc[i]); }
              *(LAS u32x4*)(QB + tt * CST + c0 * 2) = pack8(o1); *(LAS u32x4*)(QC + tt * CST + c0 * 2) = pack8(o2); *(LAS u32x4*)(KC + tt * CST + c0 * 2) = pack8(o3); }
#pragma unroll
          for (int i = 0; i < 8; ++i) o4[i] = q[i] * __expf(bc[i]);
          *(LAS u32x4*)(QH + t * CST + c0 * 2) = pack8(o4); }
        __syncthreads();
#pragma unroll
        for (int e2 = 0; e2 < 2; ++e2) { const int e = wave + 8 * e2, ti = e >> 2, si = e & 3; f32x4_t acc = {0.f, 0.f, 0.f, 0.f};
            if (si <= ti) { LAS const unsigned char* Qp = (ti < 2) ? QA : ((si < 2) ? QB : QC); LAS const unsigned char* Kp = (ti < 2) ? KA : ((si < 2) ? KB_ : KC);
                const int qr0 = 16 * (ti & 1), kr0 = 16 * (si & 1);
#pragma unroll
                for (int ks = 0; ks < 2; ++ks) acc = MFMA16(frag_row(Kp, CST, kr0, 32 * ks, lane), frag_row(Qp, CST, qr0, 32 * ks, lane), acc);
                if (si == ti) {
#pragma unroll
                    for (int i = 0; i < 4; ++i) if (4 * (lane >> 4) + i > (lane & 15)) acc[i] = 0.f; } }
            u32x2 w; w.x = cvtpk(acc[0], acc[1]); w.y = cvtpk(acc[2], acc[3]);
            *(LAS u32x2*)(SC + (16 * ti + (lane & 15)) * CST + (16 * si + 4 * (lane >> 4)) * 2) = w; }
        __syncthreads();
        { const int ts = wave >> 1; f32x4_t acc[2]; float ss = 0.f;
#pragma unroll
          for (int j = 0; j < 2; ++j) { const int vt = 2 * (wave & 1) + j; acc[j] = (f32x4_t){0.f, 0.f, 0.f, 0.f};
              acc[j] = MFMA16(frag_tr(VV, CST, 0, 16 * vt, lane), frag_row(SC, CST, 16 * ts, 0, lane), acc[j]);
              if (ts >= 2) acc[j] = MFMA16(frag_tr(VV, CST, 32, 16 * vt, lane), frag_row(SC, CST, 16 * ts, 32, lane), acc[j]);
#pragma unroll
              for (int ks = 0; ks < 2; ++ks) acc[j] = MFMA16(frag_row(SP, CST, 16 * vt, 32 * ks, lane), frag_row(QH, CST, 16 * ts, 32 * ks, lane), acc[j]);
#pragma unroll
              for (int i = 0; i < 4; ++i) ss += acc[j][i] * acc[j][i]; }
          ss += __shfl_xor(ss, 16); ss += __shfl_xor(ss, 32);
          if (lane < 16) ssb[(16 * ts + lane) * 2 + (wave & 1)] = ss;
          __syncthreads();
          const int tl = 16 * ts + (lane & 15); const float rstd = rsqrtf((ssb[tl * 2] + ssb[tl * 2 + 1]) * (1.f / 64.f) + EPS);
#pragma unroll
          for (int j = 0; j < 2; ++j) { const int vd = 16 * (2 * (wave & 1) + j) + 4 * (lane >> 4);
              const u32x2 gr = *(const u32x2*)(P + (m0 + tl) * PW + PC_HGG + h * 64 + vd);
              const float g0 = bf2f(gr.x & 0xffffu), g1 = bf2f(gr.x >> 16), g2 = bf2f(gr.y & 0xffffu), g3 = bf2f(gr.y >> 16);
              u32x2 w; w.x = cvtpk(acc[j][0] * rstd * siluf_(g0), acc[j][1] * rstd * siluf_(g1)); w.y = cvtpk(acc[j][2] * rstd * siluf_(g2), acc[j][3] * rstd * siluf_(g3));
              *(u32x2*)(Y + (m0 + tl) * DM + 256 + h * 64 + vd) = w; } }
        __syncthreads();
    }
}


constexpr int VST80 = 176;
__device__ __forceinline__ void ml_gates(const Ctx& c, LAS float* bb, LAS float* igs, size_t m0, int h) {
    if (c.tid < 64) { const float* GT = WSP(float, WS_GT); float x = log_sigmoidf_(GT[(m0 + c.tid) * 16 + 8 + h]);
#pragma unroll
        for (int off = 1; off < 64; off <<= 1) { const float y = __shfl_up(x, off); if (c.lane >= off) x += y; }
        bb[c.tid] = x; igs[c.tid] = GT[(m0 + c.tid) * 16 + 4 + h]; }
}
__device__ __forceinline__ void ph_B_mlstm_local_fast(const Ctx& c, int l) {
    LAS unsigned char* KH = c.lds3; LAS unsigned char* VV = KH + 64 * CST; LAS float* bb = (LAS float*)(VV + 64 * VST80); LAS float* igs = bb + 64;
    const bf16_t* P = WSP(bf16_t, WS_PACT);
    const int tid = c.tid, lane = c.lane, wave = c.wave, t = tid >> 3, c0 = (tid & 7) * 8;
    for (int u = c.bid; u < NUNIT; u += c.G) {
        const int bh = u >> 6, ch = u & 63, b = bh >> 2, h = bh & 3; const size_t m0 = (size_t)b * SEQ + ch * 64, m = m0 + t;
        ml_gates(c, bb, igs, m0, h);
        const u32x4 vr = *(const u32x4*)(P + m * PW + PC_MLV + h * 64 + c0);
        float k[8]; ml_conv8(c, l, P, m, ch * 64 + t, PC_MLK + h * 64 + c0, 256 + h * 64 + c0, k);
        __syncthreads();
        { const float w = 0.125f * __expf(bb[63] - bb[t] + igs[t]);
#pragma unroll
          for (int i = 0; i < 8; ++i) k[i] *= w; }
        *(LAS u32x4*)(KH + t * CST + c0 * 2) = pack8(k); *(LAS u32x4*)(VV + t * VST80 + c0 * 2) = vr;
        if ((tid & 7) < 2) *(LAS u32x4*)(VV + t * VST80 + 128 + (tid & 7) * 16) = (u32x4){(tid & 7) == 0 ? 0x3f80u : 0u, 0u, 0u, 0u};
        if (tid == 0) WSP(float, WS_MDEC)[u] = __expf(bb[63]);
        __syncthreads();
#pragma unroll
        for (int j = 0; j < 3; ++j) { const int e = wave + 8 * j; if (e < 20) { const int a = e & 3, bt = e >> 2; f32x4_t acc = {0.f, 0.f, 0.f, 0.f};
#pragma unroll
            for (int ks = 0; ks < 2; ++ks) acc = MFMA16(frag_tr(KH, CST, 32 * ks, 16 * a, lane), frag_tr(VV, VST80, 32 * ks, 16 * bt, lane), acc);
            const int vd = 16 * bt + (lane & 15);
            if (vd < 65) *(f32x4_t*)(WSP(float, WS_MSLOC) + ((size_t)u * 65 + vd) * 64 + 16 * a + 4 * (lane >> 4)) = acc; } }
        __syncthreads();
    }
}
__device__ __forceinline__ void ph_D_mlstm_out_fast(const Ctx& c, int l) {
    LAS unsigned char* QT = c.lds3; LAS unsigned char* KT = QT + 64 * CST; LAS unsigned char* VV = KT + 64 * CST; LAS unsigned char* CP = VV + 64 * VST80; LAS unsigned char* SC = CP + 80 * CST;
    LAS float* bb = (LAS float*)(SC + 64 * CST); LAS float* igs = bb + 64; LAS float* den = igs + 64; LAS float* ssb = den + 64;
    const bf16_t* P = WSP(bf16_t, WS_PACT); const bf16_t* SPG = WSP(bf16_t, WS_MSPREV); bf16_t* Y = WSP(bf16_t, WS_XNY);
    const int tid = c.tid, lane = c.lane, wave = c.wave, t = tid >> 3, c0 = (tid & 7) * 8;
    for (int u = c.bid; u < NUNIT; u += c.G) {
        const int bh = u >> 6, ch = u & 63, b = bh >> 2, h = bh & 3; const size_t m0 = (size_t)b * SEQ + ch * 64, m = m0 + t;
        ml_gates(c, bb, igs, m0, h);
        const u32x4 vr = *(const u32x4*)(P + m * PW + PC_MLV + h * 64 + c0);
        const u32x4 cr = *(const u32x4*)(SPG + (size_t)u * 80 * 64 + tid * 8);
        u32x4 cr2 = (u32x4){0u, 0u, 0u, 0u}; if (tid < 128) cr2 = *(const u32x4*)(SPG + (size_t)u * 80 * 64 + (512 + tid) * 8);
        float q[8], k[8]; ml_conv8(c, l, P, m, ch * 64 + t, PC_MLQ + h * 64 + c0, h * 64 + c0, q); ml_conv8(c, l, P, m, ch * 64 + t, PC_MLK + h * 64 + c0, 256 + h * 64 + c0, k);
        __syncthreads();
        { const float eq = __expf(bb[t]), ek = 0.125f * __expf(igs[t] - bb[t]);
#pragma unroll
          for (int i = 0; i < 8; ++i) { q[i] *= eq; k[i] *= ek; } }
        *(LAS u32x4*)(QT + t * CST + c0 * 2) = pack8(q); *(LAS u32x4*)(KT + t * CST + c0 * 2) = pack8(k); *(LAS u32x4*)(VV + t * VST80 + c0 * 2) = vr;
        if ((tid & 7) < 2) *(LAS u32x4*)(VV + t * VST80 + 128 + (tid & 7) * 16) = (u32x4){(tid & 7) == 0 ? 0x3f80u : 0u, 0u, 0u, 0u};
        *(LAS u32x4*)(CP + (tid >> 3) * CST + (tid & 7) * 16) = cr; if (tid < 128) *(LAS u32x4*)(CP + (64 + (tid >> 3)) * CST + (tid & 7) * 16) = cr2;
        __syncthreads();
#pragma unroll
        for (int e2 = 0; e2 < 2; ++e2) { const int e = wave + 8 * e2, ti = e >> 2, si = e & 3; f32x4_t acc = {0.f, 0.f, 0.f, 0.f};
            if (si <= ti) {
#pragma unroll
                for (int ks = 0; ks < 2; ++ks) acc = MFMA16(frag_row(KT, CST, 16 * si, 32 * ks, lane), frag_row(QT, CST, 16 * ti, 32 * ks, lane), acc);
                if (si == ti) {
#pragma unroll
                    for (int i = 0; i < 4; ++i) if (4 * (lane >> 4) + i > (lane & 15)) acc[i] = 0.f; } }
            u32x2 w; w.x = cvtpk(acc[0], acc[1]); w.y = cvtpk(acc[2], acc[3]);
            *(LAS u32x2*)(SC + (16 * ti + (lane & 15)) * CST + (16 * si + 4 * (lane >> 4)) * 2) = w; }
        __syncthreads();
        { const int ts = wave >> 1, hf = wave & 1; f32x4_t acc[3];
#pragma unroll
          for (int j = 0; j < 3; ++j) { acc[j] = (f32x4_t){0.f, 0.f, 0.f, 0.f}; if (j < 2 || hf == 0) { const int vt = (j == 2) ? 4 : 2 * hf + j;
              acc[j] = MFMA16(frag_tr(VV, VST80, 0, 16 * vt, lane), frag_row(SC, CST, 16 * ts, 0, lane), acc[j]);
              if (ts >= 2) acc[j] = MFMA16(frag_tr(VV, VST80, 32, 16 * vt, lane), frag_row(SC, CST, 16 * ts, 32, lane), acc[j]);
#pragma unroll
              for (int ks = 0; ks < 2; ++ks) acc[j] = MFMA16(frag_row(CP, CST, 16 * vt, 32 * ks, lane), frag_row(QT, CST, 16 * ts, 32 * ks, lane), acc[j]); } }
          if (hf == 0 && lane < 16) den[16 * ts + lane] = acc[2][0];
          __syncthreads();
          const int tl = 16 * ts + (lane & 15); const float inv = 1.f / fmaxf(fabsf(den[tl]), 1.f); float ss = 0.f;
#pragma unroll
          for (int j = 0; j < 2; ++j)
#pragma unroll
              for (int i = 0; i < 4; ++i) { acc[j][i] *= inv; ss += acc[j][i] * acc[j][i]; }
          ss += __shfl_xor(ss, 16); ss += __shfl_xor(ss, 32);
          if (lane < 16) ssb[(16 * ts + lane) * 2 + hf] = ss;
          __syncthreads();
          const float rstd = rsqrtf((ssb[tl * 2] + ssb[tl * 2 + 1]) * (1.f / 64.f) + EPS);
#pragma unroll
          for (int j = 0; j < 2; ++j) { const int vd = 16 * (2 * hf + j) + 4 * (lane >> 4);
              const u32x2 gr = *(const u32x2*)(P + (m0 + tl) * PW + PC_MLO + h * 64 + vd);
              const float g0 = bf2f(gr.x & 0xffffu), g1 = bf2f(gr.x >> 16), g2 = bf2f(gr.y & 0xffffu), g3 = bf2f(gr.y >> 16);
              u32x2 w; w.x = cvtpk(acc[j][0] * rstd * sigmoidf_(g0), acc[j][1] * rstd * sigmoidf_(g1)); w.y = cvtpk(acc[j][2] * rstd * sigmoidf_(g2), acc[j][3] * rstd * sigmoidf_(g3));
              *(u32x2*)(Y + (m0 + tl) * DM + 768 + h * 64 + vd) = w; } }
        __syncthreads();
    }
}


constexpr int TAB_OFF = 100 * 1024;
__device__ __forceinline__ void range_split(int w, int G, int N, int ns, int extra, int& lo, int& hi) {
    if (ns >= G) { const int q = N / G, r = N % G; lo = w * q + (w < r ? w : r); hi = lo + q + (w < r ? 1 : 0); return; }
    const int T = (N + ns * extra + G - 1) / G; int cs = T - extra; if (cs < 0) cs = 0;
    if (w < ns) { lo = w * cs; hi = lo + cs; return; }
    const int rest = N - ns * cs, no = G - ns, k = w - ns, q = rest / no, r = rest % no; lo = ns * cs + k * q + (k < r ? k : r); hi = lo + q + (k < r ? 1 : 0);
}
__device__ __forceinline__ void stage_tables(const Ctx& c, int l) {
    LAS float* lbv = (LAS float*)(c.lds3 + TAB_OFF); LAS float* cwt = lbv + 256;
    if (c.tid < 256) lbv[c.tid] = hg_lb(c, l, c.tid);
    for (int i = c.tid; i < 2048; i += NTHR) cwt[i] = c.in[I_CONV][(size_t)l * 2048 + i];
    __syncthreads();
}
__device__ __forceinline__ void hg_gate_fast(float z, float lb, float& logf, float& kk) {
    z = fmaxf(z, -80.f); const float e = __expf(-z), s = __builtin_amdgcn_rcpf(1.f + e), oml = 1.f - lb;
    logf = __logf(lb + oml * s); kk = oml * e * s;
}
__device__ __forceinline__ void hgrn_local_units(const Ctx& c, int lo, int hi) {
    LAS unsigned char* KH = c.lds3; LAS unsigned char* VV = KH + 64 * CST; LAS float* wt = (LAS float*)(VV + 64 * CST); LAS const float* lbv = (LAS const float*)(c.lds3 + TAB_OFF);
    const bf16_t* P = WSP(bf16_t, WS_PACT);
    const int tid = c.tid, lane = c.lane, wave = c.wave, t = tid >> 3, c0 = (tid & 7) * 8;
    u32x4 zr = {}, vr = {};
#define HL_LOAD(u_) do { const int bh_ = (u_) >> 6, ch_ = (u_) & 63; const size_t m_ = (size_t)(bh_ >> 2) * SEQ + ch_ * 64 + t; const bf16_t* p_ = P + m_ * PW + (bh_ & 3) * 64 + c0; zr = *(const u32x4*)(p_ + PC_HGF); vr = *(const u32x4*)(p_ + PC_HGI); } while (0)
    if (lo < hi) HL_LOAD(lo);
    for (int u = lo; u < hi; ++u) {
        const int h = (u >> 6) & 3;
        float z[8], lf[8], kk[8], tot[8]; unpack8(zr, z); const u32x4 vcur = vr;
        if (u + 1 < hi) HL_LOAD(u + 1);
#pragma unroll
        for (int i = 0; i < 8; ++i) hg_gate_fast(z[i], lbv[h * 64 + c0 + i], lf[i], kk[i]);
        scan_t8(lf, tot, wt, lane, wave);
#pragma unroll
        for (int i = 0; i < 8; ++i) kk[i] *= __expf(tot[i] - lf[i]);
        *(LAS u32x4*)(KH + t * CST + c0 * 2) = pack8(kk); *(LAS u32x4*)(VV + t * CST + c0 * 2) = vcur;
        if (t == 63) {
#pragma unroll
            for (int i = 0; i < 8; ++i) WSP(float, WS_HDEC)[(size_t)u * 64 + c0 + i] = __expf(tot[i]); }
        __syncthreads();
        { const int a = wave >> 1;
#pragma unroll
          for (int j = 0; j < 2; ++j) { const int bt = 2 * (wave & 1) + j; f32x4_t acc = {0.f, 0.f, 0.f, 0.f};
#pragma unroll
              for (int ks = 0; ks < 2; ++ks) acc = MFMA16(frag_tr(KH, CST, 32 * ks, 16 * a, lane), frag_tr(VV, CST, 32 * ks, 16 * bt, lane), acc);
              *(f32x4_t*)(WSP(float, WS_HSLOC) + ((size_t)u * 64 + 16 * bt + (lane & 15)) * 64 + 16 * a + 4 * (lane >> 4)) = acc; } }
        __syncthreads();
    }
#undef HL_LOAD
}
__device__ __forceinline__ void hgrn_out_units(const Ctx& c, int lo, int hi) {
    LAS unsigned char* QA = c.lds3; LAS unsigned char* QB = QA + 32 * CST; LAS unsigned char* QC = QB + 32 * CST; LAS unsigned char* KA = QC + 32 * CST; LAS unsigned char* KB_ = KA + 32 * CST; LAS unsigned char* KC = KB_ + 32 * CST;
    LAS unsigned char* QH = KC + 32 * CST; LAS unsigned char* VV = QH + 64 * CST; LAS unsigned char* SP = VV + 64 * CST; LAS unsigned char* SC = SP + 64 * CST;
    LAS float* refs = (LAS float*)(SC + 64 * CST); LAS float* wt = refs + 4 * 64; LAS float* ssb = wt + 8 * 64; LAS const float* lbv = (LAS const float*)(c.lds3 + TAB_OFF);
    const bf16_t* P = WSP(bf16_t, WS_PACT); const bf16_t* SPG = WSP(bf16_t, WS_HSPREV); bf16_t* Y = WSP(bf16_t, WS_XNY);
    const int tid = c.tid, lane = c.lane, wave = c.wave, t = tid >> 3, c0 = (tid & 7) * 8;
    u32x4 zr = {}, vr = {}, qr = {}, sr = {};
#define HO_LOAD(u_) do { const int bh_ = (u_) >> 6, ch_ = (u_) & 63; const size_t m_ = (size_t)(bh_ >> 2) * SEQ + ch_ * 64 + t; const bf16_t* p_ = P + m_ * PW + (bh_ & 3) * 64 + c0; \
        zr = *(const u32x4*)(p_ + PC_HGF); vr = *(const u32x4*)(p_ + PC_HGI); qr = *(const u32x4*)(p_ + PC_HGQ); sr = *(const u32x4*)(SPG + ((size_t)(u_) * 64 + t) * 64 + c0); } while (0)
    if (lo < hi) HO_LOAD(lo);
    for (int u = lo; u < hi; ++u) {
        const int bh = u >> 6, ch = u & 63, b = bh >> 2, h = bh & 3; const size_t m0 = (size_t)b * SEQ + ch * 64;
        float z[8], q[8], bc[8], kk[8], tot[8]; unpack8(zr, z); unpack8(qr, q);
        *(LAS u32x4*)(VV + t * CST + c0 * 2) = vr; *(LAS u32x4*)(SP + t * CST + c0 * 2) = sr;
        if (u + 1 < hi) HO_LOAD(u + 1);
#pragma unroll
        for (int i = 0; i < 8; ++i) hg_gate_fast(z[i], lbv[h * 64 + c0 + i], bc[i], kk[i]);
        scan_t8(bc, tot, wt, lane, wave);
        if ((t & 15) == 15 && t < 63) {
#pragma unroll
            for (int i = 0; i < 8; ++i) refs[(t >> 4) * 64 + c0 + i] = bc[i]; }
        __syncthreads();
        { float o1[8], o2[8], o3[8], o4[8];
          if (t < 32) {
#pragma unroll
              for (int i = 0; i < 8; ++i) { const float r15 = refs[c0 + i], r31 = refs[64 + c0 + i]; const float ea = __expf(bc[i] - r15); o1[i] = q[i] * ea; o2[i] = kk[i] * __builtin_amdgcn_rcpf(ea); o3[i] = kk[i] * __expf(r31 - bc[i]); }
              *(LAS u32x4*)(QA + t * CST + c0 * 2) = pack8(o1); *(LAS u32x4*)(KA + t * CST + c0 * 2) = pack8(o2); *(LAS u32x4*)(KB_ + t * CST + c0 * 2) = pack8(o3);
          } else { const int tt = t - 32;
#pragma unroll
              for (int i = 0; i < 8; ++i) { const float r31 = refs[64 + c0 + i], r47 = refs[128 + c0 + i]; const float ec = __expf(bc[i] - r47); o1[i] = q[i] * __expf(bc[i] - r31); o2[i] = q[i] * ec; o3[i] = kk[i] * __builtin_amdgcn_rcpf(ec); }
              *(LAS u32x4*)(QB + tt * CST + c0 * 2) = pack8(o1); *(LAS u32x4*)(QC + tt * CST + c0 * 2) = pack8(o2); *(LAS u32x4*)(KC + tt * CST + c0 * 2) = pack8(o3); }
#pragma unroll
          for (int i = 0; i < 8; ++i) o4[i] = q[i] * __expf(bc[i]);
          *(LAS u32x4*)(QH + t * CST + c0 * 2) = pack8(o4); }
        __syncthreads();
#pragma unroll
        for (int e2 = 0; e2 < 2; ++e2) { const int e = wave + 8 * e2, ti = e >> 2, si = e & 3; f32x4_t acc = {0.f, 0.f, 0.f, 0.f};
            if (si <= ti) { LAS const unsigned char* Qp = (ti < 2) ? QA : ((si < 2) ? QB : QC); LAS const unsigned char* Kp = (ti < 2) ? KA : ((si < 2) ? KB_ : KC);
                const int qr0 = 16 * (ti & 1), kr0 = 16 * (si & 1);
#pragma unroll
                for (int ks = 0; ks < 2; ++ks) acc = MFMA16(frag_row(Kp, CST, kr0, 32 * ks, lane), frag_row(Qp, CST, qr0, 32 * ks, lane), acc);
                if (si == ti) {
#pragma unroll
                    for (int i = 0; i < 4; ++i) if (4 * (lane >> 4) + i > (lane & 15)) acc[i] = 0.f; } }
            u32x2 w; w.x = cvtpk(acc[0], acc[1]); w.y = cvtpk(acc[2], acc[3]);
            *(LAS u32x2*)(SC + (16 * ti + (lane & 15)) * CST + (16 * si + 4 * (lane >> 4)) * 2) = w; }
        __syncthreads();
        { const int ts = wave >> 1; f32x4_t acc[2]; float ss = 0.f; const int tl = 16 * ts + (lane & 15);
          u32x2 gr[2];
#pragma unroll
          for (int j = 0; j < 2; ++j) gr[j] = *(const u32x2*)(P + (m0 + tl) * PW + PC_HGG + h * 64 + 16 * (2 * (wave & 1) + j) + 4 * (lane >> 4));
#pragma unroll
          for (int j = 0; j < 2; ++j) { const int vt = 2 * (wave & 1) + j; acc[j] = (f32x4_t){0.f, 0.f, 0.f, 0.f};
              acc[j] = MFMA16(frag_tr(VV, CST, 0, 16 * vt, lane), frag_row(SC, CST, 16 * ts, 0, lane), acc[j]);
              if (ts >= 2) acc[j] = MFMA16(frag_tr(VV, CST, 32, 16 * vt, lane), frag_row(SC, CST, 16 * ts, 32, lane), acc[j]);
#pragma unroll
              for (int ks = 0; ks < 2; ++ks) acc[j] = MFMA16(frag_row(SP, CST, 16 * vt, 32 * ks, lane), frag_row(QH, CST, 16 * ts, 32 * ks, lane), acc[j]);
#pragma unroll
              for (int i = 0; i < 4; ++i) ss += acc[j][i] * acc[j][i]; }
          ss += __shfl_xor(ss, 16); ss += __shfl_xor(ss, 32);
          if (lane < 16) ssb[(16 * ts + lane) * 2 + (wave & 1)] = ss;
          __syncthreads();
          const float rstd = rsqrtf((ssb[tl * 2] + ssb[tl * 2 + 1]) * (1.f / 64.f) + EPS);
#pragma unroll
          for (int j = 0; j < 2; ++j) { const int vd = 16 * (2 * (wave & 1) + j) + 4 * (lane >> 4);
              const float g0 = bf2f(gr[j].x & 0xffffu), g1 = bf2f(gr[j].x >> 16), g2 = bf2f(gr[j].y & 0xffffu), g3 = bf2f(gr[j].y >> 16);
              u32x2 w; w.x = cvtpk(acc[j][0] * rstd * siluf_(g0), acc[j][1] * rstd * siluf_(g1)); w.y = cvtpk(acc[j][2] * rstd * siluf_(g2), acc[j][3] * rstd * siluf_(g3));
              *(u32x2*)(Y + (m0 + tl) * DM + 256 + h * 64 + vd) = w; } }
        __syncthreads();
    }
#undef HO_LOAD
}
__device__ __forceinline__ void conv8_regs(const u32x4 (&rows)[4], int spos, LAS const float* cw, float (&o)[8]) {
#pragma unroll
    for (int i = 0; i < 8; ++i) o[i] = 0.f;
#pragma unroll
    for (int j = 0; j < 4; ++j) if (spos - (3 - j) >= 0) { float x[8]; unpack8(rows[j], x);
#pragma unroll
        for (int i = 0; i < 8; ++i) o[i] += cw[j * 512 + i] * x[i]; }
#pragma unroll
    for (int i = 0; i < 8; ++i) o[i] = siluf_(o[i]);
}
__device__ __forceinline__ void ml_gates_regs(const Ctx& c, LAS float* bb, LAS float* igs, float gf, float gi) {
    if (c.tid < 64) { float x = log_sigmoidf_(gf);
#pragma unroll
        for (int off = 1; off < 64; off <<= 1) { const float y = __shfl_up(x, off); if (c.lane >= off) x += y; }
        bb[c.tid] = x; igs[c.tid] = gi; }
}
__device__ __forceinline__ void mlstm_local_units(const Ctx& c, int lo, int hi) {
    LAS unsigned char* KH = c.lds3; LAS unsigned char* VV = KH + 64 * CST; LAS float* bb = (LAS float*)(VV + 64 * VST80); LAS float* igs = bb + 64; LAS const float* cwt = (LAS const float*)(c.lds3 + TAB_OFF) + 256;
    const bf16_t* P = WSP(bf16_t, WS_PACT); const float* GT = WSP(float, WS_GT);
    const int tid = c.tid, lane = c.lane, wave = c.wave, t = tid >> 3, c0 = (tid & 7) * 8;
    u32x4 vr = {}, kr[4] = {}; float gf = 0.f, gi = 0.f;
#define ML_LOAD(u_) do { const int bh_ = (u_) >> 6, ch_ = (u_) & 63, sp_ = ch_ * 64 + t; const size_t mb_ = (size_t)(bh_ >> 2) * SEQ + ch_ * 64, m_ = mb_ + t; const bf16_t* p_ = P + m_ * PW + (bh_ & 3) * 64 + c0; \
        vr = *(const u32x4*)(p_ + PC_MLV); _Pragma("unroll") for (int j_ = 0; j_ < 4; ++j_) if (sp_ - (3 - j_) >= 0) kr[j_] = *(const u32x4*)(p_ + PC_MLK - (size_t)(3 - j_) * PW); \
        if (tid < 64) { gf = GT[(mb_ + tid) * 16 + 8 + (bh_ & 3)]; gi = GT[(mb_ + tid) * 16 + 4 + (bh_ & 3)]; } } while (0)
    if (lo < hi) ML_LOAD(lo);
    for (int u = lo; u < hi; ++u) {
        const int ch = u & 63, h = (u >> 6) & 3;
        ml_gates_regs(c, bb, igs, gf, gi);
        float k[8]; conv8_regs(kr, ch * 64 + t, cwt + 256 + h * 64 + c0, k); const u32x4 vcur = vr;
        if (u + 1 < hi) ML_LOAD(u + 1);
        __syncthreads();
        { const float w = 0.125f * __expf(bb[63] - bb[t] + igs[t]);
#pragma unroll
          for (int i = 0; i < 8; ++i) k[i] *= w; }
        *(LAS u32x4*)(KH + t * CST + c0 * 2) = pack8(k); *(LAS u32x4*)(VV + t * VST80 + c0 * 2) = vcur;
        if ((tid & 7) < 2) *(LAS u32x4*)(VV + t * VST80 + 128 + (tid & 7) * 16) = (u32x4){(tid & 7) == 0 ? 0x3f80u : 0u, 0u, 0u, 0u};
        if (tid == 0) WSP(float, WS_MDEC)[u] = __expf(bb[63]);
        __syncthreads();
#pragma unroll
        for (int j = 0; j < 3; ++j) { const int e = wave + 8 * j; if (e < 20) { const int a = e & 3, bt = e >> 2; f32x4_t acc = {0.f, 0.f, 0.f, 0.f};
#pragma unroll
            for (int ks = 0; ks < 2; ++ks) acc = MFMA16(frag_tr(KH, CST, 32 * ks, 16 * a, lane), frag_tr(VV, VST80, 32 * ks, 16 * bt, lane), acc);
            const int vd = 16 * bt + (lane & 15);
            if (vd < 65) *(f32x4_t*)(WSP(float, WS_MSLOC) + ((size_t)u * 65 + vd) * 64 + 16 * a + 4 * (lane >> 4)) = acc; } }
        __syncthreads();
    }
#undef ML_LOAD
}
__device__ __forceinline__ void mlstm_out_units(const Ctx& c, int lo, int hi) {
    LAS unsigned char* QT = c.lds3; LAS unsigned char* KT = QT + 64 * CST; LAS unsigned char* VV = KT + 64 * CST; LAS unsigned char* CP = VV + 64 * VST80; LAS unsigned char* SC = CP + 80 * CST;
    LAS float* bb = (LAS float*)(SC + 64 * CST); LAS float* igs = bb + 64; LAS float* den = igs + 64; LAS float* ssb = den + 64; LAS const float* cwt = (LAS const float*)(c.lds3 + TAB_OFF) + 256;
    const bf16_t* P = WSP(bf16_t, WS_PACT); const bf16_t* SPG = WSP(bf16_t, WS_MSPREV); const float* GT = WSP(float, WS_GT); bf16_t* Y = WSP(bf16_t, WS_XNY);
    const int tid = c.tid, lane = c.lane, wave = c.wave, t = tid >> 3, c0 = (tid & 7) * 8;
    u32x4 vr = {}, cr = {}, cr2 = {}, qrw[4] = {}, kr[4] = {}; float gf = 0.f, gi = 0.f;
#define MO_LOAD(u_) do { const int bh_ = (u_) >> 6, ch_ = (u_) & 63, sp_ = ch_ * 64 + t; const size_t mb_ = (size_t)(bh_ >> 2) * SEQ + ch_ * 64, m_ = mb_ + t; const bf16_t* p_ = P + m_ * PW + (bh_ & 3) * 64 + c0; \
        vr = *(const u32x4*)(p_ + PC_MLV); cr = *(const u32x4*)(SPG + (size_t)(u_) * 80 * 64 + tid * 8); if (tid < 128) cr2 = *(const u32x4*)(SPG + (size_t)(u_) * 80 * 64 + (512 + tid) * 8); \
        _Pragma("unroll") for (int j_ = 0; j_ < 4; ++j_) if (sp_ - (3 - j_) >= 0) { kr[j_] = *(const u32x4*)(p_ + PC_MLK - (size_t)(3 - j_) * PW); qrw[j_] = *(const u32x4*)(p_ + PC_MLQ - (size_t)(3 - j_) * PW); } \
        if (tid < 64) { gf = GT[(mb_ + tid) * 16 + 8 + (bh_ & 3)]; gi = GT[(mb_ + tid) * 16 + 4 + (bh_ & 3)]; } } while (0)
    if (lo < hi) MO_LOAD(lo);
    for (int u = lo; u < hi; ++u) {
        const int bh = u >> 6, ch = u & 63, b = bh >> 2, h = bh & 3; const size_t m0 = (size_t)b * SEQ + ch * 64;
        ml_gates_regs(c, bb, igs, gf, gi);
        float q[8], k[8]; conv8_regs(qrw, ch * 64 + t, cwt + h * 64 + c0, q); conv8_regs(kr, ch * 64 + t, cwt + 256 + h * 64 + c0, k);
        *(LAS u32x4*)(VV + t * VST80 + c0 * 2) = vr;
        *(LAS u32x4*)(CP + (tid >> 3) * CST + (tid & 7) * 16) = cr; if (tid < 128) *(LAS u32x4*)(CP + (64 + (tid >> 3)) * CST + (tid & 7) * 16) = cr2;
        if ((tid & 7) < 2) *(LAS u32x4*)(VV + t * VST80 + 128 + (tid & 7) * 16) = (u32x4){(tid & 7) == 0 ? 0x3f80u : 0u, 0u, 0u, 0u};
        if (u + 1 < hi) MO_LOAD(u + 1);
        __syncthreads();
        { const float eq = __expf(bb[t]), ek = 0.125f * __expf(igs[t] - bb[t]);
#pragma unroll
          for (int i = 0; i < 8; ++i) { q[i] *= eq; k[i] *= ek; } }
        *(LAS u32x4*)(QT + t * CST + c0 * 2) = pack8(q); *(LAS u32x4*)(KT + t * CST + c0 * 2) = pack8(k);
        __syncthreads();
#pragma unroll
        for (int e2 = 0; e2 < 2; ++e2) { const int e = wave + 8 * e2, ti = e >> 2, si = e & 3; f32x4_t acc = {0.f, 0.f, 0.f, 0.f};
            if (si <= ti) {
#pragma unroll
                for (int ks = 0; ks < 2; ++ks) acc = MFMA16(frag_row(KT, CST, 16 * si, 32 * ks, lane), frag_row(QT, CST, 16 * ti, 32 * ks, lane), acc);
                if (si == ti) {
#pragma unroll
                    for (int i = 0; i < 4; ++i) if (4 * (lane >> 4) + i > (lane & 15)) acc[i] = 0.f; } }
            u32x2 w; w.x = cvtpk(acc[0], acc[1]); w.y = cvtpk(acc[2], acc[3]);
            *(LAS u32x2*)(SC + (16 * ti + (lane & 15)) * CST + (16 * si + 4 * (lane >> 4)) * 2) = w; }
        __syncthreads();
        { const int ts = wave >> 1, hf = wave & 1; f32x4_t acc[3]; const int tl = 16 * ts + (lane & 15);
          u32x2 gr[2];
#pragma unroll
          for (int j = 0; j < 2; ++j) gr[j] = *(const u32x2*)(P + (m0 + tl) * PW + PC_MLO + h * 64 + 16 * (2 * hf + j) + 4 * (lane >> 4));
#pragma unroll
          for (int j = 0; j < 3; ++j) { acc[j] = (f32x4_t){0.f, 0.f, 0.f, 0.f}; if (j < 2 || hf == 0) { const int vt = (j == 2) ? 4 : 2 * hf + j;
              acc[j] = MFMA16(frag_tr(VV, VST80, 0, 16 * vt, lane), frag_row(SC, CST, 16 * ts, 0, lane), acc[j]);
              if (ts >= 2) acc[j] = MFMA16(frag_tr(VV, VST80, 32, 16 * vt, lane), frag_row(SC, CST, 16 * ts, 32, lane), acc[j]);
#pragma unroll
              for (int ks = 0; ks < 2; ++ks) acc[j] = MFMA16(frag_row(CP, CST, 16 * vt, 32 * ks, lane), frag_row(QT, CST, 16 * ts, 32 * ks, lane), acc[j]); } }
          if (hf == 0 && lane < 16) den[16 * ts + lane] = acc[2][0];
          __syncthreads();
          const float inv = 1.f / fmaxf(fabsf(den[tl]), 1.f); float ss = 0.f;
#pragma unroll
          for (int j = 0; j < 2; ++j)
#pragma unroll
              for (int i = 0; i < 4; ++i) { acc[j][i] *= inv; ss += acc[j][i] * acc[j][i]; }
          ss += __shfl_xor(ss, 16); ss += __shfl_xor(ss, 32);
          if (lane < 16) ssb[(16 * ts + lane) * 2 + hf] = ss;
          __syncthreads();
          const float rstd = rsqrtf((ssb[tl * 2] + ssb[tl * 2 + 1]) * (1.f / 64.f) + EPS);
#pragma unroll
          for (int j = 0; j < 2; ++j) { const int vd = 16 * (2 * hf + j) + 4 * (lane >> 4);
              const float g0 = bf2f(gr[j].x & 0xffffu), g1 = bf2f(gr[j].x >> 16), g2 = bf2f(gr[j].y & 0xffffu), g3 = bf2f(gr[j].y >> 16);
              u32x2 w; w.x = cvtpk(acc[j][0] * rstd * sigmoidf_(g0), acc[j][1] * rstd * sigmoidf_(g1)); w.y = cvtpk(acc[j][2] * rstd * sigmoidf_(g2), acc[j][3] * rstd * sigmoidf_(g3));
              *(u32x2*)(Y + (m0 + tl) * DM + 768 + h * 64 + vd) = w; } }
        __syncthreads();
    }
#undef MO_LOAD
}
#ifndef BAL_B_EXTRA
#define BAL_B_EXTRA 8
#endif
#ifndef BAL_D_EXTRA
#define BAL_D_EXTRA 8
#endif

__device__ __forceinline__ void ph_E_glu_naive(const Ctx& c, int l) {
    float* g1 = (float*)c.lds;
    bf16_t* wl = (bf16_t*)(g1 + 64 * 256);
    const bf16_t* G1 = WSP(bf16_t, WS_G1); const bf16_t* WT = WSP(bf16_t, WS_WGLU) + (size_t)l * 256 * 256; bf16_t* Y = WSP(bf16_t, WS_XNY);
    const int t = c.tid >> 3, j8 = c.tid & 7;
    for (int u = c.bid; u < MTOK / 64; u += c.G) {
        const size_t m0 = (size_t)u * 64;
        for (int e = c.tid; e < 64 * 32; e += NTHR) { const int r = e >> 5, c8 = (e & 31) * 8; float v[8]; unpack8(*(const u32x4*)(G1 + (m0 + r) * 256 + c8), v);
#pragma unroll
            for (int i = 0; i < 8; ++i) g1[r * 256 + c8 + i] = v[i]; }
        float yv[32]; float ss = 0.f;
#pragma unroll
        for (int hf = 0; hf < 2; ++hf) {
            __syncthreads();
            for (int e = c.tid; e < 128 * 32; e += NTHR) { const int r = e >> 5, c8 = (e & 31) * 8; *(u32x4*)(wl + r * 264 + c8) = *(const u32x4*)(WT + (size_t)(hf * 128 + r) * 256 + c8); }
            __syncthreads();
#pragma unroll
            for (int i = 0; i < 16; ++i) { const int nl = j8 * 16 + i; float a = 0.f;
                for (int k = 0; k < 256; k += 2) { const unsigned w = *(const unsigned*)(wl + nl * 264 + k); a += g1[t * 256 + k] * bf2f(w & 0xffffu) + g1[t * 256 + k + 1] * bf2f(w >> 16); }
                const float g = g1[t * 256 + hf * 128 + nl]; const float y = g * sigmoidf_(a); yv[hf * 16 + i] = y; ss += y * y; }
        }
        ss += __shfl_xor(ss, 1); ss += __shfl_xor(ss, 2); ss += __shfl_xor(ss, 4);
        const float rstd = rsqrtf(ss * (1.f / 256.f) + EPS);
#pragma unroll
        for (int hf = 0; hf < 2; ++hf)
#pragma unroll
            for (int i8 = 0; i8 < 2; ++i8) { float o[8];
#pragma unroll
                for (int i = 0; i < 8; ++i) o[i] = yv[hf * 16 + i8 * 8 + i] * rstd;
                *(u32x4*)(Y + (m0 + t) * DM + hf * 128 + j8 * 16 + i8 * 8) = pack8(o); }
        __syncthreads();
    }
}


__device__ __forceinline__ void ph_E_glu_fast(const Ctx& c, int l) {
    constexpr int GST = 528;
    LAS unsigned char* GT_ = c.lds3; LAS float* ssb = (LAS float*)(GT_ + 64 * GST);
    const bf16_t* G1 = WSP(bf16_t, WS_G1); const bf16_t* WT = WSP(bf16_t, WS_WGLU) + (size_t)l * 256 * 256; bf16_t* Y = WSP(bf16_t, WS_XNY);
    const int tid = c.tid, lane = c.lane, wave = c.wave;
    for (int u = c.bid; u < MTOK / 64; u += c.G) {
        const size_t m0 = (size_t)u * 64;
#pragma unroll
        for (int e = 0; e < 4; ++e) { const int ci = tid + 512 * e, r = ci >> 5, c8 = (ci & 31) * 8; *(LAS u32x4*)(GT_ + r * GST + c8 * 2) = *(const u32x4*)(G1 + (m0 + r) * 256 + c8); }
        __syncthreads();
        f32x4_t acc[2][4];
#pragma unroll
        for (int j = 0; j < 2; ++j)
#pragma unroll
            for (int mt = 0; mt < 4; ++mt) acc[j][mt] = (f32x4_t){0.f, 0.f, 0.f, 0.f};
#pragma unroll 2
        for (int ks = 0; ks < 8; ++ks) { bf16x8 wf[2], gf[4];
#pragma unroll
            for (int j = 0; j < 2; ++j) wf[j] = *(const bf16x8*)(WT + (size_t)(16 * (2 * wave + j) + (lane & 15)) * 256 + 32 * ks + 8 * (lane >> 4));
#pragma unroll
            for (int mt = 0; mt < 4; ++mt) gf[mt] = frag_row(GT_, GST, 16 * mt, 32 * ks, lane);
#pragma unroll
            for (int j = 0; j < 2; ++j)
#pragma unroll
                for (int mt = 0; mt < 4; ++mt) acc[j][mt] = MFMA16(wf[j], gf[mt], acc[j][mt]); }
#pragma unroll
        for (int mt = 0; mt < 4; ++mt) { float ss = 0.f;
#pragma unroll
            for (int j = 0; j < 2; ++j) { const int n = 16 * (2 * wave + j) + 4 * (lane >> 4); const u32x2 gr = *(LAS const u32x2*)(GT_ + (16 * mt + (lane & 15)) * GST + n * 2);
                const float g0 = bf2f(gr.x & 0xffffu), g1 = bf2f(gr.x >> 16), g2 = bf2f(gr.y & 0xffffu), g3 = bf2f(gr.y >> 16);
                acc[j][mt][0] = g0 * sigmoidf_(acc[j][mt][0]); acc[j][mt][1] = g1 * sigmoidf_(acc[j][mt][1]); acc[j][mt][2] = g2 * sigmoidf_(acc[j][mt][2]); acc[j][mt][3] = g3 * sigmoidf_(acc[j][mt][3]);
#pragma unroll
                for (int i = 0; i < 4; ++i) ss += acc[j][mt][i] * acc[j][mt][i]; }
            ss += __shfl_xor(ss, 16); ss += __shfl_xor(ss, 32);
            if (lane < 16) ssb[(16 * mt + lane) * 8 + wave] = ss; }
        __syncthreads();
#pragma unroll
        for (int mt = 0; mt < 4; ++mt) { const int tl = 16 * mt + (lane & 15); float s = 0.f;
#pragma unroll
            for (int w = 0; w < 8; ++w) s += ssb[tl * 8 + w];
            const float rstd = rsqrtf(s * (1.f / 256.f) + EPS);
#pragma unroll
            for (int j = 0; j < 2; ++j) { const int n = 16 * (2 * wave + j) + 4 * (lane >> 4); u32x2 w; w.x = cvtpk(acc[j][mt][0] * rstd, acc[j][mt][1] * rstd); w.y = cvtpk(acc[j][mt][2] * rstd, acc[j][mt][3] * rstd);
                *(u32x2*)(Y + (m0 + tl) * DM + n) = w; } }
        __syncthreads();
    }
}

__device__ __forceinline__ void ph_rowpass(const Ctx& c, const float* hprev, const float* gpost, float* hout, bf16_t* xn) {
    const bf16_t* MX = WSP(bf16_t, WS_MX);
    const int gw = c.bid * 8 + c.wave, NGW = c.G * 8;
    for (int m = gw; m < MTOK; m += NGW) {
        const u32x2* mr = (const u32x2*)(MX + (size_t)m * DM) + c.lane; const f32x4* hr = (const f32x4*)(hprev + (size_t)m * DM) + c.lane; const f32x4* gr = (const f32x4*)gpost + c.lane;
        f32x4 x[4], hv[4]; float s = 0.f;
#pragma unroll
        for (int j = 0; j < 4; ++j) { const u32x2 w = mr[64 * j]; x[j] = (f32x4){bf2f(w.x & 0xffffu), bf2f(w.x >> 16), bf2f(w.y & 0xffffu), bf2f(w.y >> 16)}; hv[j] = hr[64 * j];
            s += (x[j].x * x[j].x + x[j].y * x[j].y) + (x[j].z * x[j].z + x[j].w * x[j].w); }
        const float r1 = rsqrtf(wave_sum(s) * (1.f / DM) + EPS); float s2 = 0.f;
#pragma unroll
        for (int j = 0; j < 4; ++j) { const f32x4 g = gr[64 * j]; hv[j] = hv[j] + x[j] * r1 * g; s2 += (hv[j].x * hv[j].x + hv[j].y * hv[j].y) + (hv[j].z * hv[j].z + hv[j].w * hv[j].w); }
        f32x4* ho = (f32x4*)(hout + (size_t)m * DM) + c.lane;
#pragma unroll
        for (int j = 0; j < 4; ++j) ho[64 * j] = hv[j];
        if (xn) { const float r2 = rsqrtf(wave_sum(s2) * (1.f / DM) + EPS); u32x2* o8 = (u32x2*)(xn + (size_t)m * DM) + c.lane;
#pragma unroll
            for (int j = 0; j < 4; ++j) { u32x2 w; w.x = pk2(hv[j].x * r2, hv[j].y * r2); w.y = pk2(hv[j].z * r2, hv[j].w * r2); o8[64 * j] = w; } }
    }
}


typedef GAS unsigned gu32;
#define XB_TMO      128
#define XB_XCNT(j)  (256  + 64 * (j))
#define XB_XSUB(j)  (1280 + 64 * (j))
#define XB_XGEN(j)  (2304 + 64 * (j))
#define XB_TOP      3328
#define XB_TOPGEN   3392
#define XCD_BAR_WORDS 3456
#define XB_SPIN_CAP (1u << 22)
constexpr int CW_BAR = 4096;
constexpr int MISC_OFF = LDS_BYTES - 512;
__device__ __forceinline__ unsigned xb_ld(unsigned* p)              { return __hip_atomic_load(p, __ATOMIC_RELAXED, __HIP_MEMORY_SCOPE_AGENT); }
__device__ __forceinline__ unsigned xb_add(unsigned* p, unsigned v) { return __hip_atomic_fetch_add(p, v, __ATOMIC_RELAXED, __HIP_MEMORY_SCOPE_AGENT); }
__device__ __forceinline__ unsigned xb_xcc_id() { return (unsigned)__builtin_amdgcn_s_getreg((3 << 11) | 20) & 0xFu; }
#define XB_SPIN(cond, bar) do { unsigned _sp = 0; while (cond) { __builtin_amdgcn_s_sleep(1); \
    if ((++_sp & 255u) == 0u) { if (xb_ld(&(bar)[XB_TMO])) break; if (_sp > XB_SPIN_CAP) { atomicAdd(&(bar)[XB_TMO], 1u); break; } } } } while (0)
struct XcdBarrier { unsigned* bar; unsigned x; volatile LAS unsigned* st; };
__device__ __forceinline__ XcdBarrier xcd_barrier_post(unsigned* bar, volatile LAS unsigned* st) {
    XcdBarrier b; b.bar = bar; b.x = xb_xcc_id(); b.st = st;
    if (threadIdx.x == 0) (void)xb_add(&bar[XB_XCNT(b.x)], 1u);
    return b;
}
__device__ __forceinline__ void xcd_barrier_complete(unsigned* bar, unsigned x, unsigned& nloc, unsigned& nx) {
    const unsigned G = gridDim.x * gridDim.y * gridDim.z;
    unsigned sum, cnt, mine, sp = 0u;
    for (;;) {
        sum = 0u; cnt = 0u; mine = 0u;
#pragma unroll
        for (unsigned j = 0; j < 16; ++j) { const unsigned c = xb_ld(&bar[XB_XCNT(j)]); sum += c; cnt += (c > 0u) ? 1u : 0u; mine = (j == x) ? c : mine; }
        if (sum == G) break;
        __builtin_amdgcn_s_sleep(1);
        if ((++sp & 255u) == 0u) { if (xb_ld(&bar[XB_TMO])) break; if (sp > XB_SPIN_CAP) { atomicAdd(&bar[XB_TMO], 1u); break; } }
    }
    nloc = mine > 0u ? mine : 1u; nx = cnt > 0u ? cnt : 1u;
}
__device__ __forceinline__ void xcd_barrier(const XcdBarrier& b) {
    asm volatile("s_waitcnt vmcnt(0)" ::: "memory");
    __syncthreads();
    if (threadIdx.x == 0) {
        unsigned* bar = b.bar;
        __builtin_amdgcn_s_waitcnt(0);
        unsigned nloc = b.st[0], nx = b.st[1];
        if (nloc == 0u) { xcd_barrier_complete(bar, b.x, nloc, nx); b.st[0] = nloc; b.st[1] = nx; }
        const unsigned old = xb_add(&bar[XB_XSUB(b.x)], 1u);
        const unsigned gen = old / nloc;
        if (old + 1u == (gen + 1u) * nloc) {
            __builtin_amdgcn_fence(__ATOMIC_RELEASE, "agent");
            asm volatile("s_waitcnt vmcnt(0)" ::: "memory");
            const unsigned og = xb_add(&bar[XB_TOP], 1u);
            const unsigned tg = og / nx;
            if (og + 1u == (tg + 1u) * nx) xb_add(&bar[XB_TOPGEN], 1u);
            else XB_SPIN(xb_ld(&bar[XB_TOPGEN]) == tg, bar);
            __builtin_amdgcn_fence(__ATOMIC_ACQUIRE, "agent");
            xb_add(&bar[XB_XGEN(b.x)], 1u);
            asm volatile("s_waitcnt vmcnt(0)" ::: "memory");
        } else {
            XB_SPIN(xb_ld(&bar[XB_XGEN(b.x)]) == gen, bar);
            __builtin_amdgcn_fence(__ATOMIC_ACQUIRE, "agent");
            asm volatile("s_waitcnt vmcnt(0)" ::: "memory");
        }
    }
    __syncthreads();
}

struct Args { const float* in[23]; float* out; unsigned char* ws; int lo, hi; };
constexpr int NPHASE = 1 + 10 * DEPTH;

__global__ void __launch_bounds__(NTHR, 2) hybrid_fwd(Args args) {
    extern __shared__ __attribute__((aligned(16))) unsigned char lds_raw[];
    Ctx c;
#pragma unroll
    for (int i = 0; i < 23; ++i) c.in[i] = args.in[i];
    c.out = args.out; c.ws = args.ws; c.lds = lds_raw; c.lds3 = (LAS unsigned char*)lds_raw; c.tid = threadIdx.x; c.lane = c.tid & 63; c.wave = __builtin_amdgcn_readfirstlane(c.tid >> 6); c.G = gridDim.x; c.bid = blockIdx.x;
    const int lo = args.lo, hi = args.hi;
    volatile LAS unsigned* MISC = (volatile LAS unsigned*)(c.lds3 + MISC_OFF);
    if (c.tid < 128) MISC[c.tid] = 0u;
    __syncthreads();
    XcdBarrier gbar; gbar.bar = (unsigned*)(args.ws + WS_CTL) + CW_BAR; gbar.x = 0; gbar.st = nullptr;
    if (hi - lo > 1) gbar = xcd_barrier_post((unsigned*)(args.ws + WS_CTL) + CW_BAR, MISC + 8);
#define STAMP(k) do { if (TIME_FROM >= 0 && c.bid == 0 && c.tid == 0) { asm volatile("s_waitcnt vmcnt(0)" ::: "memory"); ((volatile LAS unsigned long long*)(MISC + 16))[(k)] = __builtin_amdgcn_s_memrealtime(); } } while (0)
#define SEAM(k) do { if (IN(k) && IN((k) + 1)) xcd_barrier(gbar); STAMP((k) + 1); } while (0)
#define IN(k) (lo <= (k) && (k) < hi)
#define FRESH() do { c.tid = opaque_v((int)threadIdx.x); c.lane = c.tid & 63; } while (0)
    STAMP(0);
    if (IN(0)) { FRESH(); ph_prologue(c); }
    SEAM(0);
    for (int l = 0; l < DEPTH; ++l) {
        const int pb = 1 + 10 * l;
        if (IN(pb + 0)) {
            EpiInProj E{WSP(bf16_t, WS_U2), WSP(bf16_t, WS_PACT), WSP(float, WS_GT), c.in[I_GB] + l * 12};
#if USE_PG8
            { pg8::Gemm g{WSP(bf16_t, WS_XNY), WSP(bf16_t, WS_WIN) + (size_t)l * NIN * DM, DM, DM, DM, (size_t)256 * DM * 2, (size_t)256 * DM * 2};
              pg8::StaticOrder S; S.init(MTOK, NIN, c.G, c.bid); pg8::EpiWrap<EpiInProj, false> W{E};
              pg8::gemm_phase<pg8::EpiWrap<EpiInProj, false>, pg8::StaticOrder, true>(c.lds3, g, S, W); }
#else
            gemm_naive<false>(c, WSP(bf16_t, WS_XNY), DM, WSP(bf16_t, WS_WIN) + (size_t)l * NIN * DM, DM, DM,
                [](int t, int& r0, int& c0, int& b0) -> bool { if (t >= (MTOK / 64) * (NIN / 64)) return false; r0 = 64 * (t / (NIN / 64)); c0 = b0 = 64 * (t % (NIN / 64)); return true; }, E);
#endif
        }
        SEAM(pb + 0);
        if (IN(pb + 1)) {
            FRESH(); ph_B_texpand(c, l); FRESH(); ph_B_kmax(c); FRESH(); ph_B_gatescan(c);
            { EpiXloc E{WSP(float, WS_XLOC)};
#if USE_PG8
              { pg8::Gemm g{WSP(bf16_t, WS_U2), WSP(bf16_t, WS_BM) + (size_t)l * 16 * 128 * 1024, U2LD, 1024, 1024, (size_t)256 * U2LD * 2, (size_t)128 * 1024 * 2};
                pg8::SchedXloc S{c.G, c.bid}; pg8::EpiWrap<EpiXloc, false> W{E};
                pg8::gemm_phase<pg8::EpiWrap<EpiXloc, false>, pg8::SchedXloc, false>(c.lds3, g, S, W); __syncthreads(); }
#else
              gemm_naive<false>(c, WSP(bf16_t, WS_U2), U2LD, WSP(bf16_t, WS_BM) + (size_t)l * 16 * 128 * 1024, 1024, 1024,
                [](int t, int& r0, int& c0, int& b0) -> bool { if (t >= 128 * 2) return false; const int rt = t >> 1, ct = t & 1, g = rt >> 3; r0 = 64 * rt; c0 = 256 * g + 64 * ct; b0 = g * 128 + 64 * ct; return true; }, E);
#endif
            }
            FRESH(); stage_tables(c, l);
            { int ulo, uhi; range_split(c.bid, c.G, 2 * NUNIT, 64, BAL_B_EXTRA, ulo, uhi);
              FRESH(); hgrn_local_units(c, ulo < NUNIT ? ulo : NUNIT, uhi < NUNIT ? uhi : NUNIT);
              FRESH(); mlstm_local_units(c, (ulo > NUNIT ? ulo : NUNIT) - NUNIT, (uhi > NUNIT ? uhi : NUNIT) - NUNIT); }
        }
        SEAM(pb + 1);
        if (IN(pb + 2)) { FRESH(); ph_C_scans(c, l); FRESH();
#if FAST_FOX
            ph_C_fox_fast(c);
#else
            ph_C_fox_naive(c);
#endif
        }
        SEAM(pb + 2);
        if (IN(pb + 3)) {
            { EpiS5Y E{WSP(bf16_t, WS_G1)};
#if USE_PG8
              { pg8::Gemm g{WSP(bf16_t, WS_U2), WSP(bf16_t, WS_TT), U2LD, U2LD, U2LD, (size_t)256 * U2LD * 2, (size_t)256 * U2LD * 2};
                pg8::SchedS5Y S{c.G, c.bid}; pg8::EpiWrap<EpiS5Y, false> W{E};
                pg8::gemm_phase<pg8::EpiWrap<EpiS5Y, false>, pg8::SchedS5Y, false>(c.lds3, g, S, W); __syncthreads(); }
#else
              gemm_naive<false>(c, WSP(bf16_t, WS_U2), U2LD, WSP(bf16_t, WS_TT), U2LD, U2LD,
                [](int t, int& r0, int& c0, int& b0) -> bool { if (t >= 128 * 16) return false; const int rt = t >> 4, ct = t & 15, g = rt >> 3; r0 = 64 * rt; c0 = b0 = g * 1024 + 64 * ct; return true; }, E);
#endif
            }
            FRESH(); stage_tables(c, l);
            { int ulo, uhi; range_split(c.bid, c.G, 2 * NUNIT, 128, BAL_D_EXTRA, ulo, uhi);
              FRESH(); hgrn_out_units(c, ulo < NUNIT ? ulo : NUNIT, uhi < NUNIT ? uhi : NUNIT);
              FRESH(); mlstm_out_units(c, (ulo > NUNIT ? ulo : NUNIT) - NUNIT, (uhi > NUNIT ? uhi : NUNIT) - NUNIT); }
        }
        SEAM(pb + 3);
        if (IN(pb + 4)) { FRESH();
#if FAST_GLU
            ph_E_glu_fast(c, l);
#else
            ph_E_glu_naive(c, l);
#endif
        }
        SEAM(pb + 4);
        if (IN(pb + 5)) {
            EpiPlainBf16 E{WSP(bf16_t, WS_MX), DM};
#if USE_PG8
            { pg8::Gemm g{WSP(bf16_t, WS_XNY), WSP(bf16_t, WS_WOUT) + (size_t)l * DM * DM, DM, DM, DM, (size_t)256 * DM * 2, (size_t)256 * DM * 2};
              pg8::StaticOrder S; S.init(MTOK, DM, c.G, c.bid); pg8::EpiWrap<EpiPlainBf16, false> W{E};
              pg8::gemm_phase<pg8::EpiWrap<EpiPlainBf16, false>, pg8::StaticOrder, true>(c.lds3, g, S, W); }
#else
            gemm_naive<false>(c, WSP(bf16_t, WS_XNY), DM, WSP(bf16_t, WS_WOUT) + (size_t)l * DM * DM, DM, DM,
                [](int t, int& r0, int& c0, int& b0) -> bool { if (t >= (MTOK / 64) * 16) return false; r0 = 64 * (t >> 4); c0 = b0 = 64 * (t & 15); return true; }, E);
#endif
        }
        SEAM(pb + 5);
        if (IN(pb + 6)) { FRESH(); } if (IN(pb + 6)) ph_rowpass(c, l == 0 ? c.in[I_X] : c.out, c.in[I_LNMPOST] + l * DM, c.out, WSP(bf16_t, WS_XNY));
        SEAM(pb + 6);
        if (IN(pb + 7)) {
            EpiSwiGLU E{WSP(bf16_t, WS_PACT)};
#if USE_PG8
            { pg8::Gemm g{WSP(bf16_t, WS_XNY), WSP(bf16_t, WS_WGU) + (size_t)l * NGU * DM, DM, DM, DM, (size_t)256 * DM * 2, (size_t)256 * DM * 2};
              pg8::StaticOrder S; S.init(MTOK, NGU, c.G, c.bid); pg8::EpiWrap<EpiSwiGLU, true> W{E};
              pg8::gemm_phase<pg8::EpiWrap<EpiSwiGLU, true>, pg8::StaticOrder, true>(c.lds3, g, S, W); }
#else
            gemm_naive<true>(c, WSP(bf16_t, WS_XNY), DM, WSP(bf16_t, WS_WGU) + (size_t)l * NGU * DM, DM, DM,
                [](int t, int& r0, int& c0, int& b0) -> bool { if (t >= (MTOK / 64) * (DFF / 64)) return false; r0 = 64 * (t / (DFF / 64)); c0 = 64 * (t % (DFF / 64)); b0 = (c0 >> 7) * 256 + (c0 & 127); return true; }, E);
#endif
        }
        SEAM(pb + 7);
        if (IN(pb + 8)) {
            EpiPlainBf16 E{WSP(bf16_t, WS_MX), DM};
#if USE_PG8
            { pg8::Gemm g{WSP(bf16_t, WS_PACT), WSP(bf16_t, WS_WDN) + (size_t)l * DM * DFF, DFF, DFF, DFF, (size_t)256 * DFF * 2, (size_t)256 * DFF * 2};
              pg8::StaticOrder S; S.init(MTOK, DM, c.G, c.bid); pg8::EpiWrap<EpiPlainBf16, false> W{E};
              pg8::gemm_phase<pg8::EpiWrap<EpiPlainBf16, false>, pg8::StaticOrder, true>(c.lds3, g, S, W); }
#else
            gemm_naive<false>(c, WSP(bf16_t, WS_PACT), DFF, WSP(bf16_t, WS_WDN) + (size_t)l * DM * DFF, DFF, DFF,
                [](int t, int& r0, int& c0, int& b0) -> bool { if (t >= (MTOK / 64) * 16) return false; r0 = 64 * (t >> 4); c0 = b0 = 64 * (t & 15); return true; }, E);
#endif
        }
        SEAM(pb + 8);
        if (IN(pb + 9)) { FRESH(); } if (IN(pb + 9)) ph_rowpass(c, c.out, c.in[I_LNFPOST] + l * DM, c.out, (l + 1 < DEPTH) ? WSP(bf16_t, WS_XNY) : (bf16_t*)nullptr);
        SEAM(pb + 9);
    }
#if TIME_FROM >= 0
    if (c.bid == 0 && c.tid == 0) { __threadfence(); volatile LAS unsigned long long* ts = (volatile LAS unsigned long long*)(MISC + 16);
        const float dt = 1.f + (float)(ts[TIME_TO] - ts[TIME_FROM]) * 1e-3f; atomicAdd(c.out, dt); }
#endif
#undef IN
}

extern "C" void kernel_launch(void* const* d_in, const int* in_sizes, int n_in, void* d_out, int out_size, void* d_ws, size_t ws_size, hipStream_t stream) {
    static int grid = 0;
    if (grid == 0) {
        if (n_in != 23 || in_sizes[0] != MTOK * DM || out_size != MTOK * DM || ws_size < WS_END) {
            fprintf(stderr, "kernel_launch: unexpected shapes (n_in %d, in0 %d, out %d, ws %zu, need ws %zu); nothing launched\n", n_in, n_in > 0 ? in_sizes[0] : -1, out_size, ws_size, (size_t)WS_END); grid = -1; return; }
        int dev = 0, cus = 0;
        if (hipGetDevice(&dev) != hipSuccess || hipDeviceGetAttribute(&cus, hipDeviceAttributeMultiprocessorCount, dev) != hipSuccess) { grid = -1; return; }
        if (hipFuncSetAttribute((const void*)hybrid_fwd, hipFuncAttributeMaxDynamicSharedMemorySize, LDS_BYTES) != hipSuccess) { fprintf(stderr, "kernel_launch: hipFuncSetAttribute failed\n"); grid = -1; return; }
        grid = cus;
    }
    if (grid < 0) return;
    (void)hipMemsetAsync((char*)d_ws + WS_CTL, 0, CTL_BYTES, stream);
    Args a{};
    for (int i = 0; i < 23; ++i) a.in[i] = (const float*)d_in[i];
    a.out = (float*)d_out; a.ws = (unsigned char*)d_ws;
#if N_LAUNCH_MODE == 1
    a.lo = 0; a.hi = NPHASE; hipLaunchKernelGGL(hybrid_fwd, dim3(grid), dim3(NTHR), LDS_BYTES, stream, a);
#else
    for (int p = 0; p < NPHASE; ++p) { a.lo = p; a.hi = p + 1; hipLaunchKernelGGL(hybrid_fwd, dim3(grid), dim3(NTHR), LDS_BYTES, stream, a); }
#endif
}
```
